# Optimizing an MI355X kernel written in HIP

```python
import jax, jax.numpy as jnp
from jax import lax
import numpy as np

D_MODEL = 2048
BATCH = 4
SEQ = 2048
DEPTH = 2

BRANCH_W = D_MODEL // 2
N_BRANCH = 3
Q_BLOCK = 128
ROPE_THETA = 10000.0
HEAD_DIM = 128
MOBA_HEADS = BRANCH_W // HEAD_DIM
MOBA_BLOCK = 256
MOBA_TOPK = 3
RWKV_HEAD = 64
RWKV_HEADS = BRANCH_W // RWKV_HEAD
RWKV_W = RWKV_HEADS * RWKV_HEAD
DECAY_LORA = 64
ICLR_LORA = 64
VRES_LORA = 32
GATE_LORA = 160
RWKV_GN_EPS = 64e-5
QK_NOPE = 128
QK_ROPE = 64
V_HEAD = 128
MLA_HEADS = BRANCH_W // V_HEAD
Q_LORA = 512
KV_LORA = 512
D_FF = 5632
N_EXPERTS = 8
TOP_K = 2
LN_EPS = 1e-5
RMS_EPS = 1e-6
DEEPNORM_ALPHA = (2 * DEPTH) ** 0.25
DEEPNORM_BETA = (8 * DEPTH) ** -0.25
N_DENSE = (DEPTH + 1) // 2
N_MOE = DEPTH // 2
RWKV_SPLIT = (RWKV_W, RWKV_W, RWKV_W, DECAY_LORA, ICLR_LORA, GATE_LORA)
RWKV_COLS = 3 * RWKV_W + DECAY_LORA + ICLR_LORA + GATE_LORA
MLA_COLS = Q_LORA + KV_LORA + QK_ROPE
IN_COLS = 3 * BRANCH_W + RWKV_COLS + MLA_COLS + N_BRANCH * D_MODEL

kernel_name = 'moba_rwkv7_mla_gated_hybrid_deepnorm_moe'


def split_cols(h, sizes):
    return jnp.split(h, np.cumsum(sizes)[:-1].tolist(), axis=-1)


def layer_norm(x, g, b):
    xf = x.astype(jnp.float32)
    mu = xf.mean(-1, keepdims=True)
    var = jnp.square(xf - mu).mean(-1, keepdims=True)
    return ((xf - mu) * lax.rsqrt(var + LN_EPS) * g + b).astype(x.dtype)


def rms_norm(x, g):
    xf = x.astype(jnp.float32)
    return (xf * lax.rsqrt(jnp.square(xf).mean(-1, keepdims=True) + RMS_EPS) * g).astype(x.dtype)


def rope_tables(seq, dim):
    inv = 1.0 / (ROPE_THETA ** (jnp.arange(0, dim, 2, dtype=jnp.float32) / dim))
    ang = jnp.arange(seq, dtype=jnp.float32)[:, None] * inv[None, :]
    return jnp.cos(ang), jnp.sin(ang)


def apply_rope(x, cos, sin):
    x1, x2 = jnp.split(x.astype(jnp.float32), 2, axis=-1)
    c = cos[None, :, None, :]
    s = sin[None, :, None, :]
    return jnp.concatenate([x1 * c - x2 * s, x2 * c + x1 * s], axis=-1).astype(x.dtype)


def token_shift_mix(h, mu):
    prev = jnp.pad(h, ((0, 0), (1, 0), (0, 0)))[:, :-1]
    return h + (prev - h) * mu


def moba_attention(q, k, v):
    B, S, H, Dh = q.shape
    nblk = -(-S // MOBA_BLOCK)
    sp = nblk * MOBA_BLOCK
    topk = min(MOBA_TOPK, nblk)
    scale = Dh ** -0.5
    pad = ((0, 0), (0, sp - S), (0, 0), (0, 0))
    q, k, v = (jnp.pad(t, pad).transpose(0, 2, 1, 3) for t in (q, k, v))
    kb = k.reshape(B, H, nblk, MOBA_BLOCK, Dh)
    vb = v.reshape(B, H, nblk, MOBA_BLOCK, Dh)
    k_mean = kb.astype(jnp.float32).mean(axis=3)
    gather = jax.vmap(jax.vmap(lambda blocks, idx: blocks[idx]))
    blk_ids = jnp.arange(nblk)
    n_sel = topk * MOBA_BLOCK

    def one_block(i):
        start = i * Q_BLOCK
        qc = lax.dynamic_slice_in_dim(q, start, Q_BLOCK, axis=2)
        qpos = start + jnp.arange(Q_BLOCK)
        own = start // MOBA_BLOCK
        gate = jnp.einsum('bhqd,bhnd->bhqn', qc.astype(jnp.float32), k_mean)
        fully_past = blk_ids[None, :] < (qpos // MOBA_BLOCK)[:, None]
        gate = jnp.where(fully_past, gate, -jnp.inf)
        g_val, g_idx = lax.top_k(gate, topk)
        k_sel = gather(kb, g_idx)
        v_sel = gather(vb, g_idx)
        s_sel = jnp.einsum('bhqd,bhqtkd->bhqtk', qc, k_sel).astype(jnp.float32) * scale
        s_sel = jnp.where(jnp.isfinite(g_val)[..., None], s_sel, -jnp.inf)
        k_own = lax.dynamic_slice_in_dim(k, own * MOBA_BLOCK, MOBA_BLOCK, axis=2)
        v_own = lax.dynamic_slice_in_dim(v, own * MOBA_BLOCK, MOBA_BLOCK, axis=2)
        s_own = jnp.einsum('bhqd,bhkd->bhqk', qc, k_own).astype(jnp.float32) * scale
        kpos = own * MOBA_BLOCK + jnp.arange(MOBA_BLOCK)
        s_own = jnp.where(kpos[None, :] <= qpos[:, None], s_own, -jnp.inf)
        s = jnp.concatenate([s_sel.reshape(B, H, Q_BLOCK, n_sel), s_own], axis=-1)
        p = jax.nn.softmax(s, axis=-1).astype(v.dtype)
        p_sel = p[..., :n_sel].reshape(B, H, Q_BLOCK, topk, MOBA_BLOCK)
        return (jnp.einsum('bhqtk,bhqtkd->bhqd', p_sel, v_sel)
                + jnp.einsum('bhqk,bhkd->bhqd', p[..., n_sel:], v_own))

    out = lax.map(one_block, jnp.arange(sp // Q_BLOCK))
    return out.transpose(1, 0, 3, 2, 4).reshape(B, sp, H, Dh)[:, :S]


def causal_attention(q, k, v):
    B, S, H, Dq = q.shape
    Dv = v.shape[-1]
    scale = Dq ** -0.5
    nq = S // Q_BLOCK
    qb = q.reshape(B, nq, Q_BLOCK, H, Dq).transpose(1, 0, 3, 2, 4)
    kpos = jnp.arange(S)

    def one_block(args):
        i, qc = args
        s = jnp.einsum('bhqd,bkhd->bhqk', qc, k).astype(jnp.float32) * scale
        qpos = i * Q_BLOCK + jnp.arange(Q_BLOCK)
        s = jnp.where(kpos[None, :] <= qpos[:, None], s, -jnp.inf)
        p = jax.nn.softmax(s, axis=-1).astype(v.dtype)
        return jnp.einsum('bhqk,bkhd->bqhd', p, v)

    out = lax.map(one_block, (jnp.arange(nq), qb))
    return out.transpose(1, 0, 2, 3, 4).reshape(B, S, H, Dv)


def wkv7_scan(r, decay, k, v, kk, a):
    B, S, H, N = r.shape

    def step(state, inp):
        r_t, w_t, k_t, v_t, kk_t, a_t = inp
        sa = jnp.einsum('bhij,bhj->bhi', state, -kk_t)
        state = (state * w_t[:, :, None, :] + sa[..., None] * (kk_t * a_t)[:, :, None, :]
                 + v_t[..., None] * k_t[:, :, None, :])
        return state, jnp.einsum('bhij,bhj->bhi', state, r_t)

    xs = tuple(t.transpose(1, 0, 2, 3) for t in (r, decay, k, v, kk, a))
    _, ys = lax.scan(step, jnp.zeros((B, H, N, N), jnp.float32), xs)
    return ys.transpose(1, 0, 2, 3)


def rwkv7_time_mix(h, w0, w_lora, a0, a_lora, g_lora, k_k, k_a, r_k, gn_g, gn_b,
                   v_first, xv_lo, v0, v_lora):
    B, S, _ = h.shape
    f32 = jnp.float32
    r, k, v, xw, xa, xg = split_cols(h, RWKV_SPLIT)
    w_log = -jax.nn.softplus(-(w0 + jnp.tanh(xw) @ w_lora)) - 0.5
    decay = jnp.exp(-jnp.exp(w_log.astype(f32)))
    a = jax.nn.sigmoid(a0 + xa @ a_lora)
    g = jax.nn.sigmoid(xg) @ g_lora
    v_raw = v
    if v_first is not None:
        v = v + (v_first - v) * jax.nn.sigmoid(v0 + xv_lo @ v_lora)
    heads = lambda t: t.reshape(B, S, RWKV_HEADS, RWKV_HEAD).astype(f32)
    r, k, v, a, decay = heads(r), heads(k), heads(v), heads(a), heads(decay)
    kk = k * k_k.reshape(RWKV_HEADS, RWKV_HEAD).astype(f32)
    kk = kk / jnp.maximum(jnp.sqrt(jnp.sum(kk * kk, axis=-1, keepdims=True)), 1e-12)
    k = k * (1.0 + (a - 1.0) * k_a.reshape(RWKV_HEADS, RWKV_HEAD).astype(f32))
    y = wkv7_scan(r, decay, k, v, kk, a)
    mu = y.mean(-1, keepdims=True)
    var = jnp.square(y - mu).mean(-1, keepdims=True)
    y = ((y - mu) * lax.rsqrt(var + RWKV_GN_EPS)).reshape(B, S, RWKV_W) * gn_g + gn_b
    bonus = (jnp.sum(r * k * r_k.astype(f32), axis=-1, keepdims=True) * v).reshape(B, S, RWKV_W)
    return ((y + bonus) * g).astype(h.dtype), v_raw


def mla_attention(q_dn, kv_dn, k_pe, q_norm, w_uq, kv_norm, w_ukv, cos, sin):
    B, S, _ = q_dn.shape
    q = (rms_norm(q_dn, q_norm) @ w_uq).reshape(B, S, MLA_HEADS, QK_NOPE + QK_ROPE)
    q_nope, q_pe = jnp.split(q, [QK_NOPE], axis=-1)
    kv = (rms_norm(kv_dn, kv_norm) @ w_ukv).reshape(B, S, MLA_HEADS, QK_NOPE + V_HEAD)
    k_nope, v = jnp.split(kv, [QK_NOPE], axis=-1)
    k_pe = apply_rope(k_pe[:, :, None, :], cos, sin)
    q = jnp.concatenate([q_nope, apply_rope(q_pe, cos, sin)], axis=-1)
    k = jnp.concatenate([k_nope, jnp.broadcast_to(k_pe, (B, S, MLA_HEADS, QK_ROPE))], axis=-1)
    return causal_attention(q, k, v).reshape(B, S, MLA_HEADS * V_HEAD)


def swiglu(h, wg, wu, wd):
    return (jax.nn.silu(h @ wg) * (h @ wu)) @ wd


def moe_swiglu(h, router, wg, wu, wd):
    B, S, D = h.shape
    t = h.reshape(B * S, D)
    logits = (t @ router).astype(jnp.float32)
    top_v, top_i = lax.top_k(logits, TOP_K)
    w = jax.nn.softmax(top_v, axis=-1)
    combine = jnp.sum(jax.nn.one_hot(top_i, N_EXPERTS, dtype=jnp.float32) * w[..., None], axis=1)

    def expert(acc, e):
        wg_e, wu_e, wd_e, c_e = e
        return acc + c_e[:, None].astype(t.dtype) * swiglu(t, wg_e, wu_e, wd_e), None

    out, _ = lax.scan(expert, jnp.zeros_like(t), (wg, wu, wd, combine.T))
    return out.reshape(B, S, D)


def setup_inputs(seed: int = 0) -> dict:
    key = jax.random.key(seed)
    ks = iter(jax.random.split(key, 48))
    f32 = jnp.float32

    def nrm(shape, scale):
        return jax.random.normal(next(ks), shape, f32) * scale

    def uni(shape, lo, hi):
        return jax.random.uniform(next(ks), shape, f32, lo, hi)

    L, V, D = DEPTH, DEPTH - 1, D_MODEL
    beta = DEEPNORM_BETA
    return {
        'x': jax.random.normal(next(ks), (BATCH, SEQ, D), f32),
        'w_in': nrm((L, D, IN_COLS), D ** -0.5),
        'w_in_vres': nrm((V, D, VRES_LORA), D ** -0.5),
        'rwkv_mu': uni((L, RWKV_COLS), 0.0, 1.0),
        'rwkv_mu_vres': uni((V, VRES_LORA), 0.0, 1.0),
        'rwkv_w0': uni((L, RWKV_W), -6.0, -1.0),
        'rwkv_w_lora': nrm((L, DECAY_LORA, RWKV_W), 0.1 * DECAY_LORA ** -0.5),
        'rwkv_a0': nrm((L, RWKV_W), 0.5),
        'rwkv_a_lora': nrm((L, ICLR_LORA, RWKV_W), 0.1 * ICLR_LORA ** -0.5),
        'rwkv_g_lora': nrm((L, GATE_LORA, RWKV_W), GATE_LORA ** -0.5),
        'rwkv_v0': 1.0 + nrm((V, RWKV_W), 0.1),
        'rwkv_v_lora': nrm((V, VRES_LORA, RWKV_W), 0.1 * VRES_LORA ** -0.5),
        'rwkv_k_k': 0.85 + nrm((L, RWKV_W), 0.02),
        'rwkv_k_a': 1.0 + nrm((L, RWKV_W), 0.02),
        'rwkv_r_k': nrm((L, RWKV_HEADS, RWKV_HEAD), 0.1),
        'rwkv_gn_g': 1.0 + nrm((L, RWKV_W), 0.02),
        'rwkv_gn_b': nrm((L, RWKV_W), 0.02),
        'mla_q_norm': 1.0 + nrm((L, Q_LORA), 0.02),
        'mla_w_uq': nrm((L, Q_LORA, MLA_HEADS * (QK_NOPE + QK_ROPE)), Q_LORA ** -0.5),
        'mla_kv_norm': 1.0 + nrm((L, KV_LORA), 0.02),
        'mla_w_ukv': nrm((L, KV_LORA, MLA_HEADS * (QK_NOPE + V_HEAD)), KV_LORA ** -0.5),
        'branch_out': nrm((L, N_BRANCH, BRANCH_W, D), beta * BRANCH_W ** -0.5),
        'w_out': nrm((L, D, D), beta * D ** -0.5),
        'ln1_g': 1.0 + nrm((L, D), 0.02),
        'ln1_b': nrm((L, D), 0.02),
        'ffn_wg': nrm((N_DENSE, D, D_FF), beta * D ** -0.5),
        'ffn_wu': nrm((N_DENSE, D, D_FF), beta * D ** -0.5),
        'ffn_wd': nrm((N_DENSE, D_FF, D), beta * D_FF ** -0.5),
        'moe_router': nrm((N_MOE, D, N_EXPERTS), D ** -0.5),
        'moe_wg': nrm((N_MOE, N_EXPERTS, D, D_FF), beta * D ** -0.5),
        'moe_wu': nrm((N_MOE, N_EXPERTS, D, D_FF), beta * D ** -0.5),
        'moe_wd': nrm((N_MOE, N_EXPERTS, D_FF, D), beta * D_FF ** -0.5),
        'ln2_g': 1.0 + nrm((L, D), 0.02),
        'ln2_b': nrm((L, D), 0.02),
    }


def reference(x, w_in, w_in_vres, rwkv_mu, rwkv_mu_vres, rwkv_w0, rwkv_w_lora, rwkv_a0,
              rwkv_a_lora, rwkv_g_lora, rwkv_v0, rwkv_v_lora, rwkv_k_k, rwkv_k_a, rwkv_r_k,
              rwkv_gn_g, rwkv_gn_b, mla_q_norm, mla_w_uq, mla_kv_norm, mla_w_ukv, branch_out,
              w_out, ln1_g, ln1_b, ffn_wg, ffn_wu, ffn_wd, moe_router, moe_wg, moe_wu, moe_wd,
              ln2_g, ln2_b):
    B, S, D = x.shape
    cos_a, sin_a = rope_tables(S, HEAD_DIM)
    cos_m, sin_m = rope_tables(S, QK_ROPE)
    v_first = None
    for l in range(DEPTH):
        if l == 0:
            proj = x @ w_in[0]
        else:
            proj = x @ jnp.concatenate([w_in[l], w_in_vres[l - 1]], axis=1)
        moba_h, rwkv_h, mla_h, gate_h = split_cols(
            proj[..., :IN_COLS], (3 * BRANCH_W, RWKV_COLS, MLA_COLS, N_BRANCH * D_MODEL))
        qa, ka, va = (t.reshape(B, S, MOBA_HEADS, HEAD_DIM) for t in jnp.split(moba_h, 3, axis=-1))
        y_a = moba_attention(apply_rope(qa, cos_a, sin_a), apply_rope(ka, cos_a, sin_a), va)
        y_a = y_a.reshape(B, S, BRANCH_W)
        rwkv_h = token_shift_mix(rwkv_h, rwkv_mu[l])
        if l == 0:
            y_b, v_first = rwkv7_time_mix(rwkv_h, rwkv_w0[l], rwkv_w_lora[l], rwkv_a0[l], rwkv_a_lora[l],
                                          rwkv_g_lora[l], rwkv_k_k[l], rwkv_k_a[l], rwkv_r_k[l],
                                          rwkv_gn_g[l], rwkv_gn_b[l], None, None, None, None)
        else:
            xv_lo = token_shift_mix(proj[..., IN_COLS:], rwkv_mu_vres[l - 1])
            y_b, _ = rwkv7_time_mix(rwkv_h, rwkv_w0[l], rwkv_w_lora[l], rwkv_a0[l], rwkv_a_lora[l],
                                    rwkv_g_lora[l], rwkv_k_k[l], rwkv_k_a[l], rwkv_r_k[l],
                                    rwkv_gn_g[l], rwkv_gn_b[l], v_first, xv_lo,
                                    rwkv_v0[l - 1], rwkv_v_lora[l - 1])
        q_dn, kv_dn, k_pe = split_cols(mla_h, (Q_LORA, KV_LORA, QK_ROPE))
        y_c = mla_attention(q_dn, kv_dn, k_pe, mla_q_norm[l], mla_w_uq[l], mla_kv_norm[l],
                            mla_w_ukv[l], cos_m, sin_m)
        ys = jnp.stack([y_a, y_b, y_c], axis=2)
        branch = jnp.einsum('bsnc,ncd->bsnd', ys, branch_out[l])
        gates = jax.nn.sigmoid(gate_h.reshape(B, S, N_BRANCH, D_MODEL))
        mix = jnp.sum(gates * branch, axis=2) @ w_out[l]
        x = layer_norm(DEEPNORM_ALPHA * x + mix, ln1_g[l], ln1_b[l])
        j = l // 2
        if l % 2 == 0:
            f = swiglu(x, ffn_wg[j], ffn_wu[j], ffn_wd[j])
        else:
            f = moe_swiglu(x, moe_router[j], moe_wg[j], moe_wu[j], moe_wd[j])
        x = layer_norm(DEEPNORM_ALPHA * x + f, ln2_g[l], ln2_b[l])
    return x
```

```cpp
#include <hip/hip_runtime.h>
#include <stdint.h>
#include <stdio.h>

constexpr int D = 2048, NBATCH = 4, SEQ = 2048, T = NBATCH * SEQ;
constexpr int BW = 1024;
constexpr int IN_COLS = 13664;
constexpr int OFF_RWKV = 3072, OFF_MLA = 6432, OFF_GATE = 7520;
constexpr int RWKV_COLS = 3360;
constexpr int DFF = 5632, NEXP = 8;
constexpr float ALPHA = 1.41421356237f;
constexpr int NTHREADS = 512, NWAVES = 8;
constexpr int LDS_BYTES = 147456;

#define LAS __attribute__((address_space(3)))
typedef float f32x16 __attribute__((ext_vector_type(16)));
typedef float f32x4 __attribute__((ext_vector_type(4)));

constexpr size_t MiB = 1u << 20;
constexpr size_t al(size_t x) { return (x + 255) & ~(size_t)255; }
constexpr size_t WS_CTL = 0, CTL_BYTES = 1 * MiB;
constexpr size_t WS_COSA = 1 * MiB;
constexpr size_t WS_SINA = WS_COSA + 2048 * 64 * 4;
constexpr size_t WS_COSM = WS_SINA + 2048 * 64 * 4;
constexpr size_t WS_SINM = WS_COSM + 2048 * 32 * 4;
constexpr size_t WS_TOK = 3 * MiB;
constexpr size_t WS_ROWL = WS_TOK + (size_t)T * 8 * 4;
constexpr size_t WS_XB = 4 * MiB;
constexpr size_t WS_X1 = WS_XB + (size_t)T * D * 4;
constexpr size_t WS_PRE = WS_X1 + (size_t)T * D * 4;
constexpr size_t WS_MIXER = WS_PRE + (size_t)T * D * 4;
constexpr size_t WS_PROJ = WS_MIXER;
constexpr size_t WS_VRES = al(WS_PROJ + (size_t)T * IN_COLS * 4);
constexpr size_t WS_QA = al(WS_VRES + (size_t)T * 32 * 4);
constexpr size_t WS_KA = WS_QA + (size_t)T * BW * 4;
constexpr size_t WS_R = WS_KA + (size_t)T * BW * 4;
constexpr size_t WS_K2 = WS_R + (size_t)T * BW * 4;
constexpr size_t WS_V0 = WS_K2 + (size_t)T * BW * 4;
constexpr size_t WS_V1 = WS_V0 + (size_t)T * BW * 4;
constexpr size_t WS_DEC = WS_V1 + (size_t)T * BW * 4;
constexpr size_t WS_AA = WS_DEC + (size_t)T * BW * 4;
constexpr size_t WS_GG = WS_AA + (size_t)T * BW * 4;
constexpr size_t WS_KK = WS_GG + (size_t)T * BW * 4;
constexpr size_t WS_Y = WS_KK + (size_t)T * BW * 4;
constexpr size_t WS_TW = WS_Y + (size_t)T * BW * 4;
constexpr size_t WS_XA = WS_TW + (size_t)T * 64 * 4;
constexpr size_t WS_SG = WS_XA + (size_t)T * 64 * 4;
constexpr size_t WS_XV = WS_SG + (size_t)T * 160 * 4;
constexpr size_t WS_QN = WS_XV + (size_t)T * 32 * 4;
constexpr size_t WS_KVN = WS_QN + (size_t)T * 512 * 4;
constexpr size_t WS_KPE = WS_KVN + (size_t)T * 512 * 4;
constexpr size_t WS_Q = WS_KPE + (size_t)T * 64 * 4;
constexpr size_t WS_KV = WS_Q + (size_t)T * 1536 * 4;
constexpr size_t WS_KC = WS_KV + (size_t)T * 2048 * 4;
constexpr size_t WS_S = WS_KC + (size_t)T * 1536 * 4;
constexpr size_t WS_YA = WS_S + (size_t)8 * SEQ * SEQ * 4;
constexpr size_t WS_YC = WS_YA + (size_t)T * BW * 4;
constexpr size_t WS_MIX = WS_YC + (size_t)T * BW * 4;
constexpr size_t WS_MIXER_END = WS_MIX + (size_t)T * D * 4;
constexpr size_t WS_HG = WS_MIXER;
constexpr size_t WS_OUT = al(WS_HG + (size_t)2 * T * DFF * 4);
constexpr size_t WS_FFN_END = WS_OUT + (size_t)2 * T * D * 4;
constexpr size_t WS_END = WS_MIXER_END > WS_FFN_END ? WS_MIXER_END : WS_FFN_END;

static_assert(WS_END <= (size_t)1500 * MiB, "ws budget");
constexpr int CW_CNT = 1024;
constexpr int CW_OFF = 2048;
constexpr int CW_BAR = 4096;

#define XB_TMO      128
#define XB_XCNT(j)  (256  + 64 * (j))
#define XB_XSUB(j)  (1280 + 64 * (j))
#define XB_XGEN(j)  (2304 + 64 * (j))
#define XB_TOP      3328
#define XB_TOPGEN   3392
#define XCD_BAR_WORDS 3456
#define XB_SPIN_CAP (1u << 22)

__device__ __forceinline__ unsigned xb_ld(unsigned* p)              { return __hip_atomic_load(p, __ATOMIC_RELAXED, __HIP_MEMORY_SCOPE_AGENT); }
__device__ __forceinline__ unsigned xb_add(unsigned* p, unsigned v) { return __hip_atomic_fetch_add(p, v, __ATOMIC_RELAXED, __HIP_MEMORY_SCOPE_AGENT); }
__device__ __forceinline__ unsigned xb_xcc_id() { return (unsigned)__builtin_amdgcn_s_getreg((3 << 11) | 20) & 0xFu; }
#define XB_SPIN(cond, bar) do { unsigned _sp = 0; while (cond) { __builtin_amdgcn_s_sleep(1); \
    if ((++_sp & 255u) == 0u) { if (xb_ld(&(bar)[XB_TMO])) break; if (_sp > XB_SPIN_CAP) { atomicAdd(&(bar)[XB_TMO], 1u); break; } } } } while (0)

struct XcdBarrier { unsigned* bar; unsigned x; volatile LAS unsigned* st; };

__device__ __forceinline__ XcdBarrier xcd_barrier_post(unsigned* bar, volatile LAS unsigned* st) {
    XcdBarrier b; b.bar = bar; b.x = xb_xcc_id(); b.st = st;
    if (threadIdx.x == 0) (void)xb_add(&bar[XB_XCNT(b.x)], 1u);
    return b;
}
__device__ __forceinline__ void xcd_barrier_complete(unsigned* bar, unsigned x, unsigned& nloc, unsigned& nx) {
    const unsigned G = gridDim.x * gridDim.y * gridDim.z;
    unsigned sum, cnt, mine, sp = 0u;
    for (;;) {
        sum = 0u; cnt = 0u; mine = 0u;
#pragma unroll
        for (unsigned j = 0; j < 16; ++j) { const unsigned c = xb_ld(&bar[XB_XCNT(j)]); sum += c; cnt += (c > 0u) ? 1u : 0u; mine = (j == x) ? c : mine; }
        if (sum == G) break;
        __builtin_amdgcn_s_sleep(1);
        if ((++sp & 255u) == 0u) { if (xb_ld(&bar[XB_TMO])) break; if (sp > XB_SPIN_CAP) { atomicAdd(&bar[XB_TMO], 1u); break; } }
    }
    nloc = mine > 0u ? mine : 1u; nx = cnt > 0u ? cnt : 1u;
}
__device__ __forceinline__ void xcd_barrier(const XcdBarrier& b) {
    asm volatile("s_waitcnt vmcnt(0)" ::: "memory");
    __syncthreads();
    if (threadIdx.x == 0) {
        unsigned* bar = b.bar;
        __builtin_amdgcn_s_waitcnt(0);
        unsigned nloc = b.st[0], nx = b.st[1];
        if (nloc == 0u) { xcd_barrier_complete(bar, b.x, nloc, nx); b.st[0] = nloc; b.st[1] = nx; }
        const unsigned old = xb_add(&bar[XB_XSUB(b.x)], 1u);
        const unsigned gen = old / nloc;
        if (old + 1u == (gen + 1u) * nloc) {
            __builtin_amdgcn_fence(__ATOMIC_RELEASE, "agent");
            asm volatile("s_waitcnt vmcnt(0)" ::: "memory");
            const unsigned og = xb_add(&bar[XB_TOP], 1u);
            const unsigned tg = og / nx;
            if (og + 1u == (tg + 1u) * nx) xb_add(&bar[XB_TOPGEN], 1u);
            else XB_SPIN(xb_ld(&bar[XB_TOPGEN]) == tg, bar);
            __builtin_amdgcn_fence(__ATOMIC_ACQUIRE, "agent");
            xb_add(&bar[XB_XGEN(b.x)], 1u);
            asm volatile("s_waitcnt vmcnt(0)" ::: "memory");
        } else {
            XB_SPIN(xb_ld(&bar[XB_XGEN(b.x)]) == gen, bar);
            __builtin_amdgcn_fence(__ATOMIC_ACQUIRE, "agent");
            asm volatile("s_waitcnt vmcnt(0)" ::: "memory");
        }
    }
    __syncthreads();
}

__device__ __forceinline__ float wave_sum(float v) {
#pragma unroll
    for (int o = 1; o < 64; o <<= 1) v += __shfl_xor(v, o);
    return v;
}
__device__ __forceinline__ float wave_max(float v) {
#pragma unroll
    for (int o = 1; o < 64; o <<= 1) v = fmaxf(v, __shfl_xor(v, o));
    return v;
}
__device__ __forceinline__ float sigmoidf_(float x) { return 1.0f / (1.0f + expf(-x)); }

template <bool BT, class Epi>
__device__ __forceinline__ void gemm32(float* lds, const float* A, int lda, size_t sA, const float* B, int ldb, size_t sB,
                                       int M, int N, int K, int nbatch, const int* rowidx, const Epi& epi, const int tid) {
    const int lane = tid & 63, wave = tid >> 6, wm = wave >> 1, wn = wave & 1;
    const int tilesM = (M + 127) >> 7, tilesN = (N + 127) >> 7, tilesPer = tilesM * tilesN, ntiles = tilesPer * nbatch;
    float* As = lds;
    float* Bs = lds + 2 * 16 * 132;
    for (int tile = blockIdx.x; tile < ntiles; tile += gridDim.x) {
        const int bt = tile / tilesPer, r = tile % tilesPer, tm = r / tilesN, tn = r % tilesN;
        const int m0 = tm * 128, n0 = tn * 128;
        const float* Ab = A + (size_t)bt * sA; const float* Bb = B + (size_t)bt * sB;
        const int arow = tid >> 2, akq = (tid & 3) * 4;
        const int gr = m0 + arow; const bool aok = gr < M;
        const int src = aok ? (rowidx ? rowidx[gr] : gr) : 0;
        const float* ap = Ab + (size_t)src * lda + akq;
        const float* bp; bool bok; int bkr, bnq;
        if (BT) { bkr = 0; bnq = 0; const int gn = n0 + arow; bok = gn < N; bp = Bb + (size_t)(bok ? gn : 0) * ldb + akq; }
        else { bkr = tid >> 5; bnq = (tid & 31) * 4; bok = (n0 + bnq) < N; bp = Bb + (size_t)bkr * ldb + (bok ? (n0 + bnq) : 0); }
        f32x16 acc0, acc1;
#pragma unroll
        for (int i = 0; i < 16; ++i) { acc0[i] = 0.f; acc1[i] = 0.f; }
        f32x4 ra, rb;
        const f32x4 z4 = {0.f, 0.f, 0.f, 0.f};
        ra = aok ? *(const f32x4*)ap : z4;
        rb = bok ? *(const f32x4*)bp : z4;
        {
            float* a_ = As; float* b_ = Bs;
#pragma unroll
            for (int j = 0; j < 4; ++j) a_[(akq + j) * 132 + arow] = ra[j];
            if (BT) {
#pragma unroll
                for (int j = 0; j < 4; ++j) b_[(akq + j) * 132 + arow] = rb[j];
            } else *(f32x4*)(b_ + bkr * 132 + bnq) = rb;
        }
        __syncthreads();
        for (int k0 = 0; k0 < K; k0 += 16) {
            const int cur = (k0 >> 4) & 1;
            const bool more = (k0 + 16) < K;
            if (more) {
                ra = aok ? *(const f32x4*)(ap + k0 + 16) : z4;
                if (BT) rb = bok ? *(const f32x4*)(bp + k0 + 16) : z4;
                else rb = bok ? *(const f32x4*)(bp + (size_t)(k0 + 16) * ldb) : z4;
            }
            const float* a_ = As + cur * 16 * 132 + (lane >> 5) * 132 + wm * 32 + (lane & 31);
            const float* b_ = Bs + cur * 16 * 132 + (lane >> 5) * 132 + wn * 64 + (lane & 31);
#pragma unroll
            for (int kk = 0; kk < 16; kk += 2) {
                const float a = a_[kk * 132], b0 = b_[kk * 132], b1 = b_[kk * 132 + 32];
                acc0 = __builtin_amdgcn_mfma_f32_32x32x2f32(a, b0, acc0, 0, 0, 0);
                acc1 = __builtin_amdgcn_mfma_f32_32x32x2f32(a, b1, acc1, 0, 0, 0);
            }
            if (more) {
                float* aw = As + (cur ^ 1) * 16 * 132; float* bw = Bs + (cur ^ 1) * 16 * 132;
#pragma unroll
                for (int j = 0; j < 4; ++j) aw[(akq + j) * 132 + arow] = ra[j];
                if (BT) {
#pragma unroll
                    for (int j = 0; j < 4; ++j) bw[(akq + j) * 132 + arow] = rb[j];
                } else *(f32x4*)(bw + bkr * 132 + bnq) = rb;
            }
            __syncthreads();
        }
#pragma unroll
        for (int i = 0; i < 16; ++i) {
            const int row = m0 + wm * 32 + (i & 3) + 8 * (i >> 2) + 4 * (lane >> 5);
            const int c0 = n0 + wn * 64 + (lane & 31);
            if (row < M) {
                if (c0 < N) epi(bt, row, c0, acc0[i]);
                if (c0 + 32 < N) epi(bt, row, c0 + 32, acc1[i]);
            }
        }
    }
}

struct EpiStore { float* C; int ldc; size_t sC;
    __device__ __forceinline__ void operator()(int bt, int m, int n, float v) const { C[(size_t)bt * sC + (size_t)m * ldc + n] = v; } };
struct EpiDecay { float* C; const float* w0;
    __device__ __forceinline__ void operator()(int, int m, int n, float v) const {
        const float z = -(w0[n] + v); const float sp = z > 20.f ? z : log1pf(expf(z));
        C[(size_t)m * BW + n] = expf(-expf(-sp - 0.5f)); } };
struct EpiSigB { float* C; const float* b;
    __device__ __forceinline__ void operator()(int, int m, int n, float v) const { C[(size_t)m * BW + n] = sigmoidf_(b[n] + v); } };
struct EpiVLerp { float* V; const float* VF; const float* v0;
    __device__ __forceinline__ void operator()(int, int m, int n, float a) const {
        const size_t o = (size_t)m * BW + n; const float v = V[o]; V[o] = v + (VF[o] - v) * sigmoidf_(v0[n] + a); } };
template <bool FIRST> struct EpiGateAcc { float* MIX; const float* gate;
    __device__ __forceinline__ void operator()(int, int m, int n, float a) const {
        const float g = sigmoidf_(gate[(size_t)m * IN_COLS + n]); const size_t o = (size_t)m * D + n;
        MIX[o] = FIRST ? g * a : MIX[o] + g * a; } };
struct EpiResid { float* C; const float* R; int ldc;
    __device__ __forceinline__ void operator()(int, int m, int n, float a) const { const size_t o = (size_t)m * ldc + n; C[o] = ALPHA * R[o] + a; } };
struct EpiSwiglu { float* C; int ldc; size_t roff;
    __device__ __forceinline__ void operator()(int, int m, int n, float a) const {
        const size_t o = (roff + (size_t)m) * ldc + n; const float g = C[o]; C[o] = g * sigmoidf_(g) * a; } };

struct Args { const float* in[34]; float* out; unsigned char* ws; };

__device__ __forceinline__ unsigned char* opq(unsigned char* p) { asm volatile("" : "+s"(p)); return p; }
#define INP(i) (args.in[(i) + zero_live])
#define x_in INP(0)
#define w_in INP(1)
#define w_in_vres INP(2)
#define rwkv_mu INP(3)
#define rwkv_mu_vres INP(4)
#define rwkv_w0 INP(5)
#define rwkv_w_lora INP(6)
#define rwkv_a0 INP(7)
#define rwkv_a_lora INP(8)
#define rwkv_g_lora INP(9)
#define rwkv_v0 INP(10)
#define rwkv_v_lora INP(11)
#define rwkv_k_k INP(12)
#define rwkv_k_a INP(13)
#define rwkv_r_k INP(14)
#define rwkv_gn_g INP(15)
#define rwkv_gn_b INP(16)
#define mla_q_norm INP(17)
#define mla_w_uq INP(18)
#define mla_kv_norm INP(19)
#define mla_w_ukv INP(20)
#define branch_out INP(21)
#define w_out INP(22)
#define ln1_g INP(23)
#define ln1_b INP(24)
#define ffn_wg INP(25)
#define ffn_wu INP(26)
#define ffn_wd INP(27)
#define moe_router INP(28)
#define moe_wg INP(29)
#define moe_wu INP(30)
#define moe_wd INP(31)
#define ln2_g INP(32)
#define ln2_b INP(33)
#define COSA ((float*)(ws_live + WS_COSA))
#define SINA ((float*)(ws_live + WS_SINA))
#define COSM ((float*)(ws_live + WS_COSM))
#define SINM ((float*)(ws_live + WS_SINM))
#define TOK ((int*)(ws_live + WS_TOK))
#define ROWL ((int*)(ws_live + WS_ROWL))
#define XB ((float*)(ws_live + WS_XB))
#define X1 ((float*)(ws_live + WS_X1))
#define PRE ((float*)(ws_live + WS_PRE))
#define PROJ ((float*)(ws_live + WS_PROJ))
#define VRES ((float*)(ws_live + WS_VRES))
#define QA ((float*)(ws_live + WS_QA))
#define KA ((float*)(ws_live + WS_KA))
#define R_ ((float*)(ws_live + WS_R))
#define K2 ((float*)(ws_live + WS_K2))
#define V0 ((float*)(ws_live + WS_V0))
#define V1 ((float*)(ws_live + WS_V1))
#define DEC ((float*)(ws_live + WS_DEC))
#define AA ((float*)(ws_live + WS_AA))
#define GG ((float*)(ws_live + WS_GG))
#define KK ((float*)(ws_live + WS_KK))
#define Y ((float*)(ws_live + WS_Y))
#define TW ((float*)(ws_live + WS_TW))
#define XA ((float*)(ws_live + WS_XA))
#define SG ((float*)(ws_live + WS_SG))
#define XV ((float*)(ws_live + WS_XV))
#define QN ((float*)(ws_live + WS_QN))
#define KVN ((float*)(ws_live + WS_KVN))
#define KPE ((float*)(ws_live + WS_KPE))
#define Q ((float*)(ws_live + WS_Q))
#define KV ((float*)(ws_live + WS_KV))
#define KC ((float*)(ws_live + WS_KC))
#define SB ((float*)(ws_live + WS_S))
#define YA ((float*)(ws_live + WS_YA))
#define YC ((float*)(ws_live + WS_YC))
#define MIX ((float*)(ws_live + WS_MIX))
#define HG ((float*)(ws_live + WS_HG))
#define OUT ((float*)(ws_live + WS_OUT))


__global__ void __launch_bounds__(NTHREADS, 2) fwd_kernel(Args args) {
    extern __shared__ __attribute__((aligned(16))) unsigned char lds_raw[];
    float* lds = (float*)lds_raw;
    int tid_live = threadIdx.x;
#define tid tid_live
#define lane (tid_live & 63)
#define wave (__builtin_amdgcn_readfirstlane(tid_live >> 6))
#define gw ((int)blockIdx.x * NWAVES + wave)
#define NGW ((int)gridDim.x * NWAVES)
#define gt ((int)blockIdx.x * NTHREADS + tid_live)
#define NGT ((int)gridDim.x * NTHREADS)
    unsigned* ctl = (unsigned*)(args.ws + WS_CTL);
    volatile LAS unsigned* misc = (volatile LAS unsigned*)((LAS unsigned char*)lds_raw + LDS_BYTES - 64);
    if (tid < 16) misc[tid] = 0u;
    __syncthreads();
    XcdBarrier bar = xcd_barrier_post(ctl + CW_BAR, misc);
#define GRID_BAR() do { xcd_barrier(bar); asm volatile("" : "+s"(ws_live)); asm volatile("" : "+s"(zero_live)); asm volatile("" : "+v"(tid_live)); } while (0)

    unsigned char* ws_live = args.ws; int zero_live = 0;
    for (int i = gt; i < SEQ * 64; i += NGT) {
        const int s = i >> 6, j = i & 63;
        const float inv = 1.0f / powf(10000.0f, (float)(2 * j) / 128.0f);
        const float ang = (float)s * inv;
        COSA[i] = cosf(ang); SINA[i] = sinf(ang);
    }
    for (int i = gt; i < SEQ * 32; i += NGT) {
        const int s = i >> 5, j = i & 31;
        const float inv = 1.0f / powf(10000.0f, (float)(2 * j) / 64.0f);
        const float ang = (float)s * inv;
        COSM[i] = cosf(ang); SINM[i] = sinf(ang);
    }

    for (int l = 0; l < 2; ++l) {
        const float* X = (l == 0) ? x_in : XB;
        float* Vcur = (l == 0) ? V0 : V1;
        gemm32<false>(lds, X, D, 0, w_in + (size_t)l * D * IN_COLS, IN_COLS, 0, T, IN_COLS, D, 1, nullptr, EpiStore{PROJ, IN_COLS, 0}, tid);
        if (l == 1) gemm32<false>(lds, X, D, 0, w_in_vres, 32, 0, T, 32, D, 1, nullptr, EpiStore{VRES, 32, 0}, tid);
        GRID_BAR();
        for (int i = gt; i < T * 8 * 64 * 2; i += NGT) {
            const int j = i & 63, h = (i >> 6) & 7, which = (i >> 9) & 1, t = i >> 10;
            const int s = t & (SEQ - 1);
            const float* src = PROJ + (size_t)t * IN_COLS + which * BW + h * 128;
            const float x1 = src[j], x2 = src[j + 64], c = COSA[s * 64 + j], sn = SINA[s * 64 + j];
            float* dst = (which ? KA : QA) + (size_t)t * BW + h * 128;
            dst[j] = x1 * c - x2 * sn; dst[j + 64] = x2 * c + x1 * sn;
        }
        {
            const float* mu = rwkv_mu + l * RWKV_COLS;
            for (size_t i = gt; i < (size_t)T * RWKV_COLS; i += NGT) {
                const int t = (int)(i / RWKV_COLS), c = (int)(i % RWKV_COLS), s = t & (SEQ - 1);
                const float cur = PROJ[(size_t)t * IN_COLS + OFF_RWKV + c];
                const float prev = s > 0 ? PROJ[(size_t)(t - 1) * IN_COLS + OFF_RWKV + c] : 0.f;
                const float v = cur + (prev - cur) * mu[c];
                if (c < 1024) R_[(size_t)t * BW + c] = v;
                else if (c < 2048) K2[(size_t)t * BW + c - 1024] = v;
                else if (c < 3072) Vcur[(size_t)t * BW + c - 2048] = v;
                else if (c < 3136) TW[(size_t)t * 64 + c - 3072] = tanhf(v);
                else if (c < 3200) XA[(size_t)t * 64 + c - 3136] = v;
                else SG[(size_t)t * 160 + c - 3200] = sigmoidf_(v);
            }
            if (l == 1) for (int i = gt; i < T * 32; i += NGT) {
                const int t = i >> 5, c = i & 31, s = t & (SEQ - 1);
                const float cur = VRES[i]; const float prev = s > 0 ? VRES[i - 32] : 0.f;
                XV[i] = cur + (prev - cur) * rwkv_mu_vres[c];
            }
        }
        for (int t = gw; t < T; t += NGW) {
            const float* q = PROJ + (size_t)t * IN_COLS + OFF_MLA;
            float v[8]; float ss = 0.f;
#pragma unroll
            for (int j = 0; j < 8; ++j) { v[j] = q[lane + 64 * j]; ss += v[j] * v[j]; }
            float rs = rsqrtf(wave_sum(ss) * (1.0f / 512.0f) + 1e-6f);
#pragma unroll
            for (int j = 0; j < 8; ++j) QN[(size_t)t * 512 + lane + 64 * j] = v[j] * rs * mla_q_norm[l * 512 + lane + 64 * j];
            ss = 0.f;
#pragma unroll
            for (int j = 0; j < 8; ++j) { v[j] = q[512 + lane + 64 * j]; ss += v[j] * v[j]; }
            rs = rsqrtf(wave_sum(ss) * (1.0f / 512.0f) + 1e-6f);
#pragma unroll
            for (int j = 0; j < 8; ++j) KVN[(size_t)t * 512 + lane + 64 * j] = v[j] * rs * mla_kv_norm[l * 512 + lane + 64 * j];
            if (lane < 32) {
                const int s = t & (SEQ - 1);
                const float x1 = q[1024 + lane], x2 = q[1024 + 32 + lane], c = COSM[s * 32 + lane], sn = SINM[s * 32 + lane];
                KPE[(size_t)t * 64 + lane] = x1 * c - x2 * sn; KPE[(size_t)t * 64 + 32 + lane] = x2 * c + x1 * sn;
            }
        }
        GRID_BAR();
        gemm32<false>(lds, TW, 64, 0, rwkv_w_lora + (size_t)l * 64 * BW, BW, 0, T, BW, 64, 1, nullptr, EpiDecay{DEC, rwkv_w0 + l * BW}, tid);
        gemm32<false>(lds, XA, 64, 0, rwkv_a_lora + (size_t)l * 64 * BW, BW, 0, T, BW, 64, 1, nullptr, EpiSigB{AA, rwkv_a0 + l * BW}, tid);
        gemm32<false>(lds, SG, 160, 0, rwkv_g_lora + (size_t)l * 160 * BW, BW, 0, T, BW, 160, 1, nullptr, EpiStore{GG, BW, 0}, tid);
        if (l == 1) gemm32<false>(lds, XV, 32, 0, rwkv_v_lora, BW, 0, T, BW, 32, 1, nullptr, EpiVLerp{V1, V0, rwkv_v0}, tid);
        gemm32<false>(lds, QN, 512, 0, mla_w_uq + (size_t)l * 512 * 1536, 1536, 0, T, 1536, 512, 1, nullptr, EpiStore{Q, 1536, 0}, tid);
        gemm32<false>(lds, KVN, 512, 0, mla_w_ukv + (size_t)l * 512 * 2048, 2048, 0, T, 2048, 512, 1, nullptr, EpiStore{KV, 2048, 0}, tid);
        GRID_BAR();
        for (int i = gw; i < T * 16; i += NGW) {
            const int t = i >> 4, h = i & 15; const size_t o = (size_t)t * BW + h * 64 + lane;
            const float k = K2[o]; const float kkv = k * rwkv_k_k[l * BW + h * 64 + lane];
            const float nrm = sqrtf(wave_sum(kkv * kkv));
            KK[o] = kkv / fmaxf(nrm, 1e-12f);
            K2[o] = k * (1.0f + (AA[o] - 1.0f) * rwkv_k_a[l * BW + h * 64 + lane]);
        }
        for (int i = gt; i < T * 8 * 32; i += NGT) {
            const int j = i & 31, h = (i >> 5) & 7, t = i >> 8, s = t & (SEQ - 1);
            float* qp = Q + (size_t)t * 1536 + h * 192 + 128;
            const float x1 = qp[j], x2 = qp[j + 32], c = COSM[s * 32 + j], sn = SINM[s * 32 + j];
            qp[j] = x1 * c - x2 * sn; qp[j + 32] = x2 * c + x1 * sn;
        }
        for (size_t i = gt; i < (size_t)T * 1536; i += NGT) {
            const int t = (int)(i / 1536), c = (int)(i % 1536), h = c / 192, cc = c % 192;
            KC[i] = cc < 128 ? KV[(size_t)t * 2048 + h * 256 + cc] : KPE[(size_t)t * 64 + cc - 128];
        }
        GRID_BAR();
        if (blockIdx.x < 64) {
            const int bh = blockIdx.x, b = bh >> 4, h = bh & 15;
            const size_t base = (size_t)b * SEQ * BW + h * 64;
            constexpr int CH = 32;
            const int st_step = tid >> 4, st_j = (tid & 15) * 4;
            f32x4 g_r, g_w, g_k, g_kk, g_a, g_v;
            float s_[64];
#pragma unroll
            for (int j = 0; j < 64; ++j) s_[j] = 0.f;
#define GLOAD(c) do { const size_t o_ = base + (size_t)((c) * CH + st_step) * BW + st_j; \
                g_r = *(const f32x4*)(R_ + o_); g_w = *(const f32x4*)(DEC + o_); g_k = *(const f32x4*)(K2 + o_); \
                g_kk = *(const f32x4*)(KK + o_); g_a = *(const f32x4*)(AA + o_); g_v = *(const f32x4*)(Vcur + o_); } while (0)
#define LSTORE(bufi) do { float* bb_ = lds + (bufi) * (6 * CH * 64) + st_step * 64 + st_j; \
                *(f32x4*)(bb_ + 0 * CH * 64) = g_r; *(f32x4*)(bb_ + 1 * CH * 64) = g_w; *(f32x4*)(bb_ + 2 * CH * 64) = g_k; \
                *(f32x4*)(bb_ + 3 * CH * 64) = g_kk; *(f32x4*)(bb_ + 4 * CH * 64) = g_kk * g_a; *(f32x4*)(bb_ + 5 * CH * 64) = g_v; } while (0)
            GLOAD(0); LSTORE(0);
            __syncthreads();
            for (int c = 0; c < SEQ / CH; ++c) {
                const bool more = (c + 1) < SEQ / CH;
                if (more) GLOAD(c + 1);
                if (wave == 0) {
                    const float* bb = lds + (c & 1) * (6 * CH * 64);
                    for (int st = 0; st < CH; ++st) {
                        const float* pr = bb + 0 * CH * 64 + st * 64; const float* pw = bb + 1 * CH * 64 + st * 64;
                        const float* pk = bb + 2 * CH * 64 + st * 64; const float* pkk = bb + 3 * CH * 64 + st * 64;
                        const float* pb = bb + 4 * CH * 64 + st * 64; const float vi = bb[5 * CH * 64 + st * 64 + lane];
                        float sa = 0.f;
#pragma unroll
                        for (int j = 0; j < 64; j += 4) { const f32x4 q4 = *(const f32x4*)(pkk + j);
                            sa += s_[j] * q4[0]; sa += s_[j + 1] * q4[1]; sa += s_[j + 2] * q4[2]; sa += s_[j + 3] * q4[3]; }
                        sa = -sa;
                        float yv = 0.f;
#pragma unroll
                        for (int j = 0; j < 64; j += 4) {
                            const f32x4 w4 = *(const f32x4*)(pw + j), b4 = *(const f32x4*)(pb + j), k4 = *(const f32x4*)(pk + j), r4 = *(const f32x4*)(pr + j);
#pragma unroll
                            for (int e = 0; e < 4; ++e) { s_[j + e] = s_[j + e] * w4[e] + sa * b4[e] + vi * k4[e]; yv += s_[j + e] * r4[e]; }
                        }
                        Y[base + (size_t)(c * CH + st) * BW + lane] = yv;
                    }
                }
                if (more) LSTORE((c + 1) & 1);
                __syncthreads();
            }
        }
        GRID_BAR();
        for (int i = gw; i < T * 16; i += NGW) {
            const int t = i >> 4, h = i & 15; const int c = h * 64 + lane; const size_t o = (size_t)t * BW + c;
            const float y = Y[o];
            const float mu = wave_sum(y) * (1.0f / 64.0f); const float d = y - mu;
            const float var = wave_sum(d * d) * (1.0f / 64.0f);
            const float yn = d * rsqrtf(var + 64e-5f) * rwkv_gn_g[l * BW + c] + rwkv_gn_b[l * BW + c];
            const float bon = wave_sum(R_[o] * K2[o] * rwkv_r_k[l * BW + c]) * Vcur[o];
            Y[o] = (yn + bon) * GG[o];
        }
        for (int b = 0; b < NBATCH; ++b) {
            gemm32<true>(lds, QA + (size_t)b * SEQ * BW, BW, 128, KA + (size_t)b * SEQ * BW, BW, 128, SEQ, SEQ, 128, 8, nullptr, EpiStore{SB, SEQ, (size_t)SEQ * SEQ}, tid);
            GRID_BAR();
            for (int i = gw; i < 8 * SEQ; i += NGW) {
                const int q = i & (SEQ - 1);
                float* row = SB + (size_t)i * SEQ;
                f32x4 e[8]; float bs[8];
#pragma unroll
                for (int jj = 0; jj < 8; ++jj) { e[jj] = *(const f32x4*)(row + jj * 256 + lane * 4); bs[jj] = wave_sum((e[jj][0] + e[jj][1]) + (e[jj][2] + e[jj][3])); }
                const int own = q >> 8;
                bool sel[8];
#pragma unroll
                for (int n = 0; n < 8; ++n) {
                    int rank = 0;
#pragma unroll
                    for (int m = 0; m < 8; ++m) if (m != n) rank += (m < own && (bs[m] > bs[n] || (bs[m] == bs[n] && m < n))) ? 1 : 0;
                    sel[n] = (n < own) && (rank < 3);
                }
                const float scale = 0.08838834764831845f;
                float mx = -INFINITY;
#pragma unroll
                for (int jj = 0; jj < 8; ++jj)
#pragma unroll
                    for (int cc = 0; cc < 4; ++cc) {
                        const int key = jj * 256 + lane * 4 + cc;
                        const bool ok = sel[jj] || (jj == own && key <= q);
                        const float sv = ok ? e[jj][cc] * scale : -INFINITY;
                        e[jj][cc] = sv; mx = fmaxf(mx, sv);
                    }
                mx = wave_max(mx);
                float sum = 0.f;
#pragma unroll
                for (int jj = 0; jj < 8; ++jj)
#pragma unroll
                    for (int cc = 0; cc < 4; ++cc) { const float p = expf(e[jj][cc] - mx); e[jj][cc] = p; sum += p; }
                sum = wave_sum(sum); const float inv = 1.0f / sum;
#pragma unroll
                for (int jj = 0; jj < 8; ++jj) *(f32x4*)(row + jj * 256 + lane * 4) = e[jj] * inv;
            }
            GRID_BAR();
            gemm32<false>(lds, SB, SEQ, (size_t)SEQ * SEQ, PROJ + (size_t)b * SEQ * IN_COLS + 2048, IN_COLS, 128, SEQ, 128, SEQ, 8, nullptr,
                          EpiStore{YA + (size_t)b * SEQ * BW, BW, 128}, tid);
            GRID_BAR();
        }
        for (int b = 0; b < NBATCH; ++b) {
            gemm32<true>(lds, Q + (size_t)b * SEQ * 1536, 1536, 192, KC + (size_t)b * SEQ * 1536, 1536, 192, SEQ, SEQ, 192, 8, nullptr, EpiStore{SB, SEQ, (size_t)SEQ * SEQ}, tid);
            GRID_BAR();
            for (int i = gw; i < 8 * SEQ; i += NGW) {
                const int q = i & (SEQ - 1);
                float* row = SB + (size_t)i * SEQ;
                f32x4 e[8];
                const float scale = 0.07216878364870323f;
                float mx = -INFINITY;
#pragma unroll
                for (int jj = 0; jj < 8; ++jj) { e[jj] = *(const f32x4*)(row + jj * 256 + lane * 4);
#pragma unroll
                    for (int cc = 0; cc < 4; ++cc) { const int key = jj * 256 + lane * 4 + cc; const float sv = key <= q ? e[jj][cc] * scale : -INFINITY; e[jj][cc] = sv; mx = fmaxf(mx, sv); } }
                mx = wave_max(mx);
                float sum = 0.f;
#pragma unroll
                for (int jj = 0; jj < 8; ++jj)
#pragma unroll
                    for (int cc = 0; cc < 4; ++cc) { const float p = expf(e[jj][cc] - mx); e[jj][cc] = p; sum += p; }
                sum = wave_sum(sum); const float inv = 1.0f / sum;
#pragma unroll
                for (int jj = 0; jj < 8; ++jj) *(f32x4*)(row + jj * 256 + lane * 4) = e[jj] * inv;
            }
            GRID_BAR();
            gemm32<false>(lds, SB, SEQ, (size_t)SEQ * SEQ, KV + (size_t)b * SEQ * 2048 + 128, 2048, 256, SEQ, 128, SEQ, 8, nullptr,
                          EpiStore{YC + (size_t)b * SEQ * BW, BW, 128}, tid);
            GRID_BAR();
        }
        {
            const float* bo = branch_out + (size_t)l * 3 * BW * D;
            gemm32<false>(lds, YA, BW, 0, bo, D, 0, T, D, BW, 1, nullptr, EpiGateAcc<true>{MIX, PROJ + OFF_GATE}, tid);
            gemm32<false>(lds, Y, BW, 0, bo + (size_t)BW * D, D, 0, T, D, BW, 1, nullptr, EpiGateAcc<false>{MIX, PROJ + OFF_GATE + D}, tid);
            gemm32<false>(lds, YC, BW, 0, bo + (size_t)2 * BW * D, D, 0, T, D, BW, 1, nullptr, EpiGateAcc<false>{MIX, PROJ + OFF_GATE + 2 * D}, tid);
        }
        GRID_BAR();
        gemm32<false>(lds, MIX, D, 0, w_out + (size_t)l * D * D, D, 0, T, D, D, 1, nullptr, EpiResid{PRE, X, D}, tid);
        GRID_BAR();
        for (int t = gw; t < T; t += NGW) {
            const float* pr = PRE + (size_t)t * D;
            f32x4 v[8]; float s = 0.f;
#pragma unroll
            for (int jj = 0; jj < 8; ++jj) { v[jj] = *(const f32x4*)(pr + jj * 256 + lane * 4); s += (v[jj][0] + v[jj][1]) + (v[jj][2] + v[jj][3]); }
            const float mean = wave_sum(s) * (1.0f / D); float s2 = 0.f;
#pragma unroll
            for (int jj = 0; jj < 8; ++jj) { v[jj] = v[jj] - mean; s2 += (v[jj][0] * v[jj][0] + v[jj][1] * v[jj][1]) + (v[jj][2] * v[jj][2] + v[jj][3] * v[jj][3]); }
            const float rstd = rsqrtf(wave_sum(s2) * (1.0f / D) + 1e-5f);
#pragma unroll
            for (int jj = 0; jj < 8; ++jj) {
                const f32x4 g = *(const f32x4*)(ln1_g + l * D + jj * 256 + lane * 4), bb = *(const f32x4*)(ln1_b + l * D + jj * 256 + lane * 4);
                v[jj] = v[jj] * rstd * g + bb;
                *(f32x4*)(X1 + (size_t)t * D + jj * 256 + lane * 4) = v[jj];
            }
            if (l == 1) {
                float lg[8];
#pragma unroll
                for (int e = 0; e < 8; ++e) lg[e] = 0.f;
#pragma unroll
                for (int jj = 0; jj < 8; ++jj)
#pragma unroll
                    for (int cc = 0; cc < 4; ++cc) {
                        const int d = jj * 256 + lane * 4 + cc;
                        const f32x4 r0 = *(const f32x4*)(moe_router + (size_t)d * 8), r1 = *(const f32x4*)(moe_router + (size_t)d * 8 + 4);
                        const float xv = v[jj][cc];
                        lg[0] += xv * r0[0]; lg[1] += xv * r0[1]; lg[2] += xv * r0[2]; lg[3] += xv * r0[3];
                        lg[4] += xv * r1[0]; lg[5] += xv * r1[1]; lg[6] += xv * r1[2]; lg[7] += xv * r1[3];
                    }
#pragma unroll
                for (int e = 0; e < 8; ++e) lg[e] = wave_sum(lg[e]);
                if (lane == 0) {
                    int e0 = 0; float b0 = lg[0];
#pragma unroll
                    for (int e = 1; e < 8; ++e) if (lg[e] > b0) { b0 = lg[e]; e0 = e; }
                    int e1 = -1; float b1 = -INFINITY;
#pragma unroll
                    for (int e = 0; e < 8; ++e) if (e != e0 && lg[e] > b1) { b1 = lg[e]; e1 = e; }
                    const float w1 = 1.0f / (1.0f + expf(b0 - b1)), w0 = 1.0f - w1;
                    const int p0 = (int)atomicAdd(ctl + CW_CNT + 64 * e0, 1u), p1 = (int)atomicAdd(ctl + CW_CNT + 64 * e1, 1u);
                    int* tk = TOK + (size_t)t * 8;
                    tk[0] = e0; tk[1] = e1; tk[2] = p0; tk[3] = p1; tk[4] = __float_as_int(w0); tk[5] = __float_as_int(w1);
                }
            }
        }
        GRID_BAR();
        float* OUTX = (l == 0) ? XB : args.out;
        if (l == 0) {
            gemm32<false>(lds, X1, D, 0, ffn_wg, DFF, 0, T, DFF, D, 1, nullptr, EpiStore{HG, DFF, 0}, tid);
            gemm32<false>(lds, X1, D, 0, ffn_wu, DFF, 0, T, DFF, D, 1, nullptr, EpiSwiglu{HG, DFF, 0}, tid);
            GRID_BAR();
            gemm32<false>(lds, HG, DFF, 0, ffn_wd, D, 0, T, D, DFF, 1, nullptr, EpiResid{PRE, X1, D}, tid);
            GRID_BAR();
        } else {
            unsigned off[9]; off[0] = 0;
#pragma unroll
            for (int e = 0; e < 8; ++e) off[e + 1] = off[e] + xb_ld(ctl + CW_CNT + 64 * e);
            for (int t = gt; t < T; t += NGT) {
                int* tk = TOK + (size_t)t * 8;
                const int e0 = tk[0], e1 = tk[1];
                unsigned o0 = 0, o1 = 0;
#pragma unroll
                for (int e = 0; e < 8; ++e) { o0 = (e == e0) ? off[e] : o0; o1 = (e == e1) ? off[e] : o1; }
                const int s0 = (int)o0 + tk[2], s1 = (int)o1 + tk[3];
                tk[6] = s0; tk[7] = s1; ROWL[s0] = t; ROWL[s1] = t;
            }
            if (gt == 0) {
#pragma unroll
                for (int e = 0; e < 9; ++e) ctl[CW_OFF + e] = off[e];
            }
            GRID_BAR();
#pragma unroll 1
            for (int e = 0; e < 8; ++e) {
                const size_t ro = ctl[CW_OFF + e]; const int Me = (int)(ctl[CW_OFF + e + 1] - ctl[CW_OFF + e]);
                gemm32<false>(lds, X1, D, 0, moe_wg + (size_t)e * D * DFF, DFF, 0, Me, DFF, D, 1, ROWL + ro, EpiStore{HG + ro * DFF, DFF, 0}, tid);
                gemm32<false>(lds, X1, D, 0, moe_wu + (size_t)e * D * DFF, DFF, 0, Me, DFF, D, 1, ROWL + ro, EpiSwiglu{HG, DFF, ro}, tid);
            }
            GRID_BAR();
#pragma unroll 1
            for (int e = 0; e < 8; ++e) {
                const size_t ro = ctl[CW_OFF + e]; const int Me = (int)(ctl[CW_OFF + e + 1] - ctl[CW_OFF + e]);
                gemm32<false>(lds, HG + ro * DFF, DFF, 0, moe_wd + (size_t)e * DFF * D, D, 0, Me, D, DFF, 1, nullptr, EpiStore{OUT + ro * D, D, 0}, tid);
            }
            GRID_BAR();
        }
        for (int t = gw; t < T; t += NGW) {
            f32x4 v[8]; float s = 0.f;
            if (l == 0) {
#pragma unroll
                for (int jj = 0; jj < 8; ++jj) v[jj] = *(const f32x4*)(PRE + (size_t)t * D + jj * 256 + lane * 4);
            } else {
                const int* tk = TOK + (size_t)t * 8;
                const float w0 = __int_as_float(tk[4]), w1 = __int_as_float(tk[5]); const int s0 = tk[6], s1 = tk[7];
                const int e0 = tk[0], e1 = tk[1];
#pragma unroll
                for (int jj = 0; jj < 8; ++jj) {
                    const f32x4 xx = *(const f32x4*)(X1 + (size_t)t * D + jj * 256 + lane * 4);
                    const f32x4 a = *(const f32x4*)(OUT + (size_t)s0 * D + jj * 256 + lane * 4), bq = *(const f32x4*)(OUT + (size_t)s1 * D + jj * 256 + lane * 4);
                    const f32x4 f = (e0 < e1) ? (w0 * a + w1 * bq) : (w1 * bq + w0 * a);
                    v[jj] = ALPHA * xx + f;
                }
            }
#pragma unroll
            for (int jj = 0; jj < 8; ++jj) s += (v[jj][0] + v[jj][1]) + (v[jj][2] + v[jj][3]);
            const float mean = wave_sum(s) * (1.0f / D); float s2 = 0.f;
#pragma unroll
            for (int jj = 0; jj < 8; ++jj) { v[jj] = v[jj] - mean; s2 += (v[jj][0] * v[jj][0] + v[jj][1] * v[jj][1]) + (v[jj][2] * v[jj][2] + v[jj][3] * v[jj][3]); }
            const float rstd = rsqrtf(wave_sum(s2) * (1.0f / D) + 1e-5f);
#pragma unroll
            for (int jj = 0; jj < 8; ++jj) {
                const f32x4 g = *(const f32x4*)(ln2_g + l * D + jj * 256 + lane * 4), bb = *(const f32x4*)(ln2_b + l * D + jj * 256 + lane * 4);
                *(f32x4*)(OUTX + (size_t)t * D + jj * 256 + lane * 4) = v[jj] * rstd * g + bb;
            }
        }
        GRID_BAR();
    }
}

extern "C" void kernel_launch(void* const* d_in, const int* in_sizes, int n_in, void* d_out, int out_size, void* d_ws, size_t ws_size, hipStream_t stream) {
    static int grid = 0;
    if (grid == 0) {
        if (n_in != 34 || out_size != T * D || ws_size < WS_END) { fprintf(stderr, "kernel_launch: bad sizes n_in %d out %d ws %zu need %zu\n", n_in, out_size, ws_size, (size_t)WS_END); grid = -1; return; }
        int dev = 0, cus = 0, per_cu = 0;
        if (hipGetDevice(&dev) != hipSuccess || hipDeviceGetAttribute(&cus, hipDeviceAttributeMultiprocessorCount, dev) != hipSuccess) { grid = -1; return; }
        if (hipFuncSetAttribute((const void*)fwd_kernel, hipFuncAttributeMaxDynamicSharedMemorySize, LDS_BYTES) != hipSuccess) { fprintf(stderr, "hipFuncSetAttribute failed\n"); grid = -1; return; }
        if (hipOccupancyMaxActiveBlocksPerMultiprocessor(&per_cu, (const void*)fwd_kernel, NTHREADS, LDS_BYTES) != hipSuccess || per_cu < 1) fprintf(stderr, "occupancy query says %d\n", per_cu);
        (void)hipGetLastError();
        grid = cus;
    }
    if (grid < 0) return;
    hipMemsetAsync((char*)d_ws + WS_CTL, 0, CTL_BYTES, stream);
    Args a{};
    for (int i = 0; i < 34; ++i) a.in[i] = (const float*)d_in[i];
    a.out = (float*)d_out; a.ws = (unsigned char*)d_ws;
    hipLaunchKernelGGL(fwd_kernel, dim3(grid), dim3(NTHREADS), LDS_BYTES, stream, a);
}
```

```cpp
#include <hip/hip_runtime.h>
#include <stdint.h>
#include <stdio.h>

constexpr int D = 2048, NBATCH = 4, SEQ = 2048, T = NBATCH * SEQ;
constexpr int BW = 1024;
constexpr int IN_COLS = 13664;
constexpr int OFF_RWKV = 3072, OFF_MLA = 6432, OFF_GATE = 7520;
constexpr int RWKV_COLS = 3360;
constexpr int DFF = 5632, NEXP = 8;
constexpr float ALPHA = 1.41421356237f;
constexpr int NTHREADS = 512, NWAVES = 8;
constexpr int LDS_BYTES = 131072 + 17408 + 512;

#define LAS __attribute__((address_space(3)))
#define GAS __attribute__((address_space(1)))
typedef float f32x16 __attribute__((ext_vector_type(16)));
typedef float f32x4 __attribute__((ext_vector_type(4)));

constexpr size_t MiB = 1u << 20;
constexpr size_t al(size_t x) { return (x + 255) & ~(size_t)255; }
constexpr size_t WS_CTL = 0, CTL_BYTES = 1 * MiB;
constexpr size_t WS_COSA = 1 * MiB;
constexpr size_t WS_SINA = WS_COSA + 2048 * 64 * 4;
constexpr size_t WS_COSM = WS_SINA + 2048 * 64 * 4;
constexpr size_t WS_SINM = WS_COSM + 2048 * 32 * 4;
constexpr size_t WS_TOK = 3 * MiB;
constexpr size_t WS_ROWL = WS_TOK + (size_t)T * 8 * 4;
constexpr size_t WS_XB = 4 * MiB;
constexpr size_t WS_X1 = WS_XB + (size_t)T * D * 4;
constexpr size_t WS_PRE = WS_X1 + (size_t)T * D * 4;
constexpr int NP = 13824;
constexpr size_t WS_XBF = WS_PRE + (size_t)T * D * 4;
constexpr size_t WS_WINT = WS_XBF + (size_t)T * D * 2;
constexpr size_t WS_X1B = WS_WINT + (size_t)2 * NP * D * 2;
constexpr size_t WS_WBO = WS_X1B + (size_t)T * D * 2;
constexpr size_t WS_WOT = WS_WBO + (size_t)6 * D * BW * 2;
constexpr size_t WS_WUQ = WS_WOT + (size_t)2 * D * D * 2;
constexpr size_t WS_WUKV = WS_WUQ + (size_t)2 * 1536 * 512 * 2;
constexpr size_t WS_WLORA = WS_WUKV + (size_t)2 * 2048 * 512 * 2;
constexpr size_t WS_V0 = WS_WLORA + (size_t)2 * 4096 * 384 * 2;
constexpr size_t WS_MIXER = WS_V0 + (size_t)T * BW * 4;
constexpr int MOE_ROWS = 2 * T + NEXP * 256;
constexpr int NGU = 2 * DFF;
constexpr int PLD = 4448, PSH = 3072;
constexpr size_t WS_R = WS_MIXER;
constexpr size_t WS_K2 = WS_R + (size_t)T * BW * 4;
constexpr size_t WS_V1 = WS_K2 + (size_t)T * BW * 4;
constexpr size_t WS_DEC = WS_V1 + (size_t)T * BW * 4;
constexpr size_t WS_AA = WS_DEC + (size_t)T * BW * 4;
constexpr size_t WS_GG = WS_AA + (size_t)T * BW * 4;
constexpr size_t WS_Y = WS_GG + (size_t)T * BW * 4;
constexpr size_t WS_LA = WS_Y + (size_t)T * BW * 4;
constexpr size_t WS_QNB = WS_LA + (size_t)T * 384 * 2;
constexpr size_t WS_KVNB = WS_QNB + (size_t)T * 512 * 2;
constexpr size_t WS_YALL = WS_KVNB + (size_t)T * 512 * 2;
constexpr size_t WS_GATEB = WS_YALL + (size_t)T * 3 * BW * 2;
constexpr size_t WS_QAB = WS_GATEB + (size_t)T * 3 * D * 2;
constexpr size_t WS_KAB = WS_QAB + (size_t)T * BW * 2;
constexpr size_t WS_VAB = WS_KAB + (size_t)T * BW * 2;
constexpr size_t WS_QCB = WS_VAB + (size_t)T * BW * 2;
constexpr size_t WS_KCB = WS_QCB + (size_t)T * 1536 * 2;
constexpr size_t WS_VCB = WS_KCB + (size_t)T * 1536 * 2;
constexpr size_t WS_MIXB = WS_VCB + (size_t)T * BW * 2;
constexpr size_t WS_L_END = WS_MIXB + (size_t)T * D * 2;
constexpr size_t WS_HGB = WS_MIXER;
constexpr size_t WS_XG = WS_HGB + (size_t)MOE_ROWS * DFF * 2;
constexpr size_t WS_OUT = WS_XG + (size_t)MOE_ROWS * D * 2;
static_assert(WS_OUT + (size_t)MOE_ROWS * D * 4 <= WS_L_END, "FFN activations must stay inside region L");
constexpr size_t WS_WGU = WS_L_END;
constexpr size_t WS_PROJ = WS_WGU;
constexpr size_t WS_VRES = al(WS_PROJ + (size_t)T * PLD * 4);
constexpr size_t WS_QF = al(WS_VRES + (size_t)T * 32 * 4);
static_assert(WS_QF + (size_t)T * BW * 4 <= WS_WGU + (size_t)4 * NGU * D * 2, "region P must end inside WGU[0..3]");
constexpr size_t WS_WD = WS_WGU + (size_t)NEXP * NGU * D * 2;
constexpr size_t WS_WDD = WS_WGU + (size_t)NGU * D * 2;
constexpr size_t WS_END = WS_WD + (size_t)NEXP * D * DFF * 2;
constexpr size_t WS_KMEAN = WS_TOK + 512 * 1024;
constexpr size_t WS_SEL = WS_TOK + 768 * 1024;

static_assert(WS_END <= (size_t)1560 * MiB, "ws budget");
constexpr int CW_CNT = 1024;
constexpr int CW_OFF = 2048;
constexpr int CW_AQ = 3072;
constexpr int CW_CQ = 3328;
constexpr int CW_SD = 3584;
constexpr int CQ_ITEMS = 16;
constexpr int CW_DQ = 12288;
constexpr int CW_PD = 12544;
constexpr int DQ_J3 = 5120, DQ_J4 = 18944, DQ_J5 = 20608, DQ_J6 = 25728, DQ_J7 = DQ_J6 + 4 * 11264, DQ_N = DQ_J7 + 8 * 5632;
constexpr int CW_TILE = 2304;
constexpr int CW_BAR = 4096;

#define XB_TMO      128
#define XB_XCNT(j)  (256  + 64 * (j))
#define XB_XSUB(j)  (1280 + 64 * (j))
#define XB_XGEN(j)  (2304 + 64 * (j))
#define XB_TOP      3328
#define XB_TOPGEN   3392
#define XCD_BAR_WORDS 3456
#define XB_SPIN_CAP (1u << 22)

__device__ __forceinline__ unsigned xb_ld(unsigned* p)              { return __hip_atomic_load(p, __ATOMIC_RELAXED, __HIP_MEMORY_SCOPE_AGENT); }
__device__ __forceinline__ unsigned xb_add(unsigned* p, unsigned v) { return __hip_atomic_fetch_add(p, v, __ATOMIC_RELAXED, __HIP_MEMORY_SCOPE_AGENT); }
__device__ __forceinline__ unsigned xb_xcc_id() { return (unsigned)__builtin_amdgcn_s_getreg((3 << 11) | 20) & 0xFu; }
#define XB_SPIN(cond, bar) do { unsigned _sp = 0; while (cond) { __builtin_amdgcn_s_sleep(1); \
    if ((++_sp & 255u) == 0u) { if (xb_ld(&(bar)[XB_TMO])) break; if (_sp > XB_SPIN_CAP) { atomicAdd(&(bar)[XB_TMO], 1u); break; } } } } while (0)

struct XcdBarrier { unsigned* bar; unsigned x; volatile LAS unsigned* st; };

__device__ __forceinline__ XcdBarrier xcd_barrier_post(unsigned* bar, volatile LAS unsigned* st, const int tid0) {
    XcdBarrier b; b.bar = bar; b.x = xb_xcc_id(); b.st = st;
    if (tid0 == 0) (void)xb_add(&bar[XB_XCNT(b.x)], 1u);
    return b;
}
__device__ __forceinline__ void xcd_barrier_complete(unsigned* bar, unsigned x, unsigned& nloc, unsigned& nx) {
    const unsigned G = gridDim.x * gridDim.y * gridDim.z;
    unsigned sum, cnt, mine, sp = 0u;
    for (;;) {
        sum = 0u; cnt = 0u; mine = 0u;
#pragma unroll
        for (unsigned j = 0; j < 16; ++j) { const unsigned c = xb_ld(&bar[XB_XCNT(j)]); sum += c; cnt += (c > 0u) ? 1u : 0u; mine = (j == x) ? c : mine; }
        if (sum == G) break;
        __builtin_amdgcn_s_sleep(1);
        if ((++sp & 255u) == 0u) { if (xb_ld(&bar[XB_TMO])) break; if (sp > XB_SPIN_CAP) { atomicAdd(&bar[XB_TMO], 1u); break; } }
    }
    nloc = mine > 0u ? mine : 1u; nx = cnt > 0u ? cnt : 1u;
}
__device__ __forceinline__ void xcd_barrier(const XcdBarrier& b, const int tid0) {
    asm volatile("s_waitcnt vmcnt(0)" ::: "memory");
    __syncthreads();
    if (tid0 == 0) {
        unsigned* bar = b.bar;
        __builtin_amdgcn_s_waitcnt(0);
        unsigned nloc = b.st[0], nx = b.st[1];
        if (nloc == 0u) { xcd_barrier_complete(bar, b.x, nloc, nx); b.st[0] = nloc; b.st[1] = nx; }
        const unsigned old = xb_add(&bar[XB_XSUB(b.x)], 1u);
        const unsigned gen = old / nloc;
        if (old + 1u == (gen + 1u) * nloc) {
            __builtin_amdgcn_fence(__ATOMIC_RELEASE, "agent");
            asm volatile("s_waitcnt vmcnt(0)" ::: "memory");
            const unsigned og = xb_add(&bar[XB_TOP], 1u);
            const unsigned tg = og / nx;
            if (og + 1u == (tg + 1u) * nx) xb_add(&bar[XB_TOPGEN], 1u);
            else XB_SPIN(xb_ld(&bar[XB_TOPGEN]) == tg, bar);
            __builtin_amdgcn_fence(__ATOMIC_ACQUIRE, "agent");
            xb_add(&bar[XB_XGEN(b.x)], 1u);
            asm volatile("s_waitcnt vmcnt(0)" ::: "memory");
        } else {
            XB_SPIN(xb_ld(&bar[XB_XGEN(b.x)]) == gen, bar);
            __builtin_amdgcn_fence(__ATOMIC_ACQUIRE, "agent");
            asm volatile("s_waitcnt vmcnt(0)" ::: "memory");
        }
    }
    __syncthreads();
}

__device__ __forceinline__ float shfl_xor_(float v, int mask, int ln) { return __builtin_bit_cast(float, __builtin_amdgcn_ds_bpermute((ln ^ mask) << 2, __builtin_bit_cast(int, v))); }
__device__ __forceinline__ float wave_sum(float v, int ln) {
    v += __builtin_bit_cast(float, __builtin_amdgcn_update_dpp(0, __builtin_bit_cast(int, v), 0x128, 0xf, 0xf, false));
    v += __builtin_bit_cast(float, __builtin_amdgcn_update_dpp(0, __builtin_bit_cast(int, v), 0x124, 0xf, 0xf, false));
    v += __builtin_bit_cast(float, __builtin_amdgcn_update_dpp(0, __builtin_bit_cast(int, v), 0x122, 0xf, 0xf, false));
    v += __builtin_bit_cast(float, __builtin_amdgcn_update_dpp(0, __builtin_bit_cast(int, v), 0x121, 0xf, 0xf, false));
    v += shfl_xor_(v, 16, ln); v += shfl_xor_(v, 32, ln);
    return v;
}
__device__ __forceinline__ float sigmoidf_(float x) { return 1.0f / (1.0f + expf(-x)); }

namespace pg8 {
#define PG8_LAS __attribute__((address_space(3)))
typedef unsigned short bf16_t;
typedef short bf16x8 __attribute__((ext_vector_type(8)));
typedef float f32x4 __attribute__((ext_vector_type(4)));
typedef unsigned u32x4 __attribute__((ext_vector_type(4)));
constexpr int BM = 256, BK = 64, HALF = 128, HTB = HALF * BK * 2  , STAGE_BYTES = 8 * HTB, NXCD = 8, WGM = 8;

__host__ __device__ __forceinline__ int lds_byte(int r, int c) { const int st = (r >> 4) * 2 + (c >> 5), rr = r & 15, cc = c & 31, ob = rr * 64 + cc * 2; return st * 1024 + (ob ^ (((ob >> 9) & 1) << 5)); }
__host__ __device__ __forceinline__ void stage_rc(int b, int& R, int& C) { const int st = b / 1024, sb = b % 1024, swz = sb ^ (((sb >> 9) & 1) << 5); R = (st >> 1) * 16 + swz / 64; C = (st & 1) * 32 + (swz % 64) / 2; }
__host__ __device__ __forceinline__ int perm32(int rho) { const int n = rho >> 4, i = rho & 15; return 8 * (i >> 2) + 4 * n + (i & 3); }

struct Unit { int pm, pn; int ko = 0; };
struct Gemm { const bf16_t* A; const bf16_t* Bt; int M, N, K; int ld = 0; };

struct StaticOrder {
    int nM, nN, nwg, G, c;
    __host__ __device__ void init(int M, int N, int G_, int c_) { nM = M / BM; nN = N / BM; nwg = nM * nN; G = G_; c = c_; }
    __host__ __device__ bool next(int i, Unit& u) const {
        const long L = (long)i * G + c; if (L >= nwg) return false;
        int wgid = (int)L; { const int q = nwg / NXCD, r = nwg % NXCD, xcd = wgid % NXCD, off = wgid / NXCD; wgid = (xcd < r ? xcd * (q + 1) : r * (q + 1) + (xcd - r) * q) + off; }
        const int nig = WGM * nN, gid = wgid / nig, fm = gid * WGM, gsz = (nM - fm) < WGM ? (nM - fm) : WGM;
        u.pm = fm + ((wgid % nig) % gsz); u.pn = (wgid % nig) / gsz; return true;
    }
    __device__ __forceinline__ void a_ready(const Unit&) const {}
    __device__ __forceinline__ void done(const Unit&) const {}
};
__device__ __forceinline__ unsigned cvt_pk_bf16(float lo, float hi) { unsigned r; asm volatile("v_cvt_pk_bf16_f32 %0, %1, %2" : "=v"(r) : "v"(lo), "v"(hi)); return r; }
typedef float f32x2 __attribute__((ext_vector_type(2)));
template <class Epi, class Sched, bool STAMP = false>
__device__ __forceinline__ void gemm_phase(PG8_LAS unsigned char* lds, const Gemm g, const Sched& S, const Epi& E, unsigned long long* stamps, const int tid) {
    const int wid = __builtin_amdgcn_readfirstlane(tid >> 6), lane = tid & 63, wr = wid >> 2, wc = wid & 3, fr = lane & 15, fq = lane >> 4;
    const int K = g.K, nt = K / BK, LD = g.ld ? g.ld : g.K;
    int ts_lo = 0, ts_hi = 0, nts = 0; const unsigned long long rt_entry = STAMP ? (unsigned long long)wall_clock64() : 0ull;
#define PG8_STAMP() do { if (STAMP && wid == 0 && nts < 64) { const unsigned long long _c = (unsigned long long)clock64(); \
        ts_lo = (lane == nts) ? (int)(unsigned)_c : ts_lo; ts_hi = (lane == nts) ? (int)(unsigned)(_c >> 32) : ts_hi; ++nts; } } while (0)
    PG8_STAMP();
    unsigned voffA[2], voffB[2];
#pragma unroll
    for (int i = 0; i < 2; ++i) { int R, C; stage_rc(tid * 16 + i * 8192, R, C); const int Rb = Epi::PERM ? ((R & ~31) + perm32(R & 31)) : R;
        voffA[i] = (unsigned)(R * LD + C) * 2u; voffB[i] = (unsigned)(Rb * LD + C) * 2u; }
    const size_t kstep = (size_t)(BK * 2);
    const size_t hstep = (size_t)HALF * LD * 2;
    const size_t tstep = 2 * hstep;
    const unsigned ldsw = (unsigned)wid * 1024u;
    const int aoff = lds_byte(wr * 64 + fr, fq * 8), boff = lds_byte(wc * 32 + fr, fq * 8);
#define PG8_SA(b, h) (((b) * 2 + (h)) * HTB)
#define PG8_SB(b, h) ((4 + (b) * 2 + (h)) * HTB)
#define PG8_STAGE(bufoff, gbase, voff) do { _Pragma("unroll") for (int _i = 0; _i < 2; ++_i) \
        __builtin_amdgcn_global_load_lds((const unsigned*)((const char*)(gbase) + (voff)[_i]), (PG8_LAS unsigned*)(lds + (bufoff) + ldsw + _i * 8192), 16, 0, 0); } while (0)
#define PG8_LDA(dst, b, h) do { _Pragma("unroll") for (int m = 0; m < 4; ++m) _Pragma("unroll") for (int k = 0; k < 2; ++k) dst[m][k] = *(const PG8_LAS bf16x8*)(lds + PG8_SA(b, h) + aoff + m * 2048 + k * 1024); } while (0)
#define PG8_LDB(dst, b, h) do { _Pragma("unroll") for (int n = 0; n < 2; ++n) _Pragma("unroll") for (int k = 0; k < 2; ++k) dst[n][k] = *(const PG8_LAS bf16x8*)(lds + PG8_SB(b, h) + boff + n * 2048 + k * 1024); } while (0)
#define PG8_MMA(ai, bj, At, Bt) do { __builtin_amdgcn_s_setprio(1); _Pragma("unroll") for (int m = 0; m < 4; ++m) _Pragma("unroll") for (int n = 0; n < 2; ++n) _Pragma("unroll") for (int k = 0; k < 2; ++k) \
        acc[ai][bj][m][n] = __builtin_amdgcn_mfma_f32_16x16x32_bf16(Bt[n][k], At[m][k], acc[ai][bj][m][n], 0, 0, 0); __builtin_amdgcn_s_setprio(0); } while (0)
#define PG8_WAIT_V(n) asm volatile("s_waitcnt vmcnt(" #n ")" ::: "memory")
#define PG8_WAIT_L(n) asm volatile("s_waitcnt lgkmcnt(" #n ")" ::: "memory")
#define PG8_BAR __builtin_amdgcn_s_barrier()
#define PG8_SCHED __builtin_amdgcn_sched_barrier(0)
    Unit cur, nxt; int ui = 0;
    if (!S.next(0, cur)) return;
    f32x4 acc[2][2][4][2];
#pragma unroll
    for (int a = 0; a < 2; ++a)
#pragma unroll
        for (int b = 0; b < 2; ++b)
#pragma unroll
            for (int m = 0; m < 4; ++m)
#pragma unroll
                for (int n = 0; n < 2; ++n) acc[a][b][m][n] = (f32x4){0.f, 0.f, 0.f, 0.f};
    bf16x8 At[4][2], B0[2][2], B1[2][2];
    {
        const bf16x8 z8 = {0, 0, 0, 0, 0, 0, 0, 0};
#pragma unroll
        for (int m = 0; m < 4; ++m) { At[m][0] = z8; At[m][1] = z8; }
#pragma unroll
        for (int n = 0; n < 2; ++n) { B0[n][0] = z8; B0[n][1] = z8; B1[n][0] = z8; B1[n][1] = z8; }
    }
    const char* cA = (const char*)g.A + (size_t)cur.pm * tstep + cur.ko; const char* cB = (const char*)g.Bt + (size_t)cur.pn * tstep + cur.ko;
    S.a_ready(cur);
    PG8_STAGE(PG8_SB(0, 0), cB, voffB); PG8_STAGE(PG8_SA(0, 0), cA, voffA); PG8_STAGE(PG8_SB(0, 1), cB + hstep, voffB); PG8_STAGE(PG8_SA(0, 1), cA + hstep, voffA);
    if (wr == 1) PG8_BAR;
    PG8_WAIT_V(4); PG8_BAR;
    PG8_STAGE(PG8_SB(1, 0), cB + kstep, voffB); PG8_STAGE(PG8_SA(1, 0), cA + kstep, voffA); PG8_STAGE(PG8_SB(1, 1), cB + hstep + kstep, voffB);
    PG8_WAIT_V(6); PG8_BAR;
    PG8_STAMP();
    for (;;) {
        const bool has_next = S.next(ui + 1, nxt);
        const char* nA = has_next ? (const char*)g.A + (size_t)nxt.pm * tstep + nxt.ko : cA; const char* nB = has_next ? (const char*)g.Bt + (size_t)nxt.pn * tstep + nxt.ko : cB;
        for (int t = 0; t < nt; t += 2) {
            if constexpr (Epi::HAS_MID) { if (t == 16 || t == 32) E.mid(acc, cur, wr, wc, fr, fq, t); }
            const bool last = (t == nt - 2);
            const char* a1 = cA + (size_t)(t + 1) * kstep;
            const char* a2 = last ? nA : cA + (size_t)(t + 2) * kstep; const char* b2 = last ? nB : cB + (size_t)(t + 2) * kstep;
            const char* a3 = a2 + kstep; const char* b3 = b2 + kstep;
            if (last && has_next) S.a_ready(nxt);
            PG8_LDB(B0, 0, 0); PG8_SCHED; PG8_LDA(At, 0, 0); PG8_STAGE(PG8_SA(1, 1), a1 + hstep, voffA);
            PG8_WAIT_L(8); PG8_BAR; PG8_WAIT_L(0); PG8_MMA(0, 0, At, B0); PG8_BAR; PG8_SCHED;
            PG8_LDB(B1, 0, 1); PG8_STAGE(PG8_SB(0, 0), b2, voffB);
            PG8_BAR; PG8_WAIT_L(0); PG8_MMA(0, 1, At, B1); PG8_BAR;
            PG8_LDA(At, 0, 1); PG8_STAGE(PG8_SA(0, 0), a2, voffA);
            PG8_BAR; PG8_WAIT_L(0); PG8_MMA(1, 0, At, B0); PG8_BAR; PG8_SCHED;
            PG8_STAGE(PG8_SB(0, 1), b2 + hstep, voffB);
            PG8_WAIT_V(6); PG8_BAR; PG8_MMA(1, 1, At, B1); PG8_BAR;
            PG8_LDB(B0, 1, 0); PG8_SCHED; PG8_LDA(At, 1, 0); PG8_STAGE(PG8_SA(0, 1), a2 + hstep, voffA);
            PG8_WAIT_L(8); PG8_BAR; PG8_WAIT_L(0); PG8_MMA(0, 0, At, B0); PG8_BAR; PG8_SCHED;
            PG8_LDB(B1, 1, 1); PG8_STAGE(PG8_SB(1, 0), b3, voffB);
            PG8_BAR; PG8_WAIT_L(0); PG8_MMA(0, 1, At, B1); PG8_BAR;
            PG8_LDA(At, 1, 1); PG8_STAGE(PG8_SA(1, 0), a3, voffA);
            PG8_BAR; PG8_WAIT_L(0); PG8_MMA(1, 0, At, B0); PG8_BAR; PG8_SCHED;
            PG8_STAGE(PG8_SB(1, 1), b3 + hstep, voffB);
            PG8_WAIT_V(6); PG8_BAR; PG8_MMA(1, 1, At, B1); PG8_BAR;
        }
        PG8_STAMP();
        if constexpr (!Epi::AFTER_DRAIN) { if constexpr (Epi::STAGED) E.staged(acc, cur, wr, wc, fr, fq, lds + STAGE_BYTES, wid, lane); else E(acc, cur, wr, wc, fr, fq); S.done(cur); }
        PG8_STAMP();
        if (!has_next) break;
#pragma unroll
        for (int a = 0; a < 2; ++a)
#pragma unroll
            for (int b = 0; b < 2; ++b)
#pragma unroll
                for (int m = 0; m < 4; ++m)
#pragma unroll
                    for (int n = 0; n < 2; ++n) acc[a][b][m][n] = (f32x4){0.f, 0.f, 0.f, 0.f};
        cur = nxt; cA = nA; cB = nB; ++ui;
    }
    PG8_WAIT_V(0);
    if (wr == 0) PG8_BAR;
    PG8_BAR;
    if constexpr (Epi::AFTER_DRAIN) { E.fused(acc, cur, wr, wc, fr, fq, lds, wid, lane); S.done(cur); }
    PG8_STAMP();
    if (STAMP && wid == 0) { stamps[lane] = lane < nts ? (((unsigned long long)(unsigned)ts_hi << 32) | (unsigned)ts_lo) : 0ull;
        if (lane == 62) stamps[62] = rt_entry; if (lane == 63) stamps[63] = (unsigned long long)wall_clock64(); }
#undef PG8_STAMP
#undef PG8_SA
#undef PG8_SB
#undef PG8_STAGE
#undef PG8_LDA
#undef PG8_LDB
#undef PG8_MMA
#undef PG8_WAIT_V
#undef PG8_WAIT_L
#undef PG8_BAR
#undef PG8_SCHED
}
}


typedef unsigned short bf16;
typedef unsigned v4u __attribute__((ext_vector_type(4)));
typedef unsigned v2u __attribute__((ext_vector_type(2)));
__device__ __forceinline__ unsigned f2bf(float f) { unsigned u = __builtin_bit_cast(unsigned, f); return (u + 0x7fffu + ((u >> 16) & 1u)) >> 16; }
typedef __bf16 bf16x2_t __attribute__((ext_vector_type(2)));
__device__ __forceinline__ unsigned pk2(float lo, float hi) { bf16x2_t v; v[0] = (__bf16)lo; v[1] = (__bf16)hi; return __builtin_bit_cast(unsigned, v); }
__device__ __forceinline__ float row_allsum16(float x) {
    x += __builtin_bit_cast(float, __builtin_amdgcn_update_dpp(0, __builtin_bit_cast(int, x), 0x128, 0xf, 0xf, false));
    x += __builtin_bit_cast(float, __builtin_amdgcn_update_dpp(0, __builtin_bit_cast(int, x), 0x124, 0xf, 0xf, false));
    x += __builtin_bit_cast(float, __builtin_amdgcn_update_dpp(0, __builtin_bit_cast(int, x), 0x122, 0xf, 0xf, false));
    x += __builtin_bit_cast(float, __builtin_amdgcn_update_dpp(0, __builtin_bit_cast(int, x), 0x121, 0xf, 0xf, false));
    return x;
}
__device__ __forceinline__ float fsigmoid(float x) { return __builtin_amdgcn_rcpf(1.0f + __expf(-x)); }
__device__ __forceinline__ void transpose_item(const float* p, int ldw, bf16* WT, int K, int dst_row0, int k0, LAS float* scr, int ln) {
    if (p) {
        float tv[32];
#pragma unroll
        for (int i = 0; i < 32; ++i) tv[i] = p[(size_t)(k0 + 2 * i + (ln >> 5)) * ldw];
#pragma unroll
        for (int i = 0; i < 32; ++i) scr[(2 * i + (ln >> 5)) * 33 + (ln & 31)] = tv[i];
    } else {
#pragma unroll 8
        for (int i = 0; i < 32; ++i) { const int kk = 2 * i + (ln >> 5); scr[kk * 33 + (ln & 31)] = 0.f; }
    }
    asm volatile("s_waitcnt lgkmcnt(0)" ::: "memory");
    const int c = ln & 7;
#pragma unroll
    for (int j = 0; j < 4; ++j) { const int n = (ln >> 3) + 8 * j; const LAS float* s = scr + (8 * c) * 33 + n;
        v4u o; o.x = pk2(s[0 * 33], s[1 * 33]); o.y = pk2(s[2 * 33], s[3 * 33]); o.z = pk2(s[4 * 33], s[5 * 33]); o.w = pk2(s[6 * 33], s[7 * 33]);
        *(v4u*)(WT + (size_t)(dst_row0 + n) * K + k0 + 8 * c) = o; }
    asm volatile("s_waitcnt lgkmcnt(0)" ::: "memory");
}
struct TI { const float* p; bf16* wt; int ldw, K, r0, k0; bool zero; };
__device__ __forceinline__ void ti_load(const TI& t, float (&tv)[32], int ln) {
#pragma unroll
    for (int i = 0; i < 32; ++i) tv[i] = t.p[(size_t)(t.k0 + 2 * i + (ln >> 5)) * t.ldw];
}
__device__ __forceinline__ void ti_finish(const TI& t, const float (&tv)[32], LAS float* scr, int ln) {
#pragma unroll
    for (int i = 0; i < 32; ++i) scr[(2 * i + (ln >> 5)) * 33 + (ln & 31)] = t.zero ? 0.f : tv[i];
    asm volatile("s_waitcnt lgkmcnt(0)" ::: "memory");
    const int c = ln & 7;
#pragma unroll
    for (int j = 0; j < 4; ++j) { const int n = (ln >> 3) + 8 * j; const LAS float* s = scr + (8 * c) * 33 + n;
        v4u o; o.x = pk2(s[0 * 33], s[1 * 33]); o.y = pk2(s[2 * 33], s[3 * 33]); o.z = pk2(s[4 * 33], s[5 * 33]); o.w = pk2(s[6 * 33], s[7 * 33]);
        *(v4u*)(t.wt + (size_t)(t.r0 + n) * t.K + t.k0 + 8 * c) = o; }
    asm volatile("s_waitcnt lgkmcnt(0)" ::: "memory");
}
constexpr int STG_RS = 528;
#define EBAR() do { asm volatile("s_waitcnt lgkmcnt(0)" ::: "memory"); __builtin_amdgcn_s_barrier(); asm volatile("" ::: "memory"); } while (0)
#define EPI_ENTER(wr_) do { if ((wr_) == 0) __builtin_amdgcn_s_barrier(); } while (0)
#define EPI_LEAVE(wr_) do { if ((wr_) == 1) __builtin_amdgcn_s_barrier(); } while (0)
#define STG_READBACK512(ai_, m_, BODY) do { int ln_ = lane; asm volatile("" : "+v"(ln_)); _Pragma("unroll") for (int h_ = 0; h_ < 2; ++h_) { const int lr_ = 4 * wid + 2 * h_ + (ln_ >> 5), cb_ = (ln_ & 31) * 16; \
        const v4u sv_ = *(const LAS v4u*)(stg + lr_ * STG_RS + cb_); const int trow_ = 128 * (ai_) + 64 * (lr_ >> 4) + 16 * (m_) + (lr_ & 15); BODY } } while (0)

struct EpiSwigluBf16 {
    static constexpr bool PERM = true, AFTER_DRAIN = false, HAS_MID = false, STAGED = true;
    bf16* H; int nN;
    __device__ __forceinline__ void staged(const f32x4 (&acc)[2][2][4][2], const pg8::Unit& u, int wr, int wc, int fr, int fq, LAS unsigned char* stg, int wid, int lane) const {
        const int pnl = u.pn % nN, lrw = 16 * wr + fr;
        bf16* dst = H + (size_t)u.pm * 256 * DFF + 128 * pnl;
        EPI_ENTER(wr);
#pragma unroll
        for (int ai = 0; ai < 2; ++ai)
#pragma unroll
            for (int m = 0; m < 4; ++m) {
#pragma unroll
                for (int bj = 0; bj < 2; ++bj) {
                    const f32x4 g = acc[ai][bj][m][0], uu = acc[ai][bj][m][1]; float h[4];
#pragma unroll
                    for (int j = 0; j < 4; ++j) h[j] = g[j] * fsigmoid(g[j]) * uu[j];
                    v2u o; o.x = pk2(h[0], h[1]); o.y = pk2(h[2], h[3]);
                    *(LAS v2u*)(stg + lrw * 272 + (64 * bj + 16 * wc + 4 * fq) * 2) = o;
                }
                EBAR();
                {
                    int ln_ = lane; asm volatile("" : "+v"(ln_));
                    const int lr = 4 * wid + (ln_ >> 4), cb = (ln_ & 15) * 16;
                    const v4u sv = *(const LAS v4u*)(stg + lr * 272 + cb);
                    const int trow = 128 * ai + 64 * (lr >> 4) + 16 * m + (lr & 15);
                    *(v4u*)(dst + (size_t)trow * DFF + (ln_ & 15) * 8) = sv;
                }
                EBAR();
            }
        EPI_LEAVE(wr);
    }
};
struct EpiResidF32 {
    static constexpr bool PERM = true, AFTER_DRAIN = false, HAS_MID = false, STAGED = true;
    float* C; const float* R;
    __device__ __forceinline__ void staged(const f32x4 (&acc)[2][2][4][2], const pg8::Unit& u, int wr, int wc, int fr, int fq, LAS unsigned char* stg, int wid, int lane) const {
        const int lrw = 16 * wr + fr; const size_t t0 = (size_t)u.pm * 256 * D + (size_t)u.pn * 256;
        EPI_ENTER(wr);
#pragma unroll
        for (int ai = 0; ai < 2; ++ai)
#pragma unroll
            for (int m = 0; m < 4; ++m)
#pragma unroll
                for (int bj = 0; bj < 2; ++bj) {
                    *(LAS f32x4*)(stg + lrw * STG_RS + (wc * 32 + 8 * fq) * 4) = acc[ai][bj][m][0];
                    *(LAS f32x4*)(stg + lrw * STG_RS + (wc * 32 + 8 * fq) * 4 + 16) = acc[ai][bj][m][1];
                    EBAR();
                    STG_READBACK512(ai, m, { const size_t o_ = t0 + (size_t)trow_ * D + bj * 128 + (ln_ & 31) * 4;
                        const f32x4 r_ = *(const f32x4*)(R + o_); *(f32x4*)(C + o_) = ALPHA * r_ + __builtin_bit_cast(f32x4, sv_); });
                    EBAR();
                }
        EPI_LEAVE(wr);
    }
};
struct EpiStoreF32 {
    static constexpr bool PERM = true, AFTER_DRAIN = false, HAS_MID = false, STAGED = true;
    float* C; int nN;
    __device__ __forceinline__ void staged(const f32x4 (&acc)[2][2][4][2], const pg8::Unit& u, int wr, int wc, int fr, int fq, LAS unsigned char* stg, int wid, int lane) const {
        const int lrw = 16 * wr + fr; const size_t t0 = (size_t)u.pm * 256 * D + (size_t)(u.pn % nN) * 256;
        EPI_ENTER(wr);
#pragma unroll
        for (int ai = 0; ai < 2; ++ai)
#pragma unroll
            for (int m = 0; m < 4; ++m)
#pragma unroll
                for (int bj = 0; bj < 2; ++bj) {
                    *(LAS f32x4*)(stg + lrw * STG_RS + (wc * 32 + 8 * fq) * 4) = acc[ai][bj][m][0];
                    *(LAS f32x4*)(stg + lrw * STG_RS + (wc * 32 + 8 * fq) * 4 + 16) = acc[ai][bj][m][1];
                    EBAR();
                    STG_READBACK512(ai, m, { *(v4u*)(C + t0 + (size_t)trow_ * D + bj * 128 + (ln_ & 31) * 4) = sv_; });
                    EBAR();
                }
        EPI_LEAVE(wr);
    }
};
template <int MODE> struct EpiBranch {
    static constexpr bool PERM = true, AFTER_DRAIN = false, HAS_MID = false, STAGED = false;
    float* MIXp; bf16* MIXBp; const float* gate;
    __device__ __forceinline__ void operator()(const f32x4 (&acc)[2][2][4][2], const pg8::Unit& u, int wr, int wc, int fr, int fq) const {
        const int row0 = u.pm * 256 + wr * 64 + fr, col0 = u.pn * 256 + wc * 32 + 8 * fq;
#pragma unroll
        for (int ai = 0; ai < 2; ++ai)
#pragma unroll
            for (int m = 0; m < 4; ++m)
#pragma unroll
                for (int bj = 0; bj < 2; ++bj) {
                    const int row = row0 + ai * 128 + m * 16, col = col0 + bj * 128; const size_t o = (size_t)row * D + col;
                    const f32x4 g0 = *(const f32x4*)(gate + (size_t)row * IN_COLS + col), g1 = *(const f32x4*)(gate + (size_t)row * IN_COLS + col + 4);
                    f32x4 r0, r1;
#pragma unroll
                    for (int j = 0; j < 4; ++j) { r0[j] = fsigmoid(g0[j]) * acc[ai][bj][m][0][j]; r1[j] = fsigmoid(g1[j]) * acc[ai][bj][m][1][j]; }
                    if (MODE >= 1) { r0 += *(const f32x4*)(MIXp + o); r1 += *(const f32x4*)(MIXp + o + 4); }
                    if (MODE <= 1) { *(f32x4*)(MIXp + o) = r0; *(f32x4*)(MIXp + o + 4) = r1; }
                    else { v4u w; w.x = pk2(r0[0], r0[1]); w.y = pk2(r0[2], r0[3]); w.z = pk2(r1[0], r1[1]); w.w = pk2(r1[2], r1[3]); *(v4u*)(MIXBp + o) = w; }
                }
    }
};

struct EpiLora {
    static constexpr bool PERM = true, AFTER_DRAIN = false, HAS_MID = false, STAGED = false;
    float* DECp; float* AAp; float* GGp; float* Vp; const float* VFp; const float* w0; const float* a0; const float* v0;
    __device__ __forceinline__ void operator()(const f32x4 (&acc)[2][2][4][2], const pg8::Unit& u, int wr, int wc, int fr, int fq) const {
        const int row0 = u.pm * 256 + wr * 64 + fr, seg = __builtin_amdgcn_readfirstlane(u.pn >> 2), col0 = (u.pn & 3) * 256 + wc * 32 + 8 * fq;
        if (seg == 0) {
#pragma unroll
            for (int bj = 0; bj < 2; ++bj) { const int col = col0 + bj * 128; const f32x4 b0 = *(const f32x4*)(w0 + col), b1 = *(const f32x4*)(w0 + col + 4);
#pragma unroll
                for (int ai = 0; ai < 2; ++ai)
#pragma unroll
                    for (int m = 0; m < 4; ++m) { const size_t o = (size_t)(row0 + ai * 128 + m * 16) * BW + col;
                        f32x4 x0 = acc[ai][bj][m][0] + b0, x1 = acc[ai][bj][m][1] + b1;
#pragma unroll
                        for (int j = 0; j < 4; ++j) { const float z0 = -x0[j], z1 = -x1[j];
                            const float sp0 = z0 > 20.f ? z0 : __logf(1.0f + __expf(z0)), sp1 = z1 > 20.f ? z1 : __logf(1.0f + __expf(z1));
                            x0[j] = __expf(-__expf(-sp0 - 0.5f)); x1[j] = __expf(-__expf(-sp1 - 0.5f)); }
                        *(f32x4*)(DECp + o) = x0; *(f32x4*)(DECp + o + 4) = x1; } }
        } else if (seg == 1) {
#pragma unroll
            for (int bj = 0; bj < 2; ++bj) { const int col = col0 + bj * 128; const f32x4 b0 = *(const f32x4*)(a0 + col), b1 = *(const f32x4*)(a0 + col + 4);
#pragma unroll
                for (int ai = 0; ai < 2; ++ai)
#pragma unroll
                    for (int m = 0; m < 4; ++m) { const size_t o = (size_t)(row0 + ai * 128 + m * 16) * BW + col;
                        f32x4 x0 = acc[ai][bj][m][0] + b0, x1 = acc[ai][bj][m][1] + b1;
#pragma unroll
                        for (int j = 0; j < 4; ++j) { x0[j] = fsigmoid(x0[j]); x1[j] = fsigmoid(x1[j]); }
                        *(f32x4*)(AAp + o) = x0; *(f32x4*)(AAp + o + 4) = x1; } }
        } else if (seg == 2) {
#pragma unroll
            for (int bj = 0; bj < 2; ++bj) { const int col = col0 + bj * 128;
#pragma unroll
                for (int ai = 0; ai < 2; ++ai)
#pragma unroll
                    for (int m = 0; m < 4; ++m) { const size_t o = (size_t)(row0 + ai * 128 + m * 16) * BW + col;
                        *(f32x4*)(GGp + o) = acc[ai][bj][m][0]; *(f32x4*)(GGp + o + 4) = acc[ai][bj][m][1]; } }
        } else {
#pragma unroll
            for (int bj = 0; bj < 2; ++bj) { const int col = col0 + bj * 128; const f32x4 b0 = *(const f32x4*)(v0 + col), b1 = *(const f32x4*)(v0 + col + 4);
#pragma unroll
                for (int ai = 0; ai < 2; ++ai)
#pragma unroll
                    for (int m = 0; m < 4; ++m) { const size_t o = (size_t)(row0 + ai * 128 + m * 16) * BW + col;
                        f32x4 x0 = acc[ai][bj][m][0] + b0, x1 = acc[ai][bj][m][1] + b1;
                        const f32x4 v0_ = *(const f32x4*)(Vp + o), v1_ = *(const f32x4*)(Vp + o + 4), f0 = *(const f32x4*)(VFp + o), f1 = *(const f32x4*)(VFp + o + 4);
#pragma unroll
                        for (int j = 0; j < 4; ++j) { x0[j] = v0_[j] + (f0[j] - v0_[j]) * fsigmoid(x0[j]); x1[j] = v1_[j] + (f1[j] - v1_[j]) * fsigmoid(x1[j]); }
                        *(f32x4*)(Vp + o) = x0; *(f32x4*)(Vp + o + 4) = x1;
                        asm volatile("" ::: "memory"); } }
        }
    }
};
struct EpiMlaQ {
    static constexpr bool PERM = true, AFTER_DRAIN = false, HAS_MID = false, STAGED = false;
    bf16* QCBp; const float* COSMp; const float* SINMp;
    __device__ __forceinline__ void operator()(const f32x4 (&acc)[2][2][4][2], const pg8::Unit& u, int wr, int wc, int fr, int fq) const {
        const int row0 = u.pm * 256 + wr * 64 + fr;
#pragma unroll
        for (int bj = 0; bj < 2; ++bj) {
            const int c = u.pn * 256 + bj * 128 + wc * 32 + 8 * fq, h = c / 192, cc = c - h * 192;
#pragma unroll
            for (int ai = 0; ai < 2; ++ai)
#pragma unroll
                for (int m = 0; m < 4; ++m) {
                    const int row = row0 + ai * 128 + m * 16; const f32x4 x1 = acc[ai][bj][m][0], x2 = acc[ai][bj][m][1];
                    bf16* dst = QCBp + (size_t)row * 1536 + h * 192;
                    if (cc < 128) { v4u w; w.x = pk2(x1[0], x1[1]); w.y = pk2(x1[2], x1[3]); w.z = pk2(x2[0], x2[1]); w.w = pk2(x2[2], x2[3]); *(v4u*)(dst + cc) = w; }
                    else { const int j0 = 4 * ((cc - 128) >> 3), s = row & (SEQ - 1);
                        const f32x4 cs = *(const f32x4*)(COSMp + s * 32 + j0), sn = *(const f32x4*)(SINMp + s * 32 + j0);
                        const f32x4 o1 = x1 * cs - x2 * sn, o2 = x2 * cs + x1 * sn;
                        v2u a; a.x = pk2(o1[0], o1[1]); a.y = pk2(o1[2], o1[3]); v2u b; b.x = pk2(o2[0], o2[1]); b.y = pk2(o2[2], o2[3]);
                        *(v2u*)(dst + 128 + j0) = a; *(v2u*)(dst + 160 + j0) = b; }
                }
        }
    }
};
struct EpiMlaKV {
    static constexpr bool PERM = true, AFTER_DRAIN = false, HAS_MID = false, STAGED = false;
    bf16* KCBp; bf16* VCBp;
    __device__ __forceinline__ void operator()(const f32x4 (&acc)[2][2][4][2], const pg8::Unit& u, int wr, int wc, int fr, int fq) const {
        const int row0 = u.pm * 256 + wr * 64 + fr;
#pragma unroll
        for (int bj = 0; bj < 2; ++bj) {
            const int c = u.pn * 256 + bj * 128 + wc * 32 + 8 * fq, h = c >> 8, cc = c & 255;
#pragma unroll
            for (int ai = 0; ai < 2; ++ai)
#pragma unroll
                for (int m = 0; m < 4; ++m) {
                    const int row = row0 + ai * 128 + m * 16; const f32x4 x1 = acc[ai][bj][m][0], x2 = acc[ai][bj][m][1];
                    v4u w; w.x = pk2(x1[0], x1[1]); w.y = pk2(x1[2], x1[3]); w.z = pk2(x2[0], x2[1]); w.w = pk2(x2[2], x2[3]);
                    if (cc < 128) *(v4u*)(KCBp + (size_t)row * 1536 + h * 192 + cc) = w;
                    else *(v4u*)(VCBp + (size_t)row * BW + h * 128 + (cc - 128)) = w;
                }
        }
    }
};

struct EpiBranch3 {
    static constexpr bool PERM = true, AFTER_DRAIN = false, HAS_MID = true, STAGED = false;
    bf16* MIXBp; const bf16* G;
    __device__ __forceinline__ void mid(f32x4 (&acc)[2][2][4][2], const pg8::Unit& u, int wr, int wc, int fr, int fq, int t) const {
        int row0 = u.pm * 256 + wr * 64 + fr, col0 = u.pn * 256 + wc * 32 + 8 * fq; const int seg = t >> 4;
        asm volatile("" : "+v"(row0), "+v"(col0));
#pragma unroll
        for (int ai = 0; ai < 2; ++ai)
#pragma unroll
            for (int m = 0; m < 4; ++m)
#pragma unroll
                for (int bj = 0; bj < 2; ++bj) {
                    const bf16* gp = G + (size_t)(row0 + ai * 128 + m * 16) * (3 * D) + (seg - 1) * D + col0 + bj * 128;
                    const v4u a = *(const v4u*)gp, b = *(const v4u*)(gp + D);
                    const unsigned aw[4] = {a.x, a.y, a.z, a.w}, bw[4] = {b.x, b.y, b.z, b.w};
#pragma unroll
                    for (int j = 0; j < 4; ++j) {
                        const float r0 = __uint_as_float(aw[j] << 16) * __builtin_amdgcn_rcpf(__uint_as_float(bw[j] << 16));
                        const float r1 = __uint_as_float(aw[j] & 0xffff0000u) * __builtin_amdgcn_rcpf(__uint_as_float(bw[j] & 0xffff0000u));
                        acc[ai][bj][m][j >> 1][(j & 1) * 2] *= r0; acc[ai][bj][m][j >> 1][(j & 1) * 2 + 1] *= r1;
                    }
                    asm volatile("" : "+v"(acc[ai][bj][m][0]), "+v"(acc[ai][bj][m][1]) :: "memory");
                }
    }
    __device__ __forceinline__ void operator()(const f32x4 (&acc)[2][2][4][2], const pg8::Unit& u, int wr, int wc, int fr, int fq) const {
        const int row0 = u.pm * 256 + wr * 64 + fr, col0 = u.pn * 256 + wc * 32 + 8 * fq;
#pragma unroll
        for (int ai = 0; ai < 2; ++ai)
#pragma unroll
            for (int m = 0; m < 4; ++m)
#pragma unroll
                for (int bj = 0; bj < 2; ++bj) {
                    const int row = row0 + ai * 128 + m * 16, col = col0 + bj * 128;
                    const v4u a = *(const v4u*)(G + (size_t)row * (3 * D) + 2 * D + col);
                    const unsigned aw[4] = {a.x, a.y, a.z, a.w}; float r[8];
#pragma unroll
                    for (int j = 0; j < 4; ++j) { r[2 * j] = acc[ai][bj][m][j >> 1][(j & 1) * 2] * __uint_as_float(aw[j] << 16);
                                                  r[2 * j + 1] = acc[ai][bj][m][j >> 1][(j & 1) * 2 + 1] * __uint_as_float(aw[j] & 0xffff0000u); }
                    v4u w; w.x = pk2(r[0], r[1]); w.y = pk2(r[2], r[3]); w.z = pk2(r[4], r[5]); w.w = pk2(r[6], r[7]);
                    *(v4u*)(MIXBp + (size_t)row * D + col) = w;
                }
    }
};
struct MoeOrder {
    const unsigned* tile_e; int nMt, nN, G, c; int mt0 = 0, ks = 1, kbytes = 0;
    __device__ __forceinline__ bool next(int i, pg8::Unit& u) const {
        const long L = (long)i * G + c; if (L >= (long)nMt * nN * ks) return false;
        const int mt = mt0 + (int)(L / (nN * ks)), rem = (int)(L % (nN * ks)), pnl = rem / ks;
        u.pm = mt; u.pn = (int)tile_e[mt] * nN + pnl; u.ko = (rem % ks) * kbytes; return true;
    }
    __device__ __forceinline__ void a_ready(const pg8::Unit&) const {}
    __device__ __forceinline__ void done(const pg8::Unit&) const {}
};
struct EpiAtomicF32 {
    static constexpr bool PERM = true, AFTER_DRAIN = false, HAS_MID = false, STAGED = true;
    float* C; int nN;
    __device__ __forceinline__ void staged(const f32x4 (&acc)[2][2][4][2], const pg8::Unit& u, int wr, int wc, int fr, int fq, LAS unsigned char* stg, int wid, int lane) const {
        const int lrw = 16 * wr + fr; const size_t t0 = (size_t)u.pm * 256 * D + (size_t)(u.pn % nN) * 256;
        EPI_ENTER(wr);
#pragma unroll
        for (int ai = 0; ai < 2; ++ai)
#pragma unroll
            for (int m = 0; m < 4; ++m)
#pragma unroll
                for (int bj = 0; bj < 2; ++bj) {
                    *(LAS f32x4*)(stg + lrw * STG_RS + (wc * 32 + 8 * fq) * 4) = acc[ai][bj][m][0];
                    *(LAS f32x4*)(stg + lrw * STG_RS + (wc * 32 + 8 * fq) * 4 + 16) = acc[ai][bj][m][1];
                    EBAR();
                    { int ln_ = lane; asm volatile("" : "+v"(ln_));
#pragma unroll
                      for (int q_ = 0; q_ < 8; ++q_) { const int lr_ = 4 * wid + (q_ >> 1), cf_ = (q_ & 1) * 64 + ln_;
                          const float sv_ = *(const LAS float*)(stg + lr_ * STG_RS + cf_ * 4);
                          const int trow_ = 128 * ai + 64 * (lr_ >> 4) + 16 * m + (lr_ & 15);
                          atomicAdd(C + t0 + (size_t)trow_ * D + bj * 128 + cf_, sv_); } }
                    EBAR();
                }
        EPI_LEAVE(wr);
    }
};

struct EpiStoreBf16s { bf16* C; int ldc; size_t sC;
    __device__ __forceinline__ void operator()(int bt, int m, int n, float v) const { C[(size_t)bt * sC + (size_t)m * ldc + n] = (bf16)f2bf(v); } };
struct EpiInProjF32 {
    static constexpr bool PERM = true, AFTER_DRAIN = false, HAS_MID = false, STAGED = false;
    float* PROJp; float* VRESp; bf16* GATEp; float* QFp; bf16* KABp; bf16* VABp; const float* COSAp; const float* SINAp; int layer;
    __device__ __forceinline__ void operator()(const f32x4 (&acc)[2][2][4][2], const pg8::Unit& u, int wr, int wc, int fr, int fq) const {
        int row0 = u.pm * 256 + wr * 64 + fr;
        asm volatile("" : "+v"(row0), "+v"(fq));
        if (u.pn >= 30) {
#pragma unroll
            for (int bj = 0; bj < 2; ++bj) { const int c = (u.pn - 30) * 256 + bj * 128 + wc * 32 + 8 * fq;
#pragma unroll
                for (int ai = 0; ai < 2; ++ai)
#pragma unroll
                    for (int m = 0; m < 4; ++m) { const f32x4 x0 = acc[ai][bj][m][0], x1 = acc[ai][bj][m][1];
                        v4u w; w.x = pk2(fsigmoid(x0[0]), fsigmoid(x0[1])); w.y = pk2(fsigmoid(x0[2]), fsigmoid(x0[3]));
                        w.z = pk2(fsigmoid(x1[0]), fsigmoid(x1[1])); w.w = pk2(fsigmoid(x1[2]), fsigmoid(x1[3]));
                        *(v4u*)(GATEp + (size_t)(row0 + ai * 128 + m * 16) * (3 * D) + c) = w; } }
            return;
        }
        if (u.pn < 8) {
            const bool isk = u.pn >= 4;
#pragma unroll
            for (int bj = 0; bj < 2; ++bj) {
                const int c = (u.pn & 3) * 256 + bj * 128 + wc * 32 + 8 * fq, hh = c >> 7, j0 = ((c & 127) >> 3) * 4;
#pragma unroll
                for (int ai = 0; ai < 2; ++ai)
#pragma unroll
                    for (int m = 0; m < 4; ++m) { const int row = row0 + ai * 128 + m * 16, s = row & (SEQ - 1);
                        const f32x4 cs = *(const f32x4*)(COSAp + s * 64 + j0), sn = *(const f32x4*)(SINAp + s * 64 + j0);
                        const f32x4 x1 = acc[ai][bj][m][0], x2 = acc[ai][bj][m][1];
                        const f32x4 o1 = x1 * cs - x2 * sn, o2 = x2 * cs + x1 * sn;
                        if (!isk) { float* q = QFp + (size_t)row * BW + hh * 128 + j0; *(f32x4*)q = o1; *(f32x4*)(q + 64) = o2; }
                        else { bf16* k = KABp + (size_t)row * BW + hh * 128 + j0; v2u a; a.x = pk2(o1[0], o1[1]); a.y = pk2(o1[2], o1[3]); v2u b; b.x = pk2(o2[0], o2[1]); b.y = pk2(o2[2], o2[3]);
                            *(v2u*)k = a; *(v2u*)(k + 64) = b; }
                        asm volatile("" ::: "memory");
                    }
            }
            return;
        }
        if (u.pn < 12) {
#pragma unroll
            for (int bj = 0; bj < 2; ++bj) { const int c = (u.pn - 8) * 256 + bj * 128 + wc * 32 + 8 * fq;
#pragma unroll
                for (int ai = 0; ai < 2; ++ai)
#pragma unroll
                    for (int m = 0; m < 4; ++m) { const f32x4 x0 = acc[ai][bj][m][0], x1 = acc[ai][bj][m][1];
                        v4u w; w.x = pk2(x0[0], x0[1]); w.y = pk2(x0[2], x0[3]); w.z = pk2(x1[0], x1[1]); w.w = pk2(x1[2], x1[3]);
                        *(v4u*)(VABp + (size_t)(row0 + ai * 128 + m * 16) * BW + c) = w; } }
            return;
        }
#pragma unroll
        for (int bj = 0; bj < 2; ++bj) {
            const int c = u.pn * 256 + bj * 128 + wc * 32 + 8 * fq;
            float* dst; int ld; bool ok = true;
            if (c < 6432) { dst = PROJp + (c - PSH); ld = PLD; }
            else if (c < 6464) { dst = VRESp + (c - 6432); ld = 32; ok = layer != 0; }
            else if (c < 7552) { dst = PROJp + (c - 32 - PSH); ld = PLD; }
            else { dst = PROJp; ld = 0; ok = false; }
            if (ok) {
#pragma unroll
                for (int ai = 0; ai < 2; ++ai)
#pragma unroll
                    for (int m = 0; m < 4; ++m) { float* p = dst + (size_t)(row0 + ai * 128 + m * 16) * ld;
                        *(f32x4*)p = acc[ai][bj][m][0]; *(f32x4*)(p + 4) = acc[ai][bj][m][1]; }
            }
        }
    }
};


__device__ __forceinline__ float fma_(float a, float b, float c) { float r; asm("v_fma_f32 %0, %1, %2, %3" : "=v"(r) : "v"(a), "v"(b), "v"(c)); return r; }
__device__ __forceinline__ float mul_(float a, float b) { float r; asm("v_mul_f32 %0, %1, %2" : "=v"(r) : "v"(a), "v"(b)); return r; }
__device__ __forceinline__ float add_(float a, float b) { float r; asm("v_add_f32 %0, %1, %2" : "=v"(r) : "v"(a), "v"(b)); return r; }
typedef short s16x4 __attribute__((ext_vector_type(4)));
constexpr int AT_KOFF = 0, AT_VOFF = 25600, AT_STAGE = 25600 + 64 * 288;
#define AT_TR16(base, o) \
    asm volatile("ds_read_b64_tr_b16 %0, %16 offset:0\n\tds_read_b64_tr_b16 %1, %16 offset:4608\n\t" \
                 "ds_read_b64_tr_b16 %2, %16 offset:32\n\tds_read_b64_tr_b16 %3, %16 offset:4640\n\t" \
                 "ds_read_b64_tr_b16 %4, %16 offset:64\n\tds_read_b64_tr_b16 %5, %16 offset:4672\n\t" \
                 "ds_read_b64_tr_b16 %6, %16 offset:96\n\tds_read_b64_tr_b16 %7, %16 offset:4704\n\t" \
                 "ds_read_b64_tr_b16 %8, %16 offset:128\n\tds_read_b64_tr_b16 %9, %16 offset:4736\n\t" \
                 "ds_read_b64_tr_b16 %10, %16 offset:160\n\tds_read_b64_tr_b16 %11, %16 offset:4768\n\t" \
                 "ds_read_b64_tr_b16 %12, %16 offset:192\n\tds_read_b64_tr_b16 %13, %16 offset:4800\n\t" \
                 "ds_read_b64_tr_b16 %14, %16 offset:224\n\tds_read_b64_tr_b16 %15, %16 offset:4832\n\t" \
                 "s_waitcnt lgkmcnt(0)" \
                 : "=&v"(o[0]), "=&v"(o[1]), "=&v"(o[2]), "=&v"(o[3]), "=&v"(o[4]), "=&v"(o[5]), "=&v"(o[6]), "=&v"(o[7]), \
                   "=&v"(o[8]), "=&v"(o[9]), "=&v"(o[10]), "=&v"(o[11]), "=&v"(o[12]), "=&v"(o[13]), "=&v"(o[14]), "=&v"(o[15]) \
                 : "v"(base) : "memory")
template <int DQ, bool MOBA>
__device__ __forceinline__ void attn_tile(LAS unsigned char* lds, const int buf, const int it, const int q0, const int w, const int qq, const int g, const int qrow, const int own,
                                          const unsigned selbits, const float sc, const pg8::bf16x8 (&qf)[DQ / 32], f32x4 (&o)[8], float& m, float& l) {
    constexpr int KROW = (DQ + 8) * 2, VROW = 288, NDS = DQ / 32;
    const LAS unsigned char* kb = lds + buf * AT_STAGE + AT_KOFF;
    f32x4 st[4];
#pragma unroll
    for (int c = 0; c < 4; ++c) {
        st[c] = (f32x4){0.f, 0.f, 0.f, 0.f};
#pragma unroll
        for (int ds = 0; ds < NDS; ++ds) {
            const pg8::bf16x8 a = *(const LAS pg8::bf16x8*)(kb + (16 * c + qq) * KROW + (32 * ds + 8 * g) * 2);
            st[c] = __builtin_amdgcn_mfma_f32_16x16x32_bf16(a, qf[ds], st[c], 0, 0, 0);
        }
    }
    const int blk = it >> 2;
    const bool past = MOBA && (blk < own);
    if (past) {
        const bool selok = ((selbits >> blk) & 1u) != 0u;
#pragma unroll
        for (int c = 0; c < 4; ++c)
#pragma unroll
            for (int r = 0; r < 4; ++r) st[c][r] = selok ? st[c][r] : -INFINITY;
    } else if (it * 64 + 63 > q0 + 16 * w) {
#pragma unroll
        for (int c = 0; c < 4; ++c)
#pragma unroll
            for (int r = 0; r < 4; ++r) { const int key = it * 64 + 16 * c + 4 * g + r; st[c][r] = (key <= qrow) ? st[c][r] : -INFINITY; }
    }
    float mloc = fmaxf(fmaxf(st[0][0], st[0][1]), fmaxf(st[0][2], st[0][3]));
#pragma unroll
    for (int c = 1; c < 4; ++c) mloc = fmaxf(mloc, fmaxf(fmaxf(st[c][0], st[c][1]), fmaxf(st[c][2], st[c][3])));
    const int ln_ = qq + 16 * g;
    mloc = fmaxf(mloc, shfl_xor_(mloc, 16, ln_)); mloc = fmaxf(mloc, shfl_xor_(mloc, 32, ln_));
    const float mnew = fmaxf(m, mloc * sc);
    if (__any(mnew > m)) {
        const float alpha = __builtin_amdgcn_exp2f(m - mnew);
        l *= alpha;
#pragma unroll
        for (int i = 0; i < 8; ++i) o[i] *= alpha;
        m = mnew;
    }
    float ps = 0.f;
#pragma unroll
    for (int c = 0; c < 4; ++c)
#pragma unroll
        for (int r = 0; r < 4; ++r) { const float p = __builtin_amdgcn_exp2f(__builtin_fmaf(st[c][r], sc, -m)); st[c][r] = p; ps += p; }
    l += ps;
#pragma unroll
    for (int c0i = 0; c0i < 2; ++c0i) {
        v4u pw; pw.x = pk2(st[2 * c0i][0], st[2 * c0i][1]); pw.y = pk2(st[2 * c0i][2], st[2 * c0i][3]);
        pw.z = pk2(st[2 * c0i + 1][0], st[2 * c0i + 1][1]); pw.w = pk2(st[2 * c0i + 1][2], st[2 * c0i + 1][3]);
        const pg8::bf16x8 pb = __builtin_bit_cast(pg8::bf16x8, pw);
        const unsigned vaddr = (unsigned)(size_t)(lds + buf * AT_STAGE + AT_VOFF) + (unsigned)((32 * c0i + 4 * g + (qq >> 2)) * VROW + 8 * (qq & 3));
        s16x4 vr[16];
        AT_TR16(vaddr, vr);
#pragma unroll
        for (int i = 0; i < 8; ++i) {
            const pg8::bf16x8 a = __builtin_shufflevector(vr[2 * i], vr[2 * i + 1], 0, 1, 2, 3, 4, 5, 6, 7);
            o[i] = __builtin_amdgcn_mfma_f32_16x16x32_bf16(a, pb, o[i], 0, 0, 0);
        }
    }
}
template <int DQ, bool MOBA>
__device__ __forceinline__ void attn_unit(LAS unsigned char* lds, const bf16* Qg, int ldq, const bf16* Kg, int ldk, const bf16* Vg, int ldv,
                                          bf16* Og, int ldo, const unsigned char* sel, int qt, float sc, const int tid) {
    constexpr int KROW = (DQ + 8) * 2, VROW = 288, KCH = DQ / 8, NKC = 64 * KCH / 512, NDS = DQ / 32;
    const int lane = tid & 63, w = __builtin_amdgcn_readfirstlane(tid >> 6), qq = lane & 15, g = lane >> 4;
    const int q0 = qt * 128, qrow = q0 + 16 * w + qq, own = q0 >> 8;
    pg8::bf16x8 qf[NDS];
#pragma unroll
    for (int ds = 0; ds < NDS; ++ds) qf[ds] = *(const pg8::bf16x8*)(Qg + (size_t)qrow * ldq + 32 * ds + 8 * g);
    unsigned selbits = 0; if (MOBA) selbits = sel[(size_t)qrow * 8];
    f32x4 o[8];
#pragma unroll
    for (int i = 0; i < 8; ++i) o[i] = (f32x4){0.f, 0.f, 0.f, 0.f};
    float m = -1e30f, l = 0.f;
    const int ntiles = 2 * (qt + 1);
    v4u kA[NKC], vA[2], kB[NKC], vB[2];
    { const v4u z_ = {0u, 0u, 0u, 0u};
#pragma unroll
      for (int i_ = 0; i_ < NKC; ++i_) { kA[i_] = z_; kB[i_] = z_; }
      vA[0] = z_; vA[1] = z_; vB[0] = z_; vB[1] = z_; }
    unsigned kgo[NKC], vgo[2], klo[NKC], vlo[2];
#pragma unroll
    for (int i_ = 0; i_ < NKC; ++i_) { const int id_ = tid + 512 * i_, row_ = id_ / KCH, ch_ = id_ % KCH; kgo[i_] = (unsigned)(row_ * ldk + ch_ * 8) * 2u; klo[i_] = (unsigned)(row_ * KROW + ch_ * 16); }
#pragma unroll
    for (int i_ = 0; i_ < 2; ++i_) { const int id_ = tid + 512 * i_, row_ = id_ >> 4, ch_ = id_ & 15; vgo[i_] = (unsigned)(row_ * ldv + ch_ * 8) * 2u; vlo[i_] = (unsigned)(AT_VOFF + row_ * VROW + ch_ * 16); }
#define AT_GLOAD(KS, VS, tile) do { const char* kp_ = (const char*)Kg + (size_t)(tile) * 64 * ldk * 2; const char* vp_ = (const char*)Vg + (size_t)(tile) * 64 * ldv * 2; \
        _Pragma("unroll") for (int i_ = 0; i_ < NKC; ++i_) KS[i_] = *(const v4u*)(kp_ + kgo[i_]); \
        _Pragma("unroll") for (int i_ = 0; i_ < 2; ++i_) VS[i_] = *(const v4u*)(vp_ + vgo[i_]); } while (0)
#define AT_LSTORE(KS, VS, buf) do { _Pragma("unroll") for (int i_ = 0; i_ < NKC; ++i_) *(LAS v4u*)(lds + (buf) * AT_STAGE + klo[i_]) = KS[i_]; \
        _Pragma("unroll") for (int i_ = 0; i_ < 2; ++i_) *(LAS v4u*)(lds + (buf) * AT_STAGE + vlo[i_]) = VS[i_]; } while (0)
    AT_GLOAD(kA, vA, 0); AT_LSTORE(kA, vA, 0);
    AT_GLOAD(kA, vA, 1);
    __syncthreads();
    for (int it = 0; it < ntiles; it += 2) {
        if (it + 2 < ntiles) AT_GLOAD(kB, vB, it + 2);
        attn_tile<DQ, MOBA>(lds, 0, it, q0, w, qq, g, qrow, own, selbits, sc, qf, o, m, l);
        AT_LSTORE(kA, vA, 1);
        __syncthreads();
        if (it + 3 < ntiles) AT_GLOAD(kA, vA, it + 3);
        attn_tile<DQ, MOBA>(lds, 1, it + 1, q0, w, qq, g, qrow, own, selbits, sc, qf, o, m, l);
        if (it + 2 < ntiles) AT_LSTORE(kB, vB, 0);
        __syncthreads();
    }
    float ls = l + shfl_xor_(l, 16, lane); ls += shfl_xor_(ls, 32, lane);
    const float inv = 1.0f / ls;
#pragma unroll
    for (int i = 0; i < 8; ++i) { v2u ob; ob.x = pk2(o[i][0] * inv, o[i][1] * inv); ob.y = pk2(o[i][2] * inv, o[i][3] * inv);
        *(v2u*)(Og + (size_t)qrow * ldo + 16 * i + 4 * g) = ob; }
#undef AT_GLOAD
#undef AT_LSTORE
}
template <bool BT, class Epi>
__device__ __forceinline__ void gemm32(LAS float* lds, const float* A, int lda, size_t sA, const float* B, int ldb, size_t sB,
                                       int M, int N, int K, int nbatch, const int* rowidx, const Epi& epi, const int tid, const int G) {
    const int lane = tid & 63, wave = tid >> 6, wm = wave >> 1, wn = wave & 1;
    const int tilesM = (M + 127) >> 7, tilesN = (N + 127) >> 7, tilesPer = tilesM * tilesN, ntiles = tilesPer * nbatch;
    LAS float* As = lds;
    LAS float* Bs = lds + 2 * 16 * 132;
    for (int tile = blockIdx.x; tile < ntiles; tile += G) {
        const int bt = tile / tilesPer, r = tile % tilesPer, tm = r / tilesN, tn = r % tilesN;
        const int m0 = tm * 128, n0 = tn * 128;
        const float* Ab = A + (size_t)bt * sA; const float* Bb = B + (size_t)bt * sB;
        const int arow = tid >> 2, akq = (tid & 3) * 4;
        const int gr = m0 + arow; const bool aok = gr < M;
        const int src = aok ? (rowidx ? rowidx[gr] : gr) : 0;
        const float* ap = Ab + (size_t)src * lda + akq;
        const float* bp; bool bok; int bkr, bnq;
        if (BT) { bkr = 0; bnq = 0; const int gn = n0 + arow; bok = gn < N; bp = Bb + (size_t)(bok ? gn : 0) * ldb + akq; }
        else { bkr = tid >> 5; bnq = (tid & 31) * 4; bok = (n0 + bnq) < N; bp = Bb + (size_t)bkr * ldb + (bok ? (n0 + bnq) : 0); }
        f32x16 acc0, acc1;
#pragma unroll
        for (int i = 0; i < 16; ++i) { acc0[i] = 0.f; acc1[i] = 0.f; }
        f32x4 ra, rb;
        const f32x4 z4 = {0.f, 0.f, 0.f, 0.f};
        ra = aok ? *(const f32x4*)ap : z4;
        rb = bok ? *(const f32x4*)bp : z4;
        {
            LAS float* a_ = As; LAS float* b_ = Bs;
#pragma unroll
            for (int j = 0; j < 4; ++j) a_[(akq + j) * 132 + arow] = ra[j];
            if (BT) {
#pragma unroll
                for (int j = 0; j < 4; ++j) b_[(akq + j) * 132 + arow] = rb[j];
            } else *(LAS f32x4*)(b_ + bkr * 132 + bnq) = rb;
        }
        __syncthreads();
        for (int k0 = 0; k0 < K; k0 += 16) {
            const int cur = (k0 >> 4) & 1;
            const bool more = (k0 + 16) < K;
            if (more) {
                ra = aok ? *(const f32x4*)(ap + k0 + 16) : z4;
                if (BT) rb = bok ? *(const f32x4*)(bp + k0 + 16) : z4;
                else rb = bok ? *(const f32x4*)(bp + (size_t)(k0 + 16) * ldb) : z4;
            }
            const LAS float* a_ = As + cur * 16 * 132 + (lane >> 5) * 132 + wm * 32 + (lane & 31);
            const LAS float* b_ = Bs + cur * 16 * 132 + (lane >> 5) * 132 + wn * 64 + (lane & 31);
#pragma unroll
            for (int kk = 0; kk < 16; kk += 2) {
                const float a = a_[kk * 132], b0 = b_[kk * 132], b1 = b_[kk * 132 + 32];
                acc0 = __builtin_amdgcn_mfma_f32_32x32x2f32(a, b0, acc0, 0, 0, 0);
                acc1 = __builtin_amdgcn_mfma_f32_32x32x2f32(a, b1, acc1, 0, 0, 0);
            }
            if (more) {
                LAS float* aw = As + (cur ^ 1) * 16 * 132; LAS float* bw = Bs + (cur ^ 1) * 16 * 132;
#pragma unroll
                for (int j = 0; j < 4; ++j) aw[(akq + j) * 132 + arow] = ra[j];
                if (BT) {
#pragma unroll
                    for (int j = 0; j < 4; ++j) bw[(akq + j) * 132 + arow] = rb[j];
                } else *(LAS f32x4*)(bw + bkr * 132 + bnq) = rb;
            }
            __syncthreads();
        }
#pragma unroll
        for (int i = 0; i < 16; ++i) {
            const int row = m0 + wm * 32 + (i & 3) + 8 * (i >> 2) + 4 * (lane >> 5);
            const int c0 = n0 + wn * 64 + (lane & 31);
            if (row < M) {
                if (c0 < N) epi(bt, row, c0, acc0[i]);
                if (c0 + 32 < N) epi(bt, row, c0 + 32, acc1[i]);
            }
        }
    }
}

struct EpiStore { float* C; int ldc; size_t sC;
    __device__ __forceinline__ void operator()(int bt, int m, int n, float v) const { C[(size_t)bt * sC + (size_t)m * ldc + n] = v; } };
struct EpiDecay { float* C; const float* w0;
    __device__ __forceinline__ void operator()(int, int m, int n, float v) const {
        const float z = -(w0[n] + v); const float sp = z > 20.f ? z : log1pf(expf(z));
        C[(size_t)m * BW + n] = expf(-expf(-sp - 0.5f)); } };
struct EpiSigB { float* C; const float* b;
    __device__ __forceinline__ void operator()(int, int m, int n, float v) const { C[(size_t)m * BW + n] = sigmoidf_(b[n] + v); } };
struct EpiVLerp { float* V; const float* VF; const float* v0;
    __device__ __forceinline__ void operator()(int, int m, int n, float a) const {
        const size_t o = (size_t)m * BW + n; const float v = V[o]; V[o] = v + (VF[o] - v) * sigmoidf_(v0[n] + a); } };
template <bool FIRST> struct EpiGateAcc { float* MIX; const float* gate;
    __device__ __forceinline__ void operator()(int, int m, int n, float a) const {
        const float g = sigmoidf_(gate[(size_t)m * IN_COLS + n]); const size_t o = (size_t)m * D + n;
        MIX[o] = FIRST ? g * a : MIX[o] + g * a; } };
struct EpiResid { float* C; const float* R; int ldc;
    __device__ __forceinline__ void operator()(int, int m, int n, float a) const { const size_t o = (size_t)m * ldc + n; C[o] = ALPHA * R[o] + a; } };
struct EpiSwiglu { float* C; int ldc; size_t roff;
    __device__ __forceinline__ void operator()(int, int m, int n, float a) const {
        const size_t o = (roff + (size_t)m) * ldc + n; const float g = C[o]; C[o] = g * sigmoidf_(g) * a; } };

struct Args { const float* in[34]; float* out; unsigned char* ws; unsigned mask; int li; };

__device__ __forceinline__ unsigned char* opq(unsigned char* p) { asm volatile("" : "+s"(p)); return p; }
#define INP(i) ((const float*)(((const GAS float* const*)args.in)[(i) + zero_live]))
#define x_in INP(0)
#define w_in INP(1)
#define w_in_vres INP(2)
#define rwkv_mu INP(3)
#define rwkv_mu_vres INP(4)
#define rwkv_w0 INP(5)
#define rwkv_w_lora INP(6)
#define rwkv_a0 INP(7)
#define rwkv_a_lora INP(8)
#define rwkv_g_lora INP(9)
#define rwkv_v0 INP(10)
#define rwkv_v_lora INP(11)
#define rwkv_k_k INP(12)
#define rwkv_k_a INP(13)
#define rwkv_r_k INP(14)
#define rwkv_gn_g INP(15)
#define rwkv_gn_b INP(16)
#define mla_q_norm INP(17)
#define mla_w_uq INP(18)
#define mla_kv_norm INP(19)
#define mla_w_ukv INP(20)
#define branch_out INP(21)
#define w_out INP(22)
#define ln1_g INP(23)
#define ln1_b INP(24)
#define ffn_wg INP(25)
#define ffn_wu INP(26)
#define ffn_wd INP(27)
#define moe_router INP(28)
#define moe_wg INP(29)
#define moe_wu INP(30)
#define moe_wd INP(31)
#define ln2_g INP(32)
#define ln2_b INP(33)
#define COSA ((float*)(ws_live + WS_COSA))
#define SINA ((float*)(ws_live + WS_SINA))
#define COSM ((float*)(ws_live + WS_COSM))
#define SINM ((float*)(ws_live + WS_SINM))
#define TOK ((int*)(ws_live + WS_TOK))
#define ROWL ((int*)(ws_live + WS_ROWL))
#define XB ((float*)(ws_live + WS_XB))
#define X1 ((float*)(ws_live + WS_X1))
#define PRE ((float*)(ws_live + WS_PRE))
#define XBF ((bf16*)(ws_live + WS_XBF))
#define WINT ((bf16*)(ws_live + WS_WINT))
#define X1B ((bf16*)(ws_live + WS_X1B))
#define WBO ((bf16*)(ws_live + WS_WBO))
#define WOT ((bf16*)(ws_live + WS_WOT))
#define WGU ((bf16*)(ws_live + WS_WGU))
#define WD ((bf16*)(ws_live + WS_WD))
#define WDD ((bf16*)(ws_live + WS_WDD))
#define HGB ((bf16*)(ws_live + WS_HGB))
#define XG ((bf16*)(ws_live + WS_XG))
#define MIXB ((bf16*)(ws_live + WS_MIXB))
#define YALL ((bf16*)(ws_live + WS_YALL))
#define GATEB ((bf16*)(ws_live + WS_GATEB))
#define QAB ((bf16*)(ws_live + WS_QAB))
#define KAB ((bf16*)(ws_live + WS_KAB))
#define VAB ((bf16*)(ws_live + WS_VAB))
#define QCB ((bf16*)(ws_live + WS_QCB))
#define KCB ((bf16*)(ws_live + WS_KCB))
#define VCB ((bf16*)(ws_live + WS_VCB))
#define KMEAN ((float*)(ws_live + WS_KMEAN))
#define SELB ((unsigned char*)(ws_live + WS_SEL))
#define WUQ ((bf16*)(ws_live + WS_WUQ))
#define WUKV ((bf16*)(ws_live + WS_WUKV))
#define WLORA ((bf16*)(ws_live + WS_WLORA))
#define LA ((bf16*)(ws_live + WS_LA))
#define QNB ((bf16*)(ws_live + WS_QNB))
#define KVNB ((bf16*)(ws_live + WS_KVNB))
#define QF ((float*)(ws_live + WS_QF))
#define KMS ((float*)(ws_live + WS_KMEAN))
#define PROJ ((float*)(ws_live + WS_PROJ))
#define VRES ((float*)(ws_live + WS_VRES))
#define QA ((float*)(ws_live + WS_QA))
#define R_ ((float*)(ws_live + WS_R))
#define K2 ((float*)(ws_live + WS_K2))
#define V0 ((float*)(ws_live + WS_V0))
#define V1 ((float*)(ws_live + WS_V1))
#define DEC ((float*)(ws_live + WS_DEC))
#define AA ((float*)(ws_live + WS_AA))
#define GG ((float*)(ws_live + WS_GG))
#define Y ((float*)(ws_live + WS_Y))
#define OUT ((float*)(ws_live + WS_OUT))


__global__ void __launch_bounds__(NTHREADS, 2) fwd_kernel(Args args) {
    extern __shared__ __attribute__((aligned(16))) unsigned char lds_raw[];
#define lds ((LAS float*)lds_raw)
    int wave_live = __builtin_amdgcn_readfirstlane((int)threadIdx.x >> 6);
    int tid_live = threadIdx.x;
#define RETID() do { int ln_; asm volatile("v_mbcnt_lo_u32_b32 %0, -1, 0\n\tv_mbcnt_hi_u32_b32 %0, -1, %0" : "=v"(ln_)); asm volatile("" : "+s"(wave_live)); tid_live = wave_live * 64 + ln_; } while (0)
#define tid tid_live
#define lane (tid_live & 63)
#define wave (__builtin_amdgcn_readfirstlane(tid_live >> 6))
#define gw ((int)blockIdx.x * NWAVES + wave)
#define NGW (G_live * NWAVES)
#define gt ((int)blockIdx.x * NTHREADS + tid_live)
#define NGT (G_live * NTHREADS)
#define misc ((volatile LAS unsigned*)((LAS unsigned char*)lds_raw + LDS_BYTES - 64))
    if (tid < 16) misc[tid] = tid == 6 ? 0xffffffffu : 0u;
    __syncthreads();
#define REOPAQUE() do { asm volatile("" : "+s"(ws_live)); asm volatile("" : "+s"(zero_live)); asm volatile("" : "+s"(G_live)); RETID(); } while (0)
#define TI_WINT(t_, ll_, r_) do { constexpr int NNB_ = NP / 32; const int kb_ = (r_) / NNB_, nb_ = (r_) % NNB_, c_ = nb_ * 32; \
    const float* W_ = w_in + (size_t)(ll_) * D * IN_COLS; int ldw_ = IN_COLS, sc_ = c_; \
    if (c_ < 6432) sc_ = c_; \
    else if (c_ < 6464) { if (ll_) { W_ = w_in_vres; ldw_ = 32; sc_ = 0; } else W_ = nullptr; } \
    else if (c_ < 7552) sc_ = c_ - 32; \
    else if (c_ < 7680) W_ = nullptr; \
    else sc_ = c_ - 160; \
    int scl_ = sc_ + (lane & 31); \
    if (c_ < 2048) { const int cl_ = c_ + (lane & 31), hh_ = cl_ >> 7, cc_ = cl_ & 127, e_ = cc_ & 7; scl_ = hh_ * 128 + (e_ < 4 ? 4 * (cc_ >> 3) + e_ : 64 + 4 * (cc_ >> 3) + (e_ - 4)); } \
    (t_).zero = W_ == nullptr; (t_).p = (W_ ? W_ : w_in) + scl_; (t_).ldw = ldw_; (t_).wt = WINT + (size_t)(ll_) * NP * D; (t_).K = D; (t_).r0 = c_; (t_).k0 = kb_ * 64; } while (0)
#define TI_WBO(t_, mat_, r_) do { const int kb_ = (r_) / 64, nb_ = (r_) % 64, ll_ = (mat_) / 3, seg_ = (mat_) % 3; \
    (t_).zero = false; (t_).p = branch_out + (size_t)(mat_) * BW * D + nb_ * 32 + (lane & 31); (t_).ldw = D; (t_).wt = WBO + (size_t)ll_ * D * 3 * BW + seg_ * BW; (t_).K = 3 * BW; (t_).r0 = nb_ * 32; (t_).k0 = kb_ * 64; } while (0)
#define TI_WUQ(t_, mat_, r_) do { const int kb_ = (r_) / 48, nb_ = (r_) % 48; \
    const int np_ = nb_ * 32 + (lane & 31), hh_ = np_ / 192, cc_ = np_ - hh_ * 192, q_ = cc_ - 128, e_ = q_ & 7; \
    const int sc_ = cc_ < 128 ? hh_ * 192 + cc_ : hh_ * 192 + 128 + (e_ < 4 ? 4 * (q_ >> 3) + e_ : 32 + 4 * (q_ >> 3) + (e_ - 4)); \
    (t_).zero = false; (t_).p = mla_w_uq + (size_t)(mat_) * 512 * 1536 + sc_; (t_).ldw = 1536; (t_).wt = WUQ + (size_t)(mat_) * 1536 * 512; (t_).K = 512; (t_).r0 = nb_ * 32; (t_).k0 = kb_ * 64; } while (0)
#define TI_WUKV(t_, mat_, r_) do { const int kb_ = (r_) / 64, nb_ = (r_) % 64; \
    (t_).zero = false; (t_).p = mla_w_ukv + (size_t)(mat_) * 512 * 2048 + nb_ * 32 + (lane & 31); (t_).ldw = 2048; (t_).wt = WUKV + (size_t)(mat_) * 2048 * 512; (t_).K = 512; (t_).r0 = nb_ * 32; (t_).k0 = kb_ * 64; } while (0)
#define TI_WOT(t_, mat_, r_) do { const int kb_ = (r_) / 64, nb_ = (r_) % 64; \
    (t_).zero = false; (t_).p = w_out + (size_t)(mat_) * D * D + nb_ * 32 + (lane & 31); (t_).ldw = D; (t_).wt = WOT + (size_t)(mat_) * D * D; (t_).K = D; (t_).r0 = nb_ * 32; (t_).k0 = kb_ * 64; } while (0)
constexpr int FC_I_GU = (D / 64) * (NGU / 32), FC_I_D = (DFF / 64) * (D / 32);
#define TI_GU(t_, wg_, wu_, e_, r_) do { const int kb_ = (r_) / (NGU / 32), nb_ = (r_) % (NGU / 32); const int rr_ = lane & 31, hcol_ = 4 * (nb_ * 4 + (rr_ >> 3)) + (rr_ & 3); \
    (t_).zero = false; (t_).p = ((rr_ & 7) < 4 ? (wg_) : (wu_)) + (size_t)(e_) * D * DFF + hcol_; (t_).ldw = DFF; (t_).wt = WGU + (size_t)(e_) * NGU * D; (t_).K = D; (t_).r0 = nb_ * 32; (t_).k0 = kb_ * 64; } while (0)
#define TI_D(t_, wd_, dst_, e_, r_) do { const int kb_ = (r_) / (D / 32), nb_ = (r_) % (D / 32); \
    (t_).zero = false; (t_).p = (wd_) + (size_t)(e_) * DFF * D + nb_ * 32 + (lane & 31); (t_).ldw = D; (t_).wt = (dst_) + (size_t)(e_) * D * DFF; (t_).K = DFF; (t_).r0 = nb_ * 32; (t_).k0 = kb_ * 64; } while (0)
#define TI_RUN1(ta_) do { float va_[32]; ti_load(ta_, va_, lane); ti_finish(ta_, va_, scr, lane); } while (0)
#define TI_RUN2(ta_, tb_) do { float va_[32], vb_[32]; ti_load(ta_, va_, lane); ti_load(tb_, vb_, lane); ti_finish(ta_, va_, scr, lane); ti_finish(tb_, vb_, scr, lane); } while (0)
#define CV_WINT_ITEM(ll_, r_) do { TI t1_; TI_WINT(t1_, ll_, r_); TI_RUN1(t1_); } while (0)
#define CV_WUQ_ITEM(mat_, r_) do { TI t1_; TI_WUQ(t1_, mat_, r_); TI_RUN1(t1_); } while (0)
#define CV_WUKV_ITEM(mat_, r_) do { TI t1_; TI_WUKV(t1_, mat_, r_); TI_RUN1(t1_); } while (0)
#define CV_LORA_ITEM(ll_, r_) do { \
    for (int j_ = 0; j_ < 32; ++j_) { const int x_ = (r_) * 2048 + j_ * 64 + lane, n_ = x_ / 384, k_ = x_ % 384, seg_ = n_ >> 10, c_ = n_ & 1023; \
        float v_ = 0.f; \
        if (seg_ == 0) { if (k_ < 64) v_ = rwkv_w_lora[((size_t)(ll_) * 64 + k_) * BW + c_]; } \
        else if (seg_ == 1) { if (k_ >= 64 && k_ < 128) v_ = rwkv_a_lora[((size_t)(ll_) * 64 + (k_ - 64)) * BW + c_]; } \
        else if (seg_ == 2) { if (k_ >= 128 && k_ < 288) v_ = rwkv_g_lora[((size_t)(ll_) * 160 + (k_ - 128)) * BW + c_]; } \
        else { if ((ll_) == 1 && k_ >= 288 && k_ < 320) v_ = rwkv_v_lora[(size_t)(k_ - 288) * BW + c_]; } \
        WLORA[(size_t)(ll_) * 4096 * 384 + x_] = (bf16)f2bf(v_); } } while (0)
#define FFN_CONV_PAIR(it_) do { const int fi_ = (it_); \
    if (l == 0) { if (fi_ < FC_I_GU) PAIR_OF(TI_GU, ffn_wg, ffn_wu, 0, fi_); else PAIR_OF(TI_D, ffn_wd, WDD, 0, fi_ - FC_I_GU); } \
    else PAIR_OF(TI_GU, moe_wg, moe_wu, fi_ / FC_I_GU, fi_ % FC_I_GU); } while (0)
#define FFN_CONV_N(l_) ((l_) == 0 ? FC_I_GU + FC_I_D : 4 * FC_I_GU)
#define PAIR_OF(TIM_, ...) do { TI ta_, tb_; TIM_(ta_, __VA_ARGS__); TIM_(tb_, __VA_ARGS__ + 1); TI_RUN2(ta_, tb_); } while (0)
#define DQ_PAIR(d_) do { const int d__ = (d_); \
    if (d__ < 3072) { PAIR_OF(TI_WBO, d__ >> 10, (d__ & 1023)); asm volatile("; dq0" ::: "memory"); } \
    else if (d__ < 5120) { PAIR_OF(TI_WOT, 0, d__ - 3072); asm volatile("; dq1" ::: "memory"); } \
    else if (d__ < 18944) { PAIR_OF(TI_WINT, 1, d__ - 5120); asm volatile("; dq2" ::: "memory"); } \
    else if (d__ < 19712) { }   \
    else if (d__ < 20096) { PAIR_OF(TI_WUQ, 1, d__ - 19712); asm volatile("; dq3" ::: "memory"); } \
    else if (d__ < 20608) { PAIR_OF(TI_WUKV, 1, d__ - 20096); asm volatile("; dq4" ::: "memory"); } \
    else if (d__ < 23680) { PAIR_OF(TI_WBO, 3 + ((d__ - 20608) >> 10), ((d__ - 20608) & 1023)); asm volatile("; dq5" ::: "memory"); } \
    else if (d__ < 25728) { PAIR_OF(TI_WOT, 1, d__ - 23680); asm volatile("; dq6" ::: "memory"); } \
    else if (d__ < DQ_J7) { PAIR_OF(TI_GU, moe_wg, moe_wu, 4 + (d__ - 25728) / FC_I_GU, (d__ - 25728) % FC_I_GU); asm volatile("; dq7" ::: "memory"); } \
    else { PAIR_OF(TI_D, moe_wd, WD, (d__ - DQ_J7) / FC_I_D, (d__ - DQ_J7) % FC_I_D); asm volatile("; dq8" ::: "memory"); } } while (0)
#define DQ_HALF(base_) do { const int dit_ = (int)(base_) + 2 * wave; if (dit_ < DQ_N) DQ_PAIR(dit_); } while (0)
#define DQ_PENDING() do { const unsigned pu_ = (unsigned)__builtin_amdgcn_readfirstlane((int)misc[6]); __syncthreads(); \
        if (pu_ != 0xffffffffu) { if (tid == 0) misc[6] = 0xffffffffu; DQ_HALF(pu_); } } while (0)
#define DQ_RUN(COND_) do { DQ_PENDING(); for (;;) { \
        if (tid == 0) { unsigned u_ = 0xffffffffu; \
            if (xb_ld(ctl + CW_DQ + 64 * li_) < (unsigned)DQ_N && (COND_)) u_ = atomicAdd(ctl + CW_DQ + 64 * li_, 32u); \
            misc[4] = u_; } \
        __syncthreads(); \
        const unsigned du_ = (unsigned)__builtin_amdgcn_readfirstlane((int)misc[4]); \
        __syncthreads(); \
        if (du_ >= (unsigned)DQ_N) break; \
        DQ_HALF(du_); \
        if (tid == 0) misc[5] = (COND_) ? 1u : 0u; \
        __syncthreads(); \
        const unsigned go_ = (unsigned)__builtin_amdgcn_readfirstlane((int)misc[5]); \
        __syncthreads(); \
        if (!go_) { if (tid == 0) misc[6] = du_ + 16u; __syncthreads(); break; } \
        DQ_HALF(du_ + 16u); \
    } } while (0)
#define DQ_FLUSH(UPTO_) do { DQ_PENDING(); for (;;) { \
        if (tid == 0) { const unsigned h_ = xb_ld(ctl + CW_DQ + 64 * li_); unsigned u_ = 0xffffffffu, nb_ = 0u; \
            if (h_ < (unsigned)(UPTO_)) { nb_ = ((((unsigned)(UPTO_) - h_ + (unsigned)G_live - 1u) / (unsigned)G_live) + 7u) & ~7u; nb_ = nb_ < 16u ? 16u : nb_; u_ = atomicAdd(ctl + CW_DQ + 64 * li_, nb_); } \
            misc[4] = u_; misc[5] = nb_; } \
        __syncthreads(); \
        const unsigned du_ = (unsigned)__builtin_amdgcn_readfirstlane((int)misc[4]), dn_ = (unsigned)__builtin_amdgcn_readfirstlane((int)misc[5]); \
        __syncthreads(); \
        if (du_ >= (unsigned)DQ_N) break; \
        const int de_ = (int)min(du_ + dn_, (unsigned)DQ_N); \
        _Pragma("unroll 1") \
        for (int dit_ = (int)du_ + 2 * wave; dit_ < de_; dit_ += 16) DQ_PAIR(dit_); \
    } } while (0)
#define DQ_FILL(SLOT_, TH_) DQ_RUN(xb_ld(ctl + CW_PD + 64 * ((SLOT_) + 8 * li_)) < (unsigned)(TH_))
#define PHASE_DONE(SLOT_) do { if (tid == 0) atomicAdd(ctl + CW_PD + 64 * ((SLOT_) + 8 * li_), 1u); } while (0)
#define GRID_BAR() do { { XcdBarrier bar_; bar_.bar = ctl + CW_BAR + li_ * XCD_BAR_WORDS; bar_.x = xb_xcc_id(); bar_.st = misc; xcd_barrier(bar_, tid_live); } asm volatile("" : "+s"(ws_live)); asm volatile("" : "+s"(zero_live)); asm volatile("" : "+s"(G_live)); RETID(); } while (0)

    GAS unsigned char* ws_live = *(GAS unsigned char* const*)&args.ws; int zero_live = 0; int G_live = (int)gridDim.x; unsigned mask_live = args.mask; const int li_ = args.li;
#define RUN(p) ((mask_live >> (l * 12 + (p))) & 1u)
#define ctl ((unsigned*)(ws_live + WS_CTL))
    (void)xcd_barrier_post(ctl + CW_BAR + li_ * XCD_BAR_WORDS, misc, tid_live);
    if (mask_live & (1u << 31)) {
    for (int i = gt; i < SEQ * 64; i += NGT) {
        const int s = i >> 6, j = i & 63;
        const float inv = 1.0f / powf(10000.0f, (float)(2 * j) / 128.0f);
        const float ang = (float)s * inv;
        COSA[i] = cosf(ang); SINA[i] = sinf(ang);
    }
    for (int i = gt; i < SEQ * 32; i += NGT) {
        const int s = i >> 5, j = i & 31;
        const float inv = 1.0f / powf(10000.0f, (float)(2 * j) / 64.0f);
        const float ang = (float)s * inv;
        COSM[i] = cosf(ang); SINM[i] = sinf(ang);
    }

    {
        LAS float* scr = (LAS float*)((LAS unsigned char*)lds_raw) + wave * (64 * 33);
        for (int it = gw; it < (D / 64) * (NP / 32); it += NGW) CV_WINT_ITEM(0, it);
        for (int it = gw; it < 2 * 768; it += NGW) { const int ll = it / 768, r = it % 768; CV_LORA_ITEM(ll, r); }
        for (int it = gw; it < 8 * 48; it += NGW) CV_WUQ_ITEM(0, it);
        for (int it = gw; it < 8 * 64; it += NGW) CV_WUKV_ITEM(0, it);
        for (int t = gw; t < T; t += NGW) {
#pragma unroll
            for (int jj = 0; jj < 8; ++jj) { const f32x4 v = *(const f32x4*)(x_in + (size_t)t * D + jj * 256 + lane * 4);
                v2u o; o.x = pk2(v[0], v[1]); o.y = pk2(v[2], v[3]); *(v2u*)(XBF + (size_t)t * D + jj * 256 + lane * 4) = o; }
        }
    }
    GRID_BAR();
    }
    for (int l = 0; l < 2; ++l) {
        const float* X = (l == 0) ? x_in : XB;
        float* Vcur = (l == 0) ? V0 : V1;
        if (RUN(0)) {
        {
            pg8::Gemm g{XBF, WINT + (size_t)l * NP * D, T, NP, D}; pg8::StaticOrder S; S.init(T, NP, G_live, (int)blockIdx.x);
            EpiInProjF32 E{PROJ, VRES, GATEB, QF, KAB, VAB, COSA, SINA, l};
            pg8::gemm_phase<EpiInProjF32, pg8::StaticOrder, false>((LAS unsigned char*)lds_raw, g, S, E, nullptr, tid);
        }
        REOPAQUE();
        {
            LAS float* scr = (LAS float*)((LAS unsigned char*)lds_raw) + wave * (64 * 33);
            PHASE_DONE(l * 4 + 0);
            DQ_FILL(l * 4 + 0, 65);
        }
        GRID_BAR();
        }
        if (RUN(1)) {
        if (l == 1) { LAS float* scr = (LAS float*)((LAS unsigned char*)lds_raw) + wave * (64 * 33); DQ_FLUSH(DQ_J5); }
        for (int item = blockIdx.x; item < NBATCH * 8 * 8; item += G_live) {
            const int blk = item & 7, h = (item >> 3) & 7, b = item >> 6;
            const int kq = tid >> 4, d8 = (tid & 15) * 8;
            const bf16* kbase = KAB + ((size_t)b * SEQ + blk * 256) * BW + h * 128 + d8;
            float sacc[8];
#pragma unroll
            for (int j = 0; j < 8; ++j) sacc[j] = 0.f;
#pragma unroll
            for (int it = 0; it < 8; ++it) { const v4u kv = *(const v4u*)(kbase + (size_t)(kq + 32 * it) * BW); const unsigned kw[4] = {kv.x, kv.y, kv.z, kv.w};
#pragma unroll
                for (int j = 0; j < 4; ++j) { sacc[2 * j] += __uint_as_float(kw[j] << 16); sacc[2 * j + 1] += __uint_as_float(kw[j] & 0xffff0000u); } }
#pragma unroll
            for (int j = 0; j < 8; ++j) lds[kq * 128 + d8 + j] = sacc[j];
            __syncthreads();
            if (tid < 128) { float a = 0.f;
#pragma unroll
                for (int rr = 0; rr < 32; ++rr) a += lds[rr * 128 + tid];
                KMS[(size_t)item * 128 + tid] = a; }
            __syncthreads();
        }
        {
            const float* mu = rwkv_mu + l * RWKV_COLS;
            for (int i0 = gt; i0 < T * 768; i0 += 4 * NGT) {
                f32x4 cur[4], prev[4], mu4[4]; int tt[4], cc[4];
#pragma unroll
                for (int u_ = 0; u_ < 4; ++u_) {
                    const int i = i0 + u_ * NGT, ic = i < T * 768 ? i : gt;
                    const int t = ic / 768, c4 = (ic - t * 768) * 4, s = t & (SEQ - 1);
                    tt[u_] = i < T * 768 ? t : -1; cc[u_] = c4;
                    cur[u_] = *(const f32x4*)(PROJ + (size_t)t * PLD + (OFF_RWKV - PSH) + c4);
                    prev[u_] = *(const f32x4*)(PROJ + (size_t)(s > 0 ? t - 1 : t) * PLD + (OFF_RWKV - PSH) + c4);
                    if (s == 0) prev[u_] = (f32x4){0.f, 0.f, 0.f, 0.f};
                    mu4[u_] = *(const f32x4*)(mu + c4);
                }
#pragma unroll
                for (int u_ = 0; u_ < 4; ++u_) if (tt[u_] >= 0) {
                    const f32x4 v = cur[u_] + (prev[u_] - cur[u_]) * mu4[u_];
                    float* dst = cc[u_] < 1024 ? R_ : (cc[u_] < 2048 ? K2 : Vcur);
                    *(f32x4*)(dst + (size_t)tt[u_] * BW + (cc[u_] & 1023)) = v;
                }
            }
            for (int i = gt; i < T * 96; i += NGT) {
                const int t = i / 96, c4 = (i - t * 96) * 4, s = t & (SEQ - 1);
                f32x4 v = {0.f, 0.f, 0.f, 0.f};
                if (c4 < 288) {
                    const f32x4 cur = *(const f32x4*)(PROJ + (size_t)t * PLD + (OFF_RWKV - PSH) + 3072 + c4);
                    f32x4 prev = {0.f, 0.f, 0.f, 0.f}; if (s > 0) prev = *(const f32x4*)(PROJ + (size_t)(t - 1) * PLD + (OFF_RWKV - PSH) + 3072 + c4);
                    v = cur + (prev - cur) * *(const f32x4*)(mu + 3072 + c4);
                    if (c4 < 64) { v[0] = tanhf(v[0]); v[1] = tanhf(v[1]); v[2] = tanhf(v[2]); v[3] = tanhf(v[3]); }
                    else if (c4 >= 128) { v[0] = sigmoidf_(v[0]); v[1] = sigmoidf_(v[1]); v[2] = sigmoidf_(v[2]); v[3] = sigmoidf_(v[3]); }
                } else if (c4 < 320 && l == 1) {
                    const f32x4 cur = *(const f32x4*)(VRES + (size_t)t * 32 + (c4 - 288));
                    f32x4 prev = {0.f, 0.f, 0.f, 0.f}; if (s > 0) prev = *(const f32x4*)(VRES + (size_t)(t - 1) * 32 + (c4 - 288));
                    v = cur + (prev - cur) * *(const f32x4*)(rwkv_mu_vres + (c4 - 288));
                }
                v2u o; o.x = pk2(v[0], v[1]); o.y = pk2(v[2], v[3]); *(v2u*)(LA + (size_t)t * 384 + c4) = o;
            }
        }
        for (int t = gw; t < T; t += NGW) {
            const float* q = PROJ + (size_t)t * PLD + (OFF_MLA - PSH);
#pragma unroll
            for (int part = 0; part < 2; ++part) {
                const f32x4 a = *(const f32x4*)(q + part * 512 + lane * 8), b2 = *(const f32x4*)(q + part * 512 + lane * 8 + 4);
                const float ss = (a[0] * a[0] + a[1] * a[1]) + (a[2] * a[2] + a[3] * a[3]) + (b2[0] * b2[0] + b2[1] * b2[1]) + (b2[2] * b2[2] + b2[3] * b2[3]);
                const float rs = rsqrtf(wave_sum(ss, lane) * (1.0f / 512.0f) + 1e-6f);
                const float* gn = (part ? mla_kv_norm : mla_q_norm) + l * 512 + lane * 8;
                const f32x4 g0 = *(const f32x4*)gn, g1 = *(const f32x4*)(gn + 4);
                v4u w; w.x = pk2(a[0] * rs * g0[0], a[1] * rs * g0[1]); w.y = pk2(a[2] * rs * g0[2], a[3] * rs * g0[3]);
                w.z = pk2(b2[0] * rs * g1[0], b2[1] * rs * g1[1]); w.w = pk2(b2[2] * rs * g1[2], b2[3] * rs * g1[3]);
                *(v4u*)((part ? KVNB : QNB) + (size_t)t * 512 + lane * 8) = w;
            }
            if (lane < 32) {
                const int s = t & (SEQ - 1);
                const float x1 = q[1024 + lane], x2 = q[1024 + 32 + lane], c = COSM[s * 32 + lane], sn = SINM[s * 32 + lane];
                const bf16 o1 = (bf16)f2bf(x1 * c - x2 * sn), o2 = (bf16)f2bf(x2 * c + x1 * sn);
#pragma unroll
                for (int hh = 0; hh < 8; ++hh) { KCB[(size_t)t * 1536 + hh * 192 + 128 + lane] = o1; KCB[(size_t)t * 1536 + hh * 192 + 160 + lane] = o2; }
            }
        }
        GRID_BAR();
        }
        if (RUN(2)) {
        {
            pg8::Gemm g{LA, WLORA + (size_t)l * 4096 * 384, T, l ? 4096 : 3072, 384 + zero_live}; pg8::StaticOrder S; S.init(T, l ? 4096 : 3072, G_live, (int)blockIdx.x);
            EpiLora E{DEC, AA, GG, V1, V0, rwkv_w0 + l * BW, rwkv_a0 + l * BW, rwkv_v0};
            pg8::gemm_phase<EpiLora, pg8::StaticOrder, false>((LAS unsigned char*)lds_raw, g, S, E, nullptr, tid);
        }
        REOPAQUE();
        {
            pg8::Gemm g{QNB, WUQ + (size_t)l * 1536 * 512, T, 1536, 512 + zero_live}; pg8::StaticOrder S; S.init(T, 1536, G_live, (int)blockIdx.x);
            EpiMlaQ E{QCB, COSM, SINM};
            pg8::gemm_phase<EpiMlaQ, pg8::StaticOrder, false>((LAS unsigned char*)lds_raw, g, S, E, nullptr, tid);
        }
        REOPAQUE();
        {
            pg8::Gemm g{KVNB, WUKV + (size_t)l * 2048 * 512, T, 2048, 512 + zero_live}; pg8::StaticOrder S; S.init(T, 2048, G_live, (int)blockIdx.x);
            EpiMlaKV E{KCB, VCB};
            pg8::gemm_phase<EpiMlaKV, pg8::StaticOrder, false>((LAS unsigned char*)lds_raw, g, S, E, nullptr, tid);
        }
        REOPAQUE();
        for (int i = gt; i < T * 8 * 16; i += NGT) {
            const int th = i >> 4, jg = (i & 15) * 4, t = th >> 3, h = th & 7, s = t & (SEQ - 1), own = s >> 8;
            const float* src_ = QF + (size_t)t * BW + h * 128 + jg;
            const f32x4 q1 = *(const f32x4*)src_, q2 = *(const f32x4*)(src_ + 64);
            v2u w1; w1.x = pk2(q1[0], q1[1]); w1.y = pk2(q1[2], q1[3]); v2u w2; w2.x = pk2(q2[0], q2[1]); w2.y = pk2(q2[2], q2[3]);
            *(v2u*)(QAB + (size_t)t * BW + h * 128 + jg) = w1; *(v2u*)(QAB + (size_t)t * BW + h * 128 + 64 + jg) = w2;
            const float* km = KMS + (size_t)(((t >> 11) * 8 + h) * 8) * 128 + jg;
            float gate[7];
#pragma unroll
            for (int n = 0; n < 7; ++n) {
                const f32x4 k1 = *(const f32x4*)(km + n * 128), k2 = *(const f32x4*)(km + n * 128 + 64);
                const float part = ((q1[0] * k1[0] + q1[1] * k1[1]) + (q1[2] * k1[2] + q1[3] * k1[3])) + ((q2[0] * k2[0] + q2[1] * k2[1]) + (q2[2] * k2[2] + q2[3] * k2[3]));
                gate[n] = row_allsum16(part);
            }
            unsigned bits = 0;
#pragma unroll
            for (int n = 0; n < 7; ++n) {
                int rank = 0;
#pragma unroll
                for (int m2 = 0; m2 < 7; ++m2) if (m2 != n) rank += (m2 < own && (gate[m2] > gate[n] || (gate[m2] == gate[n] && m2 < n))) ? 1 : 0;
                bits |= ((n < own) && (rank < 3)) ? (1u << n) : 0u;
            }
            if ((i & 15) == 0) SELB[(size_t)t * 8 + h] = (unsigned char)bits;
        }
        {
            LAS float* scr = (LAS float*)((LAS unsigned char*)lds_raw) + wave * (64 * 33);
            __syncthreads();
            PHASE_DONE(l * 4 + 2);
            DQ_FILL(l * 4 + 2, l == 0 ? 129 : 65);
        }
        GRID_BAR();
        }
        if (RUN(3)) {
        if (!(mask_live & (1u << 30)))
        for (int item = blockIdx.x; item < 128; item += G_live) {
            const int bh = item >> 1, half = item & 1, b = bh >> 4, h = bh & 15;
            const size_t base = (size_t)b * SEQ * BW + h * 64;
            constexpr int CH = 32, BUFF = 6 * CH * 64;
            LAS float* ypart = lds + 2 * BUFF;
            const int st_step = tid >> 4, st_j = (tid & 15) * 4;
            const int cbase = l * BW + h * 64 + st_j;
            const f32x4 ckk = *(const f32x4*)(rwkv_k_k + cbase), cka = *(const f32x4*)(rwkv_k_a + cbase);
            const int cg = lane & 15, rl = tid >> 4, irow = 32 * half + rl;
            const bool stager = tid < CH * 16;
            f32x4 g_r = {0.f, 0.f, 0.f, 0.f}, g_w = g_r, g_k = g_r, g_a = g_r, g_v = g_r;
            float sa = 0.f, sb = 0.f, sc2 = 0.f, sd = 0.f;
#define SC_GLOAD(c) do { if (stager) { const size_t o_ = base + (size_t)((c) * CH + st_step) * BW + st_j; \
                g_r = *(const f32x4*)(R_ + ((c) * CH + st_step > 0 ? o_ - BW : o_)); g_w = *(const f32x4*)(DEC + o_); g_k = *(const f32x4*)(K2 + o_); \
                g_a = *(const f32x4*)(AA + o_); g_v = *(const f32x4*)(Vcur + o_); } } while (0)
#define SC_LSTORE(bufi) do { if (stager) { f32x4 kk_ = g_k * ckk; \
                const float n2_ = row_allsum16((kk_[0] * kk_[0] + kk_[1] * kk_[1]) + (kk_[2] * kk_[2] + kk_[3] * kk_[3])); \
                kk_ = kk_ * __builtin_amdgcn_rcpf(fmaxf(sqrtf(n2_), 1e-12f)); \
                const f32x4 k2_ = g_k * (1.0f + (g_a - 1.0f) * cka); \
                LAS float* bb_ = lds + (bufi) * BUFF + st_step * 64 + st_j; \
                *(LAS f32x4*)(bb_ + 0 * CH * 64) = g_r; *(LAS f32x4*)(bb_ + 1 * CH * 64) = g_w; *(LAS f32x4*)(bb_ + 2 * CH * 64) = k2_; \
                *(LAS f32x4*)(bb_ + 3 * CH * 64) = kk_; *(LAS f32x4*)(bb_ + 4 * CH * 64) = kk_ * g_a; *(LAS f32x4*)(bb_ + 5 * CH * 64) = g_v; } } while (0)
#define SC_LD(X, st_) do { const LAS float* p_ = bb + (st_) * 64 + 4 * cg; \
                X##r = *(const LAS f32x4*)(p_ + 0 * CH * 64); X##w = *(const LAS f32x4*)(p_ + 1 * CH * 64); X##k = *(const LAS f32x4*)(p_ + 2 * CH * 64); \
                X##q = *(const LAS f32x4*)(p_ + 3 * CH * 64); X##b = *(const LAS f32x4*)(p_ + 4 * CH * 64); X##v = bb[5 * CH * 64 + (st_) * 64 + irow]; } while (0)
#define SC_STEP(X, st_) do { float d_, y_, t0_, t1_, t2_, t3_; \
                asm("v_mul_f32 %0, %4, %8\n\tv_mul_f32 %1, %4, %12\n\tv_mul_f32 %2, %6, %10\n\tv_mul_f32 %3, %6, %14\n\t" \
                    "v_fma_f32 %0, %5, %9, %0\n\tv_fma_f32 %1, %5, %13, %1\n\tv_fma_f32 %2, %7, %11, %2\n\tv_fma_f32 %3, %7, %15, %3\n\t" \
                    "v_add_f32 %0, %0, %2\n\tv_add_f32 %1, %1, %3" \
                    : "=&v"(d_), "=&v"(y_), "=&v"(t0_), "=&v"(t1_) \
                    : "v"(sa), "v"(sb), "v"(sc2), "v"(sd), "v"(X##q[0]), "v"(X##q[1]), "v"(X##q[2]), "v"(X##q[3]), "v"(X##r[0]), "v"(X##r[1]), "v"(X##r[2]), "v"(X##r[3])); \
                asm("s_nop 1\n\tv_add_f32_dpp %0, %0, %0 quad_perm:[1,0,3,2] row_mask:0xf bank_mask:0xf bound_ctrl:1\n\ts_nop 1\n\t" \
                    "v_add_f32_dpp %0, %0, %0 quad_perm:[2,3,0,1] row_mask:0xf bank_mask:0xf bound_ctrl:1" : "+v"(y_)); \
                ypart[(st_) * 128 + rl * 4 + (cg >> 2)] = y_;     \
                asm("v_mul_f32 %5, %9, %10\n\tv_mul_f32 %6, %9, %11\n\t" \
                    "v_add_f32_dpp %0, %0, %0 row_ror:8 row_mask:0xf bank_mask:0xf bound_ctrl:1\n\t" \
                    "v_mul_f32 %7, %9, %12\n\tv_mul_f32 %8, %9, %13\n\t" \
                    "v_add_f32_dpp %0, %0, %0 row_ror:4 row_mask:0xf bank_mask:0xf bound_ctrl:1\n\t" \
                    "v_fma_f32 %5, %1, %14, %5\n\tv_fma_f32 %6, %2, %15, %6\n\t" \
                    "v_add_f32_dpp %0, %0, %0 row_ror:2 row_mask:0xf bank_mask:0xf bound_ctrl:1\n\t" \
                    "v_fma_f32 %7, %3, %16, %7\n\tv_fma_f32 %8, %4, %17, %8\n\t" \
                    "v_add_f32_dpp %0, %0, %0 row_ror:1 row_mask:0xf bank_mask:0xf bound_ctrl:1\n\t" \
                    "s_nop 1\n\t" \
                    "v_fma_f32 %1, -%0, %18, %5\n\tv_fma_f32 %2, -%0, %19, %6\n\tv_fma_f32 %3, -%0, %20, %7\n\tv_fma_f32 %4, -%0, %21, %8" \
                    : "+v"(d_), "+v"(sa), "+v"(sb), "+v"(sc2), "+v"(sd), "=&v"(t0_), "=&v"(t1_), "=&v"(t2_), "=&v"(t3_) \
                    : "v"(X##v), "v"(X##k[0]), "v"(X##k[1]), "v"(X##k[2]), "v"(X##k[3]), "v"(X##w[0]), "v"(X##w[1]), "v"(X##w[2]), "v"(X##w[3]), \
                      "v"(X##b[0]), "v"(X##b[1]), "v"(X##b[2]), "v"(X##b[3])); } while (0)
            SC_GLOAD(0); SC_LSTORE(0);
            __syncthreads();
            for (int c = 0; c < SEQ / CH; ++c) {
                const bool more = (c + 1) < SEQ / CH;
                if (c == SEQ / CH - 2 && tid == 0) atomicAdd(ctl + CW_SD + 64 * (l + 2 * li_), 1u);
                if (more) SC_GLOAD(c + 1);
                const LAS float* bb = lds + (c & 1) * BUFF;
                f32x4 Ar, Aw, Ak, Aq, Ab, Br, Bw, Bk, Bq, Bb; float Av, Bv;
                SC_LD(A, 0);
#pragma unroll 1
                for (int st = 0; st < CH; st += 2) {
                    SC_LD(B, st + 1);
                    SC_STEP(A, st);
                    if (st + 2 < CH) SC_LD(A, st + 2);
                    SC_STEP(B, st + 1);
                }
                __syncthreads();
                {
                    const int stp = tid >> 4, r2 = (tid & 15) * 2;
                    const LAS f32x4* pp = (const LAS f32x4*)(ypart + stp * 128 + r2 * 4);
                    const f32x4 a0 = pp[0], a1 = pp[1];
                    if (c * CH + stp > 0) { float* yo = Y + base + (size_t)(c * CH + stp - 1) * BW + 32 * half + r2;
                        yo[0] = (a0[0] + a0[1]) + (a0[2] + a0[3]); yo[1] = (a1[0] + a1[1]) + (a1[2] + a1[3]); }
                }
                if (more) SC_LSTORE((c + 1) & 1);
                __syncthreads();
            }
            {
                const f32x4 rl4 = *(const f32x4*)(R_ + base + (size_t)(SEQ - 1) * BW + 4 * cg);
                const float yl = row_allsum16((sa * rl4[0] + sb * rl4[1]) + (sc2 * rl4[2] + sd * rl4[3]));
                if (cg == 0) Y[base + (size_t)(SEQ - 1) * BW + irow] = yl;
            }
#undef SC_GLOAD
#undef SC_LSTORE
#undef SC_LD
#undef SC_STEP
        }
        if (!(mask_live & (1u << 29)))
        for (;;) {
            if (tid == 0) misc[4] = atomicAdd(ctl + CW_AQ + 64 * (l + 2 * li_), 1u);
            __syncthreads();
            const unsigned u = misc[4];
            __syncthreads();
            if (u >= 1024u) break;
            const int qt = 15 - (int)(u >> 6), kind = (u >> 5) & 1, b = (u >> 3) & 3, h = u & 7;
            const size_t r0 = (size_t)b * SEQ;
            if (kind == 0)
                attn_unit<128, true>((LAS unsigned char*)lds_raw, QAB + r0 * BW + h * 128, BW, KAB + r0 * BW + h * 128, BW, VAB + r0 * BW + h * 128, BW,
                                     YALL + r0 * (3 * BW) + h * 128, 3 * BW, SELB + r0 * 8 + h, qt, 0.08838834764831845f * 1.4426950408889634f, tid);
            else
                attn_unit<192, false>((LAS unsigned char*)lds_raw, QCB + r0 * 1536 + h * 192, 1536, KCB + r0 * 1536 + h * 192, 1536, VCB + r0 * BW + h * 128, BW,
                                      YALL + r0 * (3 * BW) + 2 * BW + h * 128, 3 * BW, nullptr, qt, 0.07216878364870323f * 1.4426950408889634f, tid);
        }
        {
            LAS float* scr = (LAS float*)((LAS unsigned char*)lds_raw) + wave * (64 * 33);
            const unsigned ncu = (unsigned)(FFN_CONV_N(l) / 32);
            DQ_RUN(xb_ld(ctl + CW_SD + 64 * (l + 2 * li_)) < 128u && xb_ld(ctl + CW_DQ + 64 * li_) < (unsigned)(l == 0 ? DQ_J3 : DQ_J6));
            for (;;) {
                if (tid == 0) {
                    unsigned u_ = 0xffffffffu;
                    if (xb_ld(ctl + CW_SD + 64 * (l + 2 * li_)) < 128u) u_ = atomicAdd(ctl + CW_CQ + 64 * (l + 2 * li_), 1u);
                    misc[4] = u_;
                }
                __syncthreads();
                const unsigned u = (unsigned)__builtin_amdgcn_readfirstlane((int)misc[4]);
                __syncthreads();
                if (u >= ncu) break;
#pragma unroll 1
                for (int k_ = 0; k_ < 2; ++k_) { const int it = (int)u * 32 + k_ * 16 + 2 * wave; FFN_CONV_PAIR(it); }
            }
            DQ_FLUSH(l == 0 ? DQ_J3 : DQ_J6);
        }
        GRID_BAR();
        {
            const int pc = l * BW + (gt & 255) * 4;
            const f32x4 p_g = *(const f32x4*)(rwkv_gn_g + pc), p_b = *(const f32x4*)(rwkv_gn_b + pc), p_ka = *(const f32x4*)(rwkv_k_a + pc), p_rk = *(const f32x4*)(rwkv_r_k + pc);
            const float* pY = Y; const float* pK = K2; const float* pA = AA; const float* pR = R_; const float* pV = Vcur; const float* pG = GG; bf16* pO = YALL + BW;
            for (int i0 = gt; i0 < T * 16 * 16; i0 += 4 * NGT) {
                f32x4 y[4], kr[4], aa[4], rr[4], vv[4], gg[4];
#pragma unroll
                for (int u_ = 0; u_ < 4; ++u_) { const int i = i0 + u_ * NGT, ic = i < T * 256 ? i : gt; const size_t o = (size_t)(ic >> 8) * BW + (ic & 255) * 4;
                    y[u_] = *(const f32x4*)(pY + o); kr[u_] = *(const f32x4*)(pK + o); aa[u_] = *(const f32x4*)(pA + o); rr[u_] = *(const f32x4*)(pR + o); vv[u_] = *(const f32x4*)(pV + o); gg[u_] = *(const f32x4*)(pG + o); }
#pragma unroll
                for (int u_ = 0; u_ < 4; ++u_) { const int i = i0 + u_ * NGT;
                    const float mu = row_allsum16((y[u_][0] + y[u_][1]) + (y[u_][2] + y[u_][3])) * (1.0f / 64.0f);
                    const f32x4 d = y[u_] - mu;
                    const float var = row_allsum16((d[0] * d[0] + d[1] * d[1]) + (d[2] * d[2] + d[3] * d[3])) * (1.0f / 64.0f);
                    const f32x4 yn = d * rsqrtf(var + 64e-5f) * p_g + p_b;
                    const f32x4 k2 = kr[u_] * (1.0f + (aa[u_] - 1.0f) * p_ka);
                    const f32x4 rk = rr[u_] * k2 * p_rk;
                    const float bon = row_allsum16((rk[0] + rk[1]) + (rk[2] + rk[3]));
                    const f32x4 o4 = (yn + bon * vv[u_]) * gg[u_];
                    v2u ob; ob.x = pk2(o4[0], o4[1]); ob.y = pk2(o4[2], o4[3]);
                    if (i < T * 256) *(v2u*)(pO + (size_t)(i >> 8) * (3 * BW) + (i & 255) * 4) = ob;
                }
            }
        }
        GRID_BAR();
        }
        if (RUN(4)) {
        {
            pg8::StaticOrder S; S.init(T, D, G_live, (int)blockIdx.x);
            pg8::Gemm g{YALL, WBO + (size_t)l * D * 3 * BW, T, D, 3 * BW}; EpiBranch3 E{MIXB, GATEB};
            pg8::gemm_phase<EpiBranch3, pg8::StaticOrder, false>((LAS unsigned char*)lds_raw, g, S, E, nullptr, tid);
        }
        GRID_BAR();
        }
        if (RUN(5)) {
        {
            pg8::Gemm g{MIXB, WOT + (size_t)l * D * D, T, D, D}; pg8::StaticOrder S; S.init(T, D, G_live, (int)blockIdx.x);
            EpiResidF32 E{PRE, X};
            pg8::gemm_phase<EpiResidF32, pg8::StaticOrder, false>((LAS unsigned char*)lds_raw, g, S, E, nullptr, tid);
        }
        GRID_BAR();
        }
        if (RUN(6)) {
        {
            LAS float* scr = (LAS float*)((LAS unsigned char*)lds_raw) + wave * (64 * 33);
            const int ntot = FFN_CONV_N(l);
            const int ndone = (int)min(xb_ld(ctl + CW_CQ + 64 * (l + 2 * li_)), (unsigned)(ntot / 32)) * 32;
            for (int it = ndone + 2 * gw; it < ntot; it += 2 * NGW) FFN_CONV_PAIR(it);
            if (l == 1) DQ_FLUSH(DQ_J7);
        }
        for (int t = gw; t < T; t += NGW) {
            const float* pr = PRE + (size_t)t * D;
            f32x4 v[8]; float s = 0.f;
#pragma unroll
            for (int jj = 0; jj < 8; ++jj) { v[jj] = *(const f32x4*)(pr + jj * 256 + lane * 4); s += (v[jj][0] + v[jj][1]) + (v[jj][2] + v[jj][3]); }
            const float mean = wave_sum(s, lane) * (1.0f / D); float s2 = 0.f;
#pragma unroll
            for (int jj = 0; jj < 8; ++jj) { v[jj] = v[jj] - mean; s2 += (v[jj][0] * v[jj][0] + v[jj][1] * v[jj][1]) + (v[jj][2] * v[jj][2] + v[jj][3] * v[jj][3]); }
            const float rstd = rsqrtf(wave_sum(s2, lane) * (1.0f / D) + 1e-5f);
#pragma unroll
            for (int jj = 0; jj < 8; ++jj) {
                const f32x4 g = *(const f32x4*)(ln1_g + l * D + jj * 256 + lane * 4), bb = *(const f32x4*)(ln1_b + l * D + jj * 256 + lane * 4);
                v[jj] = v[jj] * rstd * g + bb;
                *(f32x4*)(X1 + (size_t)t * D + jj * 256 + lane * 4) = v[jj];
                v2u ob; ob.x = pk2(v[jj][0], v[jj][1]); ob.y = pk2(v[jj][2], v[jj][3]); *(v2u*)(X1B + (size_t)t * D + jj * 256 + lane * 4) = ob;
            }
            if (l == 1) {
                float lg[8];
#pragma unroll
                for (int e = 0; e < 8; ++e) lg[e] = 0.f;
#pragma unroll
                for (int jj = 0; jj < 8; ++jj)
#pragma unroll
                    for (int cc = 0; cc < 4; ++cc) {
                        const int d = jj * 256 + lane * 4 + cc;
                        const f32x4 r0 = *(const f32x4*)(moe_router + (size_t)d * 8), r1 = *(const f32x4*)(moe_router + (size_t)d * 8 + 4);
                        const float xv = v[jj][cc];
                        lg[0] += xv * r0[0]; lg[1] += xv * r0[1]; lg[2] += xv * r0[2]; lg[3] += xv * r0[3];
                        lg[4] += xv * r1[0]; lg[5] += xv * r1[1]; lg[6] += xv * r1[2]; lg[7] += xv * r1[3];
                    }
#pragma unroll
                for (int e = 0; e < 8; ++e) lg[e] = wave_sum(lg[e], lane);
                if (lane == 0) {
                    int e0 = 0; float b0 = lg[0];
#pragma unroll
                    for (int e = 1; e < 8; ++e) if (lg[e] > b0) { b0 = lg[e]; e0 = e; }
                    int e1 = -1; float b1 = -INFINITY;
#pragma unroll
                    for (int e = 0; e < 8; ++e) if (e != e0 && lg[e] > b1) { b1 = lg[e]; e1 = e; }
                    const float w1 = 1.0f / (1.0f + expf(b0 - b1)), w0 = 1.0f - w1;
                    const int p0 = (int)atomicAdd(ctl + CW_CNT + 64 * e0, 1u), p1 = (int)atomicAdd(ctl + CW_CNT + 64 * e1, 1u);
                    int* tk = TOK + (size_t)t * 8;
                    tk[0] = e0; tk[1] = e1; tk[2] = p0; tk[3] = p1; tk[4] = __float_as_int(w0); tk[5] = __float_as_int(w1);
                }
            }
        }
        GRID_BAR();
        }
        float* OUTX = (l == 0) ? XB : (float*)(*(GAS float* const*)&args.out);
        if (l == 0) {
            if (RUN(7)) {
                pg8::Gemm g{X1B, WGU, T, NGU, D}; pg8::StaticOrder S; S.init(T, NGU, G_live, (int)blockIdx.x);
                EpiSwigluBf16 E{HGB, NGU / 256};
                pg8::gemm_phase<EpiSwigluBf16, pg8::StaticOrder, false>((LAS unsigned char*)lds_raw, g, S, E, nullptr, tid);
                REOPAQUE();
                {
                    LAS float* scr = (LAS float*)((LAS unsigned char*)lds_raw) + wave * (64 * 33);
                    PHASE_DONE(1);
                    DQ_FILL(1, 129);
                }
                GRID_BAR();
            }
            if (RUN(8)) {
                pg8::Gemm g{HGB, WDD, T, D, DFF}; pg8::StaticOrder S; S.init(T, D, G_live, (int)blockIdx.x);
                EpiResidF32 E{PRE, X1};
                pg8::gemm_phase<EpiResidF32, pg8::StaticOrder, false>((LAS unsigned char*)lds_raw, g, S, E, nullptr, tid);
                GRID_BAR();
            }
        } else {
            if (RUN(10)) {
            unsigned poff[9]; poff[0] = 0;
#pragma unroll
            for (int e = 0; e < 8; ++e) poff[e + 1] = poff[e] + ((xb_ld(ctl + CW_CNT + 64 * e) + 255u) & ~255u);
            for (int t = gw; t < T; t += NGW) {
                int* tk = TOK + (size_t)t * 8;
                const int e0 = tk[0], e1 = tk[1];
                unsigned o0 = 0, o1 = 0;
#pragma unroll
                for (int e = 0; e < 8; ++e) { o0 = (e == e0) ? poff[e] : o0; o1 = (e == e1) ? poff[e] : o1; }
                const int s0 = (int)o0 + tk[2], s1 = (int)o1 + tk[3];
                if (lane == 0) { tk[6] = s0; tk[7] = s1; }
#pragma unroll
                for (int j = 0; j < 4; ++j) { const v4u xv = *(const v4u*)(X1B + (size_t)t * D + j * 512 + lane * 8);
                    *(v4u*)(XG + (size_t)s0 * D + j * 512 + lane * 8) = xv; *(v4u*)(XG + (size_t)s1 * D + j * 512 + lane * 8) = xv; }
            }
            if (blockIdx.x == 0 && tid < 80) {
                unsigned e_of = 0; const unsigned mt = tid;
#pragma unroll
                for (int e = 1; e < 8; ++e) e_of += (mt * 256u >= poff[e]) ? 1u : 0u;
                ctl[CW_TILE + tid] = e_of;
                if (tid == 0) ctl[CW_TILE - 1] = poff[8] / 256u;
            }
            {
                const unsigned nmt_ = poff[8] / 256u, nfull_ = (nmt_ / 32u) * 32u; const size_t z0 = (size_t)nfull_ * 256 * D / 4, z1 = (size_t)nmt_ * 256 * D / 4;
                for (size_t i = z0 + gt; i < z1; i += NGT) *(f32x4*)(OUT + i * 4) = (f32x4){0.f, 0.f, 0.f, 0.f};
            }
            GRID_BAR();
            }
            const int nMt = (int)ctl[CW_TILE - 1];
            if (RUN(7)) {
                pg8::Gemm g{XG, WGU, MOE_ROWS, NGU, D}; MoeOrder S{ctl + CW_TILE, nMt, NGU / 256, G_live, (int)blockIdx.x};
                EpiSwigluBf16 E{HGB, NGU / 256};
                pg8::gemm_phase<EpiSwigluBf16, MoeOrder, false>((LAS unsigned char*)lds_raw, g, S, E, nullptr, tid);
                REOPAQUE();
                {
                    LAS float* scr = (LAS float*)((LAS unsigned char*)lds_raw) + wave * (64 * 33);
                    const int rem_ = ((int)ctl[CW_TILE - 1] * (NGU / 256)) % G_live;
                    PHASE_DONE(5);
                    DQ_FILL(5, (rem_ ? G_live - rem_ : 0) + 1);
                    DQ_FLUSH(DQ_N);
                }
                GRID_BAR();
            }
            if (RUN(8)) {
                const int nFull = (nMt / 32) * 32;
                { pg8::Gemm g{HGB, WD, MOE_ROWS, D, DFF}; MoeOrder S{ctl + CW_TILE, nFull, D / 256, G_live, (int)blockIdx.x};
                  EpiStoreF32 E{OUT, D / 256};
                  pg8::gemm_phase<EpiStoreF32, MoeOrder, false>((LAS unsigned char*)lds_raw, g, S, E, nullptr, tid); }
                REOPAQUE();
                { pg8::Gemm g{HGB, WD, MOE_ROWS, D, DFF / 4 + zero_live, DFF}; MoeOrder S{ctl + CW_TILE, nMt - nFull, D / 256, G_live, (int)blockIdx.x, nFull, 4, (DFF / 4) * 2};
                  EpiAtomicF32 E{OUT, D / 256};
                  pg8::gemm_phase<EpiAtomicF32, MoeOrder, false>((LAS unsigned char*)lds_raw, g, S, E, nullptr, tid); }
                GRID_BAR();
            }
        }
        if (RUN(9)) {
        if (l == 0) { LAS float* scr = (LAS float*)((LAS unsigned char*)lds_raw) + wave * (64 * 33); DQ_FLUSH(DQ_J4); }
        for (int t = gw; t < T; t += NGW) {
            f32x4 v[8]; float s = 0.f;
            if (l == 0) {
#pragma unroll
                for (int jj = 0; jj < 8; ++jj) v[jj] = *(const f32x4*)(PRE + (size_t)t * D + jj * 256 + lane * 4);
            } else {
                const int* tk = TOK + (size_t)t * 8;
                const float w0 = __int_as_float(tk[4]), w1 = __int_as_float(tk[5]); const int s0 = tk[6], s1 = tk[7];
                const int e0 = tk[0], e1 = tk[1];
#pragma unroll
                for (int jj = 0; jj < 8; ++jj) {
                    const f32x4 xx = *(const f32x4*)(X1 + (size_t)t * D + jj * 256 + lane * 4);
                    const f32x4 a = *(const f32x4*)(OUT + (size_t)s0 * D + jj * 256 + lane * 4), bq = *(const f32x4*)(OUT + (size_t)s1 * D + jj * 256 + lane * 4);
                    const f32x4 f = (e0 < e1) ? (w0 * a + w1 * bq) : (w1 * bq + w0 * a);
                    v[jj] = ALPHA * xx + f;
                }
            }
#pragma unroll
            for (int jj = 0; jj < 8; ++jj) s += (v[jj][0] + v[jj][1]) + (v[jj][2] + v[jj][3]);
            const float mean = wave_sum(s, lane) * (1.0f / D); float s2 = 0.f;
#pragma unroll
            for (int jj = 0; jj < 8; ++jj) { v[jj] = v[jj] - mean; s2 += (v[jj][0] * v[jj][0] + v[jj][1] * v[jj][1]) + (v[jj][2] * v[jj][2] + v[jj][3] * v[jj][3]); }
            const float rstd = rsqrtf(wave_sum(s2, lane) * (1.0f / D) + 1e-5f);
#pragma unroll
            for (int jj = 0; jj < 8; ++jj) {
                const f32x4 g = *(const f32x4*)(ln2_g + l * D + jj * 256 + lane * 4), bb = *(const f32x4*)(ln2_b + l * D + jj * 256 + lane * 4);
                const f32x4 o = v[jj] * rstd * g + bb;
                *(f32x4*)(OUTX + (size_t)t * D + jj * 256 + lane * 4) = o;
                if (l == 0) { v2u ob; ob.x = pk2(o[0], o[1]); ob.y = pk2(o[2], o[3]); *(v2u*)(XBF + (size_t)t * D + jj * 256 + lane * 4) = ob; }
            }
        }
        GRID_BAR();
        }
    }
}

extern "C" void kernel_launch(void* const* d_in, const int* in_sizes, int n_in, void* d_out, int out_size, void* d_ws, size_t ws_size, hipStream_t stream) {
    static int grid = 0;
    if (grid == 0) {
        if (n_in != 34 || out_size != T * D || ws_size < WS_END) { fprintf(stderr, "kernel_launch: bad sizes n_in %d out %d ws %zu need %zu\n", n_in, out_size, ws_size, (size_t)WS_END); grid = -1; return; }
        int dev = 0, cus = 0, per_cu = 0;
        if (hipGetDevice(&dev) != hipSuccess || hipDeviceGetAttribute(&cus, hipDeviceAttributeMultiprocessorCount, dev) != hipSuccess) { grid = -1; return; }
        if (hipFuncSetAttribute((const void*)fwd_kernel, hipFuncAttributeMaxDynamicSharedMemorySize, LDS_BYTES) != hipSuccess) { fprintf(stderr, "hipFuncSetAttribute failed\n"); grid = -1; return; }
        if (hipOccupancyMaxActiveBlocksPerMultiprocessor(&per_cu, (const void*)fwd_kernel, NTHREADS, LDS_BYTES) != hipSuccess || per_cu < 1) fprintf(stderr, "occupancy query says %d\n", per_cu);
        (void)hipGetLastError();
        grid = cus;
    }
    if (grid < 0) return;
    hipMemsetAsync((char*)d_ws + WS_CTL, 0, CTL_BYTES, stream);
    Args a{};
    for (int i = 0; i < 34; ++i) a.in[i] = (const float*)d_in[i];
    a.out = (float*)d_out; a.ws = (unsigned char*)d_ws; a.mask = 0x9FFFFFFFu; a.li = 0;
    hipLaunchKernelGGL(fwd_kernel, dim3(grid), dim3(NTHREADS), LDS_BYTES, stream, a);
#ifdef PROBE_MASK
    a.mask = PROBE_MASK; a.li = 1;
    hipLaunchKernelGGL(fwd_kernel, dim3(grid), dim3(NTHREADS), LDS_BYTES, stream, a);
#endif
}
```

```cpp
#include <hip/hip_runtime.h>
#include <stdint.h>
#include <stdio.h>

constexpr int D = 2048, NBATCH = 4, SEQ = 2048, T = NBATCH * SEQ;
constexpr int BW = 1024;
constexpr int IN_COLS = 13664;
constexpr int OFF_RWKV = 3072, OFF_MLA = 6432, OFF_GATE = 7520;
constexpr int RWKV_COLS = 3360;
constexpr int DFF = 5632, NEXP = 8;
constexpr float ALPHA = 1.41421356237f;
constexpr int NTHREADS = 512, NWAVES = 8;
constexpr int LDS_BYTES = 131072 + 17408 + 512;

#define LAS __attribute__((address_space(3)))
#define GAS __attribute__((address_space(1)))
typedef float f32x16 __attribute__((ext_vector_type(16)));
typedef float f32x4 __attribute__((ext_vector_type(4)));

constexpr size_t MiB = 1u << 20;
constexpr size_t al(size_t x) { return (x + 255) & ~(size_t)255; }
constexpr size_t WS_CTL = 0, CTL_BYTES = 1 * MiB;
constexpr size_t WS_COSA = 1 * MiB;
constexpr size_t WS_SINA = WS_COSA + 2048 * 64 * 4;
constexpr size_t WS_COSM = WS_SINA + 2048 * 64 * 4;
constexpr size_t WS_SINM = WS_COSM + 2048 * 32 * 4;
constexpr size_t WS_TOK = 3 * MiB;
constexpr size_t WS_ROWL = WS_TOK + (size_t)T * 8 * 4;
constexpr size_t WS_XB = 4 * MiB;
constexpr size_t WS_X1 = WS_XB + (size_t)T * D * 4;
constexpr size_t WS_PRE = WS_X1 + (size_t)T * D * 4;
constexpr int NP = 13824;
constexpr size_t WS_XBF = WS_PRE + (size_t)T * D * 4;
constexpr size_t WS_WINT = WS_XBF + (size_t)T * D * 2;
constexpr size_t WS_X1B = WS_WINT + (size_t)2 * NP * D * 2;
constexpr size_t WS_WBO = WS_X1B + (size_t)T * D * 2;
constexpr size_t WS_WOT = WS_WBO + (size_t)6 * D * BW * 2;
constexpr size_t WS_WUQ = WS_WOT + (size_t)2 * D * D * 2;
constexpr size_t WS_WUKV = WS_WUQ + (size_t)2 * 1536 * 512 * 2;
constexpr size_t WS_WLORA = WS_WUKV + (size_t)2 * 2048 * 512 * 2;
constexpr size_t WS_V0 = WS_WLORA + (size_t)2 * 4096 * 384 * 2;
constexpr size_t WS_MIXER = WS_V0 + (size_t)T * BW * 4;
constexpr int MOE_ROWS = 2 * T + NEXP * 256;
constexpr int NGU = 2 * DFF;
constexpr int PLD = 4448, PSH = 3072;
constexpr size_t WS_R = WS_MIXER;
constexpr size_t WS_K2 = WS_R + (size_t)T * BW * 4;
constexpr size_t WS_V1 = WS_K2 + (size_t)T * BW * 4;
constexpr size_t WS_DEC = WS_V1 + (size_t)T * BW * 4;
constexpr size_t WS_AA = WS_DEC + (size_t)T * BW * 4;
constexpr size_t WS_GG = WS_AA + (size_t)T * BW * 4;
constexpr size_t WS_Y = WS_GG + (size_t)T * BW * 4;
constexpr size_t WS_LA = WS_Y + (size_t)T * BW * 4;
constexpr size_t WS_QNB = WS_LA + (size_t)T * 384 * 2;
constexpr size_t WS_KVNB = WS_QNB + (size_t)T * 512 * 2;
constexpr size_t WS_YALL = WS_KVNB + (size_t)T * 512 * 2;
constexpr size_t WS_GATEB = WS_YALL + (size_t)T * 3 * BW * 2;
constexpr size_t WS_QAB = WS_GATEB + (size_t)T * 3 * D * 2;
constexpr size_t WS_KAB = WS_QAB + (size_t)T * BW * 2;
constexpr size_t WS_VAB = WS_KAB + (size_t)T * BW * 2;
constexpr size_t WS_QCB = WS_VAB + (size_t)T * BW * 2;
constexpr size_t WS_KCB = WS_QCB + (size_t)T * 1536 * 2;
constexpr size_t WS_VCB = WS_KCB + (size_t)T * 1536 * 2;
constexpr size_t WS_MIXB = WS_VCB + (size_t)T * BW * 2;
constexpr size_t WS_L_END = WS_MIXB + (size_t)T * D * 2;
constexpr size_t WS_HGB = WS_MIXER;
constexpr size_t WS_XG = WS_HGB + (size_t)MOE_ROWS * DFF * 2;
constexpr size_t WS_OUT = WS_XG + (size_t)MOE_ROWS * D * 2;
static_assert(WS_OUT + (size_t)MOE_ROWS * D * 4 <= WS_L_END, "FFN activations must stay inside region L");
constexpr size_t WS_WGU = WS_L_END;
constexpr size_t WS_PROJ = WS_WGU;
constexpr size_t WS_VRES = al(WS_PROJ + (size_t)T * PLD * 4);
constexpr size_t WS_QF = al(WS_VRES + (size_t)T * 32 * 4);
static_assert(WS_QF + (size_t)T * BW * 4 <= WS_WGU + (size_t)4 * NGU * D * 2, "region P must end inside WGU[0..3]");
constexpr size_t WS_WD = WS_WGU + (size_t)NEXP * NGU * D * 2;
constexpr size_t WS_WDD = WS_WGU + (size_t)NGU * D * 2;
constexpr size_t WS_END = WS_WD + (size_t)NEXP * D * DFF * 2;
constexpr size_t WS_KMEAN = WS_TOK + 512 * 1024;
constexpr size_t WS_SEL = WS_TOK + 768 * 1024;

static_assert(WS_END <= (size_t)1560 * MiB, "ws budget");
constexpr int CW_CNT = 1024;
constexpr int CW_OFF = 2048;
constexpr int CW_AQ = 3072;
constexpr int CW_CQ = 3328;
constexpr int CW_SD = 3584;
constexpr int CQ_ITEMS = 16;
constexpr int CW_DQ = 12288;
constexpr int CW_PD = 12544;
constexpr int DQ_J3 = 5120, DQ_J4 = 18944, DQ_J5 = 20608, DQ_J6 = 25728, DQ_J7 = DQ_J6 + 4 * 11264, DQ_N = DQ_J7 + 8 * 5632;
constexpr int CW_TILE = 2304;
constexpr int CW_BAR = 4096;

#define XB_TMO      128
#define XB_XCNT(j)  (256  + 64 * (j))
#define XB_XSUB(j)  (1280 + 64 * (j))
#define XB_XGEN(j)  (2304 + 64 * (j))
#define XB_TOP      3328
#define XB_TOPGEN   3392
#define XCD_BAR_WORDS 3456
#define XB_SPIN_CAP (1u << 22)

__device__ __forceinline__ unsigned xb_ld(unsigned* p)              { return __hip_atomic_load(p, __ATOMIC_RELAXED, __HIP_MEMORY_SCOPE_AGENT); }
__device__ __forceinline__ unsigned xb_add(unsigned* p, unsigned v) { return __hip_atomic_fetch_add(p, v, __ATOMIC_RELAXED, __HIP_MEMORY_SCOPE_AGENT); }
__device__ __forceinline__ unsigned xb_xcc_id() { return (unsigned)__builtin_amdgcn_s_getreg((3 << 11) | 20) & 0xFu; }
#define XB_SPIN(cond, bar) do { unsigned _sp = 0; while (cond) { __builtin_amdgcn_s_sleep(1); \
    if ((++_sp & 255u) == 0u) { if (xb_ld(&(bar)[XB_TMO])) break; if (_sp > XB_SPIN_CAP) { atomicAdd(&(bar)[XB_TMO], 1u); break; } } } } while (0)

struct XcdBarrier { unsigned* bar; unsigned x; volatile LAS unsigned* st; };

__device__ __forceinline__ XcdBarrier xcd_barrier_post(unsigned* bar, volatile LAS unsigned* st, const int tid0) {
    XcdBarrier b; b.bar = bar; b.x = xb_xcc_id(); b.st = st;
    if (tid0 == 0) (void)xb_add(&bar[XB_XCNT(b.x)], 1u);
    return b;
}
__device__ __forceinline__ void xcd_barrier_complete(unsigned* bar, unsigned x, unsigned& nloc, unsigned& nx) {
    const unsigned G = gridDim.x * gridDim.y * gridDim.z;
    unsigned sum, cnt, mine, sp = 0u;
    for (;;) {
        sum = 0u; cnt = 0u; mine = 0u;
#pragma unroll
        for (unsigned j = 0; j < 16; ++j) { const unsigned c = xb_ld(&bar[XB_XCNT(j)]); sum += c; cnt += (c > 0u) ? 1u : 0u; mine = (j == x) ? c : mine; }
        if (sum == G) break;
        __builtin_amdgcn_s_sleep(1);
        if ((++sp & 255u) == 0u) { if (xb_ld(&bar[XB_TMO])) break; if (sp > XB_SPIN_CAP) { atomicAdd(&bar[XB_TMO], 1u); break; } }
    }
    nloc = mine > 0u ? mine : 1u; nx = cnt > 0u ? cnt : 1u;
}
__device__ __forceinline__ void xcd_barrier(const XcdBarrier& b, const int tid0) {
    asm volatile("s_waitcnt vmcnt(0)" ::: "memory");
    __syncthreads();
    if (tid0 == 0) {
        unsigned* bar = b.bar;
        __builtin_amdgcn_s_waitcnt(0);
        unsigned nloc = b.st[0], nx = b.st[1];
        if (nloc == 0u) { xcd_barrier_complete(bar, b.x, nloc, nx); b.st[0] = nloc; b.st[1] = nx; }
        const unsigned old = xb_add(&bar[XB_XSUB(b.x)], 1u);
        const unsigned gen = old / nloc;
        if (old + 1u == (gen + 1u) * nloc) {
            __builtin_amdgcn_fence(__ATOMIC_RELEASE, "agent");
            asm volatile("s_waitcnt vmcnt(0)" ::: "memory");
            const unsigned og = xb_add(&bar[XB_TOP], 1u);
            const unsigned tg = og / nx;
            if (og + 1u == (tg + 1u) * nx) xb_add(&bar[XB_TOPGEN], 1u);
            else XB_SPIN(xb_ld(&bar[XB_TOPGEN]) == tg, bar);
            __builtin_amdgcn_fence(__ATOMIC_ACQUIRE, "agent");
            xb_add(&bar[XB_XGEN(b.x)], 1u);
            asm volatile("s_waitcnt vmcnt(0)" ::: "memory");
        } else {
            XB_SPIN(xb_ld(&bar[XB_XGEN(b.x)]) == gen, bar);
            __builtin_amdgcn_fence(__ATOMIC_ACQUIRE, "agent");
            asm volatile("s_waitcnt vmcnt(0)" ::: "memory");
        }
    }
    __syncthreads();
}

__device__ __forceinline__ float shfl_xor_(float v, int mask, int ln) { return __builtin_bit_cast(float, __builtin_amdgcn_ds_bpermute((ln ^ mask) << 2, __builtin_bit_cast(int, v))); }
__device__ __forceinline__ float wave_sum(float v, int ln) {
    v += __builtin_bit_cast(float, __builtin_amdgcn_update_dpp(0, __builtin_bit_cast(int, v), 0x128, 0xf, 0xf, false));
    v += __builtin_bit_cast(float, __builtin_amdgcn_update_dpp(0, __builtin_bit_cast(int, v), 0x124, 0xf, 0xf, false));
    v += __builtin_bit_cast(float, __builtin_amdgcn_update_dpp(0, __builtin_bit_cast(int, v), 0x122, 0xf, 0xf, false));
    v += __builtin_bit_cast(float, __builtin_amdgcn_update_dpp(0, __builtin_bit_cast(int, v), 0x121, 0xf, 0xf, false));
    v += shfl_xor_(v, 16, ln); v += shfl_xor_(v, 32, ln);
    return v;
}
__device__ __forceinline__ float sigmoidf_(float x) { return 1.0f / (1.0f + expf(-x)); }

namespace pg8 {
#define PG8_LAS __attribute__((address_space(3)))
typedef unsigned short bf16_t;
typedef short bf16x8 __attribute__((ext_vector_type(8)));
typedef float f32x4 __attribute__((ext_vector_type(4)));
typedef unsigned u32x4 __attribute__((ext_vector_type(4)));
constexpr int BM = 256, BK = 64, HALF = 128, HTB = HALF * BK * 2  , STAGE_BYTES = 8 * HTB, NXCD = 8, WGM = 8;

__host__ __device__ __forceinline__ int lds_byte(int r, int c) { const int st = (r >> 4) * 2 + (c >> 5), rr = r & 15, cc = c & 31, ob = rr * 64 + cc * 2; return st * 1024 + (ob ^ (((ob >> 9) & 1) << 5)); }
__host__ __device__ __forceinline__ void stage_rc(int b, int& R, int& C) { const int st = b / 1024, sb = b % 1024, swz = sb ^ (((sb >> 9) & 1) << 5); R = (st >> 1) * 16 + swz / 64; C = (st & 1) * 32 + (swz % 64) / 2; }
__host__ __device__ __forceinline__ int perm32(int rho) { const int n = rho >> 4, i = rho & 15; return 8 * (i >> 2) + 4 * n + (i & 3); }

struct Unit { int pm, pn; int ko = 0; };
struct Gemm { const bf16_t* A; const bf16_t* Bt; int M, N, K; int ld = 0; };

struct StaticOrder {
    int nM, nN, nwg, G, c;
    __host__ __device__ void init(int M, int N, int G_, int c_) { nM = M / BM; nN = N / BM; nwg = nM * nN; G = G_; c = c_; }
    __host__ __device__ bool next(int i, Unit& u) const {
        const long L = (long)i * G + c; if (L >= nwg) return false;
        int wgid = (int)L; { const int q = nwg / NXCD, r = nwg % NXCD, xcd = wgid % NXCD, off = wgid / NXCD; wgid = (xcd < r ? xcd * (q + 1) : r * (q + 1) + (xcd - r) * q) + off; }
        const int nig = WGM * nN, gid = wgid / nig, fm = gid * WGM, gsz = (nM - fm) < WGM ? (nM - fm) : WGM;
        u.pm = fm + ((wgid % nig) % gsz); u.pn = (wgid % nig) / gsz; return true;
    }
    __device__ __forceinline__ void a_ready(const Unit&) const {}
    __device__ __forceinline__ void done(const Unit&) const {}
};
__device__ __forceinline__ unsigned cvt_pk_bf16(float lo, float hi) { unsigned r; asm volatile("v_cvt_pk_bf16_f32 %0, %1, %2" : "=v"(r) : "v"(lo), "v"(hi)); return r; }
typedef float f32x2 __attribute__((ext_vector_type(2)));
template <class Epi, class Sched, bool STAMP = false>
__device__ __forceinline__ void gemm_phase(PG8_LAS unsigned char* lds, const Gemm g, const Sched& S, const Epi& E, unsigned long long* stamps, const int tid) {
    const int wid = __builtin_amdgcn_readfirstlane(tid >> 6), lane = tid & 63, wr = wid >> 2, wc = wid & 3, fr = lane & 15, fq = lane >> 4;
    const int K = g.K, nt = K / BK, LD = g.ld ? g.ld : g.K;
    int ts_lo = 0, ts_hi = 0, nts = 0; const unsigned long long rt_entry = STAMP ? (unsigned long long)wall_clock64() : 0ull;
#define PG8_STAMP() do { if (STAMP && wid == 0 && nts < 64) { const unsigned long long _c = (unsigned long long)clock64(); \
        ts_lo = (lane == nts) ? (int)(unsigned)_c : ts_lo; ts_hi = (lane == nts) ? (int)(unsigned)(_c >> 32) : ts_hi; ++nts; } } while (0)
    PG8_STAMP();
    unsigned voffA[2], voffB[2];
#pragma unroll
    for (int i = 0; i < 2; ++i) { int R, C; stage_rc(tid * 16 + i * 8192, R, C); const int Rb = Epi::PERM ? ((R & ~31) + perm32(R & 31)) : R;
        voffA[i] = (unsigned)(R * LD + C) * 2u; voffB[i] = (unsigned)(Rb * LD + C) * 2u; }
    const size_t kstep = (size_t)(BK * 2);
    const size_t hstep = (size_t)HALF * LD * 2;
    const size_t tstep = 2 * hstep;
    const unsigned ldsw = (unsigned)wid * 1024u;
    const int aoff = lds_byte(wr * 64 + fr, fq * 8), boff = lds_byte(wc * 32 + fr, fq * 8);
#define PG8_SA(b, h) (((b) * 2 + (h)) * HTB)
#define PG8_SB(b, h) ((4 + (b) * 2 + (h)) * HTB)
#define PG8_STAGE(bufoff, gbase, voff) do { _Pragma("unroll") for (int _i = 0; _i < 2; ++_i) \
        __builtin_amdgcn_global_load_lds((const unsigned*)((const char*)(gbase) + (voff)[_i]), (PG8_LAS unsigned*)(lds + (bufoff) + ldsw + _i * 8192), 16, 0, 0); } while (0)
#define PG8_LDA(dst, b, h) do { _Pragma("unroll") for (int m = 0; m < 4; ++m) _Pragma("unroll") for (int k = 0; k < 2; ++k) dst[m][k] = *(const PG8_LAS bf16x8*)(lds + PG8_SA(b, h) + aoff + m * 2048 + k * 1024); } while (0)
#define PG8_LDB(dst, b, h) do { _Pragma("unroll") for (int n = 0; n < 2; ++n) _Pragma("unroll") for (int k = 0; k < 2; ++k) dst[n][k] = *(const PG8_LAS bf16x8*)(lds + PG8_SB(b, h) + boff + n * 2048 + k * 1024); } while (0)
#define PG8_MMA(ai, bj, At, Bt) do { __builtin_amdgcn_s_setprio(1); _Pragma("unroll") for (int m = 0; m < 4; ++m) _Pragma("unroll") for (int n = 0; n < 2; ++n) _Pragma("unroll") for (int k = 0; k < 2; ++k) \
        acc[ai][bj][m][n] = __builtin_amdgcn_mfma_f32_16x16x32_bf16(Bt[n][k], At[m][k], acc[ai][bj][m][n], 0, 0, 0); __builtin_amdgcn_s_setprio(0); } while (0)
#define PG8_WAIT_V(n) asm volatile("s_waitcnt vmcnt(" #n ")" ::: "memory")
#define PG8_WAIT_L(n) asm volatile("s_waitcnt lgkmcnt(" #n ")" ::: "memory")
#define PG8_BAR __builtin_amdgcn_s_barrier()
#define PG8_SCHED __builtin_amdgcn_sched_barrier(0)
    Unit cur, nxt; int ui = 0;
    if (!S.next(0, cur)) return;
    f32x4 acc[2][2][4][2];
#pragma unroll
    for (int a = 0; a < 2; ++a)
#pragma unroll
        for (int b = 0; b < 2; ++b)
#pragma unroll
            for (int m = 0; m < 4; ++m)
#pragma unroll
                for (int n = 0; n < 2; ++n) acc[a][b][m][n] = (f32x4){0.f, 0.f, 0.f, 0.f};
    bf16x8 At[4][2], B0[2][2], B1[2][2];
    {
        const bf16x8 z8 = {0, 0, 0, 0, 0, 0, 0, 0};
#pragma unroll
        for (int m = 0; m < 4; ++m) { At[m][0] = z8; At[m][1] = z8; }
#pragma unroll
        for (int n = 0; n < 2; ++n) { B0[n][0] = z8; B0[n][1] = z8; B1[n][0] = z8; B1[n][1] = z8; }
    }
    const char* cA = (const char*)g.A + (size_t)cur.pm * tstep + cur.ko; const char* cB = (const char*)g.Bt + (size_t)cur.pn * tstep + cur.ko;
    S.a_ready(cur);
    PG8_STAGE(PG8_SB(0, 0), cB, voffB); PG8_STAGE(PG8_SA(0, 0), cA, voffA); PG8_STAGE(PG8_SB(0, 1), cB + hstep, voffB); PG8_STAGE(PG8_SA(0, 1), cA + hstep, voffA);
    if (wr == 1) PG8_BAR;
    PG8_WAIT_V(4); PG8_BAR;
    PG8_STAGE(PG8_SB(1, 0), cB + kstep, voffB); PG8_STAGE(PG8_SA(1, 0), cA + kstep, voffA); PG8_STAGE(PG8_SB(1, 1), cB + hstep + kstep, voffB);
    PG8_WAIT_V(6); PG8_BAR;
    PG8_STAMP();
    for (;;) {
        const bool has_next = S.next(ui + 1, nxt);
        const char* nA = has_next ? (const char*)g.A + (size_t)nxt.pm * tstep + nxt.ko : cA; const char* nB = has_next ? (const char*)g.Bt + (size_t)nxt.pn * tstep + nxt.ko : cB;
        for (int t = 0; t < nt; t += 2) {
            if constexpr (Epi::HAS_MID) { if (t == 16 || t == 32) E.mid(acc, cur, wr, wc, fr, fq, t); }
            const bool last = (t == nt - 2);
            const char* a1 = cA + (size_t)(t + 1) * kstep;
            const char* a2 = last ? nA : cA + (size_t)(t + 2) * kstep; const char* b2 = last ? nB : cB + (size_t)(t + 2) * kstep;
            const char* a3 = a2 + kstep; const char* b3 = b2 + kstep;
            if (last && has_next) S.a_ready(nxt);
            PG8_LDB(B0, 0, 0); PG8_SCHED; PG8_LDA(At, 0, 0); PG8_STAGE(PG8_SA(1, 1), a1 + hstep, voffA);
            PG8_WAIT_L(8); PG8_BAR; PG8_WAIT_L(0); PG8_MMA(0, 0, At, B0); PG8_BAR; PG8_SCHED;
            PG8_LDB(B1, 0, 1); PG8_STAGE(PG8_SB(0, 0), b2, voffB);
            PG8_BAR; PG8_WAIT_L(0); PG8_MMA(0, 1, At, B1); PG8_BAR;
            PG8_LDA(At, 0, 1); PG8_STAGE(PG8_SA(0, 0), a2, voffA);
            PG8_BAR; PG8_WAIT_L(0); PG8_MMA(1, 0, At, B0); PG8_BAR; PG8_SCHED;
            PG8_STAGE(PG8_SB(0, 1), b2 + hstep, voffB);
            PG8_WAIT_V(6); PG8_BAR; PG8_MMA(1, 1, At, B1); PG8_BAR;
            PG8_LDB(B0, 1, 0); PG8_SCHED; PG8_LDA(At, 1, 0); PG8_STAGE(PG8_SA(0, 1), a2 + hstep, voffA);
            PG8_WAIT_L(8); PG8_BAR; PG8_WAIT_L(0); PG8_MMA(0, 0, At, B0); PG8_BAR; PG8_SCHED;
            PG8_LDB(B1, 1, 1); PG8_STAGE(PG8_SB(1, 0), b3, voffB);
            PG8_BAR; PG8_WAIT_L(0); PG8_MMA(0, 1, At, B1); PG8_BAR;
            PG8_LDA(At, 1, 1); PG8_STAGE(PG8_SA(1, 0), a3, voffA);
            PG8_BAR; PG8_WAIT_L(0); PG8_MMA(1, 0, At, B0); PG8_BAR; PG8_SCHED;
            PG8_STAGE(PG8_SB(1, 1), b3 + hstep, voffB);
            PG8_WAIT_V(6); PG8_BAR; PG8_MMA(1, 1, At, B1); PG8_BAR;
        }
        PG8_STAMP();
        if constexpr (!Epi::AFTER_DRAIN) { if constexpr (Epi::STAGED) E.staged(acc, cur, wr, wc, fr, fq, lds + STAGE_BYTES, wid, lane); else E(acc, cur, wr, wc, fr, fq); S.done(cur); }
        PG8_STAMP();
        if (!has_next) break;
#pragma unroll
        for (int a = 0; a < 2; ++a)
#pragma unroll
            for (int b = 0; b < 2; ++b)
#pragma unroll
                for (int m = 0; m < 4; ++m)
#pragma unroll
                    for (int n = 0; n < 2; ++n) acc[a][b][m][n] = (f32x4){0.f, 0.f, 0.f, 0.f};
        cur = nxt; cA = nA; cB = nB; ++ui;
    }
    PG8_WAIT_V(0);
    if (wr == 0) PG8_BAR;
    PG8_BAR;
    if constexpr (Epi::AFTER_DRAIN) { E.fused(acc, cur, wr, wc, fr, fq, lds, wid, lane); S.done(cur); }
    PG8_STAMP();
    if (STAMP && wid == 0) { stamps[lane] = lane < nts ? (((unsigned long long)(unsigned)ts_hi << 32) | (unsigned)ts_lo) : 0ull;
        if (lane == 62) stamps[62] = rt_entry; if (lane == 63) stamps[63] = (unsigned long long)wall_clock64(); }
#undef PG8_STAMP
#undef PG8_SA
#undef PG8_SB
#undef PG8_STAGE
#undef PG8_LDA
#undef PG8_LDB
#undef PG8_MMA
#undef PG8_WAIT_V
#undef PG8_WAIT_L
#undef PG8_BAR
#undef PG8_SCHED
}
}


typedef unsigned short bf16;
typedef unsigned v4u __attribute__((ext_vector_type(4)));
typedef unsigned v2u __attribute__((ext_vector_type(2)));
__device__ __forceinline__ unsigned f2bf(float f) { unsigned u = __builtin_bit_cast(unsigned, f); return (u + 0x7fffu + ((u >> 16) & 1u)) >> 16; }
typedef __bf16 bf16x2_t __attribute__((ext_vector_type(2)));
__device__ __forceinline__ unsigned pk2(float lo, float hi) { bf16x2_t v; v[0] = (__bf16)lo; v[1] = (__bf16)hi; return __builtin_bit_cast(unsigned, v); }
__device__ __forceinline__ float row_allsum16(float x) {
    x += __builtin_bit_cast(float, __builtin_amdgcn_update_dpp(0, __builtin_bit_cast(int, x), 0x128, 0xf, 0xf, false));
    x += __builtin_bit_cast(float, __builtin_amdgcn_update_dpp(0, __builtin_bit_cast(int, x), 0x124, 0xf, 0xf, false));
    x += __builtin_bit_cast(float, __builtin_amdgcn_update_dpp(0, __builtin_bit_cast(int, x), 0x122, 0xf, 0xf, false));
    x += __builtin_bit_cast(float, __builtin_amdgcn_update_dpp(0, __builtin_bit_cast(int, x), 0x121, 0xf, 0xf, false));
    return x;
}
__device__ __forceinline__ float fsigmoid(float x) { return __builtin_amdgcn_rcpf(1.0f + __expf(-x)); }
__device__ __forceinline__ void transpose_item(const float* p, int ldw, bf16* WT, int K, int dst_row0, int k0, LAS float* scr, int ln) {
    if (p) {
        float tv[32];
#pragma unroll
        for (int i = 0; i < 32; ++i) tv[i] = p[(size_t)(k0 + 2 * i + (ln >> 5)) * ldw];
#pragma unroll
        for (int i = 0; i < 32; ++i) scr[(2 * i + (ln >> 5)) * 33 + (ln & 31)] = tv[i];
    } else {
#pragma unroll 8
        for (int i = 0; i < 32; ++i) { const int kk = 2 * i + (ln >> 5); scr[kk * 33 + (ln & 31)] = 0.f; }
    }
    asm volatile("s_waitcnt lgkmcnt(0)" ::: "memory");
    const int c = ln & 7;
#pragma unroll
    for (int j = 0; j < 4; ++j) { const int n = (ln >> 3) + 8 * j; const LAS float* s = scr + (8 * c) * 33 + n;
        v4u o; o.x = pk2(s[0 * 33], s[1 * 33]); o.y = pk2(s[2 * 33], s[3 * 33]); o.z = pk2(s[4 * 33], s[5 * 33]); o.w = pk2(s[6 * 33], s[7 * 33]);
        *(v4u*)(WT + (size_t)(dst_row0 + n) * K + k0 + 8 * c) = o; }
    asm volatile("s_waitcnt lgkmcnt(0)" ::: "memory");
}
struct TI { const float* p; bf16* wt; int ldw, K, r0, k0; bool zero; };
__device__ __forceinline__ void ti_load(const TI& t, float (&tv)[32], int ln) {
#pragma unroll
    for (int i = 0; i < 32; ++i) tv[i] = t.p[(size_t)(t.k0 + 2 * i + (ln >> 5)) * t.ldw];
}
__device__ __forceinline__ void ti_finish(const TI& t, const float (&tv)[32], LAS float* scr, int ln) {
#pragma unroll
    for (int i = 0; i < 32; ++i) scr[(2 * i + (ln >> 5)) * 33 + (ln & 31)] = t.zero ? 0.f : tv[i];
    asm volatile("s_waitcnt lgkmcnt(0)" ::: "memory");
    const int c = ln & 7;
#pragma unroll
    for (int j = 0; j < 4; ++j) { const int n = (ln >> 3) + 8 * j; const LAS float* s = scr + (8 * c) * 33 + n;
        v4u o; o.x = pk2(s[0 * 33], s[1 * 33]); o.y = pk2(s[2 * 33], s[3 * 33]); o.z = pk2(s[4 * 33], s[5 * 33]); o.w = pk2(s[6 * 33], s[7 * 33]);
        *(v4u*)(t.wt + (size_t)(t.r0 + n) * t.K + t.k0 + 8 * c) = o; }
    asm volatile("s_waitcnt lgkmcnt(0)" ::: "memory");
}
__device__ __forceinline__ f32x4 bf4_to_f32(const v2u w) { f32x4 r; r[0] = __builtin_bit_cast(float, w.x << 16); r[1] = __builtin_bit_cast(float, w.x & 0xffff0000u);
    r[2] = __builtin_bit_cast(float, w.y << 16); r[3] = __builtin_bit_cast(float, w.y & 0xffff0000u); return r; }
constexpr int STG_RS = 528;
#define EBAR() do { asm volatile("s_waitcnt lgkmcnt(0)" ::: "memory"); __builtin_amdgcn_s_barrier(); asm volatile("" ::: "memory"); } while (0)
#define EPI_ENTER(wr_) do { if ((wr_) == 0) __builtin_amdgcn_s_barrier(); } while (0)
#define EPI_LEAVE(wr_) do { if ((wr_) == 1) __builtin_amdgcn_s_barrier(); } while (0)
#define STG_READBACK512(ai_, m_, BODY) do { int ln_ = lane; asm volatile("" : "+v"(ln_)); _Pragma("unroll") for (int h_ = 0; h_ < 2; ++h_) { const int lr_ = 4 * wid + 2 * h_ + (ln_ >> 5), cb_ = (ln_ & 31) * 16; \
        const v4u sv_ = *(const LAS v4u*)(stg + lr_ * STG_RS + cb_); const int trow_ = 128 * (ai_) + 64 * (lr_ >> 4) + 16 * (m_) + (lr_ & 15); BODY } } while (0)

struct EpiSwigluBf16 {
    static constexpr bool PERM = true, AFTER_DRAIN = false, HAS_MID = false, STAGED = true;
    bf16* H; int nN;
    __device__ __forceinline__ void staged(const f32x4 (&acc)[2][2][4][2], const pg8::Unit& u, int wr, int wc, int fr, int fq, LAS unsigned char* stg, int wid, int lane) const {
        const int pnl = u.pn % nN, lrw = 16 * wr + fr;
        bf16* dst = H + (size_t)u.pm * 256 * DFF + 128 * pnl;
        EPI_ENTER(wr);
#pragma unroll
        for (int ai = 0; ai < 2; ++ai)
#pragma unroll
            for (int m = 0; m < 4; ++m) {
#pragma unroll
                for (int bj = 0; bj < 2; ++bj) {
                    const f32x4 g = acc[ai][bj][m][0], uu = acc[ai][bj][m][1]; float h[4];
#pragma unroll
                    for (int j = 0; j < 4; ++j) h[j] = g[j] * fsigmoid(g[j]) * uu[j];
                    v2u o; o.x = pk2(h[0], h[1]); o.y = pk2(h[2], h[3]);
                    *(LAS v2u*)(stg + lrw * 272 + (64 * bj + 16 * wc + 4 * fq) * 2) = o;
                }
                EBAR();
                {
                    int ln_ = lane; asm volatile("" : "+v"(ln_));
                    const int lr = 4 * wid + (ln_ >> 4), cb = (ln_ & 15) * 16;
                    const v4u sv = *(const LAS v4u*)(stg + lr * 272 + cb);
                    const int trow = 128 * ai + 64 * (lr >> 4) + 16 * m + (lr & 15);
                    *(v4u*)(dst + (size_t)trow * DFF + (ln_ & 15) * 8) = sv;
                }
                EBAR();
            }
        EPI_LEAVE(wr);
    }
};
struct EpiResidF32 {
    static constexpr bool PERM = true, AFTER_DRAIN = false, HAS_MID = false, STAGED = true;
    float* C; const float* R;
    __device__ __forceinline__ void staged(const f32x4 (&acc)[2][2][4][2], const pg8::Unit& u, int wr, int wc, int fr, int fq, LAS unsigned char* stg, int wid, int lane) const {
        const int lrw = 16 * wr + fr; const size_t t0 = (size_t)u.pm * 256 * D + (size_t)u.pn * 256;
        EPI_ENTER(wr);
#pragma unroll
        for (int ai = 0; ai < 2; ++ai)
#pragma unroll
            for (int m = 0; m < 4; ++m)
#pragma unroll
                for (int bj = 0; bj < 2; ++bj) {
                    *(LAS f32x4*)(stg + lrw * STG_RS + (wc * 32 + 8 * fq) * 4) = acc[ai][bj][m][0];
                    *(LAS f32x4*)(stg + lrw * STG_RS + (wc * 32 + 8 * fq) * 4 + 16) = acc[ai][bj][m][1];
                    EBAR();
                    STG_READBACK512(ai, m, { const size_t o_ = t0 + (size_t)trow_ * D + bj * 128 + (ln_ & 31) * 4;
                        const f32x4 r_ = *(const f32x4*)(R + o_); *(f32x4*)(C + o_) = ALPHA * r_ + __builtin_bit_cast(f32x4, sv_); });
                    EBAR();
                }
        EPI_LEAVE(wr);
    }
};
struct EpiStoreF32 {
    static constexpr bool PERM = true, AFTER_DRAIN = false, HAS_MID = false, STAGED = true;
    float* C; int nN;
    __device__ __forceinline__ void staged(const f32x4 (&acc)[2][2][4][2], const pg8::Unit& u, int wr, int wc, int fr, int fq, LAS unsigned char* stg, int wid, int lane) const {
        const int lrw = 16 * wr + fr; const size_t t0 = (size_t)u.pm * 256 * D + (size_t)(u.pn % nN) * 256;
        EPI_ENTER(wr);
#pragma unroll
        for (int ai = 0; ai < 2; ++ai)
#pragma unroll
            for (int m = 0; m < 4; ++m)
#pragma unroll
                for (int bj = 0; bj < 2; ++bj) {
                    *(LAS f32x4*)(stg + lrw * STG_RS + (wc * 32 + 8 * fq) * 4) = acc[ai][bj][m][0];
                    *(LAS f32x4*)(stg + lrw * STG_RS + (wc * 32 + 8 * fq) * 4 + 16) = acc[ai][bj][m][1];
                    EBAR();
                    STG_READBACK512(ai, m, { *(v4u*)(C + t0 + (size_t)trow_ * D + bj * 128 + (ln_ & 31) * 4) = sv_; });
                    EBAR();
                }
        EPI_LEAVE(wr);
    }
};
template <int MODE> struct EpiBranch {
    static constexpr bool PERM = true, AFTER_DRAIN = false, HAS_MID = false, STAGED = false;
    float* MIXp; bf16* MIXBp; const float* gate;
    __device__ __forceinline__ void operator()(const f32x4 (&acc)[2][2][4][2], const pg8::Unit& u, int wr, int wc, int fr, int fq) const {
        const int row0 = u.pm * 256 + wr * 64 + fr, col0 = u.pn * 256 + wc * 32 + 8 * fq;
#pragma unroll
        for (int ai = 0; ai < 2; ++ai)
#pragma unroll
            for (int m = 0; m < 4; ++m)
#pragma unroll
                for (int bj = 0; bj < 2; ++bj) {
                    const int row = row0 + ai * 128 + m * 16, col = col0 + bj * 128; const size_t o = (size_t)row * D + col;
                    const f32x4 g0 = *(const f32x4*)(gate + (size_t)row * IN_COLS + col), g1 = *(const f32x4*)(gate + (size_t)row * IN_COLS + col + 4);
                    f32x4 r0, r1;
#pragma unroll
                    for (int j = 0; j < 4; ++j) { r0[j] = fsigmoid(g0[j]) * acc[ai][bj][m][0][j]; r1[j] = fsigmoid(g1[j]) * acc[ai][bj][m][1][j]; }
                    if (MODE >= 1) { r0 += *(const f32x4*)(MIXp + o); r1 += *(const f32x4*)(MIXp + o + 4); }
                    if (MODE <= 1) { *(f32x4*)(MIXp + o) = r0; *(f32x4*)(MIXp + o + 4) = r1; }
                    else { v4u w; w.x = pk2(r0[0], r0[1]); w.y = pk2(r0[2], r0[3]); w.z = pk2(r1[0], r1[1]); w.w = pk2(r1[2], r1[3]); *(v4u*)(MIXBp + o) = w; }
                }
    }
};

struct EpiLora {
    static constexpr bool PERM = true, AFTER_DRAIN = false, HAS_MID = false, STAGED = false;
    float* DECp; float* AAp; float* GGp; float* Vp; const float* VFp; const float* w0; const float* a0; const float* v0;
    __device__ __forceinline__ void operator()(const f32x4 (&acc)[2][2][4][2], const pg8::Unit& u, int wr, int wc, int fr, int fq) const {
        const int row0 = u.pm * 256 + wr * 64 + fr, seg = __builtin_amdgcn_readfirstlane(u.pn >> 2), col0 = (u.pn & 3) * 256 + wc * 32 + 8 * fq;
        if (seg == 0) {
#pragma unroll
            for (int bj = 0; bj < 2; ++bj) { const int col = col0 + bj * 128; const f32x4 b0 = *(const f32x4*)(w0 + col), b1 = *(const f32x4*)(w0 + col + 4);
#pragma unroll
                for (int ai = 0; ai < 2; ++ai)
#pragma unroll
                    for (int m = 0; m < 4; ++m) { const size_t o = (size_t)(row0 + ai * 128 + m * 16) * BW + col;
                        f32x4 x0 = acc[ai][bj][m][0] + b0, x1 = acc[ai][bj][m][1] + b1;
#pragma unroll
                        for (int j = 0; j < 4; ++j) { const float z0 = -x0[j], z1 = -x1[j];
                            const float sp0 = z0 > 20.f ? z0 : __logf(1.0f + __expf(z0)), sp1 = z1 > 20.f ? z1 : __logf(1.0f + __expf(z1));
                            x0[j] = __expf(-__expf(-sp0 - 0.5f)); x1[j] = __expf(-__expf(-sp1 - 0.5f)); }
                        *(f32x4*)(DECp + o) = x0; *(f32x4*)(DECp + o + 4) = x1; } }
        } else if (seg == 1) {
#pragma unroll
            for (int bj = 0; bj < 2; ++bj) { const int col = col0 + bj * 128; const f32x4 b0 = *(const f32x4*)(a0 + col), b1 = *(const f32x4*)(a0 + col + 4);
#pragma unroll
                for (int ai = 0; ai < 2; ++ai)
#pragma unroll
                    for (int m = 0; m < 4; ++m) { const size_t o = (size_t)(row0 + ai * 128 + m * 16) * BW + col;
                        f32x4 x0 = acc[ai][bj][m][0] + b0, x1 = acc[ai][bj][m][1] + b1;
#pragma unroll
                        for (int j = 0; j < 4; ++j) { x0[j] = fsigmoid(x0[j]); x1[j] = fsigmoid(x1[j]); }
                        *(f32x4*)(AAp + o) = x0; *(f32x4*)(AAp + o + 4) = x1; } }
        } else if (seg == 2) {
#pragma unroll
            for (int bj = 0; bj < 2; ++bj) { const int col = col0 + bj * 128;
#pragma unroll
                for (int ai = 0; ai < 2; ++ai)
#pragma unroll
                    for (int m = 0; m < 4; ++m) { const size_t o = (size_t)(row0 + ai * 128 + m * 16) * BW + col;
                        *(f32x4*)(GGp + o) = acc[ai][bj][m][0]; *(f32x4*)(GGp + o + 4) = acc[ai][bj][m][1]; } }
        } else {
#pragma unroll
            for (int bj = 0; bj < 2; ++bj) { const int col = col0 + bj * 128; const f32x4 b0 = *(const f32x4*)(v0 + col), b1 = *(const f32x4*)(v0 + col + 4);
#pragma unroll
                for (int ai = 0; ai < 2; ++ai)
#pragma unroll
                    for (int m = 0; m < 4; ++m) { const size_t o = (size_t)(row0 + ai * 128 + m * 16) * BW + col;
                        f32x4 x0 = acc[ai][bj][m][0] + b0, x1 = acc[ai][bj][m][1] + b1;
                        const f32x4 v0_ = *(const f32x4*)(Vp + o), v1_ = *(const f32x4*)(Vp + o + 4), f0 = *(const f32x4*)(VFp + o), f1 = *(const f32x4*)(VFp + o + 4);
#pragma unroll
                        for (int j = 0; j < 4; ++j) { x0[j] = v0_[j] + (f0[j] - v0_[j]) * fsigmoid(x0[j]); x1[j] = v1_[j] + (f1[j] - v1_[j]) * fsigmoid(x1[j]); }
                        *(f32x4*)(Vp + o) = x0; *(f32x4*)(Vp + o + 4) = x1;
                        asm volatile("" ::: "memory"); } }
        }
    }
};
struct EpiMlaQ {
    static constexpr bool PERM = true, AFTER_DRAIN = false, HAS_MID = false, STAGED = false;
    bf16* QCBp; const float* COSMp; const float* SINMp;
    __device__ __forceinline__ void operator()(const f32x4 (&acc)[2][2][4][2], const pg8::Unit& u, int wr, int wc, int fr, int fq) const {
        const int row0 = u.pm * 256 + wr * 64 + fr;
#pragma unroll
        for (int bj = 0; bj < 2; ++bj) {
            const int c = u.pn * 256 + bj * 128 + wc * 32 + 8 * fq, h = c / 192, cc = c - h * 192;
#pragma unroll
            for (int ai = 0; ai < 2; ++ai)
#pragma unroll
                for (int m = 0; m < 4; ++m) {
                    const int row = row0 + ai * 128 + m * 16; const f32x4 x1 = acc[ai][bj][m][0], x2 = acc[ai][bj][m][1];
                    bf16* dst = QCBp + (size_t)row * 1536 + h * 192;
                    if (cc < 128) { v4u w; w.x = pk2(x1[0], x1[1]); w.y = pk2(x1[2], x1[3]); w.z = pk2(x2[0], x2[1]); w.w = pk2(x2[2], x2[3]); *(v4u*)(dst + cc) = w; }
                    else { const int j0 = 4 * ((cc - 128) >> 3), s = row & (SEQ - 1);
                        const f32x4 cs = *(const f32x4*)(COSMp + s * 32 + j0), sn = *(const f32x4*)(SINMp + s * 32 + j0);
                        const f32x4 o1 = x1 * cs - x2 * sn, o2 = x2 * cs + x1 * sn;
                        v2u a; a.x = pk2(o1[0], o1[1]); a.y = pk2(o1[2], o1[3]); v2u b; b.x = pk2(o2[0], o2[1]); b.y = pk2(o2[2], o2[3]);
                        *(v2u*)(dst + 128 + j0) = a; *(v2u*)(dst + 160 + j0) = b; }
                }
        }
    }
};
struct EpiMlaKV {
    static constexpr bool PERM = true, AFTER_DRAIN = false, HAS_MID = false, STAGED = false;
    bf16* KCBp; bf16* VCBp;
    __device__ __forceinline__ void operator()(const f32x4 (&acc)[2][2][4][2], const pg8::Unit& u, int wr, int wc, int fr, int fq) const {
        const int row0 = u.pm * 256 + wr * 64 + fr;
#pragma unroll
        for (int bj = 0; bj < 2; ++bj) {
            const int c = u.pn * 256 + bj * 128 + wc * 32 + 8 * fq, h = c >> 8, cc = c & 255;
#pragma unroll
            for (int ai = 0; ai < 2; ++ai)
#pragma unroll
                for (int m = 0; m < 4; ++m) {
                    const int row = row0 + ai * 128 + m * 16; const f32x4 x1 = acc[ai][bj][m][0], x2 = acc[ai][bj][m][1];
                    v4u w; w.x = pk2(x1[0], x1[1]); w.y = pk2(x1[2], x1[3]); w.z = pk2(x2[0], x2[1]); w.w = pk2(x2[2], x2[3]);
                    if (cc < 128) *(v4u*)(KCBp + (size_t)row * 1536 + h * 192 + cc) = w;
                    else *(v4u*)(VCBp + (size_t)row * BW + h * 128 + (cc - 128)) = w;
                }
        }
    }
};

struct EpiBranch3 {
    static constexpr bool PERM = true, AFTER_DRAIN = false, HAS_MID = true, STAGED = false;
    bf16* MIXBp; const bf16* G;
    __device__ __forceinline__ void mid(f32x4 (&acc)[2][2][4][2], const pg8::Unit& u, int wr, int wc, int fr, int fq, int t) const {
        int row0 = u.pm * 256 + wr * 64 + fr, col0 = u.pn * 256 + wc * 32 + 8 * fq; const int seg = t >> 4;
        asm volatile("" : "+v"(row0), "+v"(col0));
#pragma unroll
        for (int ai = 0; ai < 2; ++ai)
#pragma unroll
            for (int m = 0; m < 4; ++m)
#pragma unroll
                for (int bj = 0; bj < 2; ++bj) {
                    const bf16* gp = G + (size_t)(row0 + ai * 128 + m * 16) * (3 * D) + (seg - 1) * D + col0 + bj * 128;
                    const v4u a = *(const v4u*)gp, b = *(const v4u*)(gp + D);
                    const unsigned aw[4] = {a.x, a.y, a.z, a.w}, bw[4] = {b.x, b.y, b.z, b.w};
#pragma unroll
                    for (int j = 0; j < 4; ++j) {
                        const float r0 = __uint_as_float(aw[j] << 16) * __builtin_amdgcn_rcpf(__uint_as_float(bw[j] << 16));
                        const float r1 = __uint_as_float(aw[j] & 0xffff0000u) * __builtin_amdgcn_rcpf(__uint_as_float(bw[j] & 0xffff0000u));
                        acc[ai][bj][m][j >> 1][(j & 1) * 2] *= r0; acc[ai][bj][m][j >> 1][(j & 1) * 2 + 1] *= r1;
                    }
                    asm volatile("" : "+v"(acc[ai][bj][m][0]), "+v"(acc[ai][bj][m][1]) :: "memory");
                }
    }
    __device__ __forceinline__ void operator()(const f32x4 (&acc)[2][2][4][2], const pg8::Unit& u, int wr, int wc, int fr, int fq) const {
        const int row0 = u.pm * 256 + wr * 64 + fr, col0 = u.pn * 256 + wc * 32 + 8 * fq;
#pragma unroll
        for (int ai = 0; ai < 2; ++ai)
#pragma unroll
            for (int m = 0; m < 4; ++m)
#pragma unroll
                for (int bj = 0; bj < 2; ++bj) {
                    const int row = row0 + ai * 128 + m * 16, col = col0 + bj * 128;
                    const v4u a = *(const v4u*)(G + (size_t)row * (3 * D) + 2 * D + col);
                    const unsigned aw[4] = {a.x, a.y, a.z, a.w}; float r[8];
#pragma unroll
                    for (int j = 0; j < 4; ++j) { r[2 * j] = acc[ai][bj][m][j >> 1][(j & 1) * 2] * __uint_as_float(aw[j] << 16);
                                                  r[2 * j + 1] = acc[ai][bj][m][j >> 1][(j & 1) * 2 + 1] * __uint_as_float(aw[j] & 0xffff0000u); }
                    v4u w; w.x = pk2(r[0], r[1]); w.y = pk2(r[2], r[3]); w.z = pk2(r[4], r[5]); w.w = pk2(r[6], r[7]);
                    *(v4u*)(MIXBp + (size_t)row * D + col) = w;
                }
    }
};
struct MoeOrder {
    const unsigned* tile_e; int nMt, nN, G, c; int mt0 = 0, ks = 1, kbytes = 0;
    __device__ __forceinline__ bool next(int i, pg8::Unit& u) const {
        const long L = (long)i * G + c; if (L >= (long)nMt * nN * ks) return false;
        const int mt = mt0 + (int)(L / (nN * ks)), rem = (int)(L % (nN * ks)), pnl = rem / ks;
        u.pm = mt; u.pn = (int)tile_e[mt] * nN + pnl; u.ko = (rem % ks) * kbytes; return true;
    }
    __device__ __forceinline__ void a_ready(const pg8::Unit&) const {}
    __device__ __forceinline__ void done(const pg8::Unit&) const {}
};
struct EpiAtomicF32 {
    static constexpr bool PERM = true, AFTER_DRAIN = false, HAS_MID = false, STAGED = true;
    float* C; int nN;
    __device__ __forceinline__ void staged(const f32x4 (&acc)[2][2][4][2], const pg8::Unit& u, int wr, int wc, int fr, int fq, LAS unsigned char* stg, int wid, int lane) const {
        const int lrw = 16 * wr + fr; const size_t t0 = (size_t)u.pm * 256 * D + (size_t)(u.pn % nN) * 256;
        EPI_ENTER(wr);
#pragma unroll
        for (int ai = 0; ai < 2; ++ai)
#pragma unroll
            for (int m = 0; m < 4; ++m)
#pragma unroll
                for (int bj = 0; bj < 2; ++bj) {
                    *(LAS f32x4*)(stg + lrw * STG_RS + (wc * 32 + 8 * fq) * 4) = acc[ai][bj][m][0];
                    *(LAS f32x4*)(stg + lrw * STG_RS + (wc * 32 + 8 * fq) * 4 + 16) = acc[ai][bj][m][1];
                    EBAR();
                    { int ln_ = lane; asm volatile("" : "+v"(ln_));
#pragma unroll
                      for (int q_ = 0; q_ < 8; ++q_) { const int lr_ = 4 * wid + (q_ >> 1), cf_ = (q_ & 1) * 64 + ln_;
                          const float sv_ = *(const LAS float*)(stg + lr_ * STG_RS + cf_ * 4);
                          const int trow_ = 128 * ai + 64 * (lr_ >> 4) + 16 * m + (lr_ & 15);
                          atomicAdd(C + t0 + (size_t)trow_ * D + bj * 128 + cf_, sv_); } }
                    EBAR();
                }
        EPI_LEAVE(wr);
    }
};

struct EpiStoreBf16s { bf16* C; int ldc; size_t sC;
    __device__ __forceinline__ void operator()(int bt, int m, int n, float v) const { C[(size_t)bt * sC + (size_t)m * ldc + n] = (bf16)f2bf(v); } };
struct EpiInProjF32 {
    static constexpr bool PERM = true, AFTER_DRAIN = false, HAS_MID = false, STAGED = false;
    bf16* PROJp; float* VRESp; bf16* GATEp; float* QFp; bf16* KABp; bf16* VABp; const float* COSAp; const float* SINAp; int layer;
    __device__ __forceinline__ void operator()(const f32x4 (&acc)[2][2][4][2], const pg8::Unit& u, int wr, int wc, int fr, int fq) const {
        int row0 = u.pm * 256 + wr * 64 + fr;
        asm volatile("" : "+v"(row0), "+v"(fq));
        if (u.pn >= 30) {
#pragma unroll
            for (int bj = 0; bj < 2; ++bj) { const int c = (u.pn - 30) * 256 + bj * 128 + wc * 32 + 8 * fq;
#pragma unroll
                for (int ai = 0; ai < 2; ++ai)
#pragma unroll
                    for (int m = 0; m < 4; ++m) { const f32x4 x0 = acc[ai][bj][m][0], x1 = acc[ai][bj][m][1];
                        v4u w; w.x = pk2(fsigmoid(x0[0]), fsigmoid(x0[1])); w.y = pk2(fsigmoid(x0[2]), fsigmoid(x0[3]));
                        w.z = pk2(fsigmoid(x1[0]), fsigmoid(x1[1])); w.w = pk2(fsigmoid(x1[2]), fsigmoid(x1[3]));
                        *(v4u*)(GATEp + (size_t)(row0 + ai * 128 + m * 16) * (3 * D) + c) = w; } }
            return;
        }
        if (u.pn < 8) {
            const bool isk = u.pn >= 4;
#pragma unroll
            for (int bj = 0; bj < 2; ++bj) {
                const int c = (u.pn & 3) * 256 + bj * 128 + wc * 32 + 8 * fq, hh = c >> 7, j0 = ((c & 127) >> 3) * 4;
#pragma unroll
                for (int ai = 0; ai < 2; ++ai)
#pragma unroll
                    for (int m = 0; m < 4; ++m) { const int row = row0 + ai * 128 + m * 16, s = row & (SEQ - 1);
                        const f32x4 cs = *(const f32x4*)(COSAp + s * 64 + j0), sn = *(const f32x4*)(SINAp + s * 64 + j0);
                        const f32x4 x1 = acc[ai][bj][m][0], x2 = acc[ai][bj][m][1];
                        const f32x4 o1 = x1 * cs - x2 * sn, o2 = x2 * cs + x1 * sn;
                        if (!isk) { float* q = QFp + (size_t)row * BW + hh * 128 + j0; *(f32x4*)q = o1; *(f32x4*)(q + 64) = o2; }
                        else { bf16* k = KABp + (size_t)row * BW + hh * 128 + j0; v2u a; a.x = pk2(o1[0], o1[1]); a.y = pk2(o1[2], o1[3]); v2u b; b.x = pk2(o2[0], o2[1]); b.y = pk2(o2[2], o2[3]);
                            *(v2u*)k = a; *(v2u*)(k + 64) = b; }
                        asm volatile("" ::: "memory");
                    }
            }
            return;
        }
        if (u.pn < 12) {
#pragma unroll
            for (int bj = 0; bj < 2; ++bj) { const int c = (u.pn - 8) * 256 + bj * 128 + wc * 32 + 8 * fq;
#pragma unroll
                for (int ai = 0; ai < 2; ++ai)
#pragma unroll
                    for (int m = 0; m < 4; ++m) { const f32x4 x0 = acc[ai][bj][m][0], x1 = acc[ai][bj][m][1];
                        v4u w; w.x = pk2(x0[0], x0[1]); w.y = pk2(x0[2], x0[3]); w.z = pk2(x1[0], x1[1]); w.w = pk2(x1[2], x1[3]);
                        *(v4u*)(VABp + (size_t)(row0 + ai * 128 + m * 16) * BW + c) = w; } }
            return;
        }
#pragma unroll
        for (int bj = 0; bj < 2; ++bj) {
            const int c = u.pn * 256 + bj * 128 + wc * 32 + 8 * fq;
            if (c >= 6432 && c < 6464) {
                if (layer != 0) {
#pragma unroll
                    for (int ai = 0; ai < 2; ++ai)
#pragma unroll
                        for (int m = 0; m < 4; ++m) { float* p = VRESp + (c - 6432) + (size_t)(row0 + ai * 128 + m * 16) * 32;
                            *(f32x4*)p = acc[ai][bj][m][0]; *(f32x4*)(p + 4) = acc[ai][bj][m][1]; }
                }
            } else if (c < 7552) {
                bf16* dst = PROJp + ((c < 6432 ? c : c - 32) - PSH);
#pragma unroll
                for (int ai = 0; ai < 2; ++ai)
#pragma unroll
                    for (int m = 0; m < 4; ++m) { const f32x4 x0 = acc[ai][bj][m][0], x1 = acc[ai][bj][m][1];
                        v4u w; w.x = pk2(x0[0], x0[1]); w.y = pk2(x0[2], x0[3]); w.z = pk2(x1[0], x1[1]); w.w = pk2(x1[2], x1[3]);
                        *(v4u*)(dst + (size_t)(row0 + ai * 128 + m * 16) * PLD) = w; }
            }
        }
    }
};


__device__ __forceinline__ float fma_(float a, float b, float c) { float r; asm("v_fma_f32 %0, %1, %2, %3" : "=v"(r) : "v"(a), "v"(b), "v"(c)); return r; }
__device__ __forceinline__ float mul_(float a, float b) { float r; asm("v_mul_f32 %0, %1, %2" : "=v"(r) : "v"(a), "v"(b)); return r; }
__device__ __forceinline__ float add_(float a, float b) { float r; asm("v_add_f32 %0, %1, %2" : "=v"(r) : "v"(a), "v"(b)); return r; }
typedef short s16x4 __attribute__((ext_vector_type(4)));
constexpr int AT_KOFF = 0, AT_VOFF = 25600, AT_STAGE = 25600 + 64 * 288;
#define AT_TR16(base, o) \
    asm volatile("ds_read_b64_tr_b16 %0, %16 offset:0\n\tds_read_b64_tr_b16 %1, %16 offset:4608\n\t" \
                 "ds_read_b64_tr_b16 %2, %16 offset:32\n\tds_read_b64_tr_b16 %3, %16 offset:4640\n\t" \
                 "ds_read_b64_tr_b16 %4, %16 offset:64\n\tds_read_b64_tr_b16 %5, %16 offset:4672\n\t" \
                 "ds_read_b64_tr_b16 %6, %16 offset:96\n\tds_read_b64_tr_b16 %7, %16 offset:4704\n\t" \
                 "ds_read_b64_tr_b16 %8, %16 offset:128\n\tds_read_b64_tr_b16 %9, %16 offset:4736\n\t" \
                 "ds_read_b64_tr_b16 %10, %16 offset:160\n\tds_read_b64_tr_b16 %11, %16 offset:4768\n\t" \
                 "ds_read_b64_tr_b16 %12, %16 offset:192\n\tds_read_b64_tr_b16 %13, %16 offset:4800\n\t" \
                 "ds_read_b64_tr_b16 %14, %16 offset:224\n\tds_read_b64_tr_b16 %15, %16 offset:4832\n\t" \
                 "s_waitcnt lgkmcnt(0)" \
                 : "=&v"(o[0]), "=&v"(o[1]), "=&v"(o[2]), "=&v"(o[3]), "=&v"(o[4]), "=&v"(o[5]), "=&v"(o[6]), "=&v"(o[7]), \
                   "=&v"(o[8]), "=&v"(o[9]), "=&v"(o[10]), "=&v"(o[11]), "=&v"(o[12]), "=&v"(o[13]), "=&v"(o[14]), "=&v"(o[15]) \
                 : "v"(base) : "memory")
template <int DQ, bool MOBA>
__device__ __forceinline__ void attn_tile(LAS unsigned char* lds, const int buf, const int it, const int q0, const int w, const int qq, const int g, const int qrow, const int own,
                                          const unsigned selbits, const float sc, const pg8::bf16x8 (&qf)[DQ / 32], f32x4 (&o)[8], float& m, float& l) {
    constexpr int KROW = (DQ + 8) * 2, VROW = 288, NDS = DQ / 32;
    const LAS unsigned char* kb = lds + buf * AT_STAGE + AT_KOFF;
    f32x4 st[4];
#pragma unroll
    for (int c = 0; c < 4; ++c) {
        st[c] = (f32x4){0.f, 0.f, 0.f, 0.f};
#pragma unroll
        for (int ds = 0; ds < NDS; ++ds) {
            const pg8::bf16x8 a = *(const LAS pg8::bf16x8*)(kb + (16 * c + qq) * KROW + (32 * ds + 8 * g) * 2);
            st[c] = __builtin_amdgcn_mfma_f32_16x16x32_bf16(a, qf[ds], st[c], 0, 0, 0);
        }
    }
    const int blk = it >> 2;
    const bool past = MOBA && (blk < own);
    if (past) {
        const bool selok = ((selbits >> blk) & 1u) != 0u;
#pragma unroll
        for (int c = 0; c < 4; ++c)
#pragma unroll
            for (int r = 0; r < 4; ++r) st[c][r] = selok ? st[c][r] : -INFINITY;
    } else if (it * 64 + 63 > q0 + 16 * w) {
#pragma unroll
        for (int c = 0; c < 4; ++c)
#pragma unroll
            for (int r = 0; r < 4; ++r) { const int key = it * 64 + 16 * c + 4 * g + r; st[c][r] = (key <= qrow) ? st[c][r] : -INFINITY; }
    }
    float mloc = fmaxf(fmaxf(st[0][0], st[0][1]), fmaxf(st[0][2], st[0][3]));
#pragma unroll
    for (int c = 1; c < 4; ++c) mloc = fmaxf(mloc, fmaxf(fmaxf(st[c][0], st[c][1]), fmaxf(st[c][2], st[c][3])));
    const int ln_ = qq + 16 * g;
    mloc = fmaxf(mloc, shfl_xor_(mloc, 16, ln_)); mloc = fmaxf(mloc, shfl_xor_(mloc, 32, ln_));
    const float mnew = fmaxf(m, mloc * sc);
    if (__any(mnew > m)) {
        const float alpha = __builtin_amdgcn_exp2f(m - mnew);
        l *= alpha;
#pragma unroll
        for (int i = 0; i < 8; ++i) o[i] *= alpha;
        m = mnew;
    }
    float ps = 0.f;
#pragma unroll
    for (int c = 0; c < 4; ++c)
#pragma unroll
        for (int r = 0; r < 4; ++r) { const float p = __builtin_amdgcn_exp2f(__builtin_fmaf(st[c][r], sc, -m)); st[c][r] = p; ps += p; }
    l += ps;
#pragma unroll
    for (int c0i = 0; c0i < 2; ++c0i) {
        v4u pw; pw.x = pk2(st[2 * c0i][0], st[2 * c0i][1]); pw.y = pk2(st[2 * c0i][2], st[2 * c0i][3]);
        pw.z = pk2(st[2 * c0i + 1][0], st[2 * c0i + 1][1]); pw.w = pk2(st[2 * c0i + 1][2], st[2 * c0i + 1][3]);
        const pg8::bf16x8 pb = __builtin_bit_cast(pg8::bf16x8, pw);
        const unsigned vaddr = (unsigned)(size_t)(lds + buf * AT_STAGE + AT_VOFF) + (unsigned)((32 * c0i + 4 * g + (qq >> 2)) * VROW + 8 * (qq & 3));
        s16x4 vr[16];
        AT_TR16(vaddr, vr);
#pragma unroll
        for (int i = 0; i < 8; ++i) {
            const pg8::bf16x8 a = __builtin_shufflevector(vr[2 * i], vr[2 * i + 1], 0, 1, 2, 3, 4, 5, 6, 7);
            o[i] = __builtin_amdgcn_mfma_f32_16x16x32_bf16(a, pb, o[i], 0, 0, 0);
        }
    }
}
template <int DQ, bool MOBA>
__device__ __forceinline__ void attn_unit(LAS unsigned char* lds, const bf16* Qg, int ldq, const bf16* Kg, int ldk, const bf16* Vg, int ldv,
                                          bf16* Og, int ldo, const unsigned char* sel, int qt, float sc, const int tid) {
    constexpr int KROW = (DQ + 8) * 2, VROW = 288, KCH = DQ / 8, NKC = 64 * KCH / 512, NDS = DQ / 32;
    const int lane = tid & 63, w = __builtin_amdgcn_readfirstlane(tid >> 6), qq = lane & 15, g = lane >> 4;
    const int q0 = qt * 128, qrow = q0 + 16 * w + qq, own = q0 >> 8;
    pg8::bf16x8 qf[NDS];
#pragma unroll
    for (int ds = 0; ds < NDS; ++ds) qf[ds] = *(const pg8::bf16x8*)(Qg + (size_t)qrow * ldq + 32 * ds + 8 * g);
    unsigned selbits = 0; if (MOBA) selbits = sel[(size_t)qrow * 8];
    f32x4 o[8];
#pragma unroll
    for (int i = 0; i < 8; ++i) o[i] = (f32x4){0.f, 0.f, 0.f, 0.f};
    float m = -1e30f, l = 0.f;
    const int ntiles = 2 * (qt + 1);
    v4u kA[NKC], vA[2], kB[NKC], vB[2];
    { const v4u z_ = {0u, 0u, 0u, 0u};
#pragma unroll
      for (int i_ = 0; i_ < NKC; ++i_) { kA[i_] = z_; kB[i_] = z_; }
      vA[0] = z_; vA[1] = z_; vB[0] = z_; vB[1] = z_; }
    unsigned kgo[NKC], vgo[2], klo[NKC], vlo[2];
#pragma unroll
    for (int i_ = 0; i_ < NKC; ++i_) { const int id_ = tid + 512 * i_, row_ = id_ / KCH, ch_ = id_ % KCH; kgo[i_] = (unsigned)(row_ * ldk + ch_ * 8) * 2u; klo[i_] = (unsigned)(row_ * KROW + ch_ * 16); }
#pragma unroll
    for (int i_ = 0; i_ < 2; ++i_) { const int id_ = tid + 512 * i_, row_ = id_ >> 4, ch_ = id_ & 15; vgo[i_] = (unsigned)(row_ * ldv + ch_ * 8) * 2u; vlo[i_] = (unsigned)(AT_VOFF + row_ * VROW + ch_ * 16); }
#define AT_GLOAD(KS, VS, tile) do { const char* kp_ = (const char*)Kg + (size_t)(tile) * 64 * ldk * 2; const char* vp_ = (const char*)Vg + (size_t)(tile) * 64 * ldv * 2; \
        _Pragma("unroll") for (int i_ = 0; i_ < NKC; ++i_) KS[i_] = *(const v4u*)(kp_ + kgo[i_]); \
        _Pragma("unroll") for (int i_ = 0; i_ < 2; ++i_) VS[i_] = *(const v4u*)(vp_ + vgo[i_]); } while (0)
#define AT_LSTORE(KS, VS, buf) do { _Pragma("unroll") for (int i_ = 0; i_ < NKC; ++i_) *(LAS v4u*)(lds + (buf) * AT_STAGE + klo[i_]) = KS[i_]; \
        _Pragma("unroll") for (int i_ = 0; i_ < 2; ++i_) *(LAS v4u*)(lds + (buf) * AT_STAGE + vlo[i_]) = VS[i_]; } while (0)
    AT_GLOAD(kA, vA, 0); AT_LSTORE(kA, vA, 0);
    AT_GLOAD(kA, vA, 1);
    __syncthreads();
    for (int it = 0; it < ntiles; it += 2) {
        if (it + 2 < ntiles) AT_GLOAD(kB, vB, it + 2);
        attn_tile<DQ, MOBA>(lds, 0, it, q0, w, qq, g, qrow, own, selbits, sc, qf, o, m, l);
        AT_LSTORE(kA, vA, 1);
        __syncthreads();
        if (it + 3 < ntiles) AT_GLOAD(kA, vA, it + 3);
        attn_tile<DQ, MOBA>(lds, 1, it + 1, q0, w, qq, g, qrow, own, selbits, sc, qf, o, m, l);
        if (it + 2 < ntiles) AT_LSTORE(kB, vB, 0);
        __syncthreads();
    }
    float ls = l + shfl_xor_(l, 16, lane); ls += shfl_xor_(ls, 32, lane);
    const float inv = 1.0f / ls;
#pragma unroll
    for (int i = 0; i < 8; ++i) { v2u ob; ob.x = pk2(o[i][0] * inv, o[i][1] * inv); ob.y = pk2(o[i][2] * inv, o[i][3] * inv);
        *(v2u*)(Og + (size_t)qrow * ldo + 16 * i + 4 * g) = ob; }
#undef AT_GLOAD
#undef AT_LSTORE
}
template <bool BT, class Epi>
__device__ __forceinline__ void gemm32(LAS float* lds, const float* A, int lda, size_t sA, const float* B, int ldb, size_t sB,
                                       int M, int N, int K, int nbatch, const int* rowidx, const Epi& epi, const int tid, const int G) {
    const int lane = tid & 63, wave = tid >> 6, wm = wave >> 1, wn = wave & 1;
    const int tilesM = (M + 127) >> 7, tilesN = (N + 127) >> 7, tilesPer = tilesM * tilesN, ntiles = tilesPer * nbatch;
    LAS float* As = lds;
    LAS float* Bs = lds + 2 * 16 * 132;
    for (int tile = blockIdx.x; tile < ntiles; tile += G) {
        const int bt = tile / tilesPer, r = tile % tilesPer, tm = r / tilesN, tn = r % tilesN;
        const int m0 = tm * 128, n0 = tn * 128;
        const float* Ab = A + (size_t)bt * sA; const float* Bb = B + (size_t)bt * sB;
        const int arow = tid >> 2, akq = (tid & 3) * 4;
        const int gr = m0 + arow; const bool aok = gr < M;
        const int src = aok ? (rowidx ? rowidx[gr] : gr) : 0;
        const float* ap = Ab + (size_t)src * lda + akq;
        const float* bp; bool bok; int bkr, bnq;
        if (BT) { bkr = 0; bnq = 0; const int gn = n0 + arow; bok = gn < N; bp = Bb + (size_t)(bok ? gn : 0) * ldb + akq; }
        else { bkr = tid >> 5; bnq = (tid & 31) * 4; bok = (n0 + bnq) < N; bp = Bb + (size_t)bkr * ldb + (bok ? (n0 + bnq) : 0); }
        f32x16 acc0, acc1;
#pragma unroll
        for (int i = 0; i < 16; ++i) { acc0[i] = 0.f; acc1[i] = 0.f; }
        f32x4 ra, rb;
        const f32x4 z4 = {0.f, 0.f, 0.f, 0.f};
        ra = aok ? *(const f32x4*)ap : z4;
        rb = bok ? *(const f32x4*)bp : z4;
        {
            LAS float* a_ = As; LAS float* b_ = Bs;
#pragma unroll
            for (int j = 0; j < 4; ++j) a_[(akq + j) * 132 + arow] = ra[j];
            if (BT) {
#pragma unroll
                for (int j = 0; j < 4; ++j) b_[(akq + j) * 132 + arow] = rb[j];
            } else *(LAS f32x4*)(b_ + bkr * 132 + bnq) = rb;
        }
        __syncthreads();
        for (int k0 = 0; k0 < K; k0 += 16) {
            const int cur = (k0 >> 4) & 1;
            const bool more = (k0 + 16) < K;
            if (more) {
                ra = aok ? *(const f32x4*)(ap + k0 + 16) : z4;
                if (BT) rb = bok ? *(const f32x4*)(bp + k0 + 16) : z4;
                else rb = bok ? *(const f32x4*)(bp + (size_t)(k0 + 16) * ldb) : z4;
            }
            const LAS float* a_ = As + cur * 16 * 132 + (lane >> 5) * 132 + wm * 32 + (lane & 31);
            const LAS float* b_ = Bs + cur * 16 * 132 + (lane >> 5) * 132 + wn * 64 + (lane & 31);
#pragma unroll
            for (int kk = 0; kk < 16; kk += 2) {
                const float a = a_[kk * 132], b0 = b_[kk * 132], b1 = b_[kk * 132 + 32];
                acc0 = __builtin_amdgcn_mfma_f32_32x32x2f32(a, b0, acc0, 0, 0, 0);
                acc1 = __builtin_amdgcn_mfma_f32_32x32x2f32(a, b1, acc1, 0, 0, 0);
            }
            if (more) {
                LAS float* aw = As + (cur ^ 1) * 16 * 132; LAS float* bw = Bs + (cur ^ 1) * 16 * 132;
#pragma unroll
                for (int j = 0; j < 4; ++j) aw[(akq + j) * 132 + arow] = ra[j];
                if (BT) {
#pragma unroll
                    for (int j = 0; j < 4; ++j) bw[(akq + j) * 132 + arow] = rb[j];
                } else *(LAS f32x4*)(bw + bkr * 132 + bnq) = rb;
            }
            __syncthreads();
        }
#pragma unroll
        for (int i = 0; i < 16; ++i) {
            const int row = m0 + wm * 32 + (i & 3) + 8 * (i >> 2) + 4 * (lane >> 5);
            const int c0 = n0 + wn * 64 + (lane & 31);
            if (row < M) {
                if (c0 < N) epi(bt, row, c0, acc0[i]);
                if (c0 + 32 < N) epi(bt, row, c0 + 32, acc1[i]);
            }
        }
    }
}

struct EpiStore { float* C; int ldc; size_t sC;
    __device__ __forceinline__ void operator()(int bt, int m, int n, float v) const { C[(size_t)bt * sC + (size_t)m * ldc + n] = v; } };
struct EpiDecay { float* C; const float* w0;
    __device__ __forceinline__ void operator()(int, int m, int n, float v) const {
        const float z = -(w0[n] + v); const float sp = z > 20.f ? z : log1pf(expf(z));
        C[(size_t)m * BW + n] = expf(-expf(-sp - 0.5f)); } };
struct EpiSigB { float* C; const float* b;
    __device__ __forceinline__ void operator()(int, int m, int n, float v) const { C[(size_t)m * BW + n] = sigmoidf_(b[n] + v); } };
struct EpiVLerp { float* V; const float* VF; const float* v0;
    __device__ __forceinline__ void operator()(int, int m, int n, float a) const {
        const size_t o = (size_t)m * BW + n; const float v = V[o]; V[o] = v + (VF[o] - v) * sigmoidf_(v0[n] + a); } };
template <bool FIRST> struct EpiGateAcc { float* MIX; const float* gate;
    __device__ __forceinline__ void operator()(int, int m, int n, float a) const {
        const float g = sigmoidf_(gate[(size_t)m * IN_COLS + n]); const size_t o = (size_t)m * D + n;
        MIX[o] = FIRST ? g * a : MIX[o] + g * a; } };
struct EpiResid { float* C; const float* R; int ldc;
    __device__ __forceinline__ void operator()(int, int m, int n, float a) const { const size_t o = (size_t)m * ldc + n; C[o] = ALPHA * R[o] + a; } };
struct EpiSwiglu { float* C; int ldc; size_t roff;
    __device__ __forceinline__ void operator()(int, int m, int n, float a) const {
        const size_t o = (roff + (size_t)m) * ldc + n; const float g = C[o]; C[o] = g * sigmoidf_(g) * a; } };

struct Args { const float* in[34]; float* out; unsigned char* ws; unsigned mask; int li; };

__device__ __forceinline__ unsigned char* opq(unsigned char* p) { asm volatile("" : "+s"(p)); return p; }
#define INP(i) ((const float*)(((const GAS float* const*)args.in)[(i) + zero_live]))
#define x_in INP(0)
#define w_in INP(1)
#define w_in_vres INP(2)
#define rwkv_mu INP(3)
#define rwkv_mu_vres INP(4)
#define rwkv_w0 INP(5)
#define rwkv_w_lora INP(6)
#define rwkv_a0 INP(7)
#define rwkv_a_lora INP(8)
#define rwkv_g_lora INP(9)
#define rwkv_v0 INP(10)
#define rwkv_v_lora INP(11)
#define rwkv_k_k INP(12)
#define rwkv_k_a INP(13)
#define rwkv_r_k INP(14)
#define rwkv_gn_g INP(15)
#define rwkv_gn_b INP(16)
#define mla_q_norm INP(17)
#define mla_w_uq INP(18)
#define mla_kv_norm INP(19)
#define mla_w_ukv INP(20)
#define branch_out INP(21)
#define w_out INP(22)
#define ln1_g INP(23)
#define ln1_b INP(24)
#define ffn_wg INP(25)
#define ffn_wu INP(26)
#define ffn_wd INP(27)
#define moe_router INP(28)
#define moe_wg INP(29)
#define moe_wu INP(30)
#define moe_wd INP(31)
#define ln2_g INP(32)
#define ln2_b INP(33)
#define COSA ((float*)(ws_live + WS_COSA))
#define SINA ((float*)(ws_live + WS_SINA))
#define COSM ((float*)(ws_live + WS_COSM))
#define SINM ((float*)(ws_live + WS_SINM))
#define TOK ((int*)(ws_live + WS_TOK))
#define ROWL ((int*)(ws_live + WS_ROWL))
#define XB ((float*)(ws_live + WS_XB))
#define X1 ((float*)(ws_live + WS_X1))
#define PRE ((float*)(ws_live + WS_PRE))
#define XBF ((bf16*)(ws_live + WS_XBF))
#define WINT ((bf16*)(ws_live + WS_WINT))
#define X1B ((bf16*)(ws_live + WS_X1B))
#define WBO ((bf16*)(ws_live + WS_WBO))
#define WOT ((bf16*)(ws_live + WS_WOT))
#define WGU ((bf16*)(ws_live + WS_WGU))
#define WD ((bf16*)(ws_live + WS_WD))
#define WDD ((bf16*)(ws_live + WS_WDD))
#define HGB ((bf16*)(ws_live + WS_HGB))
#define XG ((bf16*)(ws_live + WS_XG))
#define MIXB ((bf16*)(ws_live + WS_MIXB))
#define YALL ((bf16*)(ws_live + WS_YALL))
#define GATEB ((bf16*)(ws_live + WS_GATEB))
#define QAB ((bf16*)(ws_live + WS_QAB))
#define KAB ((bf16*)(ws_live + WS_KAB))
#define VAB ((bf16*)(ws_live + WS_VAB))
#define QCB ((bf16*)(ws_live + WS_QCB))
#define KCB ((bf16*)(ws_live + WS_KCB))
#define VCB ((bf16*)(ws_live + WS_VCB))
#define KMEAN ((float*)(ws_live + WS_KMEAN))
#define SELB ((unsigned char*)(ws_live + WS_SEL))
#define WUQ ((bf16*)(ws_live + WS_WUQ))
#define WUKV ((bf16*)(ws_live + WS_WUKV))
#define WLORA ((bf16*)(ws_live + WS_WLORA))
#define LA ((bf16*)(ws_live + WS_LA))
#define QNB ((bf16*)(ws_live + WS_QNB))
#define KVNB ((bf16*)(ws_live + WS_KVNB))
#define QF ((float*)(ws_live + WS_QF))
#define KMS ((float*)(ws_live + WS_KMEAN))
#define PROJ ((bf16*)(ws_live + WS_PROJ))
#define VRES ((float*)(ws_live + WS_VRES))
#define QA ((float*)(ws_live + WS_QA))
#define R_ ((float*)(ws_live + WS_R))
#define K2 ((float*)(ws_live + WS_K2))
#define V0 ((float*)(ws_live + WS_V0))
#define V1 ((float*)(ws_live + WS_V1))
#define DEC ((float*)(ws_live + WS_DEC))
#define AA ((float*)(ws_live + WS_AA))
#define GG ((float*)(ws_live + WS_GG))
#define Y ((float*)(ws_live + WS_Y))
#define OUT ((float*)(ws_live + WS_OUT))


__global__ void __launch_bounds__(NTHREADS, 2) fwd_kernel(Args args) {
    extern __shared__ __attribute__((aligned(16))) unsigned char lds_raw[];
#define lds ((LAS float*)lds_raw)
    int wave_live = __builtin_amdgcn_readfirstlane((int)threadIdx.x >> 6);
    int tid_live = threadIdx.x;
#define RETID() do { int ln_; asm volatile("v_mbcnt_lo_u32_b32 %0, -1, 0\n\tv_mbcnt_hi_u32_b32 %0, -1, %0" : "=v"(ln_)); asm volatile("" : "+s"(wave_live)); tid_live = wave_live * 64 + ln_; } while (0)
#define tid tid_live
#define lane (tid_live & 63)
#define wave (__builtin_amdgcn_readfirstlane(tid_live >> 6))
#define gw ((int)blockIdx.x * NWAVES + wave)
#define NGW (G_live * NWAVES)
#define gt ((int)blockIdx.x * NTHREADS + tid_live)
#define NGT (G_live * NTHREADS)
#define misc ((volatile LAS unsigned*)((LAS unsigned char*)lds_raw + LDS_BYTES - 64))
    if (tid < 16) misc[tid] = tid == 6 ? 0xffffffffu : 0u;
    __syncthreads();
#define REOPAQUE() do { asm volatile("" : "+s"(ws_live)); asm volatile("" : "+s"(zero_live)); asm volatile("" : "+s"(G_live)); RETID(); } while (0)
#define TI_WINT(t_, ll_, r_) do { constexpr int NNB_ = NP / 32; const int kb_ = (r_) / NNB_, nb_ = (r_) % NNB_, c_ = nb_ * 32; \
    const float* W_ = w_in + (size_t)(ll_) * D * IN_COLS; int ldw_ = IN_COLS, sc_ = c_; \
    if (c_ < 6432) sc_ = c_; \
    else if (c_ < 6464) { if (ll_) { W_ = w_in_vres; ldw_ = 32; sc_ = 0; } else W_ = nullptr; } \
    else if (c_ < 7552) sc_ = c_ - 32; \
    else if (c_ < 7680) W_ = nullptr; \
    else sc_ = c_ - 160; \
    int scl_ = sc_ + (lane & 31); \
    if (c_ < 2048) { const int cl_ = c_ + (lane & 31), hh_ = cl_ >> 7, cc_ = cl_ & 127, e_ = cc_ & 7; scl_ = hh_ * 128 + (e_ < 4 ? 4 * (cc_ >> 3) + e_ : 64 + 4 * (cc_ >> 3) + (e_ - 4)); } \
    (t_).zero = W_ == nullptr; (t_).p = (W_ ? W_ : w_in) + scl_; (t_).ldw = ldw_; (t_).wt = WINT + (size_t)(ll_) * NP * D; (t_).K = D; (t_).r0 = c_; (t_).k0 = kb_ * 64; } while (0)
#define TI_WBO(t_, mat_, r_) do { const int kb_ = (r_) / 64, nb_ = (r_) % 64, ll_ = (mat_) / 3, seg_ = (mat_) % 3; \
    (t_).zero = false; (t_).p = branch_out + (size_t)(mat_) * BW * D + nb_ * 32 + (lane & 31); (t_).ldw = D; (t_).wt = WBO + (size_t)ll_ * D * 3 * BW + seg_ * BW; (t_).K = 3 * BW; (t_).r0 = nb_ * 32; (t_).k0 = kb_ * 64; } while (0)
#define TI_WUQ(t_, mat_, r_) do { const int kb_ = (r_) / 48, nb_ = (r_) % 48; \
    const int np_ = nb_ * 32 + (lane & 31), hh_ = np_ / 192, cc_ = np_ - hh_ * 192, q_ = cc_ - 128, e_ = q_ & 7; \
    const int sc_ = cc_ < 128 ? hh_ * 192 + cc_ : hh_ * 192 + 128 + (e_ < 4 ? 4 * (q_ >> 3) + e_ : 32 + 4 * (q_ >> 3) + (e_ - 4)); \
    (t_).zero = false; (t_).p = mla_w_uq + (size_t)(mat_) * 512 * 1536 + sc_; (t_).ldw = 1536; (t_).wt = WUQ + (size_t)(mat_) * 1536 * 512; (t_).K = 512; (t_).r0 = nb_ * 32; (t_).k0 = kb_ * 64; } while (0)
#define TI_WUKV(t_, mat_, r_) do { const int kb_ = (r_) / 64, nb_ = (r_) % 64; \
    (t_).zero = false; (t_).p = mla_w_ukv + (size_t)(mat_) * 512 * 2048 + nb_ * 32 + (lane & 31); (t_).ldw = 2048; (t_).wt = WUKV + (size_t)(mat_) * 2048 * 512; (t_).K = 512; (t_).r0 = nb_ * 32; (t_).k0 = kb_ * 64; } while (0)
#define TI_WOT(t_, mat_, r_) do { const int kb_ = (r_) / 64, nb_ = (r_) % 64; \
    (t_).zero = false; (t_).p = w_out + (size_t)(mat_) * D * D + nb_ * 32 + (lane & 31); (t_).ldw = D; (t_).wt = WOT + (size_t)(mat_) * D * D; (t_).K = D; (t_).r0 = nb_ * 32; (t_).k0 = kb_ * 64; } while (0)
constexpr int FC_I_GU = (D / 64) * (NGU / 32), FC_I_D = (DFF / 64) * (D / 32);
#define TI_GU(t_, wg_, wu_, e_, r_) do { const int kb_ = (r_) / (NGU / 32), nb_ = (r_) % (NGU / 32); const int rr_ = lane & 31, hcol_ = 4 * (nb_ * 4 + (rr_ >> 3)) + (rr_ & 3); \
    (t_).zero = false; (t_).p = ((rr_ & 7) < 4 ? (wg_) : (wu_)) + (size_t)(e_) * D * DFF + hcol_; (t_).ldw = DFF; (t_).wt = WGU + (size_t)(e_) * NGU * D; (t_).K = D; (t_).r0 = nb_ * 32; (t_).k0 = kb_ * 64; } while (0)
#define TI_D(t_, wd_, dst_, e_, r_) do { const int kb_ = (r_) / (D / 32), nb_ = (r_) % (D / 32); \
    (t_).zero = false; (t_).p = (wd_) + (size_t)(e_) * DFF * D + nb_ * 32 + (lane & 31); (t_).ldw = D; (t_).wt = (dst_) + (size_t)(e_) * D * DFF; (t_).K = DFF; (t_).r0 = nb_ * 32; (t_).k0 = kb_ * 64; } while (0)
#define TI_RUN1(ta_) do { float va_[32]; ti_load(ta_, va_, lane); ti_finish(ta_, va_, scr, lane); } while (0)
#define TI_RUN2(ta_, tb_) do { float va_[32], vb_[32]; ti_load(ta_, va_, lane); ti_load(tb_, vb_, lane); ti_finish(ta_, va_, scr, lane); ti_finish(tb_, vb_, scr, lane); } while (0)
#define CV_WINT_ITEM(ll_, r_) do { TI t1_; TI_WINT(t1_, ll_, r_); TI_RUN1(t1_); } while (0)
#define CV_WUQ_ITEM(mat_, r_) do { TI t1_; TI_WUQ(t1_, mat_, r_); TI_RUN1(t1_); } while (0)
#define CV_WUKV_ITEM(mat_, r_) do { TI t1_; TI_WUKV(t1_, mat_, r_); TI_RUN1(t1_); } while (0)
#define CV_LORA_ITEM(ll_, r_) do { \
    for (int j_ = 0; j_ < 32; ++j_) { const int x_ = (r_) * 2048 + j_ * 64 + lane, n_ = x_ / 384, k_ = x_ % 384, seg_ = n_ >> 10, c_ = n_ & 1023; \
        float v_ = 0.f; \
        if (seg_ == 0) { if (k_ < 64) v_ = rwkv_w_lora[((size_t)(ll_) * 64 + k_) * BW + c_]; } \
        else if (seg_ == 1) { if (k_ >= 64 && k_ < 128) v_ = rwkv_a_lora[((size_t)(ll_) * 64 + (k_ - 64)) * BW + c_]; } \
        else if (seg_ == 2) { if (k_ >= 128 && k_ < 288) v_ = rwkv_g_lora[((size_t)(ll_) * 160 + (k_ - 128)) * BW + c_]; } \
        else { if ((ll_) == 1 && k_ >= 288 && k_ < 320) v_ = rwkv_v_lora[(size_t)(k_ - 288) * BW + c_]; } \
        WLORA[(size_t)(ll_) * 4096 * 384 + x_] = (bf16)f2bf(v_); } } while (0)
#define FFN_CONV_PAIR(it_) do { const int fi_ = (it_); \
    if (l == 0) { if (fi_ < FC_I_GU) PAIR_OF(TI_GU, ffn_wg, ffn_wu, 0, fi_); else PAIR_OF(TI_D, ffn_wd, WDD, 0, fi_ - FC_I_GU); } \
    else PAIR_OF(TI_GU, moe_wg, moe_wu, fi_ / FC_I_GU, fi_ % FC_I_GU); } while (0)
#define FFN_CONV_N(l_) ((l_) == 0 ? FC_I_GU + FC_I_D : 4 * FC_I_GU)
#define PAIR_OF(TIM_, ...) do { TI ta_, tb_; TIM_(ta_, __VA_ARGS__); TIM_(tb_, __VA_ARGS__ + 1); TI_RUN2(ta_, tb_); } while (0)
#define DQ_PAIR(d_) do { const int d__ = (d_); \
    if (d__ < 3072) { PAIR_OF(TI_WBO, d__ >> 10, (d__ & 1023)); asm volatile("; dq0" ::: "memory"); } \
    else if (d__ < 5120) { PAIR_OF(TI_WOT, 0, d__ - 3072); asm volatile("; dq1" ::: "memory"); } \
    else if (d__ < 18944) { PAIR_OF(TI_WINT, 1, d__ - 5120); asm volatile("; dq2" ::: "memory"); } \
    else if (d__ < 19712) { }   \
    else if (d__ < 20096) { PAIR_OF(TI_WUQ, 1, d__ - 19712); asm volatile("; dq3" ::: "memory"); } \
    else if (d__ < 20608) { PAIR_OF(TI_WUKV, 1, d__ - 20096); asm volatile("; dq4" ::: "memory"); } \
    else if (d__ < 23680) { PAIR_OF(TI_WBO, 3 + ((d__ - 20608) >> 10), ((d__ - 20608) & 1023)); asm volatile("; dq5" ::: "memory"); } \
    else if (d__ < 25728) { PAIR_OF(TI_WOT, 1, d__ - 23680); asm volatile("; dq6" ::: "memory"); } \
    else if (d__ < DQ_J7) { PAIR_OF(TI_GU, moe_wg, moe_wu, 4 + (d__ - 25728) / FC_I_GU, (d__ - 25728) % FC_I_GU); asm volatile("; dq7" ::: "memory"); } \
    else { PAIR_OF(TI_D, moe_wd, WD, (d__ - DQ_J7) / FC_I_D, (d__ - DQ_J7) % FC_I_D); asm volatile("; dq8" ::: "memory"); } } while (0)
#define DQ_HALF(base_) do { const int dit_ = (int)(base_) + 2 * wave; if (dit_ < DQ_N) DQ_PAIR(dit_); } while (0)
#define DQ_PENDING() do { const unsigned pu_ = (unsigned)__builtin_amdgcn_readfirstlane((int)misc[6]); __syncthreads(); \
        if (pu_ != 0xffffffffu) { if (tid == 0) misc[6] = 0xffffffffu; DQ_HALF(pu_); } } while (0)
#define DQ_RUN(COND_) do { DQ_PENDING(); for (;;) { \
        if (tid == 0) { unsigned u_ = 0xffffffffu; \
            if (xb_ld(ctl + CW_DQ + 64 * li_) < (unsigned)DQ_N && (COND_)) u_ = atomicAdd(ctl + CW_DQ + 64 * li_, 32u); \
            misc[4] = u_; } \
        __syncthreads(); \
        const unsigned du_ = (unsigned)__builtin_amdgcn_readfirstlane((int)misc[4]); \
        __syncthreads(); \
        if (du_ >= (unsigned)DQ_N) break; \
        DQ_HALF(du_); \
        if (tid == 0) misc[5] = (COND_) ? 1u : 0u; \
        __syncthreads(); \
        const unsigned go_ = (unsigned)__builtin_amdgcn_readfirstlane((int)misc[5]); \
        __syncthreads(); \
        if (!go_) { if (tid == 0) misc[6] = du_ + 16u; __syncthreads(); break; } \
        DQ_HALF(du_ + 16u); \
    } } while (0)
#define DQ_FLUSH(UPTO_) do { DQ_PENDING(); for (;;) { \
        if (tid == 0) { const unsigned h_ = xb_ld(ctl + CW_DQ + 64 * li_); unsigned u_ = 0xffffffffu, nb_ = 0u; \
            if (h_ < (unsigned)(UPTO_)) { nb_ = ((((unsigned)(UPTO_) - h_ + (unsigned)G_live - 1u) / (unsigned)G_live) + 7u) & ~7u; nb_ = nb_ < 16u ? 16u : nb_; u_ = atomicAdd(ctl + CW_DQ + 64 * li_, nb_); } \
            misc[4] = u_; misc[5] = nb_; } \
        __syncthreads(); \
        const unsigned du_ = (unsigned)__builtin_amdgcn_readfirstlane((int)misc[4]), dn_ = (unsigned)__builtin_amdgcn_readfirstlane((int)misc[5]); \
        __syncthreads(); \
        if (du_ >= (unsigned)DQ_N) break; \
        const int de_ = (int)min(du_ + dn_, (unsigned)DQ_N); \
        _Pragma("unroll 1") \
        for (int dit_ = (int)du_ + 2 * wave; dit_ < de_; dit_ += 16) DQ_PAIR(dit_); \
    } } while (0)
#define DQ_FILL(SLOT_, TH_) DQ_RUN(xb_ld(ctl + CW_PD + 64 * ((SLOT_) + 8 * li_)) < (unsigned)(TH_))
#define PHASE_DONE(SLOT_) do { if (tid == 0) atomicAdd(ctl + CW_PD + 64 * ((SLOT_) + 8 * li_), 1u); } while (0)
#define GRID_BAR() do { { XcdBarrier bar_; bar_.bar = ctl + CW_BAR + li_ * XCD_BAR_WORDS; bar_.x = xb_xcc_id(); bar_.st = misc; xcd_barrier(bar_, tid_live); } asm volatile("" : "+s"(ws_live)); asm volatile("" : "+s"(zero_live)); asm volatile("" : "+s"(G_live)); RETID(); } while (0)

    GAS unsigned char* ws_live = *(GAS unsigned char* const*)&args.ws; int zero_live = 0; int G_live = (int)gridDim.x; unsigned mask_live = args.mask; const int li_ = args.li;
#define RUN(p) ((mask_live >> (l * 12 + (p))) & 1u)
#define ctl ((unsigned*)(ws_live + WS_CTL))
    (void)xcd_barrier_post(ctl + CW_BAR + li_ * XCD_BAR_WORDS, misc, tid_live);
    if (mask_live & (1u << 31)) {
    for (int i = gt; i < SEQ * 64; i += NGT) {
        const int s = i >> 6, j = i & 63;
        const float inv = 1.0f / powf(10000.0f, (float)(2 * j) / 128.0f);
        const float ang = (float)s * inv;
        COSA[i] = cosf(ang); SINA[i] = sinf(ang);
    }
    for (int i = gt; i < SEQ * 32; i += NGT) {
        const int s = i >> 5, j = i & 31;
        const float inv = 1.0f / powf(10000.0f, (float)(2 * j) / 64.0f);
        const float ang = (float)s * inv;
        COSM[i] = cosf(ang); SINM[i] = sinf(ang);
    }

    {
        LAS float* scr = (LAS float*)((LAS unsigned char*)lds_raw) + wave * (64 * 33);
        for (int it = gw; it < (D / 64) * (NP / 32); it += NGW) CV_WINT_ITEM(0, it);
        for (int it = gw; it < 2 * 768; it += NGW) { const int ll = it / 768, r = it % 768; CV_LORA_ITEM(ll, r); }
        for (int it = gw; it < 8 * 48; it += NGW) CV_WUQ_ITEM(0, it);
        for (int it = gw; it < 8 * 64; it += NGW) CV_WUKV_ITEM(0, it);
        for (int t = gw; t < T; t += NGW) {
#pragma unroll
            for (int jj = 0; jj < 8; ++jj) { const f32x4 v = *(const f32x4*)(x_in + (size_t)t * D + jj * 256 + lane * 4);
                v2u o; o.x = pk2(v[0], v[1]); o.y = pk2(v[2], v[3]); *(v2u*)(XBF + (size_t)t * D + jj * 256 + lane * 4) = o; }
        }
    }
    GRID_BAR();
    }
    for (int l = 0; l < 2; ++l) {
        const float* X = (l == 0) ? x_in : XB;
        float* Vcur = (l == 0) ? V0 : V1;
        if (RUN(0)) {
        {
            pg8::Gemm g{XBF, WINT + (size_t)l * NP * D, T, NP, D}; pg8::StaticOrder S; S.init(T, NP, G_live, (int)blockIdx.x);
            EpiInProjF32 E{PROJ, VRES, GATEB, QF, KAB, VAB, COSA, SINA, l};
            pg8::gemm_phase<EpiInProjF32, pg8::StaticOrder, false>((LAS unsigned char*)lds_raw, g, S, E, nullptr, tid);
        }
        REOPAQUE();
        {
            LAS float* scr = (LAS float*)((LAS unsigned char*)lds_raw) + wave * (64 * 33);
            PHASE_DONE(l * 4 + 0);
            DQ_FILL(l * 4 + 0, 65);
        }
        GRID_BAR();
        }
        if (RUN(1)) {
        if (l == 1) { LAS float* scr = (LAS float*)((LAS unsigned char*)lds_raw) + wave * (64 * 33); DQ_FLUSH(DQ_J5); }
        for (int item = blockIdx.x; item < NBATCH * 8 * 8; item += G_live) {
            const int blk = item & 7, h = (item >> 3) & 7, b = item >> 6;
            const int kq = tid >> 4, d8 = (tid & 15) * 8;
            const bf16* kbase = KAB + ((size_t)b * SEQ + blk * 256) * BW + h * 128 + d8;
            float sacc[8];
#pragma unroll
            for (int j = 0; j < 8; ++j) sacc[j] = 0.f;
#pragma unroll
            for (int it = 0; it < 8; ++it) { const v4u kv = *(const v4u*)(kbase + (size_t)(kq + 32 * it) * BW); const unsigned kw[4] = {kv.x, kv.y, kv.z, kv.w};
#pragma unroll
                for (int j = 0; j < 4; ++j) { sacc[2 * j] += __uint_as_float(kw[j] << 16); sacc[2 * j + 1] += __uint_as_float(kw[j] & 0xffff0000u); } }
#pragma unroll
            for (int j = 0; j < 8; ++j) lds[kq * 128 + d8 + j] = sacc[j];
            __syncthreads();
            if (tid < 128) { float a = 0.f;
#pragma unroll
                for (int rr = 0; rr < 32; ++rr) a += lds[rr * 128 + tid];
                KMS[(size_t)item * 128 + tid] = a; }
            __syncthreads();
        }
        {
            const float* mu = rwkv_mu + l * RWKV_COLS;
            for (int i0 = gt; i0 < (T / 4) * 768; i0 += 2 * NGT) {
                v2u row[2][5]; f32x4 mu4[2]; int tq[2], cc[2];
#pragma unroll
                for (int u_ = 0; u_ < 2; ++u_) {
                    const int i = i0 + u_ * NGT, ic = i < (T / 4) * 768 ? i : gt;
                    const int q = ic / 768, c4 = (ic - q * 768) * 4, t0 = 4 * q, s0 = t0 & (SEQ - 1);
                    tq[u_] = i < (T / 4) * 768 ? t0 : -1; cc[u_] = c4;
                    const bf16* pr = PROJ + (size_t)t0 * PLD + (OFF_RWKV - PSH) + c4;
                    row[u_][0] = *(const v2u*)(s0 > 0 ? pr - PLD : pr);
                    if (s0 == 0) row[u_][0] = (v2u){0u, 0u};
#pragma unroll
                    for (int k = 0; k < 4; ++k) row[u_][k + 1] = *(const v2u*)(pr + (size_t)k * PLD);
                    mu4[u_] = *(const f32x4*)(mu + c4);
                }
#pragma unroll
                for (int u_ = 0; u_ < 2; ++u_) if (tq[u_] >= 0) {
                    float* dst = (cc[u_] < 1024 ? R_ : (cc[u_] < 2048 ? K2 : Vcur)) + (size_t)tq[u_] * BW + (cc[u_] & 1023);
#pragma unroll
                    for (int k = 0; k < 4; ++k) { const f32x4 cu = bf4_to_f32(row[u_][k + 1]), pv = bf4_to_f32(row[u_][k]); *(f32x4*)(dst + (size_t)k * BW) = cu + (pv - cu) * mu4[u_]; }
                }
            }
            for (int i = gt; i < T * 96; i += NGT) {
                const int t = i / 96, c4 = (i - t * 96) * 4, s = t & (SEQ - 1);
                f32x4 v = {0.f, 0.f, 0.f, 0.f};
                if (c4 < 288) {
                    const f32x4 cur = bf4_to_f32(*(const v2u*)(PROJ + (size_t)t * PLD + (OFF_RWKV - PSH) + 3072 + c4));
                    f32x4 prev = {0.f, 0.f, 0.f, 0.f}; if (s > 0) prev = bf4_to_f32(*(const v2u*)(PROJ + (size_t)(t - 1) * PLD + (OFF_RWKV - PSH) + 3072 + c4));
                    v = cur + (prev - cur) * *(const f32x4*)(mu + 3072 + c4);
                    if (c4 < 64) { v[0] = tanhf(v[0]); v[1] = tanhf(v[1]); v[2] = tanhf(v[2]); v[3] = tanhf(v[3]); }
                    else if (c4 >= 128) { v[0] = sigmoidf_(v[0]); v[1] = sigmoidf_(v[1]); v[2] = sigmoidf_(v[2]); v[3] = sigmoidf_(v[3]); }
                } else if (c4 < 320 && l == 1) {
                    const f32x4 cur = *(const f32x4*)(VRES + (size_t)t * 32 + (c4 - 288));
                    f32x4 prev = {0.f, 0.f, 0.f, 0.f}; if (s > 0) prev = *(const f32x4*)(VRES + (size_t)(t - 1) * 32 + (c4 - 288));
                    v = cur + (prev - cur) * *(const f32x4*)(rwkv_mu_vres + (c4 - 288));
                }
                v2u o; o.x = pk2(v[0], v[1]); o.y = pk2(v[2], v[3]); *(v2u*)(LA + (size_t)t * 384 + c4) = o;
            }
        }
        for (int t = gw; t < T; t += NGW) {
            const bf16* q = PROJ + (size_t)t * PLD + (OFF_MLA - PSH);
#pragma unroll
            for (int part = 0; part < 2; ++part) {
                const v4u qw = *(const v4u*)(q + part * 512 + lane * 8); v2u qlo, qhi; qlo.x = qw.x; qlo.y = qw.y; qhi.x = qw.z; qhi.y = qw.w;
                const f32x4 a = bf4_to_f32(qlo), b2 = bf4_to_f32(qhi);
                const float ss = (a[0] * a[0] + a[1] * a[1]) + (a[2] * a[2] + a[3] * a[3]) + (b2[0] * b2[0] + b2[1] * b2[1]) + (b2[2] * b2[2] + b2[3] * b2[3]);
                const float rs = rsqrtf(wave_sum(ss, lane) * (1.0f / 512.0f) + 1e-6f);
                const float* gn = (part ? mla_kv_norm : mla_q_norm) + l * 512 + lane * 8;
                const f32x4 g0 = *(const f32x4*)gn, g1 = *(const f32x4*)(gn + 4);
                v4u w; w.x = pk2(a[0] * rs * g0[0], a[1] * rs * g0[1]); w.y = pk2(a[2] * rs * g0[2], a[3] * rs * g0[3]);
                w.z = pk2(b2[0] * rs * g1[0], b2[1] * rs * g1[1]); w.w = pk2(b2[2] * rs * g1[2], b2[3] * rs * g1[3]);
                *(v4u*)((part ? KVNB : QNB) + (size_t)t * 512 + lane * 8) = w;
            }
            if (lane < 32) {
                const int s = t & (SEQ - 1);
                const float x1 = __builtin_bit_cast(float, (unsigned)q[1024 + lane] << 16), x2 = __builtin_bit_cast(float, (unsigned)q[1024 + 32 + lane] << 16), c = COSM[s * 32 + lane], sn = SINM[s * 32 + lane];
                const bf16 o1 = (bf16)f2bf(x1 * c - x2 * sn), o2 = (bf16)f2bf(x2 * c + x1 * sn);
#pragma unroll
                for (int hh = 0; hh < 8; ++hh) { KCB[(size_t)t * 1536 + hh * 192 + 128 + lane] = o1; KCB[(size_t)t * 1536 + hh * 192 + 160 + lane] = o2; }
            }
        }
        GRID_BAR();
        }
        if (RUN(2)) {
        {
            pg8::Gemm g{LA, WLORA + (size_t)l * 4096 * 384, T, l ? 4096 : 3072, 384 + zero_live}; pg8::StaticOrder S; S.init(T, l ? 4096 : 3072, G_live, (int)blockIdx.x);
            EpiLora E{DEC, AA, GG, V1, V0, rwkv_w0 + l * BW, rwkv_a0 + l * BW, rwkv_v0};
            pg8::gemm_phase<EpiLora, pg8::StaticOrder, false>((LAS unsigned char*)lds_raw, g, S, E, nullptr, tid);
        }
        REOPAQUE();
        {
            pg8::Gemm g{QNB, WUQ + (size_t)l * 1536 * 512, T, 1536, 512 + zero_live}; pg8::StaticOrder S; S.init(T, 1536, G_live, (int)blockIdx.x);
            EpiMlaQ E{QCB, COSM, SINM};
            pg8::gemm_phase<EpiMlaQ, pg8::StaticOrder, false>((LAS unsigned char*)lds_raw, g, S, E, nullptr, tid);
        }
        REOPAQUE();
        {
            pg8::Gemm g{KVNB, WUKV + (size_t)l * 2048 * 512, T, 2048, 512 + zero_live}; pg8::StaticOrder S; S.init(T, 2048, G_live, (int)blockIdx.x);
            EpiMlaKV E{KCB, VCB};
            pg8::gemm_phase<EpiMlaKV, pg8::StaticOrder, false>((LAS unsigned char*)lds_raw, g, S, E, nullptr, tid);
        }
        REOPAQUE();
        for (int i = gt; i < T * 8 * 16; i += NGT) {
            const int th = i >> 4, jg = (i & 15) * 4, t = th >> 3, h = th & 7, s = t & (SEQ - 1), own = s >> 8;
            const float* src_ = QF + (size_t)t * BW + h * 128 + jg;
            const f32x4 q1 = *(const f32x4*)src_, q2 = *(const f32x4*)(src_ + 64);
            v2u w1; w1.x = pk2(q1[0], q1[1]); w1.y = pk2(q1[2], q1[3]); v2u w2; w2.x = pk2(q2[0], q2[1]); w2.y = pk2(q2[2], q2[3]);
            *(v2u*)(QAB + (size_t)t * BW + h * 128 + jg) = w1; *(v2u*)(QAB + (size_t)t * BW + h * 128 + 64 + jg) = w2;
            const float* km = KMS + (size_t)(((t >> 11) * 8 + h) * 8) * 128 + jg;
            float gate[7];
#pragma unroll
            for (int n = 0; n < 7; ++n) {
                const f32x4 k1 = *(const f32x4*)(km + n * 128), k2 = *(const f32x4*)(km + n * 128 + 64);
                const float part = ((q1[0] * k1[0] + q1[1] * k1[1]) + (q1[2] * k1[2] + q1[3] * k1[3])) + ((q2[0] * k2[0] + q2[1] * k2[1]) + (q2[2] * k2[2] + q2[3] * k2[3]));
                gate[n] = row_allsum16(part);
            }
            unsigned bits = 0;
#pragma unroll
            for (int n = 0; n < 7; ++n) {
                int rank = 0;
#pragma unroll
                for (int m2 = 0; m2 < 7; ++m2) if (m2 != n) rank += (m2 < own && (gate[m2] > gate[n] || (gate[m2] == gate[n] && m2 < n))) ? 1 : 0;
                bits |= ((n < own) && (rank < 3)) ? (1u << n) : 0u;
            }
            if ((i & 15) == 0) SELB[(size_t)t * 8 + h] = (unsigned char)bits;
        }
        {
            LAS float* scr = (LAS float*)((LAS unsigned char*)lds_raw) + wave * (64 * 33);
            __syncthreads();
            PHASE_DONE(l * 4 + 2);
            DQ_FILL(l * 4 + 2, l == 0 ? 129 : 65);
        }
        GRID_BAR();
        }
        if (RUN(3)) {
        if (!(mask_live & (1u << 30)))
        for (int item = blockIdx.x; item < 128; item += G_live) {
            const int bh = item >> 1, half = item & 1, b = bh >> 4, h = bh & 15;
            const size_t base = (size_t)b * SEQ * BW + h * 64;
            constexpr int CH = 32, BUFF = 6 * CH * 64;
            LAS float* ypart = lds + 2 * BUFF;
            const int st_step = tid >> 4, st_j = (tid & 15) * 4;
            const int cbase = l * BW + h * 64 + st_j;
            const f32x4 ckk = *(const f32x4*)(rwkv_k_k + cbase), cka = *(const f32x4*)(rwkv_k_a + cbase);
            const int cg = lane & 15, rl = tid >> 4, irow = 32 * half + rl;
            const bool stager = tid < CH * 16;
            f32x4 g_r = {0.f, 0.f, 0.f, 0.f}, g_w = g_r, g_k = g_r, g_a = g_r, g_v = g_r;
            float sa = 0.f, sb = 0.f, sc2 = 0.f, sd = 0.f;
#define SC_GLOAD(c) do { if (stager) { const size_t o_ = base + (size_t)((c) * CH + st_step) * BW + st_j; \
                g_r = *(const f32x4*)(R_ + ((c) * CH + st_step > 0 ? o_ - BW : o_)); g_w = *(const f32x4*)(DEC + o_); g_k = *(const f32x4*)(K2 + o_); \
                g_a = *(const f32x4*)(AA + o_); g_v = *(const f32x4*)(Vcur + o_); } } while (0)
#define SC_LSTORE(bufi) do { if (stager) { f32x4 kk_ = g_k * ckk; \
                const float n2_ = row_allsum16((kk_[0] * kk_[0] + kk_[1] * kk_[1]) + (kk_[2] * kk_[2] + kk_[3] * kk_[3])); \
                kk_ = kk_ * __builtin_amdgcn_rcpf(fmaxf(sqrtf(n2_), 1e-12f)); \
                const f32x4 k2_ = g_k * (1.0f + (g_a - 1.0f) * cka); \
                LAS float* bb_ = lds + (bufi) * BUFF + st_step * 64 + st_j; \
                *(LAS f32x4*)(bb_ + 0 * CH * 64) = g_r; *(LAS f32x4*)(bb_ + 1 * CH * 64) = g_w; *(LAS f32x4*)(bb_ + 2 * CH * 64) = k2_; \
                *(LAS f32x4*)(bb_ + 3 * CH * 64) = kk_; *(LAS f32x4*)(bb_ + 4 * CH * 64) = kk_ * g_a; *(LAS f32x4*)(bb_ + 5 * CH * 64) = g_v; } } while (0)
#define SC_LD(X, st_) do { const LAS float* p_ = bb + (st_) * 64 + 4 * cg; \
                X##r = *(const LAS f32x4*)(p_ + 0 * CH * 64); X##w = *(const LAS f32x4*)(p_ + 1 * CH * 64); X##k = *(const LAS f32x4*)(p_ + 2 * CH * 64); \
                X##q = *(const LAS f32x4*)(p_ + 3 * CH * 64); X##b = *(const LAS f32x4*)(p_ + 4 * CH * 64); X##v = bb[5 * CH * 64 + (st_) * 64 + irow]; } while (0)
#define SC_STEP(X, st_) do { float d_, y_, t0_, t1_, t2_, t3_; \
                asm("v_mul_f32 %0, %4, %8\n\tv_mul_f32 %1, %4, %12\n\tv_mul_f32 %2, %6, %10\n\tv_mul_f32 %3, %6, %14\n\t" \
                    "v_fma_f32 %0, %5, %9, %0\n\tv_fma_f32 %1, %5, %13, %1\n\tv_fma_f32 %2, %7, %11, %2\n\tv_fma_f32 %3, %7, %15, %3\n\t" \
                    "v_add_f32 %0, %0, %2\n\tv_add_f32 %1, %1, %3" \
                    : "=&v"(d_), "=&v"(y_), "=&v"(t0_), "=&v"(t1_) \
                    : "v"(sa), "v"(sb), "v"(sc2), "v"(sd), "v"(X##q[0]), "v"(X##q[1]), "v"(X##q[2]), "v"(X##q[3]), "v"(X##r[0]), "v"(X##r[1]), "v"(X##r[2]), "v"(X##r[3])); \
                asm("s_nop 1\n\tv_add_f32_dpp %0, %0, %0 quad_perm:[1,0,3,2] row_mask:0xf bank_mask:0xf bound_ctrl:1\n\ts_nop 1\n\t" \
                    "v_add_f32_dpp %0, %0, %0 quad_perm:[2,3,0,1] row_mask:0xf bank_mask:0xf bound_ctrl:1" : "+v"(y_)); \
                ypart[(st_) * 128 + rl * 4 + (cg >> 2)] = y_;     \
                asm("v_mul_f32 %5, %9, %10\n\tv_mul_f32 %6, %9, %11\n\t" \
                    "v_add_f32_dpp %0, %0, %0 row_ror:8 row_mask:0xf bank_mask:0xf bound_ctrl:1\n\t" \
                    "v_mul_f32 %7, %9, %12\n\tv_mul_f32 %8, %9, %13\n\t" \
                    "v_add_f32_dpp %0, %0, %0 row_ror:4 row_mask:0xf bank_mask:0xf bound_ctrl:1\n\t" \
                    "v_fma_f32 %5, %1, %14, %5\n\tv_fma_f32 %6, %2, %15, %6\n\t" \
                    "v_add_f32_dpp %0, %0, %0 row_ror:2 row_mask:0xf bank_mask:0xf bound_ctrl:1\n\t" \
                    "v_fma_f32 %7, %3, %16, %7\n\tv_fma_f32 %8, %4, %17, %8\n\t" \
                    "v_add_f32_dpp %0, %0, %0 row_ror:1 row_mask:0xf bank_mask:0xf bound_ctrl:1\n\t" \
                    "s_nop 1\n\t" \
                    "v_fma_f32 %1, -%0, %18, %5\n\tv_fma_f32 %2, -%0, %19, %6\n\tv_fma_f32 %3, -%0, %20, %7\n\tv_fma_f32 %4, -%0, %21, %8" \
                    : "+v"(d_), "+v"(sa), "+v"(sb), "+v"(sc2), "+v"(sd), "=&v"(t0_), "=&v"(t1_), "=&v"(t2_), "=&v"(t3_) \
                    : "v"(X##v), "v"(X##k[0]), "v"(X##k[1]), "v"(X##k[2]), "v"(X##k[3]), "v"(X##w[0]), "v"(X##w[1]), "v"(X##w[2]), "v"(X##w[3]), \
                      "v"(X##b[0]), "v"(X##b[1]), "v"(X##b[2]), "v"(X##b[3])); } while (0)
            SC_GLOAD(0); SC_LSTORE(0);
            __syncthreads();
            for (int c = 0; c < SEQ / CH; ++c) {
                const bool more = (c + 1) < SEQ / CH;
                if (c == SEQ / CH - 2 && tid == 0) atomicAdd(ctl + CW_SD + 64 * (l + 2 * li_), 1u);
                if (more) SC_GLOAD(c + 1);
                const LAS float* bb = lds + (c & 1) * BUFF;
                f32x4 Ar, Aw, Ak, Aq, Ab, Br, Bw, Bk, Bq, Bb; float Av, Bv;
                SC_LD(A, 0);
#pragma unroll 1
                for (int st = 0; st < CH; st += 2) {
                    SC_LD(B, st + 1);
                    SC_STEP(A, st);
                    if (st + 2 < CH) SC_LD(A, st + 2);
                    SC_STEP(B, st + 1);
                }
                __syncthreads();
                {
                    const int stp = tid >> 4, r2 = (tid & 15) * 2;
                    const LAS f32x4* pp = (const LAS f32x4*)(ypart + stp * 128 + r2 * 4);
                    const f32x4 a0 = pp[0], a1 = pp[1];
                    if (c * CH + stp > 0) { float* yo = Y + base + (size_t)(c * CH + stp - 1) * BW + 32 * half + r2;
                        yo[0] = (a0[0] + a0[1]) + (a0[2] + a0[3]); yo[1] = (a1[0] + a1[1]) + (a1[2] + a1[3]); }
                }
                if (more) SC_LSTORE((c + 1) & 1);
                __syncthreads();
            }
            {
                const f32x4 rl4 = *(const f32x4*)(R_ + base + (size_t)(SEQ - 1) * BW + 4 * cg);
                const float yl = row_allsum16((sa * rl4[0] + sb * rl4[1]) + (sc2 * rl4[2] + sd * rl4[3]));
                if (cg == 0) Y[base + (size_t)(SEQ - 1) * BW + irow] = yl;
            }
#undef SC_GLOAD
#undef SC_LSTORE
#undef SC_LD
#undef SC_STEP
        }
        if (!(mask_live & (1u << 29)))
        for (;;) {
            if (tid == 0) misc[4] = atomicAdd(ctl + CW_AQ + 64 * (l + 2 * li_), 1u);
            __syncthreads();
            const unsigned u = misc[4];
            __syncthreads();
            if (u >= 1024u) break;
            const int qt = 15 - (int)(u >> 6), kind = (u >> 5) & 1, b = (u >> 3) & 3, h = u & 7;
            const size_t r0 = (size_t)b * SEQ;
            if (kind == 0)
                attn_unit<128, true>((LAS unsigned char*)lds_raw, QAB + r0 * BW + h * 128, BW, KAB + r0 * BW + h * 128, BW, VAB + r0 * BW + h * 128, BW,
                                     YALL + r0 * (3 * BW) + h * 128, 3 * BW, SELB + r0 * 8 + h, qt, 0.08838834764831845f * 1.4426950408889634f, tid);
            else
                attn_unit<192, false>((LAS unsigned char*)lds_raw, QCB + r0 * 1536 + h * 192, 1536, KCB + r0 * 1536 + h * 192, 1536, VCB + r0 * BW + h * 128, BW,
                                      YALL + r0 * (3 * BW) + 2 * BW + h * 128, 3 * BW, nullptr, qt, 0.07216878364870323f * 1.4426950408889634f, tid);
        }
        {
            LAS float* scr = (LAS float*)((LAS unsigned char*)lds_raw) + wave * (64 * 33);
            const unsigned ncu = (unsigned)(FFN_CONV_N(l) / 32);
            DQ_RUN(xb_ld(ctl + CW_SD + 64 * (l + 2 * li_)) < 128u && xb_ld(ctl + CW_DQ + 64 * li_) < (unsigned)(l == 0 ? DQ_J3 : DQ_J6));
            for (;;) {
                if (tid == 0) {
                    unsigned u_ = 0xffffffffu;
                    if (xb_ld(ctl + CW_SD + 64 * (l + 2 * li_)) < 128u) u_ = atomicAdd(ctl + CW_CQ + 64 * (l + 2 * li_), 1u);
                    misc[4] = u_;
                }
                __syncthreads();
                const unsigned u = (unsigned)__builtin_amdgcn_readfirstlane((int)misc[4]);
                __syncthreads();
                if (u >= ncu) break;
#pragma unroll 1
                for (int k_ = 0; k_ < 2; ++k_) { const int it = (int)u * 32 + k_ * 16 + 2 * wave; FFN_CONV_PAIR(it); }
            }
            DQ_FLUSH(l == 0 ? DQ_J3 : DQ_J6);
        }
        GRID_BAR();
        {
            const int pc = l * BW + (gt & 255) * 4;
            const f32x4 p_g = *(const f32x4*)(rwkv_gn_g + pc), p_b = *(const f32x4*)(rwkv_gn_b + pc), p_ka = *(const f32x4*)(rwkv_k_a + pc), p_rk = *(const f32x4*)(rwkv_r_k + pc);
            const float* pY = Y; const float* pK = K2; const float* pA = AA; const float* pR = R_; const float* pV = Vcur; const float* pG = GG; bf16* pO = YALL + BW;
            for (int i0 = gt; i0 < T * 16 * 16; i0 += 4 * NGT) {
                f32x4 y[4], kr[4], aa[4], rr[4], vv[4], gg[4];
#pragma unroll
                for (int u_ = 0; u_ < 4; ++u_) { const int i = i0 + u_ * NGT, ic = i < T * 256 ? i : gt; const size_t o = (size_t)(ic >> 8) * BW + (ic & 255) * 4;
                    y[u_] = *(const f32x4*)(pY + o); kr[u_] = *(const f32x4*)(pK + o); aa[u_] = *(const f32x4*)(pA + o); rr[u_] = *(const f32x4*)(pR + o); vv[u_] = *(const f32x4*)(pV + o); gg[u_] = *(const f32x4*)(pG + o); }
#pragma unroll
                for (int u_ = 0; u_ < 4; ++u_) { const int i = i0 + u_ * NGT;
                    const float mu = row_allsum16((y[u_][0] + y[u_][1]) + (y[u_][2] + y[u_][3])) * (1.0f / 64.0f);
                    const f32x4 d = y[u_] - mu;
                    const float var = row_allsum16((d[0] * d[0] + d[1] * d[1]) + (d[2] * d[2] + d[3] * d[3])) * (1.0f / 64.0f);
                    const f32x4 yn = d * rsqrtf(var + 64e-5f) * p_g + p_b;
                    const f32x4 k2 = kr[u_] * (1.0f + (aa[u_] - 1.0f) * p_ka);
                    const f32x4 rk = rr[u_] * k2 * p_rk;
                    const float bon = row_allsum16((rk[0] + rk[1]) + (rk[2] + rk[3]));
                    const f32x4 o4 = (yn + bon * vv[u_]) * gg[u_];
                    v2u ob; ob.x = pk2(o4[0], o4[1]); ob.y = pk2(o4[2], o4[3]);
                    if (i < T * 256) *(v2u*)(pO + (size_t)(i >> 8) * (3 * BW) + (i & 255) * 4) = ob;
                }
            }
        }
        GRID_BAR();
        }
        if (RUN(4)) {
        {
            pg8::StaticOrder S; S.init(T, D, G_live, (int)blockIdx.x);
            pg8::Gemm g{YALL, WBO + (size_t)l * D * 3 * BW, T, D, 3 * BW}; EpiBranch3 E{MIXB, GATEB};
            pg8::gemm_phase<EpiBranch3, pg8::StaticOrder, false>((LAS unsigned char*)lds_raw, g, S, E, nullptr, tid);
        }
        GRID_BAR();
        }
        if (RUN(5)) {
        {
            pg8::Gemm g{MIXB, WOT + (size_t)l * D * D, T, D, D}; pg8::StaticOrder S; S.init(T, D, G_live, (int)blockIdx.x);
            EpiResidF32 E{PRE, X};
            pg8::gemm_phase<EpiResidF32, pg8::StaticOrder, false>((LAS unsigned char*)lds_raw, g, S, E, nullptr, tid);
        }
        GRID_BAR();
        }
        if (RUN(6)) {
        {
            LAS float* scr = (LAS float*)((LAS unsigned char*)lds_raw) + wave * (64 * 33);
            const int ntot = FFN_CONV_N(l);
            const int ndone = (int)min(xb_ld(ctl + CW_CQ + 64 * (l + 2 * li_)), (unsigned)(ntot / 32)) * 32;
            for (int it = ndone + 2 * gw; it < ntot; it += 2 * NGW) FFN_CONV_PAIR(it);
            if (l == 1) DQ_FLUSH(DQ_J7);
        }
        for (int t = gw; t < T; t += NGW) {
            const float* pr = PRE + (size_t)t * D;
            f32x4 v[8]; float s = 0.f;
#pragma unroll
            for (int jj = 0; jj < 8; ++jj) { v[jj] = *(const f32x4*)(pr + jj * 256 + lane * 4); s += (v[jj][0] + v[jj][1]) + (v[jj][2] + v[jj][3]); }
            const float mean = wave_sum(s, lane) * (1.0f / D); float s2 = 0.f;
#pragma unroll
            for (int jj = 0; jj < 8; ++jj) { v[jj] = v[jj] - mean; s2 += (v[jj][0] * v[jj][0] + v[jj][1] * v[jj][1]) + (v[jj][2] * v[jj][2] + v[jj][3] * v[jj][3]); }
            const float rstd = rsqrtf(wave_sum(s2, lane) * (1.0f / D) + 1e-5f);
#pragma unroll
            for (int jj = 0; jj < 8; ++jj) {
                const f32x4 g = *(const f32x4*)(ln1_g + l * D + jj * 256 + lane * 4), bb = *(const f32x4*)(ln1_b + l * D + jj * 256 + lane * 4);
                v[jj] = v[jj] * rstd * g + bb;
                *(f32x4*)(X1 + (size_t)t * D + jj * 256 + lane * 4) = v[jj];
                v2u ob; ob.x = pk2(v[jj][0], v[jj][1]); ob.y = pk2(v[jj][2], v[jj][3]); *(v2u*)(X1B + (size_t)t * D + jj * 256 + lane * 4) = ob;
            }
            if (l == 1) {
                float lg[8];
#pragma unroll
                for (int e = 0; e < 8; ++e) lg[e] = 0.f;
#pragma unroll
                for (int jj = 0; jj < 8; ++jj)
#pragma unroll
                    for (int cc = 0; cc < 4; ++cc) {
                        const int d = jj * 256 + lane * 4 + cc;
                        const f32x4 r0 = *(const f32x4*)(moe_router + (size_t)d * 8), r1 = *(const f32x4*)(moe_router + (size_t)d * 8 + 4);
                        const float xv = v[jj][cc];
                        lg[0] += xv * r0[0]; lg[1] += xv * r0[1]; lg[2] += xv * r0[2]; lg[3] += xv * r0[3];
                        lg[4] += xv * r1[0]; lg[5] += xv * r1[1]; lg[6] += xv * r1[2]; lg[7] += xv * r1[3];
                    }
#pragma unroll
                for (int e = 0; e < 8; ++e) lg[e] = wave_sum(lg[e], lane);
                if (lane == 0) {
                    int e0 = 0; float b0 = lg[0];
#pragma unroll
                    for (int e = 1; e < 8; ++e) if (lg[e] > b0) { b0 = lg[e]; e0 = e; }
                    int e1 = -1; float b1 = -INFINITY;
#pragma unroll
                    for (int e = 0; e < 8; ++e) if (e != e0 && lg[e] > b1) { b1 = lg[e]; e1 = e; }
                    const float w1 = 1.0f / (1.0f + expf(b0 - b1)), w0 = 1.0f - w1;
                    const int p0 = (int)atomicAdd(ctl + CW_CNT + 64 * e0, 1u), p1 = (int)atomicAdd(ctl + CW_CNT + 64 * e1, 1u);
                    int* tk = TOK + (size_t)t * 8;
                    tk[0] = e0; tk[1] = e1; tk[2] = p0; tk[3] = p1; tk[4] = __float_as_int(w0); tk[5] = __float_as_int(w1);
                }
            }
        }
        GRID_BAR();
        }
        float* OUTX = (l == 0) ? XB : (float*)(*(GAS float* const*)&args.out);
        if (l == 0) {
            if (RUN(7)) {
                pg8::Gemm g{X1B, WGU, T, NGU, D}; pg8::StaticOrder S; S.init(T, NGU, G_live, (int)blockIdx.x);
                EpiSwigluBf16 E{HGB, NGU / 256};
                pg8::gemm_phase<EpiSwigluBf16, pg8::StaticOrder, false>((LAS unsigned char*)lds_raw, g, S, E, nullptr, tid);
                REOPAQUE();
                {
                    LAS float* scr = (LAS float*)((LAS unsigned char*)lds_raw) + wave * (64 * 33);
                    PHASE_DONE(1);
                    DQ_FILL(1, 129);
                }
                GRID_BAR();
            }
            if (RUN(8)) {
                pg8::Gemm g{HGB, WDD, T, D, DFF}; pg8::StaticOrder S; S.init(T, D, G_live, (int)blockIdx.x);
                EpiResidF32 E{PRE, X1};
                pg8::gemm_phase<EpiResidF32, pg8::StaticOrder, false>((LAS unsigned char*)lds_raw, g, S, E, nullptr, tid);
                GRID_BAR();
            }
        } else {
            if (RUN(10)) {
            unsigned poff[9]; poff[0] = 0;
#pragma unroll
            for (int e = 0; e < 8; ++e) poff[e + 1] = poff[e] + ((xb_ld(ctl + CW_CNT + 64 * e) + 255u) & ~255u);
            for (int t = gw; t < T; t += NGW) {
                int* tk = TOK + (size_t)t * 8;
                const int e0 = tk[0], e1 = tk[1];
                unsigned o0 = 0, o1 = 0;
#pragma unroll
                for (int e = 0; e < 8; ++e) { o0 = (e == e0) ? poff[e] : o0; o1 = (e == e1) ? poff[e] : o1; }
                const int s0 = (int)o0 + tk[2], s1 = (int)o1 + tk[3];
                if (lane == 0) { tk[6] = s0; tk[7] = s1; }
#pragma unroll
                for (int j = 0; j < 4; ++j) { const v4u xv = *(const v4u*)(X1B + (size_t)t * D + j * 512 + lane * 8);
                    *(v4u*)(XG + (size_t)s0 * D + j * 512 + lane * 8) = xv; *(v4u*)(XG + (size_t)s1 * D + j * 512 + lane * 8) = xv; }
            }
            if (blockIdx.x == 0 && tid < 80) {
                unsigned e_of = 0; const unsigned mt = tid;
#pragma unroll
                for (int e = 1; e < 8; ++e) e_of += (mt * 256u >= poff[e]) ? 1u : 0u;
                ctl[CW_TILE + tid] = e_of;
                if (tid == 0) ctl[CW_TILE - 1] = poff[8] / 256u;
            }
            {
                const unsigned nmt_ = poff[8] / 256u, nfull_ = (nmt_ / 32u) * 32u; const size_t z0 = (size_t)nfull_ * 256 * D / 4, z1 = (size_t)nmt_ * 256 * D / 4;
                for (size_t i = z0 + gt; i < z1; i += NGT) *(f32x4*)(OUT + i * 4) = (f32x4){0.f, 0.f, 0.f, 0.f};
            }
            GRID_BAR();
            }
            const int nMt = (int)ctl[CW_TILE - 1];
            if (RUN(7)) {
                pg8::Gemm g{XG, WGU, MOE_ROWS, NGU, D}; MoeOrder S{ctl + CW_TILE, nMt, NGU / 256, G_live, (int)blockIdx.x};
                EpiSwigluBf16 E{HGB, NGU / 256};
                pg8::gemm_phase<EpiSwigluBf16, MoeOrder, false>((LAS unsigned char*)lds_raw, g, S, E, nullptr, tid);
                REOPAQUE();
                {
                    LAS float* scr = (LAS float*)((LAS unsigned char*)lds_raw) + wave * (64 * 33);
                    const int rem_ = ((int)ctl[CW_TILE - 1] * (NGU / 256)) % G_live;
                    PHASE_DONE(5);
                    DQ_FILL(5, (rem_ ? G_live - rem_ : 0) + 1);
                    DQ_FLUSH(DQ_N);
                }
                GRID_BAR();
            }
            if (RUN(8)) {
                const int nFull = (nMt / 32) * 32;
                { pg8::Gemm g{HGB, WD, MOE_ROWS, D, DFF}; MoeOrder S{ctl + CW_TILE, nFull, D / 256, G_live, (int)blockIdx.x};
                  EpiStoreF32 E{OUT, D / 256};
                  pg8::gemm_phase<EpiStoreF32, MoeOrder, false>((LAS unsigned char*)lds_raw, g, S, E, nullptr, tid); }
                REOPAQUE();
                { pg8::Gemm g{HGB, WD, MOE_ROWS, D, DFF / 4 + zero_live, DFF}; MoeOrder S{ctl + CW_TILE, nMt - nFull, D / 256, G_live, (int)blockIdx.x, nFull, 4, (DFF / 4) * 2};
                  EpiAtomicF32 E{OUT, D / 256};
                  pg8::gemm_phase<EpiAtomicF32, MoeOrder, false>((LAS unsigned char*)lds_raw, g, S, E, nullptr, tid); }
                GRID_BAR();
            }
        }
        if (RUN(9)) {
        if (l == 0) { LAS float* scr = (LAS float*)((LAS unsigned char*)lds_raw) + wave * (64 * 33); DQ_FLUSH(DQ_J4); }
        for (int t = gw; t < T; t += NGW) {
            f32x4 v[8]; float s = 0.f;
            if (l == 0) {
#pragma unroll
                for (int jj = 0; jj < 8; ++jj) v[jj] = *(const f32x4*)(PRE + (size_t)t * D + jj * 256 + lane * 4);
            } else {
                const int* tk = TOK + (size_t)t * 8;
                const float w0 = __int_as_float(tk[4]), w1 = __int_as_float(tk[5]); const int s0 = tk[6], s1 = tk[7];
                const int e0 = tk[0], e1 = tk[1];
#pragma unroll
                for (int jj = 0; jj < 8; ++jj) {
                    const f32x4 xx = *(const f32x4*)(X1 + (size_t)t * D + jj * 256 + lane * 4);
                    const f32x4 a = *(const f32x4*)(OUT + (size_t)s0 * D + jj * 256 + lane * 4), bq = *(const f32x4*)(OUT + (size_t)s1 * D + jj * 256 + lane * 4);
                    const f32x4 f = (e0 < e1) ? (w0 * a + w1 * bq) : (w1 * bq + w0 * a);
                    v[jj] = ALPHA * xx + f;
                }
            }
#pragma unroll
            for (int jj = 0; jj < 8; ++jj) s += (v[jj][0] + v[jj][1]) + (v[jj][2] + v[jj][3]);
            const float mean = wave_sum(s, lane) * (1.0f / D); float s2 = 0.f;
#pragma unroll
            for (int jj = 0; jj < 8; ++jj) { v[jj] = v[jj] - mean; s2 += (v[jj][0] * v[jj][0] + v[jj][1] * v[jj][1]) + (v[jj][2] * v[jj][2] + v[jj][3] * v[jj][3]); }
            const float rstd = rsqrtf(wave_sum(s2, lane) * (1.0f / D) + 1e-5f);
#pragma unroll
            for (int jj = 0; jj < 8; ++jj) {
                const f32x4 g = *(const f32x4*)(ln2_g + l * D + jj * 256 + lane * 4), bb = *(const f32x4*)(ln2_b + l * D + jj * 256 + lane * 4);
                const f32x4 o = v[jj] * rstd * g + bb;
                *(f32x4*)(OUTX + (size_t)t * D + jj * 256 + lane * 4) = o;
                if (l == 0) { v2u ob; ob.x = pk2(o[0], o[1]); ob.y = pk2(o[2], o[3]); *(v2u*)(XBF + (size_t)t * D + jj * 256 + lane * 4) = ob; }
            }
        }
        GRID_BAR();
        }
    }
}

extern "C" void kernel_launch(void* const* d_in, const int* in_sizes, int n_in, void* d_out, int out_size, void* d_ws, size_t ws_size, hipStream_t stream) {
    static int grid = 0;
    if (grid == 0) {
        if (n_in != 34 || out_size != T * D || ws_size < WS_END) { fprintf(stderr, "kernel_launch: bad sizes n_in %d out %d ws %zu need %zu\n", n_in, out_size, ws_size, (size_t)WS_END); grid = -1; return; }
        int dev = 0, cus = 0, per_cu = 0;
        if (hipGetDevice(&dev) != hipSuccess || hipDeviceGetAttribute(&cus, hipDeviceAttributeMultiprocessorCount, dev) != hipSuccess) { grid = -1; return; }
        if (hipFuncSetAttribute((const void*)fwd_kernel, hipFuncAttributeMaxDynamicSharedMemorySize, LDS_BYTES) != hipSuccess) { fprintf(stderr, "hipFuncSetAttribute failed\n"); grid = -1; return; }
        if (hipOccupancyMaxActiveBlocksPerMultiprocessor(&per_cu, (const void*)fwd_kernel, NTHREADS, LDS_BYTES) != hipSuccess || per_cu < 1) fprintf(stderr, "occupancy query says %d\n", per_cu);
        (void)hipGetLastError();
        grid = cus;
    }
    if (grid < 0) return;
    hipMemsetAsync((char*)d_ws + WS_CTL, 0, CTL_BYTES, stream);
    Args a{};
    for (int i = 0; i < 34; ++i) a.in[i] = (const float*)d_in[i];
    a.out = (float*)d_out; a.ws = (unsigned char*)d_ws; a.mask = 0x9FFFFFFFu; a.li = 0;
    hipLaunchKernelGGL(fwd_kernel, dim3(grid), dim3(NTHREADS), LDS_BYTES, stream, a);
#ifdef PROBE_MASK
    a.mask = PROBE_MASK; a.li = 1;
    hipLaunchKernelGGL(fwd_kernel, dim3(grid), dim3(NTHREADS), LDS_BYTES, stream, a);
#endif
}
```

```cpp
#include <hip/hip_runtime.h>
#include <stdint.h>
#include <stdio.h>

constexpr int D = 2048, NBATCH = 4, SEQ = 2048, T = NBATCH * SEQ;
constexpr int BW = 1024;
constexpr int IN_COLS = 13664;
constexpr int OFF_RWKV = 3072, OFF_MLA = 6432, OFF_GATE = 7520;
constexpr int RWKV_COLS = 3360;
constexpr int DFF = 5632, NEXP = 8;
constexpr float ALPHA = 1.41421356237f;
constexpr int NTHREADS = 512, NWAVES = 8;
constexpr int LDS_BYTES = 131072 + 17408 + 512;

#define LAS __attribute__((address_space(3)))
#define GAS __attribute__((address_space(1)))
typedef float f32x16 __attribute__((ext_vector_type(16)));
typedef float f32x4 __attribute__((ext_vector_type(4)));

constexpr size_t MiB = 1u << 20;
constexpr size_t al(size_t x) { return (x + 255) & ~(size_t)255; }
constexpr size_t WS_CTL = 0, CTL_BYTES = 1 * MiB;
constexpr size_t WS_COSA = 1 * MiB;
constexpr size_t WS_SINA = WS_COSA + 2048 * 64 * 4;
constexpr size_t WS_COSM = WS_SINA + 2048 * 64 * 4;
constexpr size_t WS_SINM = WS_COSM + 2048 * 32 * 4;
constexpr size_t WS_TOK = 3 * MiB;
constexpr size_t WS_ROWL = WS_TOK + (size_t)T * 8 * 4;
constexpr size_t WS_XB = 4 * MiB;
constexpr size_t WS_X1 = WS_XB + (size_t)T * D * 4;
constexpr size_t WS_PRE = WS_X1 + (size_t)T * D * 4;
constexpr int NP = 13824;
constexpr size_t WS_XBF = WS_PRE + (size_t)T * D * 4;
constexpr size_t WS_WINT = WS_XBF + (size_t)T * D * 2;
constexpr size_t WS_X1B = WS_WINT + (size_t)2 * NP * D * 2;
constexpr size_t WS_WBO = WS_X1B + (size_t)T * D * 2;
constexpr size_t WS_WOT = WS_WBO + (size_t)6 * D * BW * 2;
constexpr size_t WS_WUQ = WS_WOT + (size_t)2 * D * D * 2;
constexpr size_t WS_WUKV = WS_WUQ + (size_t)2 * 1536 * 512 * 2;
constexpr size_t WS_WLORA = WS_WUKV + (size_t)2 * 2048 * 512 * 2;
constexpr size_t WS_V0 = WS_WLORA + (size_t)2 * 4096 * 384 * 2;
constexpr size_t WS_MIXER = WS_V0 + (size_t)T * BW * 4;
constexpr int MOE_ROWS = 2 * T + NEXP * 256;
constexpr int NGU = 2 * DFF;
constexpr int PLD = 4448, PSH = 3072;
constexpr size_t WS_PROJ = WS_MIXER;
constexpr size_t WS_V1 = al(WS_PROJ + (size_t)T * PLD * 2);
constexpr size_t WS_DEC = WS_V1 + (size_t)T * BW * 4;
constexpr size_t WS_AA = WS_DEC + (size_t)T * BW * 4;
constexpr size_t WS_GG = WS_AA + (size_t)T * BW * 4;
constexpr size_t WS_Y = WS_GG + (size_t)T * BW * 4;
constexpr size_t WS_LA = WS_Y + (size_t)T * BW * 4;
constexpr size_t WS_QNB = WS_LA + (size_t)T * 384 * 2;
constexpr size_t WS_KVNB = WS_QNB + (size_t)T * 512 * 2;
constexpr size_t WS_YALL = WS_KVNB + (size_t)T * 512 * 2;
constexpr size_t WS_GATEB = WS_YALL + (size_t)T * 3 * BW * 2;
constexpr size_t WS_QAB = WS_GATEB + (size_t)T * 3 * D * 2;
constexpr size_t WS_KAB = WS_QAB + (size_t)T * BW * 2;
constexpr size_t WS_VAB = WS_KAB + (size_t)T * BW * 2;
constexpr size_t WS_QCB = WS_VAB + (size_t)T * BW * 2;
constexpr size_t WS_KCB = WS_QCB + (size_t)T * 1536 * 2;
constexpr size_t WS_VCB = WS_KCB + (size_t)T * 1536 * 2;
constexpr size_t WS_MIXB = WS_VCB + (size_t)T * BW * 2;
constexpr size_t WS_L_END = WS_MIXB + (size_t)T * D * 2;
constexpr size_t WS_HGB = WS_MIXER;
constexpr size_t WS_XG = WS_HGB + (size_t)MOE_ROWS * DFF * 2;
constexpr size_t WS_OUT = WS_XG + (size_t)MOE_ROWS * D * 2;
static_assert(WS_OUT + (size_t)MOE_ROWS * D * 4 <= WS_L_END, "FFN activations must stay inside region L");
constexpr size_t WS_WGU = WS_L_END;
constexpr size_t WS_VRES = WS_WGU;
constexpr size_t WS_QF = al(WS_VRES + (size_t)T * 32 * 4);
static_assert(WS_QF + (size_t)T * BW * 4 <= WS_WGU + (size_t)4 * NGU * D * 2, "region P must end inside WGU[0..3]");
constexpr size_t WS_WD = WS_WGU + (size_t)NEXP * NGU * D * 2;
constexpr size_t WS_WDD = WS_WGU + (size_t)NGU * D * 2;
constexpr size_t WS_END = WS_WD + (size_t)NEXP * D * DFF * 2;
constexpr size_t WS_KMEAN = WS_TOK + 512 * 1024;
constexpr size_t WS_SEL = WS_TOK + 768 * 1024;

static_assert(WS_END <= (size_t)1560 * MiB, "ws budget");
constexpr int CW_CNT = 1024;
constexpr int CW_OFF = 2048;
constexpr int CW_AQ = 3072;
constexpr int CW_CQ = 3328;
constexpr int CW_SD = 3584;
constexpr int CQ_ITEMS = 16;
constexpr int CW_DQ = 12288;
constexpr int CW_PD = 12544;
constexpr int DQ_J3 = 5120, DQ_J4 = 18944, DQ_J5 = 20608, DQ_J6 = 25728, DQ_J7 = DQ_J6 + 4 * 11264, DQ_N = DQ_J7 + 8 * 5632;
constexpr int CW_TILE = 2304;
constexpr int CW_BAR = 4096;

#define XB_TMO      128
#define XB_XCNT(j)  (256  + 64 * (j))
#define XB_XSUB(j)  (1280 + 64 * (j))
#define XB_XGEN(j)  (2304 + 64 * (j))
#define XB_TOP      3328
#define XB_TOPGEN   3392
#define XCD_BAR_WORDS 3456
#define XB_SPIN_CAP (1u << 22)

__device__ __forceinline__ unsigned xb_ld(unsigned* p)              { return __hip_atomic_load(p, __ATOMIC_RELAXED, __HIP_MEMORY_SCOPE_AGENT); }
__device__ __forceinline__ unsigned xb_add(unsigned* p, unsigned v) { return __hip_atomic_fetch_add(p, v, __ATOMIC_RELAXED, __HIP_MEMORY_SCOPE_AGENT); }
__device__ __forceinline__ unsigned xb_xcc_id() { return (unsigned)__builtin_amdgcn_s_getreg((3 << 11) | 20) & 0xFu; }
#define XB_SPIN(cond, bar) do { unsigned _sp = 0; while (cond) { __builtin_amdgcn_s_sleep(1); \
    if ((++_sp & 255u) == 0u) { if (xb_ld(&(bar)[XB_TMO])) break; if (_sp > XB_SPIN_CAP) { atomicAdd(&(bar)[XB_TMO], 1u); break; } } } } while (0)

struct XcdBarrier { unsigned* bar; unsigned x; volatile LAS unsigned* st; };

__device__ __forceinline__ XcdBarrier xcd_barrier_post(unsigned* bar, volatile LAS unsigned* st, const int tid0) {
    XcdBarrier b; b.bar = bar; b.x = xb_xcc_id(); b.st = st;
    if (tid0 == 0) (void)xb_add(&bar[XB_XCNT(b.x)], 1u);
    return b;
}
__device__ __forceinline__ void xcd_barrier_complete(unsigned* bar, unsigned x, unsigned& nloc, unsigned& nx) {
    const unsigned G = gridDim.x * gridDim.y * gridDim.z;
    unsigned sum, cnt, mine, sp = 0u;
    for (;;) {
        sum = 0u; cnt = 0u; mine = 0u;
#pragma unroll
        for (unsigned j = 0; j < 16; ++j) { const unsigned c = xb_ld(&bar[XB_XCNT(j)]); sum += c; cnt += (c > 0u) ? 1u : 0u; mine = (j == x) ? c : mine; }
        if (sum == G) break;
        __builtin_amdgcn_s_sleep(1);
        if ((++sp & 255u) == 0u) { if (xb_ld(&bar[XB_TMO])) break; if (sp > XB_SPIN_CAP) { atomicAdd(&bar[XB_TMO], 1u); break; } }
    }
    nloc = mine > 0u ? mine : 1u; nx = cnt > 0u ? cnt : 1u;
}
__device__ __forceinline__ void xcd_barrier(const XcdBarrier& b, const int tid0) {
    asm volatile("s_waitcnt vmcnt(0)" ::: "memory");
    __syncthreads();
    if (tid0 == 0) {
        unsigned* bar = b.bar;
        __builtin_amdgcn_s_waitcnt(0);
        unsigned nloc = b.st[0], nx = b.st[1];
        if (nloc == 0u) { xcd_barrier_complete(bar, b.x, nloc, nx); b.st[0] = nloc; b.st[1] = nx; }
        const unsigned old = xb_add(&bar[XB_XSUB(b.x)], 1u);
        const unsigned gen = old / nloc;
        if (old + 1u == (gen + 1u) * nloc) {
            __builtin_amdgcn_fence(__ATOMIC_RELEASE, "agent");
            asm volatile("s_waitcnt vmcnt(0)" ::: "memory");
            const unsigned og = xb_add(&bar[XB_TOP], 1u);
            const unsigned tg = og / nx;
            if (og + 1u == (tg + 1u) * nx) xb_add(&bar[XB_TOPGEN], 1u);
            else XB_SPIN(xb_ld(&bar[XB_TOPGEN]) == tg, bar);
            __builtin_amdgcn_fence(__ATOMIC_ACQUIRE, "agent");
            xb_add(&bar[XB_XGEN(b.x)], 1u);
            asm volatile("s_waitcnt vmcnt(0)" ::: "memory");
        } else {
            XB_SPIN(xb_ld(&bar[XB_XGEN(b.x)]) == gen, bar);
            __builtin_amdgcn_fence(__ATOMIC_ACQUIRE, "agent");
            asm volatile("s_waitcnt vmcnt(0)" ::: "memory");
        }
    }
    __syncthreads();
}

__device__ __forceinline__ float shfl_xor_(float v, int mask, int ln) { return __builtin_bit_cast(float, __builtin_amdgcn_ds_bpermute((ln ^ mask) << 2, __builtin_bit_cast(int, v))); }
__device__ __forceinline__ float wave_sum(float v, int ln) {
    v += __builtin_bit_cast(float, __builtin_amdgcn_update_dpp(0, __builtin_bit_cast(int, v), 0x128, 0xf, 0xf, false));
    v += __builtin_bit_cast(float, __builtin_amdgcn_update_dpp(0, __builtin_bit_cast(int, v), 0x124, 0xf, 0xf, false));
    v += __builtin_bit_cast(float, __builtin_amdgcn_update_dpp(0, __builtin_bit_cast(int, v), 0x122, 0xf, 0xf, false));
    v += __builtin_bit_cast(float, __builtin_amdgcn_update_dpp(0, __builtin_bit_cast(int, v), 0x121, 0xf, 0xf, false));
    v += shfl_xor_(v, 16, ln); v += shfl_xor_(v, 32, ln);
    return v;
}
__device__ __forceinline__ float sigmoidf_(float x) { return 1.0f / (1.0f + expf(-x)); }

namespace pg8 {
#define PG8_LAS __attribute__((address_space(3)))
typedef unsigned short bf16_t;
typedef short bf16x8 __attribute__((ext_vector_type(8)));
typedef float f32x4 __attribute__((ext_vector_type(4)));
typedef unsigned u32x4 __attribute__((ext_vector_type(4)));
constexpr int BM = 256, BK = 64, HALF = 128, HTB = HALF * BK * 2  , STAGE_BYTES = 8 * HTB, NXCD = 8, WGM = 8;

__host__ __device__ __forceinline__ int lds_byte(int r, int c) { const int st = (r >> 4) * 2 + (c >> 5), rr = r & 15, cc = c & 31, ob = rr * 64 + cc * 2; return st * 1024 + (ob ^ (((ob >> 9) & 1) << 5)); }
__host__ __device__ __forceinline__ void stage_rc(int b, int& R, int& C) { const int st = b / 1024, sb = b % 1024, swz = sb ^ (((sb >> 9) & 1) << 5); R = (st >> 1) * 16 + swz / 64; C = (st & 1) * 32 + (swz % 64) / 2; }
__host__ __device__ __forceinline__ int perm32(int rho) { const int n = rho >> 4, i = rho & 15; return 8 * (i >> 2) + 4 * n + (i & 3); }

struct Unit { int pm, pn; int ko = 0; };
struct Gemm { const bf16_t* A; const bf16_t* Bt; int M, N, K; int ld = 0; };

struct StaticOrder {
    int nM, nN, nwg, G, c;
    __host__ __device__ void init(int M, int N, int G_, int c_) { nM = M / BM; nN = N / BM; nwg = nM * nN; G = G_; c = c_; }
    __host__ __device__ bool next(int i, Unit& u) const {
        const long L = (long)i * G + c; if (L >= nwg) return false;
        int wgid = (int)L; { const int q = nwg / NXCD, r = nwg % NXCD, xcd = wgid % NXCD, off = wgid / NXCD; wgid = (xcd < r ? xcd * (q + 1) : r * (q + 1) + (xcd - r) * q) + off; }
        const int nig = WGM * nN, gid = wgid / nig, fm = gid * WGM, gsz = (nM - fm) < WGM ? (nM - fm) : WGM;
        u.pm = fm + ((wgid % nig) % gsz); u.pn = (wgid % nig) / gsz; return true;
    }
    __device__ __forceinline__ void a_ready(const Unit&) const {}
    __device__ __forceinline__ void done(const Unit&) const {}
};
__device__ __forceinline__ unsigned cvt_pk_bf16(float lo, float hi) { unsigned r; asm volatile("v_cvt_pk_bf16_f32 %0, %1, %2" : "=v"(r) : "v"(lo), "v"(hi)); return r; }
typedef float f32x2 __attribute__((ext_vector_type(2)));
template <class Epi, class Sched, bool STAMP = false>
__device__ __forceinline__ void gemm_phase(PG8_LAS unsigned char* lds, const Gemm g, const Sched& S, const Epi& E, unsigned long long* stamps, const int tid) {
    const int wid = __builtin_amdgcn_readfirstlane(tid >> 6), lane = tid & 63, wr = wid >> 2, wc = wid & 3, fr = lane & 15, fq = lane >> 4;
    const int K = g.K, nt = K / BK, LD = g.ld ? g.ld : g.K;
    int ts_lo = 0, ts_hi = 0, nts = 0; const unsigned long long rt_entry = STAMP ? (unsigned long long)wall_clock64() : 0ull;
#define PG8_STAMP() do { if (STAMP && wid == 0 && nts < 64) { const unsigned long long _c = (unsigned long long)clock64(); \
        ts_lo = (lane == nts) ? (int)(unsigned)_c : ts_lo; ts_hi = (lane == nts) ? (int)(unsigned)(_c >> 32) : ts_hi; ++nts; } } while (0)
    PG8_STAMP();
    unsigned voffA[2], voffB[2];
#pragma unroll
    for (int i = 0; i < 2; ++i) { int R, C; stage_rc(tid * 16 + i * 8192, R, C); const int Rb = Epi::PERM ? ((R & ~31) + perm32(R & 31)) : R;
        voffA[i] = (unsigned)(R * LD + C) * 2u; voffB[i] = (unsigned)(Rb * LD + C) * 2u; }
    const size_t kstep = (size_t)(BK * 2);
    const size_t hstep = (size_t)HALF * LD * 2;
    const size_t tstep = 2 * hstep;
    const unsigned ldsw = (unsigned)wid * 1024u;
    const int aoff = lds_byte(wr * 64 + fr, fq * 8), boff = lds_byte(wc * 32 + fr, fq * 8);
#define PG8_SA(b, h) (((b) * 2 + (h)) * HTB)
#define PG8_SB(b, h) ((4 + (b) * 2 + (h)) * HTB)
#define PG8_STAGE(bufoff, gbase, voff) do { _Pragma("unroll") for (int _i = 0; _i < 2; ++_i) \
        __builtin_amdgcn_global_load_lds((const unsigned*)((const char*)(gbase) + (voff)[_i]), (PG8_LAS unsigned*)(lds + (bufoff) + ldsw + _i * 8192), 16, 0, 0); } while (0)
#define PG8_LDA(dst, b, h) do { _Pragma("unroll") for (int m = 0; m < 4; ++m) _Pragma("unroll") for (int k = 0; k < 2; ++k) dst[m][k] = *(const PG8_LAS bf16x8*)(lds + PG8_SA(b, h) + aoff + m * 2048 + k * 1024); } while (0)
#define PG8_LDB(dst, b, h) do { _Pragma("unroll") for (int n = 0; n < 2; ++n) _Pragma("unroll") for (int k = 0; k < 2; ++k) dst[n][k] = *(const PG8_LAS bf16x8*)(lds + PG8_SB(b, h) + boff + n * 2048 + k * 1024); } while (0)
#define PG8_MMA(ai, bj, At, Bt) do { __builtin_amdgcn_s_setprio(1); _Pragma("unroll") for (int m = 0; m < 4; ++m) _Pragma("unroll") for (int n = 0; n < 2; ++n) _Pragma("unroll") for (int k = 0; k < 2; ++k) \
        acc[ai][bj][m][n] = __builtin_amdgcn_mfma_f32_16x16x32_bf16(Bt[n][k], At[m][k], acc[ai][bj][m][n], 0, 0, 0); __builtin_amdgcn_s_setprio(0); } while (0)
#define PG8_WAIT_V(n) asm volatile("s_waitcnt vmcnt(" #n ")" ::: "memory")
#define PG8_WAIT_L(n) asm volatile("s_waitcnt lgkmcnt(" #n ")" ::: "memory")
#define PG8_BAR __builtin_amdgcn_s_barrier()
#define PG8_SCHED __builtin_amdgcn_sched_barrier(0)
    Unit cur, nxt; int ui = 0;
    if (!S.next(0, cur)) return;
    f32x4 acc[2][2][4][2];
#pragma unroll
    for (int a = 0; a < 2; ++a)
#pragma unroll
        for (int b = 0; b < 2; ++b)
#pragma unroll
            for (int m = 0; m < 4; ++m)
#pragma unroll
                for (int n = 0; n < 2; ++n) acc[a][b][m][n] = (f32x4){0.f, 0.f, 0.f, 0.f};
    bf16x8 At[4][2], B0[2][2], B1[2][2];
    {
        const bf16x8 z8 = {0, 0, 0, 0, 0, 0, 0, 0};
#pragma unroll
        for (int m = 0; m < 4; ++m) { At[m][0] = z8; At[m][1] = z8; }
#pragma unroll
        for (int n = 0; n < 2; ++n) { B0[n][0] = z8; B0[n][1] = z8; B1[n][0] = z8; B1[n][1] = z8; }
    }
    const char* cA = (const char*)g.A + (size_t)cur.pm * tstep + cur.ko; const char* cB = (const char*)g.Bt + (size_t)cur.pn * tstep + cur.ko;
    S.a_ready(cur);
    PG8_STAGE(PG8_SB(0, 0), cB, voffB); PG8_STAGE(PG8_SA(0, 0), cA, voffA); PG8_STAGE(PG8_SB(0, 1), cB + hstep, voffB); PG8_STAGE(PG8_SA(0, 1), cA + hstep, voffA);
    if (wr == 1) PG8_BAR;
    PG8_WAIT_V(4); PG8_BAR;
    PG8_STAGE(PG8_SB(1, 0), cB + kstep, voffB); PG8_STAGE(PG8_SA(1, 0), cA + kstep, voffA); PG8_STAGE(PG8_SB(1, 1), cB + hstep + kstep, voffB);
    PG8_WAIT_V(6); PG8_BAR;
    PG8_STAMP();
    for (;;) {
        const bool has_next = S.next(ui + 1, nxt);
        const char* nA = has_next ? (const char*)g.A + (size_t)nxt.pm * tstep + nxt.ko : cA; const char* nB = has_next ? (const char*)g.Bt + (size_t)nxt.pn * tstep + nxt.ko : cB;
        for (int t = 0; t < nt; t += 2) {
            if constexpr (Epi::HAS_MID) { if (t == 16 || t == 32) E.mid(acc, cur, wr, wc, fr, fq, t); }
            const bool last = (t == nt - 2);
            const char* a1 = cA + (size_t)(t + 1) * kstep;
            const char* a2 = last ? nA : cA + (size_t)(t + 2) * kstep; const char* b2 = last ? nB : cB + (size_t)(t + 2) * kstep;
            const char* a3 = a2 + kstep; const char* b3 = b2 + kstep;
            if (last && has_next) S.a_ready(nxt);
            PG8_LDB(B0, 0, 0); PG8_SCHED; PG8_LDA(At, 0, 0); PG8_STAGE(PG8_SA(1, 1), a1 + hstep, voffA);
            PG8_WAIT_L(8); PG8_BAR; PG8_WAIT_L(0); PG8_MMA(0, 0, At, B0); PG8_BAR; PG8_SCHED;
            PG8_LDB(B1, 0, 1); PG8_STAGE(PG8_SB(0, 0), b2, voffB);
            PG8_BAR; PG8_WAIT_L(0); PG8_MMA(0, 1, At, B1); PG8_BAR;
            PG8_LDA(At, 0, 1); PG8_STAGE(PG8_SA(0, 0), a2, voffA);
            PG8_BAR; PG8_WAIT_L(0); PG8_MMA(1, 0, At, B0); PG8_BAR; PG8_SCHED;
            PG8_STAGE(PG8_SB(0, 1), b2 + hstep, voffB);
            PG8_WAIT_V(6); PG8_BAR; PG8_MMA(1, 1, At, B1); PG8_BAR;
            PG8_LDB(B0, 1, 0); PG8_SCHED; PG8_LDA(At, 1, 0); PG8_STAGE(PG8_SA(0, 1), a2 + hstep, voffA);
            PG8_WAIT_L(8); PG8_BAR; PG8_WAIT_L(0); PG8_MMA(0, 0, At, B0); PG8_BAR; PG8_SCHED;
            PG8_LDB(B1, 1, 1); PG8_STAGE(PG8_SB(1, 0), b3, voffB);
            PG8_BAR; PG8_WAIT_L(0); PG8_MMA(0, 1, At, B1); PG8_BAR;
            PG8_LDA(At, 1, 1); PG8_STAGE(PG8_SA(1, 0), a3, voffA);
            PG8_BAR; PG8_WAIT_L(0); PG8_MMA(1, 0, At, B0); PG8_BAR; PG8_SCHED;
            PG8_STAGE(PG8_SB(1, 1), b3 + hstep, voffB);
            PG8_WAIT_V(6); PG8_BAR; PG8_MMA(1, 1, At, B1); PG8_BAR;
        }
        PG8_STAMP();
        if constexpr (!Epi::AFTER_DRAIN) { if constexpr (Epi::STAGED) E.staged(acc, cur, wr, wc, fr, fq, lds + STAGE_BYTES, wid, lane); else E(acc, cur, wr, wc, fr, fq); S.done(cur); }
        PG8_STAMP();
        if (!has_next) break;
#pragma unroll
        for (int a = 0; a < 2; ++a)
#pragma unroll
            for (int b = 0; b < 2; ++b)
#pragma unroll
                for (int m = 0; m < 4; ++m)
#pragma unroll
                    for (int n = 0; n < 2; ++n) acc[a][b][m][n] = (f32x4){0.f, 0.f, 0.f, 0.f};
        cur = nxt; cA = nA; cB = nB; ++ui;
    }
    PG8_WAIT_V(0);
    if (wr == 0) PG8_BAR;
    PG8_BAR;
    if constexpr (Epi::AFTER_DRAIN) { E.fused(acc, cur, wr, wc, fr, fq, lds, wid, lane); S.done(cur); }
    PG8_STAMP();
    if (STAMP && wid == 0) { stamps[lane] = lane < nts ? (((unsigned long long)(unsigned)ts_hi << 32) | (unsigned)ts_lo) : 0ull;
        if (lane == 62) stamps[62] = rt_entry; if (lane == 63) stamps[63] = (unsigned long long)wall_clock64(); }
#undef PG8_STAMP
#undef PG8_SA
#undef PG8_SB
#undef PG8_STAGE
#undef PG8_LDA
#undef PG8_LDB
#undef PG8_MMA
#undef PG8_WAIT_V
#undef PG8_WAIT_L
#undef PG8_BAR
#undef PG8_SCHED
}
}


typedef unsigned short bf16;
typedef unsigned v4u __attribute__((ext_vector_type(4)));
typedef unsigned v2u __attribute__((ext_vector_type(2)));
__device__ __forceinline__ unsigned f2bf(float f) { unsigned u = __builtin_bit_cast(unsigned, f); return (u + 0x7fffu + ((u >> 16) & 1u)) >> 16; }
typedef __bf16 bf16x2_t __attribute__((ext_vector_type(2)));
__device__ __forceinline__ unsigned pk2(float lo, float hi) { bf16x2_t v; v[0] = (__bf16)lo; v[1] = (__bf16)hi; return __builtin_bit_cast(unsigned, v); }
__device__ __forceinline__ float row_allsum16(float x) {
    x += __builtin_bit_cast(float, __builtin_amdgcn_update_dpp(0, __builtin_bit_cast(int, x), 0x128, 0xf, 0xf, false));
    x += __builtin_bit_cast(float, __builtin_amdgcn_update_dpp(0, __builtin_bit_cast(int, x), 0x124, 0xf, 0xf, false));
    x += __builtin_bit_cast(float, __builtin_amdgcn_update_dpp(0, __builtin_bit_cast(int, x), 0x122, 0xf, 0xf, false));
    x += __builtin_bit_cast(float, __builtin_amdgcn_update_dpp(0, __builtin_bit_cast(int, x), 0x121, 0xf, 0xf, false));
    return x;
}
__device__ __forceinline__ float fsigmoid(float x) { return __builtin_amdgcn_rcpf(1.0f + __expf(-x)); }
__device__ __forceinline__ void transpose_item(const float* p, int ldw, bf16* WT, int K, int dst_row0, int k0, LAS float* scr, int ln) {
    if (p) {
        float tv[32];
#pragma unroll
        for (int i = 0; i < 32; ++i) tv[i] = p[(size_t)(k0 + 2 * i + (ln >> 5)) * ldw];
#pragma unroll
        for (int i = 0; i < 32; ++i) scr[(2 * i + (ln >> 5)) * 33 + (ln & 31)] = tv[i];
    } else {
#pragma unroll 8
        for (int i = 0; i < 32; ++i) { const int kk = 2 * i + (ln >> 5); scr[kk * 33 + (ln & 31)] = 0.f; }
    }
    asm volatile("s_waitcnt lgkmcnt(0)" ::: "memory");
    const int c = ln & 7;
#pragma unroll
    for (int j = 0; j < 4; ++j) { const int n = (ln >> 3) + 8 * j; const LAS float* s = scr + (8 * c) * 33 + n;
        v4u o; o.x = pk2(s[0 * 33], s[1 * 33]); o.y = pk2(s[2 * 33], s[3 * 33]); o.z = pk2(s[4 * 33], s[5 * 33]); o.w = pk2(s[6 * 33], s[7 * 33]);
        *(v4u*)(WT + (size_t)(dst_row0 + n) * K + k0 + 8 * c) = o; }
    asm volatile("s_waitcnt lgkmcnt(0)" ::: "memory");
}
struct TI { const float* p; bf16* wt; int ldw, K, r0, k0; bool zero; };
__device__ __forceinline__ void ti_load(const TI& t, float (&tv)[32], int ln) {
#pragma unroll
    for (int i = 0; i < 32; ++i) tv[i] = t.p[(size_t)(t.k0 + 2 * i + (ln >> 5)) * t.ldw];
}
__device__ __forceinline__ void ti_finish(const TI& t, const float (&tv)[32], LAS float* scr, int ln) {
#pragma unroll
    for (int i = 0; i < 32; ++i) scr[(2 * i + (ln >> 5)) * 33 + (ln & 31)] = t.zero ? 0.f : tv[i];
    asm volatile("s_waitcnt lgkmcnt(0)" ::: "memory");
    const int c = ln & 7;
#pragma unroll
    for (int j = 0; j < 4; ++j) { const int n = (ln >> 3) + 8 * j; const LAS float* s = scr + (8 * c) * 33 + n;
        v4u o; o.x = pk2(s[0 * 33], s[1 * 33]); o.y = pk2(s[2 * 33], s[3 * 33]); o.z = pk2(s[4 * 33], s[5 * 33]); o.w = pk2(s[6 * 33], s[7 * 33]);
        *(v4u*)(t.wt + (size_t)(t.r0 + n) * t.K + t.k0 + 8 * c) = o; }
    asm volatile("s_waitcnt lgkmcnt(0)" ::: "memory");
}
__device__ __forceinline__ f32x4 bf4_to_f32(const v2u w) { f32x4 r; r[0] = __builtin_bit_cast(float, w.x << 16); r[1] = __builtin_bit_cast(float, w.x & 0xffff0000u);
    r[2] = __builtin_bit_cast(float, w.y << 16); r[3] = __builtin_bit_cast(float, w.y & 0xffff0000u); return r; }
constexpr int STG_RS = 528;
#define EBAR() do { asm volatile("s_waitcnt lgkmcnt(0)" ::: "memory"); __builtin_amdgcn_s_barrier(); asm volatile("" ::: "memory"); } while (0)
#define EPI_ENTER(wr_) do { if ((wr_) == 0) __builtin_amdgcn_s_barrier(); } while (0)
#define EPI_LEAVE(wr_) do { if ((wr_) == 1) __builtin_amdgcn_s_barrier(); } while (0)
#define STG_READBACK512(ai_, m_, BODY) do { int ln_ = lane; asm volatile("" : "+v"(ln_)); _Pragma("unroll") for (int h_ = 0; h_ < 2; ++h_) { const int lr_ = 4 * wid + 2 * h_ + (ln_ >> 5), cb_ = (ln_ & 31) * 16; \
        const v4u sv_ = *(const LAS v4u*)(stg + lr_ * STG_RS + cb_); const int trow_ = 128 * (ai_) + 64 * (lr_ >> 4) + 16 * (m_) + (lr_ & 15); BODY } } while (0)

struct EpiSwigluBf16 {
    static constexpr bool PERM = true, AFTER_DRAIN = false, HAS_MID = false, STAGED = true;
    bf16* H; int nN;
    __device__ __forceinline__ void staged(const f32x4 (&acc)[2][2][4][2], const pg8::Unit& u, int wr, int wc, int fr, int fq, LAS unsigned char* stg, int wid, int lane) const {
        const int pnl = u.pn % nN, lrw = 16 * wr + fr;
        bf16* dst = H + (size_t)u.pm * 256 * DFF + 128 * pnl;
        EPI_ENTER(wr);
#pragma unroll
        for (int ai = 0; ai < 2; ++ai)
#pragma unroll
            for (int m = 0; m < 4; ++m) {
#pragma unroll
                for (int bj = 0; bj < 2; ++bj) {
                    const f32x4 g = acc[ai][bj][m][0], uu = acc[ai][bj][m][1]; float h[4];
#pragma unroll
                    for (int j = 0; j < 4; ++j) h[j] = g[j] * fsigmoid(g[j]) * uu[j];
                    v2u o; o.x = pk2(h[0], h[1]); o.y = pk2(h[2], h[3]);
                    *(LAS v2u*)(stg + lrw * 272 + (64 * bj + 16 * wc + 4 * fq) * 2) = o;
                }
                EBAR();
                {
                    int ln_ = lane; asm volatile("" : "+v"(ln_));
                    const int lr = 4 * wid + (ln_ >> 4), cb = (ln_ & 15) * 16;
                    const v4u sv = *(const LAS v4u*)(stg + lr * 272 + cb);
                    const int trow = 128 * ai + 64 * (lr >> 4) + 16 * m + (lr & 15);
                    *(v4u*)(dst + (size_t)trow * DFF + (ln_ & 15) * 8) = sv;
                }
                EBAR();
            }
        EPI_LEAVE(wr);
    }
};
struct EpiResidF32 {
    static constexpr bool PERM = true, AFTER_DRAIN = false, HAS_MID = false, STAGED = true;
    float* C; const float* R;
    __device__ __forceinline__ void staged(const f32x4 (&acc)[2][2][4][2], const pg8::Unit& u, int wr, int wc, int fr, int fq, LAS unsigned char* stg, int wid, int lane) const {
        const int lrw = 16 * wr + fr; const size_t t0 = (size_t)u.pm * 256 * D + (size_t)u.pn * 256;
        EPI_ENTER(wr);
#pragma unroll
        for (int ai = 0; ai < 2; ++ai)
#pragma unroll
            for (int m = 0; m < 4; ++m)
#pragma unroll
                for (int bj = 0; bj < 2; ++bj) {
                    *(LAS f32x4*)(stg + lrw * STG_RS + (wc * 32 + 8 * fq) * 4) = acc[ai][bj][m][0];
                    *(LAS f32x4*)(stg + lrw * STG_RS + (wc * 32 + 8 * fq) * 4 + 16) = acc[ai][bj][m][1];
                    EBAR();
                    STG_READBACK512(ai, m, { const size_t o_ = t0 + (size_t)trow_ * D + bj * 128 + (ln_ & 31) * 4;
                        const f32x4 r_ = *(const f32x4*)(R + o_); *(f32x4*)(C + o_) = ALPHA * r_ + __builtin_bit_cast(f32x4, sv_); });
                    EBAR();
                }
        EPI_LEAVE(wr);
    }
};
struct EpiStoreF32 {
    static constexpr bool PERM = true, AFTER_DRAIN = false, HAS_MID = false, STAGED = true;
    float* C; int nN;
    __device__ __forceinline__ void staged(const f32x4 (&acc)[2][2][4][2], const pg8::Unit& u, int wr, int wc, int fr, int fq, LAS unsigned char* stg, int wid, int lane) const {
        const int lrw = 16 * wr + fr; const size_t t0 = (size_t)u.pm * 256 * D + (size_t)(u.pn % nN) * 256;
        EPI_ENTER(wr);
#pragma unroll
        for (int ai = 0; ai < 2; ++ai)
#pragma unroll
            for (int m = 0; m < 4; ++m)
#pragma unroll
                for (int bj = 0; bj < 2; ++bj) {
                    *(LAS f32x4*)(stg + lrw * STG_RS + (wc * 32 + 8 * fq) * 4) = acc[ai][bj][m][0];
                    *(LAS f32x4*)(stg + lrw * STG_RS + (wc * 32 + 8 * fq) * 4 + 16) = acc[ai][bj][m][1];
                    EBAR();
                    STG_READBACK512(ai, m, { *(v4u*)(C + t0 + (size_t)trow_ * D + bj * 128 + (ln_ & 31) * 4) = sv_; });
                    EBAR();
                }
        EPI_LEAVE(wr);
    }
};
template <int MODE> struct EpiBranch {
    static constexpr bool PERM = true, AFTER_DRAIN = false, HAS_MID = false, STAGED = false;
    float* MIXp; bf16* MIXBp; const float* gate;
    __device__ __forceinline__ void operator()(const f32x4 (&acc)[2][2][4][2], const pg8::Unit& u, int wr, int wc, int fr, int fq) const {
        const int row0 = u.pm * 256 + wr * 64 + fr, col0 = u.pn * 256 + wc * 32 + 8 * fq;
#pragma unroll
        for (int ai = 0; ai < 2; ++ai)
#pragma unroll
            for (int m = 0; m < 4; ++m)
#pragma unroll
                for (int bj = 0; bj < 2; ++bj) {
                    const int row = row0 + ai * 128 + m * 16, col = col0 + bj * 128; const size_t o = (size_t)row * D + col;
                    const f32x4 g0 = *(const f32x4*)(gate + (size_t)row * IN_COLS + col), g1 = *(const f32x4*)(gate + (size_t)row * IN_COLS + col + 4);
                    f32x4 r0, r1;
#pragma unroll
                    for (int j = 0; j < 4; ++j) { r0[j] = fsigmoid(g0[j]) * acc[ai][bj][m][0][j]; r1[j] = fsigmoid(g1[j]) * acc[ai][bj][m][1][j]; }
                    if (MODE >= 1) { r0 += *(const f32x4*)(MIXp + o); r1 += *(const f32x4*)(MIXp + o + 4); }
                    if (MODE <= 1) { *(f32x4*)(MIXp + o) = r0; *(f32x4*)(MIXp + o + 4) = r1; }
                    else { v4u w; w.x = pk2(r0[0], r0[1]); w.y = pk2(r0[2], r0[3]); w.z = pk2(r1[0], r1[1]); w.w = pk2(r1[2], r1[3]); *(v4u*)(MIXBp + o) = w; }
                }
    }
};

struct EpiLora {
    static constexpr bool PERM = true, AFTER_DRAIN = false, HAS_MID = false, STAGED = false;
    float* DECp; float* AAp; float* GGp; float* Vp; const float* VFp; const float* w0; const float* a0; const float* v0;
    __device__ __forceinline__ void operator()(const f32x4 (&acc)[2][2][4][2], const pg8::Unit& u, int wr, int wc, int fr, int fq) const {
        const int row0 = u.pm * 256 + wr * 64 + fr, seg = __builtin_amdgcn_readfirstlane(u.pn >> 2), col0 = (u.pn & 3) * 256 + wc * 32 + 8 * fq;
        if (seg == 0) {
#pragma unroll
            for (int bj = 0; bj < 2; ++bj) { const int col = col0 + bj * 128; const f32x4 b0 = *(const f32x4*)(w0 + col), b1 = *(const f32x4*)(w0 + col + 4);
#pragma unroll
                for (int ai = 0; ai < 2; ++ai)
#pragma unroll
                    for (int m = 0; m < 4; ++m) { const size_t o = (size_t)(row0 + ai * 128 + m * 16) * BW + col;
                        f32x4 x0 = acc[ai][bj][m][0] + b0, x1 = acc[ai][bj][m][1] + b1;
#pragma unroll
                        for (int j = 0; j < 4; ++j) { const float z0 = -x0[j], z1 = -x1[j];
                            const float sp0 = z0 > 20.f ? z0 : __logf(1.0f + __expf(z0)), sp1 = z1 > 20.f ? z1 : __logf(1.0f + __expf(z1));
                            x0[j] = __expf(-__expf(-sp0 - 0.5f)); x1[j] = __expf(-__expf(-sp1 - 0.5f)); }
                        *(f32x4*)(DECp + o) = x0; *(f32x4*)(DECp + o + 4) = x1; } }
        } else if (seg == 1) {
#pragma unroll
            for (int bj = 0; bj < 2; ++bj) { const int col = col0 + bj * 128; const f32x4 b0 = *(const f32x4*)(a0 + col), b1 = *(const f32x4*)(a0 + col + 4);
#pragma unroll
                for (int ai = 0; ai < 2; ++ai)
#pragma unroll
                    for (int m = 0; m < 4; ++m) { const size_t o = (size_t)(row0 + ai * 128 + m * 16) * BW + col;
                        f32x4 x0 = acc[ai][bj][m][0] + b0, x1 = acc[ai][bj][m][1] + b1;
#pragma unroll
                        for (int j = 0; j < 4; ++j) { x0[j] = fsigmoid(x0[j]); x1[j] = fsigmoid(x1[j]); }
                        *(f32x4*)(AAp + o) = x0; *(f32x4*)(AAp + o + 4) = x1; } }
        } else if (seg == 2) {
#pragma unroll
            for (int bj = 0; bj < 2; ++bj) { const int col = col0 + bj * 128;
#pragma unroll
                for (int ai = 0; ai < 2; ++ai)
#pragma unroll
                    for (int m = 0; m < 4; ++m) { const size_t o = (size_t)(row0 + ai * 128 + m * 16) * BW + col;
                        *(f32x4*)(GGp + o) = acc[ai][bj][m][0]; *(f32x4*)(GGp + o + 4) = acc[ai][bj][m][1]; } }
        } else {
#pragma unroll
            for (int bj = 0; bj < 2; ++bj) { const int col = col0 + bj * 128; const f32x4 b0 = *(const f32x4*)(v0 + col), b1 = *(const f32x4*)(v0 + col + 4);
#pragma unroll
                for (int ai = 0; ai < 2; ++ai)
#pragma unroll
                    for (int m = 0; m < 4; ++m) { const size_t o = (size_t)(row0 + ai * 128 + m * 16) * BW + col;
                        f32x4 x0 = acc[ai][bj][m][0] + b0, x1 = acc[ai][bj][m][1] + b1;
                        const f32x4 v0_ = *(const f32x4*)(Vp + o), v1_ = *(const f32x4*)(Vp + o + 4), f0 = *(const f32x4*)(VFp + o), f1 = *(const f32x4*)(VFp + o + 4);
#pragma unroll
                        for (int j = 0; j < 4; ++j) { x0[j] = v0_[j] + (f0[j] - v0_[j]) * fsigmoid(x0[j]); x1[j] = v1_[j] + (f1[j] - v1_[j]) * fsigmoid(x1[j]); }
                        *(f32x4*)(Vp + o) = x0; *(f32x4*)(Vp + o + 4) = x1;
                        asm volatile("" ::: "memory"); } }
        }
    }
};
struct EpiMlaQ {
    static constexpr bool PERM = true, AFTER_DRAIN = false, HAS_MID = false, STAGED = false;
    bf16* QCBp; const float* COSMp; const float* SINMp;
    __device__ __forceinline__ void operator()(const f32x4 (&acc)[2][2][4][2], const pg8::Unit& u, int wr, int wc, int fr, int fq) const {
        const int row0 = u.pm * 256 + wr * 64 + fr;
#pragma unroll
        for (int bj = 0; bj < 2; ++bj) {
            const int c = u.pn * 256 + bj * 128 + wc * 32 + 8 * fq, h = c / 192, cc = c - h * 192;
#pragma unroll
            for (int ai = 0; ai < 2; ++ai)
#pragma unroll
                for (int m = 0; m < 4; ++m) {
                    const int row = row0 + ai * 128 + m * 16; const f32x4 x1 = acc[ai][bj][m][0], x2 = acc[ai][bj][m][1];
                    bf16* dst = QCBp + (size_t)row * 1536 + h * 192;
                    if (cc < 128) { v4u w; w.x = pk2(x1[0], x1[1]); w.y = pk2(x1[2], x1[3]); w.z = pk2(x2[0], x2[1]); w.w = pk2(x2[2], x2[3]); *(v4u*)(dst + cc) = w; }
                    else { const int j0 = 4 * ((cc - 128) >> 3), s = row & (SEQ - 1);
                        const f32x4 cs = *(const f32x4*)(COSMp + s * 32 + j0), sn = *(const f32x4*)(SINMp + s * 32 + j0);
                        const f32x4 o1 = x1 * cs - x2 * sn, o2 = x2 * cs + x1 * sn;
                        v2u a; a.x = pk2(o1[0], o1[1]); a.y = pk2(o1[2], o1[3]); v2u b; b.x = pk2(o2[0], o2[1]); b.y = pk2(o2[2], o2[3]);
                        *(v2u*)(dst + 128 + j0) = a; *(v2u*)(dst + 160 + j0) = b; }
                }
        }
    }
};
struct EpiMlaKV {
    static constexpr bool PERM = true, AFTER_DRAIN = false, HAS_MID = false, STAGED = false;
    bf16* KCBp; bf16* VCBp;
    __device__ __forceinline__ void operator()(const f32x4 (&acc)[2][2][4][2], const pg8::Unit& u, int wr, int wc, int fr, int fq) const {
        const int row0 = u.pm * 256 + wr * 64 + fr;
#pragma unroll
        for (int bj = 0; bj < 2; ++bj) {
            const int c = u.pn * 256 + bj * 128 + wc * 32 + 8 * fq, h = c >> 8, cc = c & 255;
#pragma unroll
            for (int ai = 0; ai < 2; ++ai)
#pragma unroll
                for (int m = 0; m < 4; ++m) {
                    const int row = row0 + ai * 128 + m * 16; const f32x4 x1 = acc[ai][bj][m][0], x2 = acc[ai][bj][m][1];
                    v4u w; w.x = pk2(x1[0], x1[1]); w.y = pk2(x1[2], x1[3]); w.z = pk2(x2[0], x2[1]); w.w = pk2(x2[2], x2[3]);
                    if (cc < 128) *(v4u*)(KCBp + (size_t)row * 1536 + h * 192 + cc) = w;
                    else *(v4u*)(VCBp + (size_t)row * BW + h * 128 + (cc - 128)) = w;
                }
        }
    }
};

struct EpiBranch3 {
    static constexpr bool PERM = true, AFTER_DRAIN = false, HAS_MID = true, STAGED = false;
    bf16* MIXBp; const bf16* G;
    __device__ __forceinline__ void mid(f32x4 (&acc)[2][2][4][2], const pg8::Unit& u, int wr, int wc, int fr, int fq, int t) const {
        int row0 = u.pm * 256 + wr * 64 + fr, col0 = u.pn * 256 + wc * 32 + 8 * fq; const int seg = t >> 4;
        asm volatile("" : "+v"(row0), "+v"(col0));
#pragma unroll
        for (int ai = 0; ai < 2; ++ai)
#pragma unroll
            for (int m = 0; m < 4; ++m)
#pragma unroll
                for (int bj = 0; bj < 2; ++bj) {
                    const bf16* gp = G + (size_t)(row0 + ai * 128 + m * 16) * (3 * D) + (seg - 1) * D + col0 + bj * 128;
                    const v4u a = *(const v4u*)gp, b = *(const v4u*)(gp + D);
                    const unsigned aw[4] = {a.x, a.y, a.z, a.w}, bw[4] = {b.x, b.y, b.z, b.w};
#pragma unroll
                    for (int j = 0; j < 4; ++j) {
                        const float r0 = __uint_as_float(aw[j] << 16) * __builtin_amdgcn_rcpf(__uint_as_float(bw[j] << 16));
                        const float r1 = __uint_as_float(aw[j] & 0xffff0000u) * __builtin_amdgcn_rcpf(__uint_as_float(bw[j] & 0xffff0000u));
                        acc[ai][bj][m][j >> 1][(j & 1) * 2] *= r0; acc[ai][bj][m][j >> 1][(j & 1) * 2 + 1] *= r1;
                    }
                    asm volatile("" : "+v"(acc[ai][bj][m][0]), "+v"(acc[ai][bj][m][1]) :: "memory");
                }
    }
    __device__ __forceinline__ void operator()(const f32x4 (&acc)[2][2][4][2], const pg8::Unit& u, int wr, int wc, int fr, int fq) const {
        const int row0 = u.pm * 256 + wr * 64 + fr, col0 = u.pn * 256 + wc * 32 + 8 * fq;
#pragma unroll
        for (int ai = 0; ai < 2; ++ai)
#pragma unroll
            for (int m = 0; m < 4; ++m)
#pragma unroll
                for (int bj = 0; bj < 2; ++bj) {
                    const int row = row0 + ai * 128 + m * 16, col = col0 + bj * 128;
                    const v4u a = *(const v4u*)(G + (size_t)row * (3 * D) + 2 * D + col);
                    const unsigned aw[4] = {a.x, a.y, a.z, a.w}; float r[8];
#pragma unroll
                    for (int j = 0; j < 4; ++j) { r[2 * j] = acc[ai][bj][m][j >> 1][(j & 1) * 2] * __uint_as_float(aw[j] << 16);
                                                  r[2 * j + 1] = acc[ai][bj][m][j >> 1][(j & 1) * 2 + 1] * __uint_as_float(aw[j] & 0xffff0000u); }
                    v4u w; w.x = pk2(r[0], r[1]); w.y = pk2(r[2], r[3]); w.z = pk2(r[4], r[5]); w.w = pk2(r[6], r[7]);
                    *(v4u*)(MIXBp + (size_t)row * D + col) = w;
                }
    }
};
struct MoeOrder {
    const unsigned* tile_e; int nMt, nN, G, c; int mt0 = 0, ks = 1, kbytes = 0;
    __device__ __forceinline__ bool next(int i, pg8::Unit& u) const {
        const long L = (long)i * G + c; if (L >= (long)nMt * nN * ks) return false;
        const int mt = mt0 + (int)(L / (nN * ks)), rem = (int)(L % (nN * ks)), pnl = rem / ks;
        u.pm = mt; u.pn = (int)tile_e[mt] * nN + pnl; u.ko = (rem % ks) * kbytes; return true;
    }
    __device__ __forceinline__ void a_ready(const pg8::Unit&) const {}
    __device__ __forceinline__ void done(const pg8::Unit&) const {}
};
struct EpiAtomicF32 {
    static constexpr bool PERM = true, AFTER_DRAIN = false, HAS_MID = false, STAGED = true;
    float* C; int nN;
    __device__ __forceinline__ void staged(const f32x4 (&acc)[2][2][4][2], const pg8::Unit& u, int wr, int wc, int fr, int fq, LAS unsigned char* stg, int wid, int lane) const {
        const int lrw = 16 * wr + fr; const size_t t0 = (size_t)u.pm * 256 * D + (size_t)(u.pn % nN) * 256;
        EPI_ENTER(wr);
#pragma unroll
        for (int ai = 0; ai < 2; ++ai)
#pragma unroll
            for (int m = 0; m < 4; ++m)
#pragma unroll
                for (int bj = 0; bj < 2; ++bj) {
                    *(LAS f32x4*)(stg + lrw * STG_RS + (wc * 32 + 8 * fq) * 4) = acc[ai][bj][m][0];
                    *(LAS f32x4*)(stg + lrw * STG_RS + (wc * 32 + 8 * fq) * 4 + 16) = acc[ai][bj][m][1];
                    EBAR();
                    { int ln_ = lane; asm volatile("" : "+v"(ln_));
#pragma unroll
                      for (int q_ = 0; q_ < 8; ++q_) { const int lr_ = 4 * wid + (q_ >> 1), cf_ = (q_ & 1) * 64 + ln_;
                          const float sv_ = *(const LAS float*)(stg + lr_ * STG_RS + cf_ * 4);
                          const int trow_ = 128 * ai + 64 * (lr_ >> 4) + 16 * m + (lr_ & 15);
                          atomicAdd(C + t0 + (size_t)trow_ * D + bj * 128 + cf_, sv_); } }
                    EBAR();
                }
        EPI_LEAVE(wr);
    }
};

struct EpiStoreBf16s { bf16* C; int ldc; size_t sC;
    __device__ __forceinline__ void operator()(int bt, int m, int n, float v) const { C[(size_t)bt * sC + (size_t)m * ldc + n] = (bf16)f2bf(v); } };
struct EpiInProjF32 {
    static constexpr bool PERM = true, AFTER_DRAIN = false, HAS_MID = false, STAGED = false;
    bf16* PROJp; float* VRESp; bf16* GATEp; float* QFp; bf16* KABp; bf16* VABp; const float* COSAp; const float* SINAp; int layer;
    __device__ __forceinline__ void operator()(const f32x4 (&acc)[2][2][4][2], const pg8::Unit& u, int wr, int wc, int fr, int fq) const {
        int row0 = u.pm * 256 + wr * 64 + fr;
        asm volatile("" : "+v"(row0), "+v"(fq));
        if (u.pn >= 30) {
#pragma unroll
            for (int bj = 0; bj < 2; ++bj) { const int c = (u.pn - 30) * 256 + bj * 128 + wc * 32 + 8 * fq;
#pragma unroll
                for (int ai = 0; ai < 2; ++ai)
#pragma unroll
                    for (int m = 0; m < 4; ++m) { const f32x4 x0 = acc[ai][bj][m][0], x1 = acc[ai][bj][m][1];
                        v4u w; w.x = pk2(fsigmoid(x0[0]), fsigmoid(x0[1])); w.y = pk2(fsigmoid(x0[2]), fsigmoid(x0[3]));
                        w.z = pk2(fsigmoid(x1[0]), fsigmoid(x1[1])); w.w = pk2(fsigmoid(x1[2]), fsigmoid(x1[3]));
                        *(v4u*)(GATEp + (size_t)(row0 + ai * 128 + m * 16) * (3 * D) + c) = w; } }
            return;
        }
        if (u.pn < 8) {
            const bool isk = u.pn >= 4;
#pragma unroll
            for (int bj = 0; bj < 2; ++bj) {
                const int c = (u.pn & 3) * 256 + bj * 128 + wc * 32 + 8 * fq, hh = c >> 7, j0 = ((c & 127) >> 3) * 4;
#pragma unroll
                for (int ai = 0; ai < 2; ++ai)
#pragma unroll
                    for (int m = 0; m < 4; ++m) { const int row = row0 + ai * 128 + m * 16, s = row & (SEQ - 1);
                        const f32x4 cs = *(const f32x4*)(COSAp + s * 64 + j0), sn = *(const f32x4*)(SINAp + s * 64 + j0);
                        const f32x4 x1 = acc[ai][bj][m][0], x2 = acc[ai][bj][m][1];
                        const f32x4 o1 = x1 * cs - x2 * sn, o2 = x2 * cs + x1 * sn;
                        if (!isk) { float* q = QFp + (size_t)row * BW + hh * 128 + j0; *(f32x4*)q = o1; *(f32x4*)(q + 64) = o2; }
                        else { bf16* k = KABp + (size_t)row * BW + hh * 128 + j0; v2u a; a.x = pk2(o1[0], o1[1]); a.y = pk2(o1[2], o1[3]); v2u b; b.x = pk2(o2[0], o2[1]); b.y = pk2(o2[2], o2[3]);
                            *(v2u*)k = a; *(v2u*)(k + 64) = b; }
                        asm volatile("" ::: "memory");
                    }
            }
            return;
        }
        if (u.pn < 12) {
#pragma unroll
            for (int bj = 0; bj < 2; ++bj) { const int c = (u.pn - 8) * 256 + bj * 128 + wc * 32 + 8 * fq;
#pragma unroll
                for (int ai = 0; ai < 2; ++ai)
#pragma unroll
                    for (int m = 0; m < 4; ++m) { const f32x4 x0 = acc[ai][bj][m][0], x1 = acc[ai][bj][m][1];
                        v4u w; w.x = pk2(x0[0], x0[1]); w.y = pk2(x0[2], x0[3]); w.z = pk2(x1[0], x1[1]); w.w = pk2(x1[2], x1[3]);
                        *(v4u*)(VABp + (size_t)(row0 + ai * 128 + m * 16) * BW + c) = w; } }
            return;
        }
#pragma unroll
        for (int bj = 0; bj < 2; ++bj) {
            const int c = u.pn * 256 + bj * 128 + wc * 32 + 8 * fq;
            if (c >= 6432 && c < 6464) {
                if (layer != 0) {
#pragma unroll
                    for (int ai = 0; ai < 2; ++ai)
#pragma unroll
                        for (int m = 0; m < 4; ++m) { float* p = VRESp + (c - 6432) + (size_t)(row0 + ai * 128 + m * 16) * 32;
                            *(f32x4*)p = acc[ai][bj][m][0]; *(f32x4*)(p + 4) = acc[ai][bj][m][1]; }
                }
            } else if (c < 7552) {
                bf16* dst = PROJp + ((c < 6432 ? c : c - 32) - PSH);
#pragma unroll
                for (int ai = 0; ai < 2; ++ai)
#pragma unroll
                    for (int m = 0; m < 4; ++m) { const f32x4 x0 = acc[ai][bj][m][0], x1 = acc[ai][bj][m][1];
                        v4u w; w.x = pk2(x0[0], x0[1]); w.y = pk2(x0[2], x0[3]); w.z = pk2(x1[0], x1[1]); w.w = pk2(x1[2], x1[3]);
                        *(v4u*)(dst + (size_t)(row0 + ai * 128 + m * 16) * PLD) = w; }
            }
        }
    }
};


__device__ __forceinline__ float fma_(float a, float b, float c) { float r; asm("v_fma_f32 %0, %1, %2, %3" : "=v"(r) : "v"(a), "v"(b), "v"(c)); return r; }
__device__ __forceinline__ float mul_(float a, float b) { float r; asm("v_mul_f32 %0, %1, %2" : "=v"(r) : "v"(a), "v"(b)); return r; }
__device__ __forceinline__ float add_(float a, float b) { float r; asm("v_add_f32 %0, %1, %2" : "=v"(r) : "v"(a), "v"(b)); return r; }
typedef short s16x4 __attribute__((ext_vector_type(4)));
constexpr int AT_KOFF = 0, AT_VOFF = 25600, AT_STAGE = 25600 + 64 * 288;
#define AT_TR16(base, o) \
    asm volatile("ds_read_b64_tr_b16 %0, %16 offset:0\n\tds_read_b64_tr_b16 %1, %16 offset:4608\n\t" \
                 "ds_read_b64_tr_b16 %2, %16 offset:32\n\tds_read_b64_tr_b16 %3, %16 offset:4640\n\t" \
                 "ds_read_b64_tr_b16 %4, %16 offset:64\n\tds_read_b64_tr_b16 %5, %16 offset:4672\n\t" \
                 "ds_read_b64_tr_b16 %6, %16 offset:96\n\tds_read_b64_tr_b16 %7, %16 offset:4704\n\t" \
                 "ds_read_b64_tr_b16 %8, %16 offset:128\n\tds_read_b64_tr_b16 %9, %16 offset:4736\n\t" \
                 "ds_read_b64_tr_b16 %10, %16 offset:160\n\tds_read_b64_tr_b16 %11, %16 offset:4768\n\t" \
                 "ds_read_b64_tr_b16 %12, %16 offset:192\n\tds_read_b64_tr_b16 %13, %16 offset:4800\n\t" \
                 "ds_read_b64_tr_b16 %14, %16 offset:224\n\tds_read_b64_tr_b16 %15, %16 offset:4832\n\t" \
                 "s_waitcnt lgkmcnt(0)" \
                 : "=&v"(o[0]), "=&v"(o[1]), "=&v"(o[2]), "=&v"(o[3]), "=&v"(o[4]), "=&v"(o[5]), "=&v"(o[6]), "=&v"(o[7]), \
                   "=&v"(o[8]), "=&v"(o[9]), "=&v"(o[10]), "=&v"(o[11]), "=&v"(o[12]), "=&v"(o[13]), "=&v"(o[14]), "=&v"(o[15]) \
                 : "v"(base) : "memory")
template <int DQ, bool MOBA>
__device__ __forceinline__ void attn_tile(LAS unsigned char* lds, const int buf, const int it, const int q0, const int w, const int qq, const int g, const int qrow, const int own,
                                          const unsigned selbits, const float sc, const pg8::bf16x8 (&qf)[DQ / 32], f32x4 (&o)[8], float& m, float& l) {
    constexpr int KROW = (DQ + 8) * 2, VROW = 288, NDS = DQ / 32;
    const LAS unsigned char* kb = lds + buf * AT_STAGE + AT_KOFF;
    f32x4 st[4];
#pragma unroll
    for (int c = 0; c < 4; ++c) {
        st[c] = (f32x4){0.f, 0.f, 0.f, 0.f};
#pragma unroll
        for (int ds = 0; ds < NDS; ++ds) {
            const pg8::bf16x8 a = *(const LAS pg8::bf16x8*)(kb + (16 * c + qq) * KROW + (32 * ds + 8 * g) * 2);
            st[c] = __builtin_amdgcn_mfma_f32_16x16x32_bf16(a, qf[ds], st[c], 0, 0, 0);
        }
    }
    const int blk = it >> 2;
    const bool past = MOBA && (blk < own);
    if (past) {
        const bool selok = ((selbits >> blk) & 1u) != 0u;
#pragma unroll
        for (int c = 0; c < 4; ++c)
#pragma unroll
            for (int r = 0; r < 4; ++r) st[c][r] = selok ? st[c][r] : -INFINITY;
    } else if (it * 64 + 63 > q0 + 16 * w) {
#pragma unroll
        for (int c = 0; c < 4; ++c)
#pragma unroll
            for (int r = 0; r < 4; ++r) { const int key = it * 64 + 16 * c + 4 * g + r; st[c][r] = (key <= qrow) ? st[c][r] : -INFINITY; }
    }
    float mloc = fmaxf(fmaxf(st[0][0], st[0][1]), fmaxf(st[0][2], st[0][3]));
#pragma unroll
    for (int c = 1; c < 4; ++c) mloc = fmaxf(mloc, fmaxf(fmaxf(st[c][0], st[c][1]), fmaxf(st[c][2], st[c][3])));
    const int ln_ = qq + 16 * g;
    mloc = fmaxf(mloc, shfl_xor_(mloc, 16, ln_)); mloc = fmaxf(mloc, shfl_xor_(mloc, 32, ln_));
    const float mnew = fmaxf(m, mloc * sc);
    if (__any(mnew > m)) {
        const float alpha = __builtin_amdgcn_exp2f(m - mnew);
        l *= alpha;
#pragma unroll
        for (int i = 0; i < 8; ++i) o[i] *= alpha;
        m = mnew;
    }
    float ps = 0.f;
#pragma unroll
    for (int c = 0; c < 4; ++c)
#pragma unroll
        for (int r = 0; r < 4; ++r) { const float p = __builtin_amdgcn_exp2f(__builtin_fmaf(st[c][r], sc, -m)); st[c][r] = p; ps += p; }
    l += ps;
#pragma unroll
    for (int c0i = 0; c0i < 2; ++c0i) {
        v4u pw; pw.x = pk2(st[2 * c0i][0], st[2 * c0i][1]); pw.y = pk2(st[2 * c0i][2], st[2 * c0i][3]);
        pw.z = pk2(st[2 * c0i + 1][0], st[2 * c0i + 1][1]); pw.w = pk2(st[2 * c0i + 1][2], st[2 * c0i + 1][3]);
        const pg8::bf16x8 pb = __builtin_bit_cast(pg8::bf16x8, pw);
        const unsigned vaddr = (unsigned)(size_t)(lds + buf * AT_STAGE + AT_VOFF) + (unsigned)((32 * c0i + 4 * g + (qq >> 2)) * VROW + 8 * (qq & 3));
        s16x4 vr[16];
        AT_TR16(vaddr, vr);
#pragma unroll
        for (int i = 0; i < 8; ++i) {
            const pg8::bf16x8 a = __builtin_shufflevector(vr[2 * i], vr[2 * i + 1], 0, 1, 2, 3, 4, 5, 6, 7);
            o[i] = __builtin_amdgcn_mfma_f32_16x16x32_bf16(a, pb, o[i], 0, 0, 0);
        }
    }
}
template <int DQ, bool MOBA>
__device__ __forceinline__ void attn_unit(LAS unsigned char* lds, const bf16* Qg, int ldq, const bf16* Kg, int ldk, const bf16* Vg, int ldv,
                                          bf16* Og, int ldo, const unsigned char* sel, int qt, float sc, const int tid) {
    constexpr int KROW = (DQ + 8) * 2, VROW = 288, KCH = DQ / 8, NKC = 64 * KCH / 512, NDS = DQ / 32;
    const int lane = tid & 63, w = __builtin_amdgcn_readfirstlane(tid >> 6), qq = lane & 15, g = lane >> 4;
    const int q0 = qt * 128, qrow = q0 + 16 * w + qq, own = q0 >> 8;
    pg8::bf16x8 qf[NDS];
#pragma unroll
    for (int ds = 0; ds < NDS; ++ds) qf[ds] = *(const pg8::bf16x8*)(Qg + (size_t)qrow * ldq + 32 * ds + 8 * g);
    unsigned selbits = 0; if (MOBA) selbits = sel[(size_t)qrow * 8];
    f32x4 o[8];
#pragma unroll
    for (int i = 0; i < 8; ++i) o[i] = (f32x4){0.f, 0.f, 0.f, 0.f};
    float m = -1e30f, l = 0.f;
    const int ntiles = 2 * (qt + 1);
    v4u kA[NKC], vA[2], kB[NKC], vB[2];
    { const v4u z_ = {0u, 0u, 0u, 0u};
#pragma unroll
      for (int i_ = 0; i_ < NKC; ++i_) { kA[i_] = z_; kB[i_] = z_; }
      vA[0] = z_; vA[1] = z_; vB[0] = z_; vB[1] = z_; }
    unsigned kgo[NKC], vgo[2], klo[NKC], vlo[2];
#pragma unroll
    for (int i_ = 0; i_ < NKC; ++i_) { const int id_ = tid + 512 * i_, row_ = id_ / KCH, ch_ = id_ % KCH; kgo[i_] = (unsigned)(row_ * ldk + ch_ * 8) * 2u; klo[i_] = (unsigned)(row_ * KROW + ch_ * 16); }
#pragma unroll
    for (int i_ = 0; i_ < 2; ++i_) { const int id_ = tid + 512 * i_, row_ = id_ >> 4, ch_ = id_ & 15; vgo[i_] = (unsigned)(row_ * ldv + ch_ * 8) * 2u; vlo[i_] = (unsigned)(AT_VOFF + row_ * VROW + ch_ * 16); }
#define AT_GLOAD(KS, VS, tile) do { const char* kp_ = (const char*)Kg + (size_t)(tile) * 64 * ldk * 2; const char* vp_ = (const char*)Vg + (size_t)(tile) * 64 * ldv * 2; \
        _Pragma("unroll") for (int i_ = 0; i_ < NKC; ++i_) KS[i_] = *(const v4u*)(kp_ + kgo[i_]); \
        _Pragma("unroll") for (int i_ = 0; i_ < 2; ++i_) VS[i_] = *(const v4u*)(vp_ + vgo[i_]); } while (0)
#define AT_LSTORE(KS, VS, buf) do { _Pragma("unroll") for (int i_ = 0; i_ < NKC; ++i_) *(LAS v4u*)(lds + (buf) * AT_STAGE + klo[i_]) = KS[i_]; \
        _Pragma("unroll") for (int i_ = 0; i_ < 2; ++i_) *(LAS v4u*)(lds + (buf) * AT_STAGE + vlo[i_]) = VS[i_]; } while (0)
    AT_GLOAD(kA, vA, 0); AT_LSTORE(kA, vA, 0);
    AT_GLOAD(kA, vA, 1);
    __syncthreads();
    for (int it = 0; it < ntiles; it += 2) {
        if (it + 2 < ntiles) AT_GLOAD(kB, vB, it + 2);
        attn_tile<DQ, MOBA>(lds, 0, it, q0, w, qq, g, qrow, own, selbits, sc, qf, o, m, l);
        AT_LSTORE(kA, vA, 1);
        __syncthreads();
        if (it + 3 < ntiles) AT_GLOAD(kA, vA, it + 3);
        attn_tile<DQ, MOBA>(lds, 1, it + 1, q0, w, qq, g, qrow, own, selbits, sc, qf, o, m, l);
        if (it + 2 < ntiles) AT_LSTORE(kB, vB, 0);
        __syncthreads();
    }
    float ls = l + shfl_xor_(l, 16, lane); ls += shfl_xor_(ls, 32, lane);
    const float inv = 1.0f / ls;
#pragma unroll
    for (int i = 0; i < 8; ++i) { v2u ob; ob.x = pk2(o[i][0] * inv, o[i][1] * inv); ob.y = pk2(o[i][2] * inv, o[i][3] * inv);
        *(v2u*)(Og + (size_t)qrow * ldo + 16 * i + 4 * g) = ob; }
#undef AT_GLOAD
#undef AT_LSTORE
}
template <bool BT, class Epi>
__device__ __forceinline__ void gemm32(LAS float* lds, const float* A, int lda, size_t sA, const float* B, int ldb, size_t sB,
                                       int M, int N, int K, int nbatch, const int* rowidx, const Epi& epi, const int tid, const int G) {
    const int lane = tid & 63, wave = tid >> 6, wm = wave >> 1, wn = wave & 1;
    const int tilesM = (M + 127) >> 7, tilesN = (N + 127) >> 7, tilesPer = tilesM * tilesN, ntiles = tilesPer * nbatch;
    LAS float* As = lds;
    LAS float* Bs = lds + 2 * 16 * 132;
    for (int tile = blockIdx.x; tile < ntiles; tile += G) {
        const int bt = tile / tilesPer, r = tile % tilesPer, tm = r / tilesN, tn = r % tilesN;
        const int m0 = tm * 128, n0 = tn * 128;
        const float* Ab = A + (size_t)bt * sA; const float* Bb = B + (size_t)bt * sB;
        const int arow = tid >> 2, akq = (tid & 3) * 4;
        const int gr = m0 + arow; const bool aok = gr < M;
        const int src = aok ? (rowidx ? rowidx[gr] : gr) : 0;
        const float* ap = Ab + (size_t)src * lda + akq;
        const float* bp; bool bok; int bkr, bnq;
        if (BT) { bkr = 0; bnq = 0; const int gn = n0 + arow; bok = gn < N; bp = Bb + (size_t)(bok ? gn : 0) * ldb + akq; }
        else { bkr = tid >> 5; bnq = (tid & 31) * 4; bok = (n0 + bnq) < N; bp = Bb + (size_t)bkr * ldb + (bok ? (n0 + bnq) : 0); }
        f32x16 acc0, acc1;
#pragma unroll
        for (int i = 0; i < 16; ++i) { acc0[i] = 0.f; acc1[i] = 0.f; }
        f32x4 ra, rb;
        const f32x4 z4 = {0.f, 0.f, 0.f, 0.f};
        ra = aok ? *(const f32x4*)ap : z4;
        rb = bok ? *(const f32x4*)bp : z4;
        {
            LAS float* a_ = As; LAS float* b_ = Bs;
#pragma unroll
            for (int j = 0; j < 4; ++j) a_[(akq + j) * 132 + arow] = ra[j];
            if (BT) {
#pragma unroll
                for (int j = 0; j < 4; ++j) b_[(akq + j) * 132 + arow] = rb[j];
            } else *(LAS f32x4*)(b_ + bkr * 132 + bnq) = rb;
        }
        __syncthreads();
        for (int k0 = 0; k0 < K; k0 += 16) {
            const int cur = (k0 >> 4) & 1;
            const bool more = (k0 + 16) < K;
            if (more) {
                ra = aok ? *(const f32x4*)(ap + k0 + 16) : z4;
                if (BT) rb = bok ? *(const f32x4*)(bp + k0 + 16) : z4;
                else rb = bok ? *(const f32x4*)(bp + (size_t)(k0 + 16) * ldb) : z4;
            }
            const LAS float* a_ = As + cur * 16 * 132 + (lane >> 5) * 132 + wm * 32 + (lane & 31);
            const LAS float* b_ = Bs + cur * 16 * 132 + (lane >> 5) * 132 + wn * 64 + (lane & 31);
#pragma unroll
            for (int kk = 0; kk < 16; kk += 2) {
                const float a = a_[kk * 132], b0 = b_[kk * 132], b1 = b_[kk * 132 + 32];
                acc0 = __builtin_amdgcn_mfma_f32_32x32x2f32(a, b0, acc0, 0, 0, 0);
                acc1 = __builtin_amdgcn_mfma_f32_32x32x2f32(a, b1, acc1, 0, 0, 0);
            }
            if (more) {
                LAS float* aw = As + (cur ^ 1) * 16 * 132; LAS float* bw = Bs + (cur ^ 1) * 16 * 132;
#pragma unroll
                for (int j = 0; j < 4; ++j) aw[(akq + j) * 132 + arow] = ra[j];
                if (BT) {
#pragma unroll
                    for (int j = 0; j < 4; ++j) bw[(akq + j) * 132 + arow] = rb[j];
                } else *(LAS f32x4*)(bw + bkr * 132 + bnq) = rb;
            }
            __syncthreads();
        }
#pragma unroll
        for (int i = 0; i < 16; ++i) {
            const int row = m0 + wm * 32 + (i & 3) + 8 * (i >> 2) + 4 * (lane >> 5);
            const int c0 = n0 + wn * 64 + (lane & 31);
            if (row < M) {
                if (c0 < N) epi(bt, row, c0, acc0[i]);
                if (c0 + 32 < N) epi(bt, row, c0 + 32, acc1[i]);
            }
        }
    }
}

struct EpiStore { float* C; int ldc; size_t sC;
    __device__ __forceinline__ void operator()(int bt, int m, int n, float v) const { C[(size_t)bt * sC + (size_t)m * ldc + n] = v; } };
struct EpiDecay { float* C; const float* w0;
    __device__ __forceinline__ void operator()(int, int m, int n, float v) const {
        const float z = -(w0[n] + v); const float sp = z > 20.f ? z : log1pf(expf(z));
        C[(size_t)m * BW + n] = expf(-expf(-sp - 0.5f)); } };
struct EpiSigB { float* C; const float* b;
    __device__ __forceinline__ void operator()(int, int m, int n, float v) const { C[(size_t)m * BW + n] = sigmoidf_(b[n] + v); } };
struct EpiVLerp { float* V; const float* VF; const float* v0;
    __device__ __forceinline__ void operator()(int, int m, int n, float a) const {
        const size_t o = (size_t)m * BW + n; const float v = V[o]; V[o] = v + (VF[o] - v) * sigmoidf_(v0[n] + a); } };
template <bool FIRST> struct EpiGateAcc { float* MIX; const float* gate;
    __device__ __forceinline__ void operator()(int, int m, int n, float a) const {
        const float g = sigmoidf_(gate[(size_t)m * IN_COLS + n]); const size_t o = (size_t)m * D + n;
        MIX[o] = FIRST ? g * a : MIX[o] + g * a; } };
struct EpiResid { float* C; const float* R; int ldc;
    __device__ __forceinline__ void operator()(int, int m, int n, float a) const { const size_t o = (size_t)m * ldc + n; C[o] = ALPHA * R[o] + a; } };
struct EpiSwiglu { float* C; int ldc; size_t roff;
    __device__ __forceinline__ void operator()(int, int m, int n, float a) const {
        const size_t o = (roff + (size_t)m) * ldc + n; const float g = C[o]; C[o] = g * sigmoidf_(g) * a; } };

struct Args { const float* in[34]; float* out; unsigned char* ws; unsigned mask; int li; };

__device__ __forceinline__ unsigned char* opq(unsigned char* p) { asm volatile("" : "+s"(p)); return p; }
#define INP(i) ((const float*)(((const GAS float* const*)args.in)[(i) + zero_live]))
#define x_in INP(0)
#define w_in INP(1)
#define w_in_vres INP(2)
#define rwkv_mu INP(3)
#define rwkv_mu_vres INP(4)
#define rwkv_w0 INP(5)
#define rwkv_w_lora INP(6)
#define rwkv_a0 INP(7)
#define rwkv_a_lora INP(8)
#define rwkv_g_lora INP(9)
#define rwkv_v0 INP(10)
#define rwkv_v_lora INP(11)
#define rwkv_k_k INP(12)
#define rwkv_k_a INP(13)
#define rwkv_r_k INP(14)
#define rwkv_gn_g INP(15)
#define rwkv_gn_b INP(16)
#define mla_q_norm INP(17)
#define mla_w_uq INP(18)
#define mla_kv_norm INP(19)
#define mla_w_ukv INP(20)
#define branch_out INP(21)
#define w_out INP(22)
#define ln1_g INP(23)
#define ln1_b INP(24)
#define ffn_wg INP(25)
#define ffn_wu INP(26)
#define ffn_wd INP(27)
#define moe_router INP(28)
#define moe_wg INP(29)
#define moe_wu INP(30)
#define moe_wd INP(31)
#define ln2_g INP(32)
#define ln2_b INP(33)
#define COSA ((float*)(ws_live + WS_COSA))
#define SINA ((float*)(ws_live + WS_SINA))
#define COSM ((float*)(ws_live + WS_COSM))
#define SINM ((float*)(ws_live + WS_SINM))
#define TOK ((int*)(ws_live + WS_TOK))
#define ROWL ((int*)(ws_live + WS_ROWL))
#define XB ((float*)(ws_live + WS_XB))
#define X1 ((float*)(ws_live + WS_X1))
#define PRE ((float*)(ws_live + WS_PRE))
#define XBF ((bf16*)(ws_live + WS_XBF))
#define WINT ((bf16*)(ws_live + WS_WINT))
#define X1B ((bf16*)(ws_live + WS_X1B))
#define WBO ((bf16*)(ws_live + WS_WBO))
#define WOT ((bf16*)(ws_live + WS_WOT))
#define WGU ((bf16*)(ws_live + WS_WGU))
#define WD ((bf16*)(ws_live + WS_WD))
#define WDD ((bf16*)(ws_live + WS_WDD))
#define HGB ((bf16*)(ws_live + WS_HGB))
#define XG ((bf16*)(ws_live + WS_XG))
#define MIXB ((bf16*)(ws_live + WS_MIXB))
#define YALL ((bf16*)(ws_live + WS_YALL))
#define GATEB ((bf16*)(ws_live + WS_GATEB))
#define QAB ((bf16*)(ws_live + WS_QAB))
#define KAB ((bf16*)(ws_live + WS_KAB))
#define VAB ((bf16*)(ws_live + WS_VAB))
#define QCB ((bf16*)(ws_live + WS_QCB))
#define KCB ((bf16*)(ws_live + WS_KCB))
#define VCB ((bf16*)(ws_live + WS_VCB))
#define KMEAN ((float*)(ws_live + WS_KMEAN))
#define SELB ((unsigned char*)(ws_live + WS_SEL))
#define WUQ ((bf16*)(ws_live + WS_WUQ))
#define WUKV ((bf16*)(ws_live + WS_WUKV))
#define WLORA ((bf16*)(ws_live + WS_WLORA))
#define LA ((bf16*)(ws_live + WS_LA))
#define QNB ((bf16*)(ws_live + WS_QNB))
#define KVNB ((bf16*)(ws_live + WS_KVNB))
#define QF ((float*)(ws_live + WS_QF))
#define KMS ((float*)(ws_live + WS_KMEAN))
#define PROJ ((bf16*)(ws_live + WS_PROJ))
#define VRES ((float*)(ws_live + WS_VRES))
#define QA ((float*)(ws_live + WS_QA))
#define V0 ((float*)(ws_live + WS_V0))
#define V1 ((float*)(ws_live + WS_V1))
#define DEC ((float*)(ws_live + WS_DEC))
#define AA ((float*)(ws_live + WS_AA))
#define GG ((float*)(ws_live + WS_GG))
#define Y ((float*)(ws_live + WS_Y))
#define OUT ((float*)(ws_live + WS_OUT))


__global__ void __launch_bounds__(NTHREADS, 2) fwd_kernel(Args args) {
    extern __shared__ __attribute__((aligned(16))) unsigned char lds_raw[];
#define lds ((LAS float*)lds_raw)
    int wave_live = __builtin_amdgcn_readfirstlane((int)threadIdx.x >> 6);
    int tid_live = threadIdx.x;
#define RETID() do { int ln_; asm volatile("v_mbcnt_lo_u32_b32 %0, -1, 0\n\tv_mbcnt_hi_u32_b32 %0, -1, %0" : "=v"(ln_)); asm volatile("" : "+s"(wave_live)); tid_live = wave_live * 64 + ln_; } while (0)
#define tid tid_live
#define lane (tid_live & 63)
#define wave (__builtin_amdgcn_readfirstlane(tid_live >> 6))
#define gw ((int)blockIdx.x * NWAVES + wave)
#define NGW (G_live * NWAVES)
#define gt ((int)blockIdx.x * NTHREADS + tid_live)
#define NGT (G_live * NTHREADS)
#define misc ((volatile LAS unsigned*)((LAS unsigned char*)lds_raw + LDS_BYTES - 64))
    if (tid < 16) misc[tid] = tid == 6 ? 0xffffffffu : 0u;
    __syncthreads();
#define REOPAQUE() do { asm volatile("" : "+s"(ws_live)); asm volatile("" : "+s"(zero_live)); asm volatile("" : "+s"(G_live)); RETID(); } while (0)
#define TI_WINT(t_, ll_, r_) do { constexpr int NNB_ = NP / 32; const int kb_ = (r_) / NNB_, nb_ = (r_) % NNB_, c_ = nb_ * 32; \
    const float* W_ = w_in + (size_t)(ll_) * D * IN_COLS; int ldw_ = IN_COLS, sc_ = c_; \
    if (c_ < 6432) sc_ = c_; \
    else if (c_ < 6464) { if (ll_) { W_ = w_in_vres; ldw_ = 32; sc_ = 0; } else W_ = nullptr; } \
    else if (c_ < 7552) sc_ = c_ - 32; \
    else if (c_ < 7680) W_ = nullptr; \
    else sc_ = c_ - 160; \
    int scl_ = sc_ + (lane & 31); \
    if (c_ < 2048) { const int cl_ = c_ + (lane & 31), hh_ = cl_ >> 7, cc_ = cl_ & 127, e_ = cc_ & 7; scl_ = hh_ * 128 + (e_ < 4 ? 4 * (cc_ >> 3) + e_ : 64 + 4 * (cc_ >> 3) + (e_ - 4)); } \
    (t_).zero = W_ == nullptr; (t_).p = (W_ ? W_ : w_in) + scl_; (t_).ldw = ldw_; (t_).wt = WINT + (size_t)(ll_) * NP * D; (t_).K = D; (t_).r0 = c_; (t_).k0 = kb_ * 64; } while (0)
#define TI_WBO(t_, mat_, r_) do { const int kb_ = (r_) / 64, nb_ = (r_) % 64, ll_ = (mat_) / 3, seg_ = (mat_) % 3; \
    (t_).zero = false; (t_).p = branch_out + (size_t)(mat_) * BW * D + nb_ * 32 + (lane & 31); (t_).ldw = D; (t_).wt = WBO + (size_t)ll_ * D * 3 * BW + seg_ * BW; (t_).K = 3 * BW; (t_).r0 = nb_ * 32; (t_).k0 = kb_ * 64; } while (0)
#define TI_WUQ(t_, mat_, r_) do { const int kb_ = (r_) / 48, nb_ = (r_) % 48; \
    const int np_ = nb_ * 32 + (lane & 31), hh_ = np_ / 192, cc_ = np_ - hh_ * 192, q_ = cc_ - 128, e_ = q_ & 7; \
    const int sc_ = cc_ < 128 ? hh_ * 192 + cc_ : hh_ * 192 + 128 + (e_ < 4 ? 4 * (q_ >> 3) + e_ : 32 + 4 * (q_ >> 3) + (e_ - 4)); \
    (t_).zero = false; (t_).p = mla_w_uq + (size_t)(mat_) * 512 * 1536 + sc_; (t_).ldw = 1536; (t_).wt = WUQ + (size_t)(mat_) * 1536 * 512; (t_).K = 512; (t_).r0 = nb_ * 32; (t_).k0 = kb_ * 64; } while (0)
#define TI_WUKV(t_, mat_, r_) do { const int kb_ = (r_) / 64, nb_ = (r_) % 64; \
    (t_).zero = false; (t_).p = mla_w_ukv + (size_t)(mat_) * 512 * 2048 + nb_ * 32 + (lane & 31); (t_).ldw = 2048; (t_).wt = WUKV + (size_t)(mat_) * 2048 * 512; (t_).K = 512; (t_).r0 = nb_ * 32; (t_).k0 = kb_ * 64; } while (0)
#define TI_WOT(t_, mat_, r_) do { const int kb_ = (r_) / 64, nb_ = (r_) % 64; \
    (t_).zero = false; (t_).p = w_out + (size_t)(mat_) * D * D + nb_ * 32 + (lane & 31); (t_).ldw = D; (t_).wt = WOT + (size_t)(mat_) * D * D; (t_).K = D; (t_).r0 = nb_ * 32; (t_).k0 = kb_ * 64; } while (0)
constexpr int FC_I_GU = (D / 64) * (NGU / 32), FC_I_D = (DFF / 64) * (D / 32);
#define TI_GU(t_, wg_, wu_, e_, r_) do { const int kb_ = (r_) / (NGU / 32), nb_ = (r_) % (NGU / 32); const int rr_ = lane & 31, hcol_ = 4 * (nb_ * 4 + (rr_ >> 3)) + (rr_ & 3); \
    (t_).zero = false; (t_).p = ((rr_ & 7) < 4 ? (wg_) : (wu_)) + (size_t)(e_) * D * DFF + hcol_; (t_).ldw = DFF; (t_).wt = WGU + (size_t)(e_) * NGU * D; (t_).K = D; (t_).r0 = nb_ * 32; (t_).k0 = kb_ * 64; } while (0)
#define TI_D(t_, wd_, dst_, e_, r_) do { const int kb_ = (r_) / (D / 32), nb_ = (r_) % (D / 32); \
    (t_).zero = false; (t_).p = (wd_) + (size_t)(e_) * DFF * D + nb_ * 32 + (lane & 31); (t_).ldw = D; (t_).wt = (dst_) + (size_t)(e_) * D * DFF; (t_).K = DFF; (t_).r0 = nb_ * 32; (t_).k0 = kb_ * 64; } while (0)
#define TI_RUN1(ta_) do { float va_[32]; ti_load(ta_, va_, lane); ti_finish(ta_, va_, scr, lane); } while (0)
#define TI_RUN2(ta_, tb_) do { float va_[32], vb_[32]; ti_load(ta_, va_, lane); ti_load(tb_, vb_, lane); ti_finish(ta_, va_, scr, lane); ti_finish(tb_, vb_, scr, lane); } while (0)
#define CV_WINT_ITEM(ll_, r_) do { TI t1_; TI_WINT(t1_, ll_, r_); TI_RUN1(t1_); } while (0)
#define CV_WUQ_ITEM(mat_, r_) do { TI t1_; TI_WUQ(t1_, mat_, r_); TI_RUN1(t1_); } while (0)
#define CV_WUKV_ITEM(mat_, r_) do { TI t1_; TI_WUKV(t1_, mat_, r_); TI_RUN1(t1_); } while (0)
#define CV_LORA_ITEM(ll_, r_) do { \
    for (int j_ = 0; j_ < 32; ++j_) { const int x_ = (r_) * 2048 + j_ * 64 + lane, n_ = x_ / 384, k_ = x_ % 384, seg_ = n_ >> 10, c_ = n_ & 1023; \
        float v_ = 0.f; \
        if (seg_ == 0) { if (k_ < 64) v_ = rwkv_w_lora[((size_t)(ll_) * 64 + k_) * BW + c_]; } \
        else if (seg_ == 1) { if (k_ >= 64 && k_ < 128) v_ = rwkv_a_lora[((size_t)(ll_) * 64 + (k_ - 64)) * BW + c_]; } \
        else if (seg_ == 2) { if (k_ >= 128 && k_ < 288) v_ = rwkv_g_lora[((size_t)(ll_) * 160 + (k_ - 128)) * BW + c_]; } \
        else { if ((ll_) == 1 && k_ >= 288 && k_ < 320) v_ = rwkv_v_lora[(size_t)(k_ - 288) * BW + c_]; } \
        WLORA[(size_t)(ll_) * 4096 * 384 + x_] = (bf16)f2bf(v_); } } while (0)
#define FFN_CONV_PAIR(it_) do { const int fi_ = (it_); \
    if (l == 0) { if (fi_ < FC_I_GU) PAIR_OF(TI_GU, ffn_wg, ffn_wu, 0, fi_); else PAIR_OF(TI_D, ffn_wd, WDD, 0, fi_ - FC_I_GU); } \
    else PAIR_OF(TI_GU, moe_wg, moe_wu, fi_ / FC_I_GU, fi_ % FC_I_GU); } while (0)
#define FFN_CONV_N(l_) ((l_) == 0 ? FC_I_GU + FC_I_D : 4 * FC_I_GU)
#define PAIR_OF(TIM_, ...) do { TI ta_, tb_; TIM_(ta_, __VA_ARGS__); TIM_(tb_, __VA_ARGS__ + 1); TI_RUN2(ta_, tb_); } while (0)
#define DQ_PAIR(d_) do { const int d__ = (d_); \
    if (d__ < 3072) { PAIR_OF(TI_WBO, d__ >> 10, (d__ & 1023)); asm volatile("; dq0" ::: "memory"); } \
    else if (d__ < 5120) { PAIR_OF(TI_WOT, 0, d__ - 3072); asm volatile("; dq1" ::: "memory"); } \
    else if (d__ < 18944) { PAIR_OF(TI_WINT, 1, d__ - 5120); asm volatile("; dq2" ::: "memory"); } \
    else if (d__ < 19712) { }   \
    else if (d__ < 20096) { PAIR_OF(TI_WUQ, 1, d__ - 19712); asm volatile("; dq3" ::: "memory"); } \
    else if (d__ < 20608) { PAIR_OF(TI_WUKV, 1, d__ - 20096); asm volatile("; dq4" ::: "memory"); } \
    else if (d__ < 23680) { PAIR_OF(TI_WBO, 3 + ((d__ - 20608) >> 10), ((d__ - 20608) & 1023)); asm volatile("; dq5" ::: "memory"); } \
    else if (d__ < 25728) { PAIR_OF(TI_WOT, 1, d__ - 23680); asm volatile("; dq6" ::: "memory"); } \
    else if (d__ < DQ_J7) { PAIR_OF(TI_GU, moe_wg, moe_wu, 4 + (d__ - 25728) / FC_I_GU, (d__ - 25728) % FC_I_GU); asm volatile("; dq7" ::: "memory"); } \
    else { PAIR_OF(TI_D, moe_wd, WD, (d__ - DQ_J7) / FC_I_D, (d__ - DQ_J7) % FC_I_D); asm volatile("; dq8" ::: "memory"); } } while (0)
#define DQ_HALF(base_) do { const int dit_ = (int)(base_) + 2 * wave; if (dit_ < DQ_N) DQ_PAIR(dit_); } while (0)
#define DQ_PENDING() do { const unsigned pu_ = (unsigned)__builtin_amdgcn_readfirstlane((int)misc[6]); __syncthreads(); \
        if (pu_ != 0xffffffffu) { if (tid == 0) misc[6] = 0xffffffffu; DQ_HALF(pu_); } } while (0)
#define DQ_RUN(COND_) do { DQ_PENDING(); for (;;) { \
        if (tid == 0) { unsigned u_ = 0xffffffffu; \
            if (xb_ld(ctl + CW_DQ + 64 * li_) < (unsigned)DQ_N && (COND_)) u_ = atomicAdd(ctl + CW_DQ + 64 * li_, 32u); \
            misc[4] = u_; } \
        __syncthreads(); \
        const unsigned du_ = (unsigned)__builtin_amdgcn_readfirstlane((int)misc[4]); \
        __syncthreads(); \
        if (du_ >= (unsigned)DQ_N) break; \
        DQ_HALF(du_); \
        if (tid == 0) misc[5] = (COND_) ? 1u : 0u; \
        __syncthreads(); \
        const unsigned go_ = (unsigned)__builtin_amdgcn_readfirstlane((int)misc[5]); \
        __syncthreads(); \
        if (!go_) { if (tid == 0) misc[6] = du_ + 16u; __syncthreads(); break; } \
        DQ_HALF(du_ + 16u); \
    } } while (0)
#define DQ_FLUSH(UPTO_) do { DQ_PENDING(); for (;;) { \
        if (tid == 0) { const unsigned h_ = xb_ld(ctl + CW_DQ + 64 * li_); unsigned u_ = 0xffffffffu, nb_ = 0u; \
            if (h_ < (unsigned)(UPTO_)) { nb_ = ((((unsigned)(UPTO_) - h_ + (unsigned)G_live - 1u) / (unsigned)G_live) + 7u) & ~7u; nb_ = nb_ < 16u ? 16u : nb_; u_ = atomicAdd(ctl + CW_DQ + 64 * li_, nb_); } \
            misc[4] = u_; misc[5] = nb_; } \
        __syncthreads(); \
        const unsigned du_ = (unsigned)__builtin_amdgcn_readfirstlane((int)misc[4]), dn_ = (unsigned)__builtin_amdgcn_readfirstlane((int)misc[5]); \
        __syncthreads(); \
        if (du_ >= (unsigned)DQ_N) break; \
        const int de_ = (int)min(du_ + dn_, (unsigned)DQ_N); \
        _Pragma("unroll 1") \
        for (int dit_ = (int)du_ + 2 * wave; dit_ < de_; dit_ += 16) DQ_PAIR(dit_); \
    } } while (0)
#define DQ_FILL(SLOT_, TH_) DQ_RUN(xb_ld(ctl + CW_PD + 64 * ((SLOT_) + 8 * li_)) < (unsigned)(TH_))
#define PHASE_DONE(SLOT_) do { if (tid == 0) atomicAdd(ctl + CW_PD + 64 * ((SLOT_) + 8 * li_), 1u); } while (0)
#define GRID_BAR() do { { XcdBarrier bar_; bar_.bar = ctl + CW_BAR + li_ * XCD_BAR_WORDS; bar_.x = xb_xcc_id(); bar_.st = misc; xcd_barrier(bar_, tid_live); } asm volatile("" : "+s"(ws_live)); asm volatile("" : "+s"(zero_live)); asm volatile("" : "+s"(G_live)); RETID(); } while (0)

    GAS unsigned char* ws_live = *(GAS unsigned char* const*)&args.ws; int zero_live = 0; int G_live = (int)gridDim.x; unsigned mask_live = args.mask; const int li_ = args.li;
#define RUN(p) ((mask_live >> (l * 12 + (p))) & 1u)
#define ctl ((unsigned*)(ws_live + WS_CTL))
    (void)xcd_barrier_post(ctl + CW_BAR + li_ * XCD_BAR_WORDS, misc, tid_live);
    if (mask_live & (1u << 31)) {
    for (int i = gt; i < SEQ * 64; i += NGT) {
        const int s = i >> 6, j = i & 63;
        const float inv = 1.0f / powf(10000.0f, (float)(2 * j) / 128.0f);
        const float ang = (float)s * inv;
        COSA[i] = cosf(ang); SINA[i] = sinf(ang);
    }
    for (int i = gt; i < SEQ * 32; i += NGT) {
        const int s = i >> 5, j = i & 31;
        const float inv = 1.0f / powf(10000.0f, (float)(2 * j) / 64.0f);
        const float ang = (float)s * inv;
        COSM[i] = cosf(ang); SINM[i] = sinf(ang);
    }

    {
        LAS float* scr = (LAS float*)((LAS unsigned char*)lds_raw) + wave * (64 * 33);
        for (int it = gw; it < (D / 64) * (NP / 32); it += NGW) CV_WINT_ITEM(0, it);
        for (int it = gw; it < 2 * 768; it += NGW) { const int ll = it / 768, r = it % 768; CV_LORA_ITEM(ll, r); }
        for (int it = gw; it < 8 * 48; it += NGW) CV_WUQ_ITEM(0, it);
        for (int it = gw; it < 8 * 64; it += NGW) CV_WUKV_ITEM(0, it);
        for (int t = gw; t < T; t += NGW) {
#pragma unroll
            for (int jj = 0; jj < 8; ++jj) { const f32x4 v = *(const f32x4*)(x_in + (size_t)t * D + jj * 256 + lane * 4);
                v2u o; o.x = pk2(v[0], v[1]); o.y = pk2(v[2], v[3]); *(v2u*)(XBF + (size_t)t * D + jj * 256 + lane * 4) = o; }
        }
    }
    GRID_BAR();
    }
    for (int l = 0; l < 2; ++l) {
        const float* X = (l == 0) ? x_in : XB;
        float* Vcur = (l == 0) ? V0 : V1;
        if (RUN(0)) {
        {
            pg8::Gemm g{XBF, WINT + (size_t)l * NP * D, T, NP, D}; pg8::StaticOrder S; S.init(T, NP, G_live, (int)blockIdx.x);
            EpiInProjF32 E{PROJ, VRES, GATEB, QF, KAB, VAB, COSA, SINA, l};
            pg8::gemm_phase<EpiInProjF32, pg8::StaticOrder, false>((LAS unsigned char*)lds_raw, g, S, E, nullptr, tid);
        }
        REOPAQUE();
        {
            LAS float* scr = (LAS float*)((LAS unsigned char*)lds_raw) + wave * (64 * 33);
            PHASE_DONE(l * 4 + 0);
            DQ_FILL(l * 4 + 0, 65);
        }
        GRID_BAR();
        }
        if (RUN(1)) {
        if (l == 1) { LAS float* scr = (LAS float*)((LAS unsigned char*)lds_raw) + wave * (64 * 33); DQ_FLUSH(DQ_J5); }
        for (int item = blockIdx.x; item < NBATCH * 8 * 8; item += G_live) {
            const int blk = item & 7, h = (item >> 3) & 7, b = item >> 6;
            const int kq = tid >> 4, d8 = (tid & 15) * 8;
            const bf16* kbase = KAB + ((size_t)b * SEQ + blk * 256) * BW + h * 128 + d8;
            float sacc[8];
#pragma unroll
            for (int j = 0; j < 8; ++j) sacc[j] = 0.f;
#pragma unroll
            for (int it = 0; it < 8; ++it) { const v4u kv = *(const v4u*)(kbase + (size_t)(kq + 32 * it) * BW); const unsigned kw[4] = {kv.x, kv.y, kv.z, kv.w};
#pragma unroll
                for (int j = 0; j < 4; ++j) { sacc[2 * j] += __uint_as_float(kw[j] << 16); sacc[2 * j + 1] += __uint_as_float(kw[j] & 0xffff0000u); } }
#pragma unroll
            for (int j = 0; j < 8; ++j) lds[kq * 128 + d8 + j] = sacc[j];
            __syncthreads();
            if (tid < 128) { float a = 0.f;
#pragma unroll
                for (int rr = 0; rr < 32; ++rr) a += lds[rr * 128 + tid];
                KMS[(size_t)item * 128 + tid] = a; }
            __syncthreads();
        }
        {
            const float* mu = rwkv_mu + l * RWKV_COLS;
            for (int i0 = gt; i0 < (T / 4) * 256; i0 += 2 * NGT) {
                v2u row[2][5]; f32x4 mu4[2]; int tq[2], cc[2];
#pragma unroll
                for (int u_ = 0; u_ < 2; ++u_) {
                    const int i = i0 + u_ * NGT, ic = i < (T / 4) * 256 ? i : gt;
                    const int q = ic / 256, c4 = 2048 + (ic - q * 256) * 4, t0 = 4 * q, s0 = t0 & (SEQ - 1);
                    tq[u_] = i < (T / 4) * 256 ? t0 : -1; cc[u_] = c4;
                    const bf16* pr = PROJ + (size_t)t0 * PLD + (OFF_RWKV - PSH) + c4;
                    row[u_][0] = *(const v2u*)(s0 > 0 ? pr - PLD : pr);
                    if (s0 == 0) row[u_][0] = (v2u){0u, 0u};
#pragma unroll
                    for (int k = 0; k < 4; ++k) row[u_][k + 1] = *(const v2u*)(pr + (size_t)k * PLD);
                    mu4[u_] = *(const f32x4*)(mu + c4);
                }
#pragma unroll
                for (int u_ = 0; u_ < 2; ++u_) if (tq[u_] >= 0) {
                    float* dst = Vcur + (size_t)tq[u_] * BW + (cc[u_] & 1023);
#pragma unroll
                    for (int k = 0; k < 4; ++k) { const f32x4 cu = bf4_to_f32(row[u_][k + 1]), pv = bf4_to_f32(row[u_][k]); *(f32x4*)(dst + (size_t)k * BW) = cu + (pv - cu) * mu4[u_]; }
                }
            }
            for (int i = gt; i < T * 96; i += NGT) {
                const int t = i / 96, c4 = (i - t * 96) * 4, s = t & (SEQ - 1);
                f32x4 v = {0.f, 0.f, 0.f, 0.f};
                if (c4 < 288) {
                    const f32x4 cur = bf4_to_f32(*(const v2u*)(PROJ + (size_t)t * PLD + (OFF_RWKV - PSH) + 3072 + c4));
                    f32x4 prev = {0.f, 0.f, 0.f, 0.f}; if (s > 0) prev = bf4_to_f32(*(const v2u*)(PROJ + (size_t)(t - 1) * PLD + (OFF_RWKV - PSH) + 3072 + c4));
                    v = cur + (prev - cur) * *(const f32x4*)(mu + 3072 + c4);
                    if (c4 < 64) { v[0] = tanhf(v[0]); v[1] = tanhf(v[1]); v[2] = tanhf(v[2]); v[3] = tanhf(v[3]); }
                    else if (c4 >= 128) { v[0] = sigmoidf_(v[0]); v[1] = sigmoidf_(v[1]); v[2] = sigmoidf_(v[2]); v[3] = sigmoidf_(v[3]); }
                } else if (c4 < 320 && l == 1) {
                    const f32x4 cur = *(const f32x4*)(VRES + (size_t)t * 32 + (c4 - 288));
                    f32x4 prev = {0.f, 0.f, 0.f, 0.f}; if (s > 0) prev = *(const f32x4*)(VRES + (size_t)(t - 1) * 32 + (c4 - 288));
                    v = cur + (prev - cur) * *(const f32x4*)(rwkv_mu_vres + (c4 - 288));
                }
                v2u o; o.x = pk2(v[0], v[1]); o.y = pk2(v[2], v[3]); *(v2u*)(LA + (size_t)t * 384 + c4) = o;
            }
        }
        for (int t = gw; t < T; t += NGW) {
            const bf16* q = PROJ + (size_t)t * PLD + (OFF_MLA - PSH);
#pragma unroll
            for (int part = 0; part < 2; ++part) {
                const v4u qw = *(const v4u*)(q + part * 512 + lane * 8); v2u qlo, qhi; qlo.x = qw.x; qlo.y = qw.y; qhi.x = qw.z; qhi.y = qw.w;
                const f32x4 a = bf4_to_f32(qlo), b2 = bf4_to_f32(qhi);
                const float ss = (a[0] * a[0] + a[1] * a[1]) + (a[2] * a[2] + a[3] * a[3]) + (b2[0] * b2[0] + b2[1] * b2[1]) + (b2[2] * b2[2] + b2[3] * b2[3]);
                const float rs = rsqrtf(wave_sum(ss, lane) * (1.0f / 512.0f) + 1e-6f);
                const float* gn = (part ? mla_kv_norm : mla_q_norm) + l * 512 + lane * 8;
                const f32x4 g0 = *(const f32x4*)gn, g1 = *(const f32x4*)(gn + 4);
                v4u w; w.x = pk2(a[0] * rs * g0[0], a[1] * rs * g0[1]); w.y = pk2(a[2] * rs * g0[2], a[3] * rs * g0[3]);
                w.z = pk2(b2[0] * rs * g1[0], b2[1] * rs * g1[1]); w.w = pk2(b2[2] * rs * g1[2], b2[3] * rs * g1[3]);
                *(v4u*)((part ? KVNB : QNB) + (size_t)t * 512 + lane * 8) = w;
            }
            if (lane < 32) {
                const int s = t & (SEQ - 1);
                const float x1 = __builtin_bit_cast(float, (unsigned)q[1024 + lane] << 16), x2 = __builtin_bit_cast(float, (unsigned)q[1024 + 32 + lane] << 16), c = COSM[s * 32 + lane], sn = SINM[s * 32 + lane];
                const bf16 o1 = (bf16)f2bf(x1 * c - x2 * sn), o2 = (bf16)f2bf(x2 * c + x1 * sn);
#pragma unroll
                for (int hh = 0; hh < 8; ++hh) { KCB[(size_t)t * 1536 + hh * 192 + 128 + lane] = o1; KCB[(size_t)t * 1536 + hh * 192 + 160 + lane] = o2; }
            }
        }
        GRID_BAR();
        }
        if (RUN(2)) {
        {
            pg8::Gemm g{LA, WLORA + (size_t)l * 4096 * 384, T, l ? 4096 : 3072, 384 + zero_live}; pg8::StaticOrder S; S.init(T, l ? 4096 : 3072, G_live, (int)blockIdx.x);
            EpiLora E{DEC, AA, GG, V1, V0, rwkv_w0 + l * BW, rwkv_a0 + l * BW, rwkv_v0};
            pg8::gemm_phase<EpiLora, pg8::StaticOrder, false>((LAS unsigned char*)lds_raw, g, S, E, nullptr, tid);
        }
        REOPAQUE();
        {
            pg8::Gemm g{QNB, WUQ + (size_t)l * 1536 * 512, T, 1536, 512 + zero_live}; pg8::StaticOrder S; S.init(T, 1536, G_live, (int)blockIdx.x);
            EpiMlaQ E{QCB, COSM, SINM};
            pg8::gemm_phase<EpiMlaQ, pg8::StaticOrder, false>((LAS unsigned char*)lds_raw, g, S, E, nullptr, tid);
        }
        REOPAQUE();
        {
            pg8::Gemm g{KVNB, WUKV + (size_t)l * 2048 * 512, T, 2048, 512 + zero_live}; pg8::StaticOrder S; S.init(T, 2048, G_live, (int)blockIdx.x);
            EpiMlaKV E{KCB, VCB};
            pg8::gemm_phase<EpiMlaKV, pg8::StaticOrder, false>((LAS unsigned char*)lds_raw, g, S, E, nullptr, tid);
        }
        REOPAQUE();
        for (int i = gt; i < T * 8 * 16; i += NGT) {
            const int th = i >> 4, jg = (i & 15) * 4, t = th >> 3, h = th & 7, s = t & (SEQ - 1), own = s >> 8;
            const float* src_ = QF + (size_t)t * BW + h * 128 + jg;
            const f32x4 q1 = *(const f32x4*)src_, q2 = *(const f32x4*)(src_ + 64);
            v2u w1; w1.x = pk2(q1[0], q1[1]); w1.y = pk2(q1[2], q1[3]); v2u w2; w2.x = pk2(q2[0], q2[1]); w2.y = pk2(q2[2], q2[3]);
            *(v2u*)(QAB + (size_t)t * BW + h * 128 + jg) = w1; *(v2u*)(QAB + (size_t)t * BW + h * 128 + 64 + jg) = w2;
            const float* km = KMS + (size_t)(((t >> 11) * 8 + h) * 8) * 128 + jg;
            float gate[7];
#pragma unroll
            for (int n = 0; n < 7; ++n) {
                const f32x4 k1 = *(const f32x4*)(km + n * 128), k2 = *(const f32x4*)(km + n * 128 + 64);
                const float part = ((q1[0] * k1[0] + q1[1] * k1[1]) + (q1[2] * k1[2] + q1[3] * k1[3])) + ((q2[0] * k2[0] + q2[1] * k2[1]) + (q2[2] * k2[2] + q2[3] * k2[3]));
                gate[n] = row_allsum16(part);
            }
            unsigned bits = 0;
#pragma unroll
            for (int n = 0; n < 7; ++n) {
                int rank = 0;
#pragma unroll
                for (int m2 = 0; m2 < 7; ++m2) if (m2 != n) rank += (m2 < own && (gate[m2] > gate[n] || (gate[m2] == gate[n] && m2 < n))) ? 1 : 0;
                bits |= ((n < own) && (rank < 3)) ? (1u << n) : 0u;
            }
            if ((i & 15) == 0) SELB[(size_t)t * 8 + h] = (unsigned char)bits;
        }
        {
            LAS float* scr = (LAS float*)((LAS unsigned char*)lds_raw) + wave * (64 * 33);
            __syncthreads();
            PHASE_DONE(l * 4 + 2);
            DQ_FILL(l * 4 + 2, l == 0 ? 129 : 65);
        }
        GRID_BAR();
        }
        if (RUN(3)) {
        if (!(mask_live & (1u << 30)))
        for (int item = blockIdx.x; item < 128; item += G_live) {
            const int bh = item >> 1, half = item & 1, b = bh >> 4, h = bh & 15;
            const size_t base = (size_t)b * SEQ * BW + h * 64;
            constexpr int CH = 32, BUFF = 6 * CH * 64;
            LAS float* ypart = lds + 2 * BUFF;
            const int st_step = tid >> 4, st_j = (tid & 15) * 4;
            const int cbase = l * BW + h * 64 + st_j;
            const f32x4 ckk = *(const f32x4*)(rwkv_k_k + cbase), cka = *(const f32x4*)(rwkv_k_a + cbase);
            const int cg = lane & 15, rl = tid >> 4, irow = 32 * half + rl;
            const bool stager = tid < CH * 16;
            f32x4 g_w = {0.f, 0.f, 0.f, 0.f}, g_a = g_w, g_v = g_w;
            v2u g_rc = {0u, 0u}, g_rp = g_rc, g_kc = g_rc, g_kp = g_rc; int g_s = 0;
            const f32x4 mur = *(const f32x4*)(rwkv_mu + l * RWKV_COLS + h * 64 + st_j), muk = *(const f32x4*)(rwkv_mu + l * RWKV_COLS + 1024 + h * 64 + st_j);
            const bf16* pbase = PROJ + (size_t)b * SEQ * PLD + (OFF_RWKV - PSH) + h * 64 + st_j;
            float sa = 0.f, sb = 0.f, sc2 = 0.f, sd = 0.f;
#define SC_GLOAD(c) do { if (stager) { const size_t o_ = base + (size_t)((c) * CH + st_step) * BW + st_j; \
                g_s = (c) * CH + st_step; const bf16* pk_ = pbase + (size_t)g_s * PLD; \
                g_kc = *(const v2u*)(pk_ + 1024); g_kp = *(const v2u*)(pk_ - (g_s > 0 ? PLD : 0) + 1024); \
                g_rc = *(const v2u*)(pk_ - (g_s > 0 ? PLD : 0)); g_rp = *(const v2u*)(pk_ - (g_s > 1 ? 2 * PLD : 0)); \
                g_w = *(const f32x4*)(DEC + o_); g_a = *(const f32x4*)(AA + o_); g_v = *(const f32x4*)(Vcur + o_); } } while (0)
#define SC_LSTORE(bufi) do { if (stager) { \
                const f32x4 kc_ = bf4_to_f32(g_kc), rc_ = bf4_to_f32(g_rc); f32x4 kp_ = bf4_to_f32(g_kp), rp_ = bf4_to_f32(g_rp); \
                if (g_s == 0) kp_ = (f32x4){0.f, 0.f, 0.f, 0.f}; if (g_s <= 1) rp_ = (f32x4){0.f, 0.f, 0.f, 0.f}; \
                const f32x4 g_k = kc_ + (kp_ - kc_) * muk, g_r = rc_ + (rp_ - rc_) * mur; \
                f32x4 kk_ = g_k * ckk; \
                const float n2_ = row_allsum16((kk_[0] * kk_[0] + kk_[1] * kk_[1]) + (kk_[2] * kk_[2] + kk_[3] * kk_[3])); \
                kk_ = kk_ * __builtin_amdgcn_rcpf(fmaxf(sqrtf(n2_), 1e-12f)); \
                const f32x4 k2_ = g_k * (1.0f + (g_a - 1.0f) * cka); \
                LAS float* bb_ = lds + (bufi) * BUFF + st_step * 64 + st_j; \
                *(LAS f32x4*)(bb_ + 0 * CH * 64) = g_r; *(LAS f32x4*)(bb_ + 1 * CH * 64) = g_w; *(LAS f32x4*)(bb_ + 2 * CH * 64) = k2_; \
                *(LAS f32x4*)(bb_ + 3 * CH * 64) = kk_; *(LAS f32x4*)(bb_ + 4 * CH * 64) = kk_ * g_a; *(LAS f32x4*)(bb_ + 5 * CH * 64) = g_v; } } while (0)
#define SC_LD(X, st_) do { const LAS float* p_ = bb + (st_) * 64 + 4 * cg; \
                X##r = *(const LAS f32x4*)(p_ + 0 * CH * 64); X##w = *(const LAS f32x4*)(p_ + 1 * CH * 64); X##k = *(const LAS f32x4*)(p_ + 2 * CH * 64); \
                X##q = *(const LAS f32x4*)(p_ + 3 * CH * 64); X##b = *(const LAS f32x4*)(p_ + 4 * CH * 64); X##v = bb[5 * CH * 64 + (st_) * 64 + irow]; } while (0)
#define SC_STEP(X, st_) do { float d_, y_, t0_, t1_, t2_, t3_; \
                asm("v_mul_f32 %0, %4, %8\n\tv_mul_f32 %1, %4, %12\n\tv_mul_f32 %2, %6, %10\n\tv_mul_f32 %3, %6, %14\n\t" \
                    "v_fma_f32 %0, %5, %9, %0\n\tv_fma_f32 %1, %5, %13, %1\n\tv_fma_f32 %2, %7, %11, %2\n\tv_fma_f32 %3, %7, %15, %3\n\t" \
                    "v_add_f32 %0, %0, %2\n\tv_add_f32 %1, %1, %3" \
                    : "=&v"(d_), "=&v"(y_), "=&v"(t0_), "=&v"(t1_) \
                    : "v"(sa), "v"(sb), "v"(sc2), "v"(sd), "v"(X##q[0]), "v"(X##q[1]), "v"(X##q[2]), "v"(X##q[3]), "v"(X##r[0]), "v"(X##r[1]), "v"(X##r[2]), "v"(X##r[3])); \
                asm("s_nop 1\n\tv_add_f32_dpp %0, %0, %0 quad_perm:[1,0,3,2] row_mask:0xf bank_mask:0xf bound_ctrl:1\n\ts_nop 1\n\t" \
                    "v_add_f32_dpp %0, %0, %0 quad_perm:[2,3,0,1] row_mask:0xf bank_mask:0xf bound_ctrl:1" : "+v"(y_)); \
                ypart[(st_) * 128 + rl * 4 + (cg >> 2)] = y_;     \
                asm("v_mul_f32 %5, %9, %10\n\tv_mul_f32 %6, %9, %11\n\t" \
                    "v_add_f32_dpp %0, %0, %0 row_ror:8 row_mask:0xf bank_mask:0xf bound_ctrl:1\n\t" \
                    "v_mul_f32 %7, %9, %12\n\tv_mul_f32 %8, %9, %13\n\t" \
                    "v_add_f32_dpp %0, %0, %0 row_ror:4 row_mask:0xf bank_mask:0xf bound_ctrl:1\n\t" \
                    "v_fma_f32 %5, %1, %14, %5\n\tv_fma_f32 %6, %2, %15, %6\n\t" \
                    "v_add_f32_dpp %0, %0, %0 row_ror:2 row_mask:0xf bank_mask:0xf bound_ctrl:1\n\t" \
                    "v_fma_f32 %7, %3, %16, %7\n\tv_fma_f32 %8, %4, %17, %8\n\t" \
                    "v_add_f32_dpp %0, %0, %0 row_ror:1 row_mask:0xf bank_mask:0xf bound_ctrl:1\n\t" \
                    "s_nop 1\n\t" \
                    "v_fma_f32 %1, -%0, %18, %5\n\tv_fma_f32 %2, -%0, %19, %6\n\tv_fma_f32 %3, -%0, %20, %7\n\tv_fma_f32 %4, -%0, %21, %8" \
                    : "+v"(d_), "+v"(sa), "+v"(sb), "+v"(sc2), "+v"(sd), "=&v"(t0_), "=&v"(t1_), "=&v"(t2_), "=&v"(t3_) \
                    : "v"(X##v), "v"(X##k[0]), "v"(X##k[1]), "v"(X##k[2]), "v"(X##k[3]), "v"(X##w[0]), "v"(X##w[1]), "v"(X##w[2]), "v"(X##w[3]), \
                      "v"(X##b[0]), "v"(X##b[1]), "v"(X##b[2]), "v"(X##b[3])); } while (0)
            SC_GLOAD(0); SC_LSTORE(0);
            __syncthreads();
            for (int c = 0; c < SEQ / CH; ++c) {
                const bool more = (c + 1) < SEQ / CH;
                if (c == SEQ / CH - 2 && tid == 0) atomicAdd(ctl + CW_SD + 64 * (l + 2 * li_), 1u);
                if (more) SC_GLOAD(c + 1);
                const LAS float* bb = lds + (c & 1) * BUFF;
                f32x4 Ar, Aw, Ak, Aq, Ab, Br, Bw, Bk, Bq, Bb; float Av, Bv;
                SC_LD(A, 0);
#pragma unroll 1
                for (int st = 0; st < CH; st += 2) {
                    SC_LD(B, st + 1);
                    SC_STEP(A, st);
                    if (st + 2 < CH) SC_LD(A, st + 2);
                    SC_STEP(B, st + 1);
                }
                __syncthreads();
                {
                    const int stp = tid >> 4, r2 = (tid & 15) * 2;
                    const LAS f32x4* pp = (const LAS f32x4*)(ypart + stp * 128 + r2 * 4);
                    const f32x4 a0 = pp[0], a1 = pp[1];
                    if (c * CH + stp > 0) { float* yo = Y + base + (size_t)(c * CH + stp - 1) * BW + 32 * half + r2;
                        yo[0] = (a0[0] + a0[1]) + (a0[2] + a0[3]); yo[1] = (a1[0] + a1[1]) + (a1[2] + a1[3]); }
                }
                if (more) SC_LSTORE((c + 1) & 1);
                __syncthreads();
            }
            {
                const bf16* pl_ = PROJ + ((size_t)b * SEQ + SEQ - 1) * PLD + (OFF_RWKV - PSH) + h * 64 + 4 * cg;
                const f32x4 rcl = bf4_to_f32(*(const v2u*)pl_), rpl = bf4_to_f32(*(const v2u*)(pl_ - PLD));
                const f32x4 rl4 = rcl + (rpl - rcl) * *(const f32x4*)(rwkv_mu + l * RWKV_COLS + h * 64 + 4 * cg);
                const float yl = row_allsum16((sa * rl4[0] + sb * rl4[1]) + (sc2 * rl4[2] + sd * rl4[3]));
                if (cg == 0) Y[base + (size_t)(SEQ - 1) * BW + irow] = yl;
            }
#undef SC_GLOAD
#undef SC_LSTORE
#undef SC_LD
#undef SC_STEP
        }
        if (!(mask_live & (1u << 29)))
        for (;;) {
            if (tid == 0) misc[4] = atomicAdd(ctl + CW_AQ + 64 * (l + 2 * li_), 1u);
            __syncthreads();
            const unsigned u = misc[4];
            __syncthreads();
            if (u >= 1024u) break;
            const int qt = 15 - (int)(u >> 6), kind = (u >> 5) & 1, b = (u >> 3) & 3, h = u & 7;
            const size_t r0 = (size_t)b * SEQ;
            if (kind == 0)
                attn_unit<128, true>((LAS unsigned char*)lds_raw, QAB + r0 * BW + h * 128, BW, KAB + r0 * BW + h * 128, BW, VAB + r0 * BW + h * 128, BW,
                                     YALL + r0 * (3 * BW) + h * 128, 3 * BW, SELB + r0 * 8 + h, qt, 0.08838834764831845f * 1.4426950408889634f, tid);
            else
                attn_unit<192, false>((LAS unsigned char*)lds_raw, QCB + r0 * 1536 + h * 192, 1536, KCB + r0 * 1536 + h * 192, 1536, VCB + r0 * BW + h * 128, BW,
                                      YALL + r0 * (3 * BW) + 2 * BW + h * 128, 3 * BW, nullptr, qt, 0.07216878364870323f * 1.4426950408889634f, tid);
        }
        {
            LAS float* scr = (LAS float*)((LAS unsigned char*)lds_raw) + wave * (64 * 33);
            const unsigned ncu = (unsigned)(FFN_CONV_N(l) / 32);
            DQ_RUN(xb_ld(ctl + CW_SD + 64 * (l + 2 * li_)) < 128u && xb_ld(ctl + CW_DQ + 64 * li_) < (unsigned)(l == 0 ? DQ_J3 : DQ_J6));
            for (;;) {
                if (tid == 0) {
                    unsigned u_ = 0xffffffffu;
                    if (xb_ld(ctl + CW_SD + 64 * (l + 2 * li_)) < 128u) u_ = atomicAdd(ctl + CW_CQ + 64 * (l + 2 * li_), 1u);
                    misc[4] = u_;
                }
                __syncthreads();
                const unsigned u = (unsigned)__builtin_amdgcn_readfirstlane((int)misc[4]);
                __syncthreads();
                if (u >= ncu) break;
#pragma unroll 1
                for (int k_ = 0; k_ < 2; ++k_) { const int it = (int)u * 32 + k_ * 16 + 2 * wave; FFN_CONV_PAIR(it); }
            }
            DQ_FLUSH(l == 0 ? DQ_J3 : DQ_J6);
        }
        GRID_BAR();
        {
            const int pc = l * BW + (gt & 255) * 4;
            const f32x4 p_g = *(const f32x4*)(rwkv_gn_g + pc), p_b = *(const f32x4*)(rwkv_gn_b + pc), p_ka = *(const f32x4*)(rwkv_k_a + pc), p_rk = *(const f32x4*)(rwkv_r_k + pc);
            const float* pY = Y; const float* pA = AA; const float* pV = Vcur; const float* pG = GG; bf16* pO = YALL + BW;
            const bf16* pP = PROJ + (OFF_RWKV - PSH) + (gt & 255) * 4;
            const f32x4 p_mr = *(const f32x4*)(rwkv_mu + l * RWKV_COLS + (gt & 255) * 4), p_mk = *(const f32x4*)(rwkv_mu + l * RWKV_COLS + 1024 + (gt & 255) * 4);
            for (int i0 = gt; i0 < T * 16 * 16; i0 += 4 * NGT) {
                f32x4 y[4], aa[4], vv[4], gg[4]; v2u rc[4], rp[4], kc[4], kp[4];
#pragma unroll
                for (int u_ = 0; u_ < 4; ++u_) { const int i = i0 + u_ * NGT, ic = i < T * 256 ? i : gt; const size_t o = (size_t)(ic >> 8) * BW + (ic & 255) * 4;
                    const bf16* pp = pP + (size_t)(ic >> 8) * PLD; const int back = ((ic >> 8) & (SEQ - 1)) > 0 ? PLD : 0;
                    y[u_] = *(const f32x4*)(pY + o); aa[u_] = *(const f32x4*)(pA + o); vv[u_] = *(const f32x4*)(pV + o); gg[u_] = *(const f32x4*)(pG + o);
                    rc[u_] = *(const v2u*)pp; rp[u_] = *(const v2u*)(pp - back); kc[u_] = *(const v2u*)(pp + 1024); kp[u_] = *(const v2u*)(pp - back + 1024); }
#pragma unroll
                for (int u_ = 0; u_ < 4; ++u_) { const int i = i0 + u_ * NGT;
                    f32x4 kr, rr;
                    { const bool first = (((i < T * 256 ? i : gt) >> 8) & (SEQ - 1)) == 0; const f32x4 z4 = {0.f, 0.f, 0.f, 0.f};
                      const f32x4 rcf = bf4_to_f32(rc[u_]), kcf = bf4_to_f32(kc[u_]), rpf = first ? z4 : bf4_to_f32(rp[u_]), kpf = first ? z4 : bf4_to_f32(kp[u_]);
                      rr = rcf + (rpf - rcf) * p_mr; kr = kcf + (kpf - kcf) * p_mk; }
                    const float mu = row_allsum16((y[u_][0] + y[u_][1]) + (y[u_][2] + y[u_][3])) * (1.0f / 64.0f);
                    const f32x4 d = y[u_] - mu;
                    const float var = row_allsum16((d[0] * d[0] + d[1] * d[1]) + (d[2] * d[2] + d[3] * d[3])) * (1.0f / 64.0f);
                    const f32x4 yn = d * rsqrtf(var + 64e-5f) * p_g + p_b;
                    const f32x4 k2 = kr * (1.0f + (aa[u_] - 1.0f) * p_ka);
                    const f32x4 rk = rr * k2 * p_rk;
                    const float bon = row_allsum16((rk[0] + rk[1]) + (rk[2] + rk[3]));
                    const f32x4 o4 = (yn + bon * vv[u_]) * gg[u_];
                    v2u ob; ob.x = pk2(o4[0], o4[1]); ob.y = pk2(o4[2], o4[3]);
                    if (i < T * 256) *(v2u*)(pO + (size_t)(i >> 8) * (3 * BW) + (i & 255) * 4) = ob;
                }
            }
        }
        GRID_BAR();
        }
        if (RUN(4)) {
        {
            pg8::StaticOrder S; S.init(T, D, G_live, (int)blockIdx.x);
            pg8::Gemm g{YALL, WBO + (size_t)l * D * 3 * BW, T, D, 3 * BW}; EpiBranch3 E{MIXB, GATEB};
            pg8::gemm_phase<EpiBranch3, pg8::StaticOrder, false>((LAS unsigned char*)lds_raw, g, S, E, nullptr, tid);
        }
        GRID_BAR();
        }
        if (RUN(5)) {
        {
            pg8::Gemm g{MIXB, WOT + (size_t)l * D * D, T, D, D}; pg8::StaticOrder S; S.init(T, D, G_live, (int)blockIdx.x);
            EpiResidF32 E{PRE, X};
            pg8::gemm_phase<EpiResidF32, pg8::StaticOrder, false>((LAS unsigned char*)lds_raw, g, S, E, nullptr, tid);
        }
        GRID_BAR();
        }
        if (RUN(6)) {
        {
            LAS float* scr = (LAS float*)((LAS unsigned char*)lds_raw) + wave * (64 * 33);
            const int ntot = FFN_CONV_N(l);
            const int ndone = (int)min(xb_ld(ctl + CW_CQ + 64 * (l + 2 * li_)), (unsigned)(ntot / 32)) * 32;
            for (int it = ndone + 2 * gw; it < ntot; it += 2 * NGW) FFN_CONV_PAIR(it);
            if (l == 1) DQ_FLUSH(DQ_J7);
        }
        for (int t = gw; t < T; t += NGW) {
            const float* pr = PRE + (size_t)t * D;
            f32x4 v[8]; float s = 0.f;
#pragma unroll
            for (int jj = 0; jj < 8; ++jj) { v[jj] = *(const f32x4*)(pr + jj * 256 + lane * 4); s += (v[jj][0] + v[jj][1]) + (v[jj][2] + v[jj][3]); }
            const float mean = wave_sum(s, lane) * (1.0f / D); float s2 = 0.f;
#pragma unroll
            for (int jj = 0; jj < 8; ++jj) { v[jj] = v[jj] - mean; s2 += (v[jj][0] * v[jj][0] + v[jj][1] * v[jj][1]) + (v[jj][2] * v[jj][2] + v[jj][3] * v[jj][3]); }
            const float rstd = rsqrtf(wave_sum(s2, lane) * (1.0f / D) + 1e-5f);
#pragma unroll
            for (int jj = 0; jj < 8; ++jj) {
                const f32x4 g = *(const f32x4*)(ln1_g + l * D + jj * 256 + lane * 4), bb = *(const f32x4*)(ln1_b + l * D + jj * 256 + lane * 4);
                v[jj] = v[jj] * rstd * g + bb;
                *(f32x4*)(X1 + (size_t)t * D + jj * 256 + lane * 4) = v[jj];
                v2u ob; ob.x = pk2(v[jj][0], v[jj][1]); ob.y = pk2(v[jj][2], v[jj][3]); *(v2u*)(X1B + (size_t)t * D + jj * 256 + lane * 4) = ob;
            }
            if (l == 1) {
                float lg[8];
#pragma unroll
                for (int e = 0; e < 8; ++e) lg[e] = 0.f;
#pragma unroll
                for (int jj = 0; jj < 8; ++jj)
#pragma unroll
                    for (int cc = 0; cc < 4; ++cc) {
                        const int d = jj * 256 + lane * 4 + cc;
                        const f32x4 r0 = *(const f32x4*)(moe_router + (size_t)d * 8), r1 = *(const f32x4*)(moe_router + (size_t)d * 8 + 4);
                        const float xv = v[jj][cc];
                        lg[0] += xv * r0[0]; lg[1] += xv * r0[1]; lg[2] += xv * r0[2]; lg[3] += xv * r0[3];
                        lg[4] += xv * r1[0]; lg[5] += xv * r1[1]; lg[6] += xv * r1[2]; lg[7] += xv * r1[3];
                    }
#pragma unroll
                for (int e = 0; e < 8; ++e) lg[e] = wave_sum(lg[e], lane);
                if (lane == 0) {
                    int e0 = 0; float b0 = lg[0];
#pragma unroll
                    for (int e = 1; e < 8; ++e) if (lg[e] > b0) { b0 = lg[e]; e0 = e; }
                    int e1 = -1; float b1 = -INFINITY;
#pragma unroll
                    for (int e = 0; e < 8; ++e) if (e != e0 && lg[e] > b1) { b1 = lg[e]; e1 = e; }
                    const float w1 = 1.0f / (1.0f + expf(b0 - b1)), w0 = 1.0f - w1;
                    const int p0 = (int)atomicAdd(ctl + CW_CNT + 64 * e0, 1u), p1 = (int)atomicAdd(ctl + CW_CNT + 64 * e1, 1u);
                    int* tk = TOK + (size_t)t * 8;
                    tk[0] = e0; tk[1] = e1; tk[2] = p0; tk[3] = p1; tk[4] = __float_as_int(w0); tk[5] = __float_as_int(w1);
                }
            }
        }
        GRID_BAR();
        }
        float* OUTX = (l == 0) ? XB : (float*)(*(GAS float* const*)&args.out);
        if (l == 0) {
            if (RUN(7)) {
                pg8::Gemm g{X1B, WGU, T, NGU, D}; pg8::StaticOrder S; S.init(T, NGU, G_live, (int)blockIdx.x);
                EpiSwigluBf16 E{HGB, NGU / 256};
                pg8::gemm_phase<EpiSwigluBf16, pg8::StaticOrder, false>((LAS unsigned char*)lds_raw, g, S, E, nullptr, tid);
                REOPAQUE();
                {
                    LAS float* scr = (LAS float*)((LAS unsigned char*)lds_raw) + wave * (64 * 33);
                    PHASE_DONE(1);
                    DQ_FILL(1, 129);
                }
                GRID_BAR();
            }
            if (RUN(8)) {
                pg8::Gemm g{HGB, WDD, T, D, DFF}; pg8::StaticOrder S; S.init(T, D, G_live, (int)blockIdx.x);
                EpiResidF32 E{PRE, X1};
                pg8::gemm_phase<EpiResidF32, pg8::StaticOrder, false>((LAS unsigned char*)lds_raw, g, S, E, nullptr, tid);
                GRID_BAR();
            }
        } else {
            if (RUN(10)) {
            unsigned poff[9]; poff[0] = 0;
#pragma unroll
            for (int e = 0; e < 8; ++e) poff[e + 1] = poff[e] + ((xb_ld(ctl + CW_CNT + 64 * e) + 255u) & ~255u);
            for (int t = gw; t < T; t += NGW) {
                int* tk = TOK + (size_t)t * 8;
                const int e0 = tk[0], e1 = tk[1];
                unsigned o0 = 0, o1 = 0;
#pragma unroll
                for (int e = 0; e < 8; ++e) { o0 = (e == e0) ? poff[e] : o0; o1 = (e == e1) ? poff[e] : o1; }
                const int s0 = (int)o0 + tk[2], s1 = (int)o1 + tk[3];
                if (lane == 0) { tk[6] = s0; tk[7] = s1; }
#pragma unroll
                for (int j = 0; j < 4; ++j) { const v4u xv = *(const v4u*)(X1B + (size_t)t * D + j * 512 + lane * 8);
                    *(v4u*)(XG + (size_t)s0 * D + j * 512 + lane * 8) = xv; *(v4u*)(XG + (size_t)s1 * D + j * 512 + lane * 8) = xv; }
            }
            if (blockIdx.x == 0 && tid < 80) {
                unsigned e_of = 0; const unsigned mt = tid;
#pragma unroll
                for (int e = 1; e < 8; ++e) e_of += (mt * 256u >= poff[e]) ? 1u : 0u;
                ctl[CW_TILE + tid] = e_of;
                if (tid == 0) ctl[CW_TILE - 1] = poff[8] / 256u;
            }
            {
                const unsigned nmt_ = poff[8] / 256u, nfull_ = (nmt_ / 32u) * 32u; const size_t z0 = (size_t)nfull_ * 256 * D / 4, z1 = (size_t)nmt_ * 256 * D / 4;
                for (size_t i = z0 + gt; i < z1; i += NGT) *(f32x4*)(OUT + i * 4) = (f32x4){0.f, 0.f, 0.f, 0.f};
            }
            GRID_BAR();
            }
            const int nMt = (int)ctl[CW_TILE - 1];
            if (RUN(7)) {
                pg8::Gemm g{XG, WGU, MOE_ROWS, NGU, D}; MoeOrder S{ctl + CW_TILE, nMt, NGU / 256, G_live, (int)blockIdx.x};
                EpiSwigluBf16 E{HGB, NGU / 256};
                pg8::gemm_phase<EpiSwigluBf16, MoeOrder, false>((LAS unsigned char*)lds_raw, g, S, E, nullptr, tid);
                REOPAQUE();
                {
                    LAS float* scr = (LAS float*)((LAS unsigned char*)lds_raw) + wave * (64 * 33);
                    const int rem_ = ((int)ctl[CW_TILE - 1] * (NGU / 256)) % G_live;
                    PHASE_DONE(5);
                    DQ_FILL(5, (rem_ ? G_live - rem_ : 0) + 1);
                    DQ_FLUSH(DQ_N);
                }
                GRID_BAR();
            }
            if (RUN(8)) {
                const int nFull = (nMt / 32) * 32;
                { pg8::Gemm g{HGB, WD, MOE_ROWS, D, DFF}; MoeOrder S{ctl + CW_TILE, nFull, D / 256, G_live, (int)blockIdx.x};
                  EpiStoreF32 E{OUT, D / 256};
                  pg8::gemm_phase<EpiStoreF32, MoeOrder, false>((LAS unsigned char*)lds_raw, g, S, E, nullptr, tid); }
                REOPAQUE();
                { pg8::Gemm g{HGB, WD, MOE_ROWS, D, DFF / 4 + zero_live, DFF}; MoeOrder S{ctl + CW_TILE, nMt - nFull, D / 256, G_live, (int)blockIdx.x, nFull, 4, (DFF / 4) * 2};
                  EpiAtomicF32 E{OUT, D / 256};
                  pg8::gemm_phase<EpiAtomicF32, MoeOrder, false>((LAS unsigned char*)lds_raw, g, S, E, nullptr, tid); }
                GRID_BAR();
            }
        }
        if (RUN(9)) {
        if (l == 0) { LAS float* scr = (LAS float*)((LAS unsigned char*)lds_raw) + wave * (64 * 33); DQ_FLUSH(DQ_J4); }
        for (int t = gw; t < T; t += NGW) {
            f32x4 v[8]; float s = 0.f;
            if (l == 0) {
#pragma unroll
                for (int jj = 0; jj < 8; ++jj) v[jj] = *(const f32x4*)(PRE + (size_t)t * D + jj * 256 + lane * 4);
            } else {
                const int* tk = TOK + (size_t)t * 8;
                const float w0 = __int_as_float(tk[4]), w1 = __int_as_float(tk[5]); const int s0 = tk[6], s1 = tk[7];
                const int e0 = tk[0], e1 = tk[1];
#pragma unroll
                for (int jj = 0; jj < 8; ++jj) {
                    const f32x4 xx = *(const f32x4*)(X1 + (size_t)t * D + jj * 256 + lane * 4);
                    const f32x4 a = *(const f32x4*)(OUT + (size_t)s0 * D + jj * 256 + lane * 4), bq = *(const f32x4*)(OUT + (size_t)s1 * D + jj * 256 + lane * 4);
                    const f32x4 f = (e0 < e1) ? (w0 * a + w1 * bq) : (w1 * bq + w0 * a);
                    v[jj] = ALPHA * xx + f;
                }
            }
#pragma unroll
            for (int jj = 0; jj < 8; ++jj) s += (v[jj][0] + v[jj][1]) + (v[jj][2] + v[jj][3]);
            const float mean = wave_sum(s, lane) * (1.0f / D); float s2 = 0.f;
#pragma unroll
            for (int jj = 0; jj < 8; ++jj) { v[jj] = v[jj] - mean; s2 += (v[jj][0] * v[jj][0] + v[jj][1] * v[jj][1]) + (v[jj][2] * v[jj][2] + v[jj][3] * v[jj][3]); }
            const float rstd = rsqrtf(wave_sum(s2, lane) * (1.0f / D) + 1e-5f);
#pragma unroll
            for (int jj = 0; jj < 8; ++jj) {
                const f32x4 g = *(const f32x4*)(ln2_g + l * D + jj * 256 + lane * 4), bb = *(const f32x4*)(ln2_b + l * D + jj * 256 + lane * 4);
                const f32x4 o = v[jj] * rstd * g + bb;
                *(f32x4*)(OUTX + (size_t)t * D + jj * 256 + lane * 4) = o;
                if (l == 0) { v2u ob; ob.x = pk2(o[0], o[1]); ob.y = pk2(o[2], o[3]); *(v2u*)(XBF + (size_t)t * D + jj * 256 + lane * 4) = ob; }
            }
        }
        GRID_BAR();
        }
    }
}

extern "C" void kernel_launch(void* const* d_in, const int* in_sizes, int n_in, void* d_out, int out_size, void* d_ws, size_t ws_size, hipStream_t stream) {
    static int grid = 0;
    if (grid == 0) {
        if (n_in != 34 || out_size != T * D || ws_size < WS_END) { fprintf(stderr, "kernel_launch: bad sizes n_in %d out %d ws %zu need %zu\n", n_in, out_size, ws_size, (size_t)WS_END); grid = -1; return; }
        int dev = 0, cus = 0, per_cu = 0;
        if (hipGetDevice(&dev) != hipSuccess || hipDeviceGetAttribute(&cus, hipDeviceAttributeMultiprocessorCount, dev) != hipSuccess) { grid = -1; return; }
        if (hipFuncSetAttribute((const void*)fwd_kernel, hipFuncAttributeMaxDynamicSharedMemorySize, LDS_BYTES) != hipSuccess) { fprintf(stderr, "hipFuncSetAttribute failed\n"); grid = -1; return; }
        if (hipOccupancyMaxActiveBlocksPerMultiprocessor(&per_cu, (const void*)fwd_kernel, NTHREADS, LDS_BYTES) != hipSuccess || per_cu < 1) fprintf(stderr, "occupancy query says %d\n", per_cu);
        (void)hipGetLastError();
        grid = cus;
    }
    if (grid < 0) return;
    hipMemsetAsync((char*)d_ws + WS_CTL, 0, CTL_BYTES, stream);
    Args a{};
    for (int i = 0; i < 34; ++i) a.in[i] = (const float*)d_in[i];
    a.out = (float*)d_out; a.ws = (unsigned char*)d_ws; a.mask = 0x9FFFFFFFu; a.li = 0;
    hipLaunchKernelGGL(fwd_kernel, dim3(grid), dim3(NTHREADS), LDS_BYTES, stream, a);
#ifdef PROBE_MASK
    a.mask = PROBE_MASK; a.li = 1;
    hipLaunchKernelGGL(fwd_kernel, dim3(grid), dim3(NTHREADS), LDS_BYTES, stream, a);
#endif
}
```

```cpp
#include <hip/hip_runtime.h>
#include <stdint.h>
#include <stdio.h>

constexpr int D = 2048, NBATCH = 4, SEQ = 2048, T = NBATCH * SEQ;
constexpr int BW = 1024;
constexpr int IN_COLS = 13664;
constexpr int OFF_RWKV = 3072, OFF_MLA = 6432, OFF_GATE = 7520;
constexpr int RWKV_COLS = 3360;
constexpr int DFF = 5632, NEXP = 8;
constexpr float ALPHA = 1.41421356237f;
constexpr int NTHREADS = 512, NWAVES = 8;
constexpr int LDS_BYTES = 131072 + 17408 + 512;

#define LAS __attribute__((address_space(3)))
#define GAS __attribute__((address_space(1)))
typedef float f32x16 __attribute__((ext_vector_type(16)));
typedef float f32x4 __attribute__((ext_vector_type(4)));

constexpr size_t MiB = 1u << 20;
constexpr size_t al(size_t x) { return (x + 255) & ~(size_t)255; }
constexpr size_t WS_CTL = 0, CTL_BYTES = 1 * MiB;
constexpr size_t WS_COSA = 1 * MiB;
constexpr size_t WS_SINA = WS_COSA + 2048 * 64 * 4;
constexpr size_t WS_COSM = WS_SINA + 2048 * 64 * 4;
constexpr size_t WS_SINM = WS_COSM + 2048 * 32 * 4;
constexpr size_t WS_TOK = 3 * MiB;
constexpr size_t WS_ROWL = WS_TOK + (size_t)T * 8 * 4;
constexpr size_t WS_XB = 4 * MiB;
constexpr size_t WS_X1 = WS_XB + (size_t)T * D * 4;
constexpr size_t WS_PRE = WS_X1 + (size_t)T * D * 4;
constexpr int NP = 13824;
constexpr size_t WS_XBF = WS_PRE + (size_t)T * D * 4;
constexpr size_t WS_WINT = WS_XBF + (size_t)T * D * 2;
constexpr size_t WS_X1B = WS_WINT + (size_t)2 * NP * D * 2;
constexpr size_t WS_WBO = WS_X1B + (size_t)T * D * 2;
constexpr size_t WS_WOT = WS_WBO + (size_t)6 * D * BW * 2;
constexpr size_t WS_WUQ = WS_WOT + (size_t)2 * D * D * 2;
constexpr size_t WS_WUKV = WS_WUQ + (size_t)2 * 1536 * 512 * 2;
constexpr size_t WS_WLORA = WS_WUKV + (size_t)2 * 2048 * 512 * 2;
constexpr size_t WS_V0 = WS_WLORA + (size_t)2 * 4096 * 384 * 2;
constexpr size_t WS_MIXER = WS_V0 + (size_t)T * BW * 4;
constexpr int MOE_ROWS = 2 * T + NEXP * 256;
constexpr int NGU = 2 * DFF;
constexpr int PLD = 4448, PSH = 3072;
constexpr size_t WS_PROJ = WS_MIXER;
constexpr size_t WS_V1 = al(WS_PROJ + (size_t)T * PLD * 2);
constexpr size_t WS_DEC = WS_V1 + (size_t)T * BW * 4;
constexpr size_t WS_AA = WS_DEC + (size_t)T * BW * 4;
constexpr size_t WS_GG = WS_AA + (size_t)T * BW * 4;
constexpr size_t WS_Y = WS_GG + (size_t)T * BW * 4;
constexpr size_t WS_LA = WS_Y + (size_t)T * BW * 4;
constexpr size_t WS_QNB = WS_LA + (size_t)T * 384 * 2;
constexpr size_t WS_KVNB = WS_QNB + (size_t)T * 512 * 2;
constexpr size_t WS_YALL = WS_KVNB + (size_t)T * 512 * 2;
constexpr size_t WS_GATEB = WS_YALL + (size_t)T * 3 * BW * 2;
constexpr size_t WS_QAB = WS_GATEB + (size_t)T * 3 * D * 2;
constexpr size_t WS_KAB = WS_QAB + (size_t)T * BW * 2;
constexpr size_t WS_VAB = WS_KAB + (size_t)T * BW * 2;
constexpr size_t WS_QCB = WS_VAB + (size_t)T * BW * 2;
constexpr size_t WS_KCB = WS_QCB + (size_t)T * 1536 * 2;
constexpr size_t WS_VCB = WS_KCB + (size_t)T * 1536 * 2;
constexpr size_t WS_MIXB = WS_VCB + (size_t)T * BW * 2;
constexpr size_t WS_L_END = WS_MIXB + (size_t)T * D * 2;
constexpr size_t WS_HGB = WS_MIXER;
constexpr size_t WS_XG = WS_HGB + (size_t)MOE_ROWS * DFF * 2;
constexpr size_t WS_OUT = WS_XG + (size_t)MOE_ROWS * D * 2;
static_assert(WS_OUT + (size_t)MOE_ROWS * D * 4 <= WS_L_END, "FFN activations must stay inside region L");
constexpr size_t WS_WGU = WS_L_END;
constexpr size_t WS_VRES = WS_WGU;
constexpr size_t WS_QF = al(WS_VRES + (size_t)T * 32 * 4);
static_assert(WS_QF + (size_t)T * BW * 4 <= WS_WGU + (size_t)4 * NGU * D * 2, "region P must end inside WGU[0..3]");
constexpr size_t WS_WD = WS_WGU + (size_t)NEXP * NGU * D * 2;
constexpr size_t WS_WDD = WS_WGU + (size_t)NGU * D * 2;
constexpr size_t WS_END = WS_WD + (size_t)NEXP * D * DFF * 2;
constexpr size_t WS_KMEAN = WS_TOK + 512 * 1024;
constexpr size_t WS_SEL = WS_TOK + 768 * 1024;

static_assert(WS_END <= (size_t)1560 * MiB, "ws budget");
constexpr int CW_CNT = 1024;
constexpr int CW_OFF = 2048;
constexpr int CW_AQ = 3072;
constexpr int CW_CQ = 3328;
constexpr int CW_SD = 3584;
constexpr int CQ_ITEMS = 16;
constexpr int CW_DQ = 12288;
constexpr int CW_PD = 12544;
constexpr int DQ_J3 = 5120, DQ_J4 = 18944, DQ_J5 = 20608, DQ_J6 = 25728, DQ_J7 = DQ_J6 + 4 * 11264, DQ_N = DQ_J7 + 8 * 5632;
constexpr int CW_TILE = 2304;
constexpr int CW_BAR = 4096;

#define XB_TMO      128
#define XB_XCNT(j)  (256  + 64 * (j))
#define XB_XSUB(j)  (1280 + 64 * (j))
#define XB_XGEN(j)  (2304 + 64 * (j))
#define XB_TOP      3328
#define XB_TOPGEN   3392
#define XCD_BAR_WORDS 3456
#define XB_SPIN_CAP (1u << 22)

__device__ __forceinline__ unsigned xb_ld(unsigned* p)              { return __hip_atomic_load(p, __ATOMIC_RELAXED, __HIP_MEMORY_SCOPE_AGENT); }
__device__ __forceinline__ unsigned xb_add(unsigned* p, unsigned v) { return __hip_atomic_fetch_add(p, v, __ATOMIC_RELAXED, __HIP_MEMORY_SCOPE_AGENT); }
__device__ __forceinline__ unsigned xb_xcc_id() { return (unsigned)__builtin_amdgcn_s_getreg((3 << 11) | 20) & 0xFu; }
#define XB_SPIN(cond, bar) do { unsigned _sp = 0; while (cond) { __builtin_amdgcn_s_sleep(1); \
    if ((++_sp & 255u) == 0u) { if (xb_ld(&(bar)[XB_TMO])) break; if (_sp > XB_SPIN_CAP) { atomicAdd(&(bar)[XB_TMO], 1u); break; } } } } while (0)

struct XcdBarrier { unsigned* bar; unsigned x; volatile LAS unsigned* st; };

__device__ __forceinline__ XcdBarrier xcd_barrier_post(unsigned* bar, volatile LAS unsigned* st, const int tid0) {
    XcdBarrier b; b.bar = bar; b.x = xb_xcc_id(); b.st = st;
    if (tid0 == 0) (void)xb_add(&bar[XB_XCNT(b.x)], 1u);
    return b;
}
__device__ __forceinline__ void xcd_barrier_complete(unsigned* bar, unsigned x, unsigned& nloc, unsigned& nx) {
    const unsigned G = gridDim.x * gridDim.y * gridDim.z;
    unsigned sum, cnt, mine, sp = 0u;
    for (;;) {
        sum = 0u; cnt = 0u; mine = 0u;
#pragma unroll
        for (unsigned j = 0; j < 16; ++j) { const unsigned c = xb_ld(&bar[XB_XCNT(j)]); sum += c; cnt += (c > 0u) ? 1u : 0u; mine = (j == x) ? c : mine; }
        if (sum == G) break;
        __builtin_amdgcn_s_sleep(1);
        if ((++sp & 255u) == 0u) { if (xb_ld(&bar[XB_TMO])) break; if (sp > XB_SPIN_CAP) { atomicAdd(&bar[XB_TMO], 1u); break; } }
    }
    nloc = mine > 0u ? mine : 1u; nx = cnt > 0u ? cnt : 1u;
}
__device__ __forceinline__ void xcd_barrier(const XcdBarrier& b, const int tid0) {
    asm volatile("s_waitcnt vmcnt(0)" ::: "memory");
    __syncthreads();
    if (tid0 == 0) {
        unsigned* bar = b.bar;
        __builtin_amdgcn_s_waitcnt(0);
        unsigned nloc = b.st[0], nx = b.st[1];
        if (nloc == 0u) { xcd_barrier_complete(bar, b.x, nloc, nx); b.st[0] = nloc; b.st[1] = nx; }
        const unsigned old = xb_add(&bar[XB_XSUB(b.x)], 1u);
        const unsigned gen = old / nloc;
        if (old + 1u == (gen + 1u) * nloc) {
            __builtin_amdgcn_fence(__ATOMIC_RELEASE, "agent");
            asm volatile("s_waitcnt vmcnt(0)" ::: "memory");
            const unsigned og = xb_add(&bar[XB_TOP], 1u);
            const unsigned tg = og / nx;
            if (og + 1u == (tg + 1u) * nx) xb_add(&bar[XB_TOPGEN], 1u);
            else XB_SPIN(xb_ld(&bar[XB_TOPGEN]) == tg, bar);
            __builtin_amdgcn_fence(__ATOMIC_ACQUIRE, "agent");
            xb_add(&bar[XB_XGEN(b.x)], 1u);
            asm volatile("s_waitcnt vmcnt(0)" ::: "memory");
        } else {
            XB_SPIN(xb_ld(&bar[XB_XGEN(b.x)]) == gen, bar);
            __builtin_amdgcn_fence(__ATOMIC_ACQUIRE, "agent");
            asm volatile("s_waitcnt vmcnt(0)" ::: "memory");
        }
    }
    __syncthreads();
}

__device__ __forceinline__ float shfl_xor_(float v, int mask, int ln) { return __builtin_bit_cast(float, __builtin_amdgcn_ds_bpermute((ln ^ mask) << 2, __builtin_bit_cast(int, v))); }
__device__ __forceinline__ float wave_sum(float v, int ln) {
    v += __builtin_bit_cast(float, __builtin_amdgcn_update_dpp(0, __builtin_bit_cast(int, v), 0x128, 0xf, 0xf, false));
    v += __builtin_bit_cast(float, __builtin_amdgcn_update_dpp(0, __builtin_bit_cast(int, v), 0x124, 0xf, 0xf, false));
    v += __builtin_bit_cast(float, __builtin_amdgcn_update_dpp(0, __builtin_bit_cast(int, v), 0x122, 0xf, 0xf, false));
    v += __builtin_bit_cast(float, __builtin_amdgcn_update_dpp(0, __builtin_bit_cast(int, v), 0x121, 0xf, 0xf, false));
    v += shfl_xor_(v, 16, ln); v += shfl_xor_(v, 32, ln);
    return v;
}
__device__ __forceinline__ float sigmoidf_(float x) { return 1.0f / (1.0f + expf(-x)); }

namespace pg8 {
#define PG8_LAS __attribute__((address_space(3)))
typedef unsigned short bf16_t;
typedef short bf16x8 __attribute__((ext_vector_type(8)));
typedef float f32x4 __attribute__((ext_vector_type(4)));
typedef unsigned u32x4 __attribute__((ext_vector_type(4)));
constexpr int BM = 256, BK = 64, HALF = 128, HTB = HALF * BK * 2  , STAGE_BYTES = 8 * HTB, NXCD = 8, WGM = 8;

__host__ __device__ __forceinline__ int lds_byte(int r, int c) { const int st = (r >> 4) * 2 + (c >> 5), rr = r & 15, cc = c & 31, ob = rr * 64 + cc * 2; return st * 1024 + (ob ^ (((ob >> 9) & 1) << 5)); }
__host__ __device__ __forceinline__ void stage_rc(int b, int& R, int& C) { const int st = b / 1024, sb = b % 1024, swz = sb ^ (((sb >> 9) & 1) << 5); R = (st >> 1) * 16 + swz / 64; C = (st & 1) * 32 + (swz % 64) / 2; }
__host__ __device__ __forceinline__ int perm32(int rho) { const int n = rho >> 4, i = rho & 15; return 8 * (i >> 2) + 4 * n + (i & 3); }

struct Unit { int pm, pn; int ko = 0; };
struct Gemm { const bf16_t* A; const bf16_t* Bt; int M, N, K; int ld = 0; };

struct StaticOrder {
    int nM, nN, nwg, G, c;
    __host__ __device__ void init(int M, int N, int G_, int c_) { nM = M / BM; nN = N / BM; nwg = nM * nN; G = G_; c = c_; }
    __host__ __device__ bool next(int i, Unit& u) const {
        const long L = (long)i * G + c; if (L >= nwg) return false;
        int wgid = (int)L; { const int q = nwg / NXCD, r = nwg % NXCD, xcd = wgid % NXCD, off = wgid / NXCD; wgid = (xcd < r ? xcd * (q + 1) : r * (q + 1) + (xcd - r) * q) + off; }
        const int nig = WGM * nN, gid = wgid / nig, fm = gid * WGM, gsz = (nM - fm) < WGM ? (nM - fm) : WGM;
        u.pm = fm + ((wgid % nig) % gsz); u.pn = (wgid % nig) / gsz; return true;
    }
    __device__ __forceinline__ void a_ready(const Unit&) const {}
    __device__ __forceinline__ void done(const Unit&) const {}
};
__device__ __forceinline__ unsigned cvt_pk_bf16(float lo, float hi) { unsigned r; asm volatile("v_cvt_pk_bf16_f32 %0, %1, %2" : "=v"(r) : "v"(lo), "v"(hi)); return r; }
typedef float f32x2 __attribute__((ext_vector_type(2)));
template <class Epi, class Sched, bool STAMP = false>
__device__ __forceinline__ void gemm_phase(PG8_LAS unsigned char* lds, const Gemm g, const Sched& S, const Epi& E, unsigned long long* stamps, const int tid) {
    const int wid = __builtin_amdgcn_readfirstlane(tid >> 6), lane = tid & 63, wr = wid >> 2, wc = wid & 3, fr = lane & 15, fq = lane >> 4;
    const int K = g.K, nt = K / BK, LD = g.ld ? g.ld : g.K;
    int ts_lo = 0, ts_hi = 0, nts = 0; const unsigned long long rt_entry = STAMP ? (unsigned long long)wall_clock64() : 0ull;
#define PG8_STAMP() do { if (STAMP && wid == 0 && nts < 64) { const unsigned long long _c = (unsigned long long)clock64(); \
        ts_lo = (lane == nts) ? (int)(unsigned)_c : ts_lo; ts_hi = (lane == nts) ? (int)(unsigned)(_c >> 32) : ts_hi; ++nts; } } while (0)
    PG8_STAMP();
    unsigned voffA[2], voffB[2];
#pragma unroll
    for (int i = 0; i < 2; ++i) { int R, C; stage_rc(tid * 16 + i * 8192, R, C); const int Rb = Epi::PERM ? ((R & ~31) + perm32(R & 31)) : R;
        voffA[i] = (unsigned)(R * LD + C) * 2u; voffB[i] = (unsigned)(Rb * LD + C) * 2u; }
    const size_t kstep = (size_t)(BK * 2);
    const size_t hstep = (size_t)HALF * LD * 2;
    const size_t tstep = 2 * hstep;
    const unsigned ldsw = (unsigned)wid * 1024u;
    const int aoff = lds_byte(wr * 64 + fr, fq * 8), boff = lds_byte(wc * 32 + fr, fq * 8);
#define PG8_SA(b, h) (((b) * 2 + (h)) * HTB)
#define PG8_SB(b, h) ((4 + (b) * 2 + (h)) * HTB)
#define PG8_STAGE(bufoff, gbase, voff) do { _Pragma("unroll") for (int _i = 0; _i < 2; ++_i) \
        __builtin_amdgcn_global_load_lds((const unsigned*)((const char*)(gbase) + (voff)[_i]), (PG8_LAS unsigned*)(lds + (bufoff) + ldsw + _i * 8192), 16, 0, 0); } while (0)
#define PG8_LDA(dst, b, h) do { _Pragma("unroll") for (int m = 0; m < 4; ++m) _Pragma("unroll") for (int k = 0; k < 2; ++k) dst[m][k] = *(const PG8_LAS bf16x8*)(lds + PG8_SA(b, h) + aoff + m * 2048 + k * 1024); } while (0)
#define PG8_LDB(dst, b, h) do { _Pragma("unroll") for (int n = 0; n < 2; ++n) _Pragma("unroll") for (int k = 0; k < 2; ++k) dst[n][k] = *(const PG8_LAS bf16x8*)(lds + PG8_SB(b, h) + boff + n * 2048 + k * 1024); } while (0)
#define PG8_MMA(ai, bj, At, Bt) do { __builtin_amdgcn_s_setprio(1); _Pragma("unroll") for (int m = 0; m < 4; ++m) _Pragma("unroll") for (int n = 0; n < 2; ++n) _Pragma("unroll") for (int k = 0; k < 2; ++k) \
        acc[ai][bj][m][n] = __builtin_amdgcn_mfma_f32_16x16x32_bf16(Bt[n][k], At[m][k], acc[ai][bj][m][n], 0, 0, 0); __builtin_amdgcn_s_setprio(0); } while (0)
#define PG8_WAIT_V(n) asm volatile("s_waitcnt vmcnt(" #n ")" ::: "memory")
#define PG8_WAIT_L(n) asm volatile("s_waitcnt lgkmcnt(" #n ")" ::: "memory")
#define PG8_BAR __builtin_amdgcn_s_barrier()
#define PG8_SCHED __builtin_amdgcn_sched_barrier(0)
    Unit cur, nxt; int ui = 0;
    if (!S.next(0, cur)) return;
    f32x4 acc[2][2][4][2];
#pragma unroll
    for (int a = 0; a < 2; ++a)
#pragma unroll
        for (int b = 0; b < 2; ++b)
#pragma unroll
            for (int m = 0; m < 4; ++m)
#pragma unroll
                for (int n = 0; n < 2; ++n) acc[a][b][m][n] = (f32x4){0.f, 0.f, 0.f, 0.f};
    bf16x8 At[4][2], B0[2][2], B1[2][2];
    {
        const bf16x8 z8 = {0, 0, 0, 0, 0, 0, 0, 0};
#pragma unroll
        for (int m = 0; m < 4; ++m) { At[m][0] = z8; At[m][1] = z8; }
#pragma unroll
        for (int n = 0; n < 2; ++n) { B0[n][0] = z8; B0[n][1] = z8; B1[n][0] = z8; B1[n][1] = z8; }
    }
    const char* cA = (const char*)g.A + (size_t)cur.pm * tstep + cur.ko; const char* cB = (const char*)g.Bt + (size_t)cur.pn * tstep + cur.ko;
    S.a_ready(cur);
    PG8_STAGE(PG8_SB(0, 0), cB, voffB); PG8_STAGE(PG8_SA(0, 0), cA, voffA); PG8_STAGE(PG8_SB(0, 1), cB + hstep, voffB); PG8_STAGE(PG8_SA(0, 1), cA + hstep, voffA);
    if (wr == 1) PG8_BAR;
    PG8_WAIT_V(4); PG8_BAR;
    PG8_STAGE(PG8_SB(1, 0), cB + kstep, voffB); PG8_STAGE(PG8_SA(1, 0), cA + kstep, voffA); PG8_STAGE(PG8_SB(1, 1), cB + hstep + kstep, voffB);
    PG8_WAIT_V(6); PG8_BAR;
    PG8_STAMP();
    for (;;) {
        const bool has_next = S.next(ui + 1, nxt);
        const char* nA = has_next ? (const char*)g.A + (size_t)nxt.pm * tstep + nxt.ko : cA; const char* nB = has_next ? (const char*)g.Bt + (size_t)nxt.pn * tstep + nxt.ko : cB;
        for (int t = 0; t < nt; t += 2) {
            if constexpr (Epi::HAS_MID) { if (t == 16 || t == 32) E.mid(acc, cur, wr, wc, fr, fq, t); }
            const bool last = (t == nt - 2);
            const char* a1 = cA + (size_t)(t + 1) * kstep;
            const char* a2 = last ? nA : cA + (size_t)(t + 2) * kstep; const char* b2 = last ? nB : cB + (size_t)(t + 2) * kstep;
            const char* a3 = a2 + kstep; const char* b3 = b2 + kstep;
            if (last && has_next) S.a_ready(nxt);
            PG8_LDB(B0, 0, 0); PG8_SCHED; PG8_LDA(At, 0, 0); PG8_STAGE(PG8_SA(1, 1), a1 + hstep, voffA);
            PG8_WAIT_L(8); PG8_BAR; PG8_WAIT_L(0); PG8_MMA(0, 0, At, B0); PG8_BAR; PG8_SCHED;
            PG8_LDB(B1, 0, 1); PG8_STAGE(PG8_SB(0, 0), b2, voffB);
            PG8_BAR; PG8_WAIT_L(0); PG8_MMA(0, 1, At, B1); PG8_BAR;
            PG8_LDA(At, 0, 1); PG8_STAGE(PG8_SA(0, 0), a2, voffA);
            PG8_BAR; PG8_WAIT_L(0); PG8_MMA(1, 0, At, B0); PG8_BAR; PG8_SCHED;
            PG8_STAGE(PG8_SB(0, 1), b2 + hstep, voffB);
            PG8_WAIT_V(6); PG8_BAR; PG8_MMA(1, 1, At, B1); PG8_BAR;
            PG8_LDB(B0, 1, 0); PG8_SCHED; PG8_LDA(At, 1, 0); PG8_STAGE(PG8_SA(0, 1), a2 + hstep, voffA);
            PG8_WAIT_L(8); PG8_BAR; PG8_WAIT_L(0); PG8_MMA(0, 0, At, B0); PG8_BAR; PG8_SCHED;
            PG8_LDB(B1, 1, 1); PG8_STAGE(PG8_SB(1, 0), b3, voffB);
            PG8_BAR; PG8_WAIT_L(0); PG8_MMA(0, 1, At, B1); PG8_BAR;
            PG8_LDA(At, 1, 1); PG8_STAGE(PG8_SA(1, 0), a3, voffA);
            PG8_BAR; PG8_WAIT_L(0); PG8_MMA(1, 0, At, B0); PG8_BAR; PG8_SCHED;
            PG8_STAGE(PG8_SB(1, 1), b3 + hstep, voffB);
            PG8_WAIT_V(6); PG8_BAR; PG8_MMA(1, 1, At, B1); PG8_BAR;
        }
        PG8_STAMP();
        if constexpr (!Epi::AFTER_DRAIN) { if constexpr (Epi::STAGED) E.staged(acc, cur, wr, wc, fr, fq, lds + STAGE_BYTES, wid, lane); else E(acc, cur, wr, wc, fr, fq); S.done(cur); }
        PG8_STAMP();
        if (!has_next) break;
#pragma unroll
        for (int a = 0; a < 2; ++a)
#pragma unroll
            for (int b = 0; b < 2; ++b)
#pragma unroll
                for (int m = 0; m < 4; ++m)
#pragma unroll
                    for (int n = 0; n < 2; ++n) acc[a][b][m][n] = (f32x4){0.f, 0.f, 0.f, 0.f};
        cur = nxt; cA = nA; cB = nB; ++ui;
    }
    PG8_WAIT_V(0);
    if (wr == 0) PG8_BAR;
    PG8_BAR;
    if constexpr (Epi::AFTER_DRAIN) { E.fused(acc, cur, wr, wc, fr, fq, lds, wid, lane); S.done(cur); }
    PG8_STAMP();
    if (STAMP && wid == 0) { stamps[lane] = lane < nts ? (((unsigned long long)(unsigned)ts_hi << 32) | (unsigned)ts_lo) : 0ull;
        if (lane == 62) stamps[62] = rt_entry; if (lane == 63) stamps[63] = (unsigned long long)wall_clock64(); }
#undef PG8_STAMP
#undef PG8_SA
#undef PG8_SB
#undef PG8_STAGE
#undef PG8_LDA
#undef PG8_LDB
#undef PG8_MMA
#undef PG8_WAIT_V
#undef PG8_WAIT_L
#undef PG8_BAR
#undef PG8_SCHED
}
}


typedef unsigned short bf16;
typedef unsigned v4u __attribute__((ext_vector_type(4)));
typedef unsigned v2u __attribute__((ext_vector_type(2)));
__device__ __forceinline__ unsigned f2bf(float f) { unsigned u = __builtin_bit_cast(unsigned, f); return (u + 0x7fffu + ((u >> 16) & 1u)) >> 16; }
typedef __bf16 bf16x2_t __attribute__((ext_vector_type(2)));
__device__ __forceinline__ unsigned pk2(float lo, float hi) { bf16x2_t v; v[0] = (__bf16)lo; v[1] = (__bf16)hi; return __builtin_bit_cast(unsigned, v); }
__device__ __forceinline__ float row_allsum16(float x) {
    x += __builtin_bit_cast(float, __builtin_amdgcn_update_dpp(0, __builtin_bit_cast(int, x), 0x128, 0xf, 0xf, false));
    x += __builtin_bit_cast(float, __builtin_amdgcn_update_dpp(0, __builtin_bit_cast(int, x), 0x124, 0xf, 0xf, false));
    x += __builtin_bit_cast(float, __builtin_amdgcn_update_dpp(0, __builtin_bit_cast(int, x), 0x122, 0xf, 0xf, false));
    x += __builtin_bit_cast(float, __builtin_amdgcn_update_dpp(0, __builtin_bit_cast(int, x), 0x121, 0xf, 0xf, false));
    return x;
}
__device__ __forceinline__ float fsigmoid(float x) { return __builtin_amdgcn_rcpf(1.0f + __expf(-x)); }
__device__ __forceinline__ void transpose_item(const float* p, int ldw, bf16* WT, int K, int dst_row0, int k0, LAS float* scr, int ln) {
    if (p) {
        float tv[32];
#pragma unroll
        for (int i = 0; i < 32; ++i) tv[i] = p[(size_t)(k0 + 2 * i + (ln >> 5)) * ldw];
#pragma unroll
        for (int i = 0; i < 32; ++i) scr[(2 * i + (ln >> 5)) * 33 + (ln & 31)] = tv[i];
    } else {
#pragma unroll 8
        for (int i = 0; i < 32; ++i) { const int kk = 2 * i + (ln >> 5); scr[kk * 33 + (ln & 31)] = 0.f; }
    }
    asm volatile("s_waitcnt lgkmcnt(0)" ::: "memory");
    const int c = ln & 7;
#pragma unroll
    for (int j = 0; j < 4; ++j) { const int n = (ln >> 3) + 8 * j; const LAS float* s = scr + (8 * c) * 33 + n;
        v4u o; o.x = pk2(s[0 * 33], s[1 * 33]); o.y = pk2(s[2 * 33], s[3 * 33]); o.z = pk2(s[4 * 33], s[5 * 33]); o.w = pk2(s[6 * 33], s[7 * 33]);
        *(v4u*)(WT + (size_t)(dst_row0 + n) * K + k0 + 8 * c) = o; }
    asm volatile("s_waitcnt lgkmcnt(0)" ::: "memory");
}
struct TI { const float* p; bf16* wt; int ldw, K, r0, k0; bool zero; };
__device__ __forceinline__ void ti_load(const TI& t, float (&tv)[32], int ln) {
#pragma unroll
    for (int i = 0; i < 32; ++i) tv[i] = t.p[(size_t)(t.k0 + 2 * i + (ln >> 5)) * t.ldw];
}
__device__ __forceinline__ void ti_finish(const TI& t, const float (&tv)[32], LAS float* scr, int ln) {
#pragma unroll
    for (int i = 0; i < 32; ++i) scr[(2 * i + (ln >> 5)) * 33 + (ln & 31)] = t.zero ? 0.f : tv[i];
    asm volatile("s_waitcnt lgkmcnt(0)" ::: "memory");
    const int c = ln & 7;
#pragma unroll
    for (int j = 0; j < 4; ++j) { const int n = (ln >> 3) + 8 * j; const LAS float* s = scr + (8 * c) * 33 + n;
        v4u o; o.x = pk2(s[0 * 33], s[1 * 33]); o.y = pk2(s[2 * 33], s[3 * 33]); o.z = pk2(s[4 * 33], s[5 * 33]); o.w = pk2(s[6 * 33], s[7 * 33]);
        *(v4u*)(t.wt + (size_t)(t.r0 + n) * t.K + t.k0 + 8 * c) = o; }
    asm volatile("s_waitcnt lgkmcnt(0)" ::: "memory");
}
__device__ __forceinline__ f32x4 bf4_to_f32(const v2u w) { f32x4 r; r[0] = __builtin_bit_cast(float, w.x << 16); r[1] = __builtin_bit_cast(float, w.x & 0xffff0000u);
    r[2] = __builtin_bit_cast(float, w.y << 16); r[3] = __builtin_bit_cast(float, w.y & 0xffff0000u); return r; }
constexpr int STG_RS = 528;
#define EBAR() do { asm volatile("s_waitcnt lgkmcnt(0)" ::: "memory"); __builtin_amdgcn_s_barrier(); asm volatile("" ::: "memory"); } while (0)
#define EPI_ENTER(wr_) do { if ((wr_) == 0) __builtin_amdgcn_s_barrier(); } while (0)
#define EPI_LEAVE(wr_) do { if ((wr_) == 1) __builtin_amdgcn_s_barrier(); } while (0)
#define STG_READBACK512(ai_, m_, BODY) do { int ln_ = lane; asm volatile("" : "+v"(ln_)); _Pragma("unroll") for (int h_ = 0; h_ < 2; ++h_) { const int lr_ = 4 * wid + 2 * h_ + (ln_ >> 5), cb_ = (ln_ & 31) * 16; \
        const v4u sv_ = *(const LAS v4u*)(stg + lr_ * STG_RS + cb_); const int trow_ = 128 * (ai_) + 64 * (lr_ >> 4) + 16 * (m_) + (lr_ & 15); BODY } } while (0)

struct EpiSwigluBf16 {
    static constexpr bool PERM = true, AFTER_DRAIN = false, HAS_MID = false, STAGED = true;
    bf16* H; int nN;
    __device__ __forceinline__ void staged(const f32x4 (&acc)[2][2][4][2], const pg8::Unit& u, int wr, int wc, int fr, int fq, LAS unsigned char* stg, int wid, int lane) const {
        const int pnl = u.pn % nN, lrw = 16 * wr + fr;
        bf16* dst = H + (size_t)u.pm * 256 * DFF + 128 * pnl;
        EPI_ENTER(wr);
#pragma unroll
        for (int ai = 0; ai < 2; ++ai)
#pragma unroll
            for (int m = 0; m < 4; ++m) {
#pragma unroll
                for (int bj = 0; bj < 2; ++bj) {
                    const f32x4 g = acc[ai][bj][m][0], uu = acc[ai][bj][m][1]; float h[4];
#pragma unroll
                    for (int j = 0; j < 4; ++j) h[j] = g[j] * fsigmoid(g[j]) * uu[j];
                    v2u o; o.x = pk2(h[0], h[1]); o.y = pk2(h[2], h[3]);
                    *(LAS v2u*)(stg + lrw * 272 + (64 * bj + 16 * wc + 4 * fq) * 2) = o;
                }
                EBAR();
                {
                    int ln_ = lane; asm volatile("" : "+v"(ln_));
                    const int lr = 4 * wid + (ln_ >> 4), cb = (ln_ & 15) * 16;
                    const v4u sv = *(const LAS v4u*)(stg + lr * 272 + cb);
                    const int trow = 128 * ai + 64 * (lr >> 4) + 16 * m + (lr & 15);
                    *(v4u*)(dst + (size_t)trow * DFF + (ln_ & 15) * 8) = sv;
                }
                EBAR();
            }
        EPI_LEAVE(wr);
    }
};
struct EpiResidF32 {
    static constexpr bool PERM = true, AFTER_DRAIN = false, HAS_MID = false, STAGED = true;
    float* C; const float* R;
    __device__ __forceinline__ void staged(const f32x4 (&acc)[2][2][4][2], const pg8::Unit& u, int wr, int wc, int fr, int fq, LAS unsigned char* stg, int wid, int lane) const {
        const int lrw = 16 * wr + fr; const size_t t0 = (size_t)u.pm * 256 * D + (size_t)u.pn * 256;
        EPI_ENTER(wr);
#pragma unroll
        for (int ai = 0; ai < 2; ++ai)
#pragma unroll
            for (int m = 0; m < 4; ++m)
#pragma unroll
                for (int bj = 0; bj < 2; ++bj) {
                    *(LAS f32x4*)(stg + lrw * STG_RS + (wc * 32 + 8 * fq) * 4) = acc[ai][bj][m][0];
                    *(LAS f32x4*)(stg + lrw * STG_RS + (wc * 32 + 8 * fq) * 4 + 16) = acc[ai][bj][m][1];
                    EBAR();
                    STG_READBACK512(ai, m, { const size_t o_ = t0 + (size_t)trow_ * D + bj * 128 + (ln_ & 31) * 4;
                        const f32x4 r_ = *(const f32x4*)(R + o_); *(f32x4*)(C + o_) = ALPHA * r_ + __builtin_bit_cast(f32x4, sv_); });
                    EBAR();
                }
        EPI_LEAVE(wr);
    }
};
struct EpiStoreF32 {
    static constexpr bool PERM = true, AFTER_DRAIN = false, HAS_MID = false, STAGED = true;
    float* C; int nN;
    __device__ __forceinline__ void staged(const f32x4 (&acc)[2][2][4][2], const pg8::Unit& u, int wr, int wc, int fr, int fq, LAS unsigned char* stg, int wid, int lane) const {
        const int lrw = 16 * wr + fr; const size_t t0 = (size_t)u.pm * 256 * D + (size_t)(u.pn % nN) * 256;
        EPI_ENTER(wr);
#pragma unroll
        for (int ai = 0; ai < 2; ++ai)
#pragma unroll
            for (int m = 0; m < 4; ++m)
#pragma unroll
                for (int bj = 0; bj < 2; ++bj) {
                    *(LAS f32x4*)(stg + lrw * STG_RS + (wc * 32 + 8 * fq) * 4) = acc[ai][bj][m][0];
                    *(LAS f32x4*)(stg + lrw * STG_RS + (wc * 32 + 8 * fq) * 4 + 16) = acc[ai][bj][m][1];
                    EBAR();
                    STG_READBACK512(ai, m, { *(v4u*)(C + t0 + (size_t)trow_ * D + bj * 128 + (ln_ & 31) * 4) = sv_; });
                    EBAR();
                }
        EPI_LEAVE(wr);
    }
};
template <int MODE> struct EpiBranch {
    static constexpr bool PERM = true, AFTER_DRAIN = false, HAS_MID = false, STAGED = false;
    float* MIXp; bf16* MIXBp; const float* gate;
    __device__ __forceinline__ void operator()(const f32x4 (&acc)[2][2][4][2], const pg8::Unit& u, int wr, int wc, int fr, int fq) const {
        const int row0 = u.pm * 256 + wr * 64 + fr, col0 = u.pn * 256 + wc * 32 + 8 * fq;
#pragma unroll
        for (int ai = 0; ai < 2; ++ai)
#pragma unroll
            for (int m = 0; m < 4; ++m)
#pragma unroll
                for (int bj = 0; bj < 2; ++bj) {
                    const int row = row0 + ai * 128 + m * 16, col = col0 + bj * 128; const size_t o = (size_t)row * D + col;
                    const f32x4 g0 = *(const f32x4*)(gate + (size_t)row * IN_COLS + col), g1 = *(const f32x4*)(gate + (size_t)row * IN_COLS + col + 4);
                    f32x4 r0, r1;
#pragma unroll
                    for (int j = 0; j < 4; ++j) { r0[j] = fsigmoid(g0[j]) * acc[ai][bj][m][0][j]; r1[j] = fsigmoid(g1[j]) * acc[ai][bj][m][1][j]; }
                    if (MODE >= 1) { r0 += *(const f32x4*)(MIXp + o); r1 += *(const f32x4*)(MIXp + o + 4); }
                    if (MODE <= 1) { *(f32x4*)(MIXp + o) = r0; *(f32x4*)(MIXp + o + 4) = r1; }
                    else { v4u w; w.x = pk2(r0[0], r0[1]); w.y = pk2(r0[2], r0[3]); w.z = pk2(r1[0], r1[1]); w.w = pk2(r1[2], r1[3]); *(v4u*)(MIXBp + o) = w; }
                }
    }
};

struct EpiLora {
    static constexpr bool PERM = true, AFTER_DRAIN = false, HAS_MID = false, STAGED = false;
    float* DECp; bf16* AAp; bf16* GGp; float* Vp; const float* VFp; const float* w0; const float* a0; const float* v0;
    __device__ __forceinline__ void operator()(const f32x4 (&acc)[2][2][4][2], const pg8::Unit& u, int wr, int wc, int fr, int fq) const {
        const int row0 = u.pm * 256 + wr * 64 + fr, seg = __builtin_amdgcn_readfirstlane(u.pn >> 2), col0 = (u.pn & 3) * 256 + wc * 32 + 8 * fq;
        if (seg == 0) {
#pragma unroll
            for (int bj = 0; bj < 2; ++bj) { const int col = col0 + bj * 128; const f32x4 b0 = *(const f32x4*)(w0 + col), b1 = *(const f32x4*)(w0 + col + 4);
#pragma unroll
                for (int ai = 0; ai < 2; ++ai)
#pragma unroll
                    for (int m = 0; m < 4; ++m) { const size_t o = (size_t)(row0 + ai * 128 + m * 16) * BW + col;
                        f32x4 x0 = acc[ai][bj][m][0] + b0, x1 = acc[ai][bj][m][1] + b1;
#pragma unroll
                        for (int j = 0; j < 4; ++j) { const float z0 = -x0[j], z1 = -x1[j];
                            const float sp0 = z0 > 20.f ? z0 : __logf(1.0f + __expf(z0)), sp1 = z1 > 20.f ? z1 : __logf(1.0f + __expf(z1));
                            x0[j] = __expf(-__expf(-sp0 - 0.5f)); x1[j] = __expf(-__expf(-sp1 - 0.5f)); }
                        *(f32x4*)(DECp + o) = x0; *(f32x4*)(DECp + o + 4) = x1; } }
        } else if (seg == 1) {
#pragma unroll
            for (int bj = 0; bj < 2; ++bj) { const int col = col0 + bj * 128; const f32x4 b0 = *(const f32x4*)(a0 + col), b1 = *(const f32x4*)(a0 + col + 4);
#pragma unroll
                for (int ai = 0; ai < 2; ++ai)
#pragma unroll
                    for (int m = 0; m < 4; ++m) { const size_t o = (size_t)(row0 + ai * 128 + m * 16) * BW + col;
                        f32x4 x0 = acc[ai][bj][m][0] + b0, x1 = acc[ai][bj][m][1] + b1;
#pragma unroll
                        for (int j = 0; j < 4; ++j) { x0[j] = fsigmoid(x0[j]); x1[j] = fsigmoid(x1[j]); }
                        v4u w; w.x = pk2(x0[0], x0[1]); w.y = pk2(x0[2], x0[3]); w.z = pk2(x1[0], x1[1]); w.w = pk2(x1[2], x1[3]); *(v4u*)(AAp + o) = w; } }
        } else if (seg == 2) {
#pragma unroll
            for (int bj = 0; bj < 2; ++bj) { const int col = col0 + bj * 128;
#pragma unroll
                for (int ai = 0; ai < 2; ++ai)
#pragma unroll
                    for (int m = 0; m < 4; ++m) { const size_t o = (size_t)(row0 + ai * 128 + m * 16) * BW + col;
                        const f32x4 x0 = acc[ai][bj][m][0], x1 = acc[ai][bj][m][1];
                        v4u w; w.x = pk2(x0[0], x0[1]); w.y = pk2(x0[2], x0[3]); w.z = pk2(x1[0], x1[1]); w.w = pk2(x1[2], x1[3]); *(v4u*)(GGp + o) = w; } }
        } else {
#pragma unroll
            for (int bj = 0; bj < 2; ++bj) { const int col = col0 + bj * 128; const f32x4 b0 = *(const f32x4*)(v0 + col), b1 = *(const f32x4*)(v0 + col + 4);
#pragma unroll
                for (int ai = 0; ai < 2; ++ai)
#pragma unroll
                    for (int m = 0; m < 4; ++m) { const size_t o = (size_t)(row0 + ai * 128 + m * 16) * BW + col;
                        f32x4 x0 = acc[ai][bj][m][0] + b0, x1 = acc[ai][bj][m][1] + b1;
                        const f32x4 v0_ = *(const f32x4*)(Vp + o), v1_ = *(const f32x4*)(Vp + o + 4), f0 = *(const f32x4*)(VFp + o), f1 = *(const f32x4*)(VFp + o + 4);
#pragma unroll
                        for (int j = 0; j < 4; ++j) { x0[j] = v0_[j] + (f0[j] - v0_[j]) * fsigmoid(x0[j]); x1[j] = v1_[j] + (f1[j] - v1_[j]) * fsigmoid(x1[j]); }
                        *(f32x4*)(Vp + o) = x0; *(f32x4*)(Vp + o + 4) = x1;
                        asm volatile("" ::: "memory"); } }
        }
    }
};
struct EpiMlaQ {
    static constexpr bool PERM = true, AFTER_DRAIN = false, HAS_MID = false, STAGED = false;
    bf16* QCBp; const float* COSMp; const float* SINMp;
    __device__ __forceinline__ void operator()(const f32x4 (&acc)[2][2][4][2], const pg8::Unit& u, int wr, int wc, int fr, int fq) const {
        const int row0 = u.pm * 256 + wr * 64 + fr;
#pragma unroll
        for (int bj = 0; bj < 2; ++bj) {
            const int c = u.pn * 256 + bj * 128 + wc * 32 + 8 * fq, h = c / 192, cc = c - h * 192;
#pragma unroll
            for (int ai = 0; ai < 2; ++ai)
#pragma unroll
                for (int m = 0; m < 4; ++m) {
                    const int row = row0 + ai * 128 + m * 16; const f32x4 x1 = acc[ai][bj][m][0], x2 = acc[ai][bj][m][1];
                    bf16* dst = QCBp + (size_t)row * 1536 + h * 192;
                    if (cc < 128) { v4u w; w.x = pk2(x1[0], x1[1]); w.y = pk2(x1[2], x1[3]); w.z = pk2(x2[0], x2[1]); w.w = pk2(x2[2], x2[3]); *(v4u*)(dst + cc) = w; }
                    else { const int j0 = 4 * ((cc - 128) >> 3), s = row & (SEQ - 1);
                        const f32x4 cs = *(const f32x4*)(COSMp + s * 32 + j0), sn = *(const f32x4*)(SINMp + s * 32 + j0);
                        const f32x4 o1 = x1 * cs - x2 * sn, o2 = x2 * cs + x1 * sn;
                        v2u a; a.x = pk2(o1[0], o1[1]); a.y = pk2(o1[2], o1[3]); v2u b; b.x = pk2(o2[0], o2[1]); b.y = pk2(o2[2], o2[3]);
                        *(v2u*)(dst + 128 + j0) = a; *(v2u*)(dst + 160 + j0) = b; }
                }
        }
    }
};
struct EpiMlaKV {
    static constexpr bool PERM = true, AFTER_DRAIN = false, HAS_MID = false, STAGED = false;
    bf16* KCBp; bf16* VCBp;
    __device__ __forceinline__ void operator()(const f32x4 (&acc)[2][2][4][2], const pg8::Unit& u, int wr, int wc, int fr, int fq) const {
        const int row0 = u.pm * 256 + wr * 64 + fr;
#pragma unroll
        for (int bj = 0; bj < 2; ++bj) {
            const int c = u.pn * 256 + bj * 128 + wc * 32 + 8 * fq, h = c >> 8, cc = c & 255;
#pragma unroll
            for (int ai = 0; ai < 2; ++ai)
#pragma unroll
                for (int m = 0; m < 4; ++m) {
                    const int row = row0 + ai * 128 + m * 16; const f32x4 x1 = acc[ai][bj][m][0], x2 = acc[ai][bj][m][1];
                    v4u w; w.x = pk2(x1[0], x1[1]); w.y = pk2(x1[2], x1[3]); w.z = pk2(x2[0], x2[1]); w.w = pk2(x2[2], x2[3]);
                    if (cc < 128) *(v4u*)(KCBp + (size_t)row * 1536 + h * 192 + cc) = w;
                    else *(v4u*)(VCBp + (size_t)row * BW + h * 128 + (cc - 128)) = w;
                }
        }
    }
};

struct EpiBranch3 {
    static constexpr bool PERM = true, AFTER_DRAIN = false, HAS_MID = true, STAGED = false;
    bf16* MIXBp; const bf16* G;
    __device__ __forceinline__ void mid(f32x4 (&acc)[2][2][4][2], const pg8::Unit& u, int wr, int wc, int fr, int fq, int t) const {
        int row0 = u.pm * 256 + wr * 64 + fr, col0 = u.pn * 256 + wc * 32 + 8 * fq; const int seg = t >> 4;
        asm volatile("" : "+v"(row0), "+v"(col0));
#pragma unroll
        for (int ai = 0; ai < 2; ++ai)
#pragma unroll
            for (int m = 0; m < 4; ++m)
#pragma unroll
                for (int bj = 0; bj < 2; ++bj) {
                    const bf16* gp = G + (size_t)(row0 + ai * 128 + m * 16) * (3 * D) + (seg - 1) * D + col0 + bj * 128;
                    const v4u a = *(const v4u*)gp, b = *(const v4u*)(gp + D);
                    const unsigned aw[4] = {a.x, a.y, a.z, a.w}, bw[4] = {b.x, b.y, b.z, b.w};
#pragma unroll
                    for (int j = 0; j < 4; ++j) {
                        const float r0 = __uint_as_float(aw[j] << 16) * __builtin_amdgcn_rcpf(__uint_as_float(bw[j] << 16));
                        const float r1 = __uint_as_float(aw[j] & 0xffff0000u) * __builtin_amdgcn_rcpf(__uint_as_float(bw[j] & 0xffff0000u));
                        acc[ai][bj][m][j >> 1][(j & 1) * 2] *= r0; acc[ai][bj][m][j >> 1][(j & 1) * 2 + 1] *= r1;
                    }
                    asm volatile("" : "+v"(acc[ai][bj][m][0]), "+v"(acc[ai][bj][m][1]) :: "memory");
                }
    }
    __device__ __forceinline__ void operator()(const f32x4 (&acc)[2][2][4][2], const pg8::Unit& u, int wr, int wc, int fr, int fq) const {
        const int row0 = u.pm * 256 + wr * 64 + fr, col0 = u.pn * 256 + wc * 32 + 8 * fq;
#pragma unroll
        for (int ai = 0; ai < 2; ++ai)
#pragma unroll
            for (int m = 0; m < 4; ++m)
#pragma unroll
                for (int bj = 0; bj < 2; ++bj) {
                    const int row = row0 + ai * 128 + m * 16, col = col0 + bj * 128;
                    const v4u a = *(const v4u*)(G + (size_t)row * (3 * D) + 2 * D + col);
                    const unsigned aw[4] = {a.x, a.y, a.z, a.w}; float r[8];
#pragma unroll
                    for (int j = 0; j < 4; ++j) { r[2 * j] = acc[ai][bj][m][j >> 1][(j & 1) * 2] * __uint_as_float(aw[j] << 16);
                                                  r[2 * j + 1] = acc[ai][bj][m][j >> 1][(j & 1) * 2 + 1] * __uint_as_float(aw[j] & 0xffff0000u); }
                    v4u w; w.x = pk2(r[0], r[1]); w.y = pk2(r[2], r[3]); w.z = pk2(r[4], r[5]); w.w = pk2(r[6], r[7]);
                    *(v4u*)(MIXBp + (size_t)row * D + col) = w;
                }
    }
};
struct MoeOrder {
    const unsigned* tile_e; int nMt, nN, G, c; int mt0 = 0, ks = 1, kbytes = 0;
    __device__ __forceinline__ bool next(int i, pg8::Unit& u) const {
        const long L = (long)i * G + c; if (L >= (long)nMt * nN * ks) return false;
        const int mt = mt0 + (int)(L / (nN * ks)), rem = (int)(L % (nN * ks)), pnl = rem / ks;
        u.pm = mt; u.pn = (int)tile_e[mt] * nN + pnl; u.ko = (rem % ks) * kbytes; return true;
    }
    __device__ __forceinline__ void a_ready(const pg8::Unit&) const {}
    __device__ __forceinline__ void done(const pg8::Unit&) const {}
};
struct EpiAtomicF32 {
    static constexpr bool PERM = true, AFTER_DRAIN = false, HAS_MID = false, STAGED = true;
    float* C; int nN;
    __device__ __forceinline__ void staged(const f32x4 (&acc)[2][2][4][2], const pg8::Unit& u, int wr, int wc, int fr, int fq, LAS unsigned char* stg, int wid, int lane) const {
        const int lrw = 16 * wr + fr; const size_t t0 = (size_t)u.pm * 256 * D + (size_t)(u.pn % nN) * 256;
        EPI_ENTER(wr);
#pragma unroll
        for (int ai = 0; ai < 2; ++ai)
#pragma unroll
            for (int m = 0; m < 4; ++m)
#pragma unroll
                for (int bj = 0; bj < 2; ++bj) {
                    *(LAS f32x4*)(stg + lrw * STG_RS + (wc * 32 + 8 * fq) * 4) = acc[ai][bj][m][0];
                    *(LAS f32x4*)(stg + lrw * STG_RS + (wc * 32 + 8 * fq) * 4 + 16) = acc[ai][bj][m][1];
                    EBAR();
                    { int ln_ = lane; asm volatile("" : "+v"(ln_));
#pragma unroll
                      for (int q_ = 0; q_ < 8; ++q_) { const int lr_ = 4 * wid + (q_ >> 1), cf_ = (q_ & 1) * 64 + ln_;
                          const float sv_ = *(const LAS float*)(stg + lr_ * STG_RS + cf_ * 4);
                          const int trow_ = 128 * ai + 64 * (lr_ >> 4) + 16 * m + (lr_ & 15);
                          atomicAdd(C + t0 + (size_t)trow_ * D + bj * 128 + cf_, sv_); } }
                    EBAR();
                }
        EPI_LEAVE(wr);
    }
};

struct EpiStoreBf16s { bf16* C; int ldc; size_t sC;
    __device__ __forceinline__ void operator()(int bt, int m, int n, float v) const { C[(size_t)bt * sC + (size_t)m * ldc + n] = (bf16)f2bf(v); } };
struct EpiInProjF32 {
    static constexpr bool PERM = true, AFTER_DRAIN = false, HAS_MID = false, STAGED = false;
    bf16* PROJp; float* VRESp; bf16* GATEp; float* QFp; bf16* KABp; bf16* VABp; const float* COSAp; const float* SINAp; int layer;
    __device__ __forceinline__ void operator()(const f32x4 (&acc)[2][2][4][2], const pg8::Unit& u, int wr, int wc, int fr, int fq) const {
        int row0 = u.pm * 256 + wr * 64 + fr;
        asm volatile("" : "+v"(row0), "+v"(fq));
        if (u.pn >= 30) {
#pragma unroll
            for (int bj = 0; bj < 2; ++bj) { const int c = (u.pn - 30) * 256 + bj * 128 + wc * 32 + 8 * fq;
#pragma unroll
                for (int ai = 0; ai < 2; ++ai)
#pragma unroll
                    for (int m = 0; m < 4; ++m) { const f32x4 x0 = acc[ai][bj][m][0], x1 = acc[ai][bj][m][1];
                        v4u w; w.x = pk2(fsigmoid(x0[0]), fsigmoid(x0[1])); w.y = pk2(fsigmoid(x0[2]), fsigmoid(x0[3]));
                        w.z = pk2(fsigmoid(x1[0]), fsigmoid(x1[1])); w.w = pk2(fsigmoid(x1[2]), fsigmoid(x1[3]));
                        *(v4u*)(GATEp + (size_t)(row0 + ai * 128 + m * 16) * (3 * D) + c) = w; } }
            return;
        }
        if (u.pn < 8) {
            const bool isk = u.pn >= 4;
#pragma unroll
            for (int bj = 0; bj < 2; ++bj) {
                const int c = (u.pn & 3) * 256 + bj * 128 + wc * 32 + 8 * fq, hh = c >> 7, j0 = ((c & 127) >> 3) * 4;
#pragma unroll
                for (int ai = 0; ai < 2; ++ai)
#pragma unroll
                    for (int m = 0; m < 4; ++m) { const int row = row0 + ai * 128 + m * 16, s = row & (SEQ - 1);
                        const f32x4 cs = *(const f32x4*)(COSAp + s * 64 + j0), sn = *(const f32x4*)(SINAp + s * 64 + j0);
                        const f32x4 x1 = acc[ai][bj][m][0], x2 = acc[ai][bj][m][1];
                        const f32x4 o1 = x1 * cs - x2 * sn, o2 = x2 * cs + x1 * sn;
                        if (!isk) { float* q = QFp + (size_t)row * BW + hh * 128 + j0; *(f32x4*)q = o1; *(f32x4*)(q + 64) = o2; }
                        else { bf16* k = KABp + (size_t)row * BW + hh * 128 + j0; v2u a; a.x = pk2(o1[0], o1[1]); a.y = pk2(o1[2], o1[3]); v2u b; b.x = pk2(o2[0], o2[1]); b.y = pk2(o2[2], o2[3]);
                            *(v2u*)k = a; *(v2u*)(k + 64) = b; }
                        asm volatile("" ::: "memory");
                    }
            }
            return;
        }
        if (u.pn < 12) {
#pragma unroll
            for (int bj = 0; bj < 2; ++bj) { const int c = (u.pn - 8) * 256 + bj * 128 + wc * 32 + 8 * fq;
#pragma unroll
                for (int ai = 0; ai < 2; ++ai)
#pragma unroll
                    for (int m = 0; m < 4; ++m) { const f32x4 x0 = acc[ai][bj][m][0], x1 = acc[ai][bj][m][1];
                        v4u w; w.x = pk2(x0[0], x0[1]); w.y = pk2(x0[2], x0[3]); w.z = pk2(x1[0], x1[1]); w.w = pk2(x1[2], x1[3]);
                        *(v4u*)(VABp + (size_t)(row0 + ai * 128 + m * 16) * BW + c) = w; } }
            return;
        }
#pragma unroll
        for (int bj = 0; bj < 2; ++bj) {
            const int c = u.pn * 256 + bj * 128 + wc * 32 + 8 * fq;
            if (c >= 6432 && c < 6464) {
                if (layer != 0) {
#pragma unroll
                    for (int ai = 0; ai < 2; ++ai)
#pragma unroll
                        for (int m = 0; m < 4; ++m) { float* p = VRESp + (c - 6432) + (size_t)(row0 + ai * 128 + m * 16) * 32;
                            *(f32x4*)p = acc[ai][bj][m][0]; *(f32x4*)(p + 4) = acc[ai][bj][m][1]; }
                }
            } else if (c < 7552) {
                bf16* dst = PROJp + ((c < 6432 ? c : c - 32) - PSH);
#pragma unroll
                for (int ai = 0; ai < 2; ++ai)
#pragma unroll
                    for (int m = 0; m < 4; ++m) { const f32x4 x0 = acc[ai][bj][m][0], x1 = acc[ai][bj][m][1];
                        v4u w; w.x = pk2(x0[0], x0[1]); w.y = pk2(x0[2], x0[3]); w.z = pk2(x1[0], x1[1]); w.w = pk2(x1[2], x1[3]);
                        *(v4u*)(dst + (size_t)(row0 + ai * 128 + m * 16) * PLD) = w; }
            }
        }
    }
};


__device__ __forceinline__ float fma_(float a, float b, float c) { float r; asm("v_fma_f32 %0, %1, %2, %3" : "=v"(r) : "v"(a), "v"(b), "v"(c)); return r; }
__device__ __forceinline__ float mul_(float a, float b) { float r; asm("v_mul_f32 %0, %1, %2" : "=v"(r) : "v"(a), "v"(b)); return r; }
__device__ __forceinline__ float add_(float a, float b) { float r; asm("v_add_f32 %0, %1, %2" : "=v"(r) : "v"(a), "v"(b)); return r; }
typedef short s16x4 __attribute__((ext_vector_type(4)));
constexpr int AT_KOFF = 0, AT_VOFF = 25600, AT_STAGE = 25600 + 64 * 288;
#define AT_TR16(base, o) \
    asm volatile("ds_read_b64_tr_b16 %0, %16 offset:0\n\tds_read_b64_tr_b16 %1, %16 offset:4608\n\t" \
                 "ds_read_b64_tr_b16 %2, %16 offset:32\n\tds_read_b64_tr_b16 %3, %16 offset:4640\n\t" \
                 "ds_read_b64_tr_b16 %4, %16 offset:64\n\tds_read_b64_tr_b16 %5, %16 offset:4672\n\t" \
                 "ds_read_b64_tr_b16 %6, %16 offset:96\n\tds_read_b64_tr_b16 %7, %16 offset:4704\n\t" \
                 "ds_read_b64_tr_b16 %8, %16 offset:128\n\tds_read_b64_tr_b16 %9, %16 offset:4736\n\t" \
                 "ds_read_b64_tr_b16 %10, %16 offset:160\n\tds_read_b64_tr_b16 %11, %16 offset:4768\n\t" \
                 "ds_read_b64_tr_b16 %12, %16 offset:192\n\tds_read_b64_tr_b16 %13, %16 offset:4800\n\t" \
                 "ds_read_b64_tr_b16 %14, %16 offset:224\n\tds_read_b64_tr_b16 %15, %16 offset:4832\n\t" \
                 "s_waitcnt lgkmcnt(0)" \
                 : "=&v"(o[0]), "=&v"(o[1]), "=&v"(o[2]), "=&v"(o[3]), "=&v"(o[4]), "=&v"(o[5]), "=&v"(o[6]), "=&v"(o[7]), \
                   "=&v"(o[8]), "=&v"(o[9]), "=&v"(o[10]), "=&v"(o[11]), "=&v"(o[12]), "=&v"(o[13]), "=&v"(o[14]), "=&v"(o[15]) \
                 : "v"(base) : "memory")
template <int DQ, bool MOBA>
__device__ __forceinline__ void attn_tile(LAS unsigned char* lds, const int buf, const int it, const int q0, const int w, const int qq, const int g, const int qrow, const int own,
                                          const unsigned selbits, const float sc, const pg8::bf16x8 (&qf)[DQ / 32], f32x4 (&o)[8], float& m, float& l) {
    constexpr int KROW = (DQ + 8) * 2, VROW = 288, NDS = DQ / 32;
    const LAS unsigned char* kb = lds + buf * AT_STAGE + AT_KOFF;
    f32x4 st[4];
#pragma unroll
    for (int c = 0; c < 4; ++c) {
        st[c] = (f32x4){0.f, 0.f, 0.f, 0.f};
#pragma unroll
        for (int ds = 0; ds < NDS; ++ds) {
            const pg8::bf16x8 a = *(const LAS pg8::bf16x8*)(kb + (16 * c + qq) * KROW + (32 * ds + 8 * g) * 2);
            st[c] = __builtin_amdgcn_mfma_f32_16x16x32_bf16(a, qf[ds], st[c], 0, 0, 0);
        }
    }
    const int blk = it >> 2;
    const bool past = MOBA && (blk < own);
    if (past) {
        const bool selok = ((selbits >> blk) & 1u) != 0u;
#pragma unroll
        for (int c = 0; c < 4; ++c)
#pragma unroll
            for (int r = 0; r < 4; ++r) st[c][r] = selok ? st[c][r] : -INFINITY;
    } else if (it * 64 + 63 > q0 + 16 * w) {
#pragma unroll
        for (int c = 0; c < 4; ++c)
#pragma unroll
            for (int r = 0; r < 4; ++r) { const int key = it * 64 + 16 * c + 4 * g + r; st[c][r] = (key <= qrow) ? st[c][r] : -INFINITY; }
    }
    float mloc = fmaxf(fmaxf(st[0][0], st[0][1]), fmaxf(st[0][2], st[0][3]));
#pragma unroll
    for (int c = 1; c < 4; ++c) mloc = fmaxf(mloc, fmaxf(fmaxf(st[c][0], st[c][1]), fmaxf(st[c][2], st[c][3])));
    const int ln_ = qq + 16 * g;
    mloc = fmaxf(mloc, shfl_xor_(mloc, 16, ln_)); mloc = fmaxf(mloc, shfl_xor_(mloc, 32, ln_));
    const float mnew = fmaxf(m, mloc * sc);
    if (__any(mnew > m)) {
        const float alpha = __builtin_amdgcn_exp2f(m - mnew);
        l *= alpha;
#pragma unroll
        for (int i = 0; i < 8; ++i) o[i] *= alpha;
        m = mnew;
    }
    float ps = 0.f;
#pragma unroll
    for (int c = 0; c < 4; ++c)
#pragma unroll
        for (int r = 0; r < 4; ++r) { const float p = __builtin_amdgcn_exp2f(__builtin_fmaf(st[c][r], sc, -m)); st[c][r] = p; ps += p; }
    l += ps;
#pragma unroll
    for (int c0i = 0; c0i < 2; ++c0i) {
        v4u pw; pw.x = pk2(st[2 * c0i][0], st[2 * c0i][1]); pw.y = pk2(st[2 * c0i][2], st[2 * c0i][3]);
        pw.z = pk2(st[2 * c0i + 1][0], st[2 * c0i + 1][1]); pw.w = pk2(st[2 * c0i + 1][2], st[2 * c0i + 1][3]);
        const pg8::bf16x8 pb = __builtin_bit_cast(pg8::bf16x8, pw);
        const unsigned vaddr = (unsigned)(size_t)(lds + buf * AT_STAGE + AT_VOFF) + (unsigned)((32 * c0i + 4 * g + (qq >> 2)) * VROW + 8 * (qq & 3));
        s16x4 vr[16];
        AT_TR16(vaddr, vr);
#pragma unroll
        for (int i = 0; i < 8; ++i) {
            const pg8::bf16x8 a = __builtin_shufflevector(vr[2 * i], vr[2 * i + 1], 0, 1, 2, 3, 4, 5, 6, 7);
            o[i] = __builtin_amdgcn_mfma_f32_16x16x32_bf16(a, pb, o[i], 0, 0, 0);
        }
    }
}
template <int DQ, bool MOBA>
__device__ __forceinline__ void attn_unit(LAS unsigned char* lds, const bf16* Qg, int ldq, const bf16* Kg, int ldk, const bf16* Vg, int ldv,
                                          bf16* Og, int ldo, const unsigned char* sel, int qt, float sc, const int tid) {
    constexpr int KROW = (DQ + 8) * 2, VROW = 288, KCH = DQ / 8, NKC = 64 * KCH / 512, NDS = DQ / 32;
    const int lane = tid & 63, w = __builtin_amdgcn_readfirstlane(tid >> 6), qq = lane & 15, g = lane >> 4;
    const int q0 = qt * 128, qrow = q0 + 16 * w + qq, own = q0 >> 8;
    pg8::bf16x8 qf[NDS];
#pragma unroll
    for (int ds = 0; ds < NDS; ++ds) qf[ds] = *(const pg8::bf16x8*)(Qg + (size_t)qrow * ldq + 32 * ds + 8 * g);
    unsigned selbits = 0; if (MOBA) selbits = sel[(size_t)qrow * 8];
    f32x4 o[8];
#pragma unroll
    for (int i = 0; i < 8; ++i) o[i] = (f32x4){0.f, 0.f, 0.f, 0.f};
    float m = -1e30f, l = 0.f;
    const int ntiles = 2 * (qt + 1);
    v4u kA[NKC], vA[2], kB[NKC], vB[2];
    { const v4u z_ = {0u, 0u, 0u, 0u};
#pragma unroll
      for (int i_ = 0; i_ < NKC; ++i_) { kA[i_] = z_; kB[i_] = z_; }
      vA[0] = z_; vA[1] = z_; vB[0] = z_; vB[1] = z_; }
    unsigned kgo[NKC], vgo[2], klo[NKC], vlo[2];
#pragma unroll
    for (int i_ = 0; i_ < NKC; ++i_) { const int id_ = tid + 512 * i_, row_ = id_ / KCH, ch_ = id_ % KCH; kgo[i_] = (unsigned)(row_ * ldk + ch_ * 8) * 2u; klo[i_] = (unsigned)(row_ * KROW + ch_ * 16); }
#pragma unroll
    for (int i_ = 0; i_ < 2; ++i_) { const int id_ = tid + 512 * i_, row_ = id_ >> 4, ch_ = id_ & 15; vgo[i_] = (unsigned)(row_ * ldv + ch_ * 8) * 2u; vlo[i_] = (unsigned)(AT_VOFF + row_ * VROW + ch_ * 16); }
#define AT_GLOAD(KS, VS, tile) do { const char* kp_ = (const char*)Kg + (size_t)(tile) * 64 * ldk * 2; const char* vp_ = (const char*)Vg + (size_t)(tile) * 64 * ldv * 2; \
        _Pragma("unroll") for (int i_ = 0; i_ < NKC; ++i_) KS[i_] = *(const v4u*)(kp_ + kgo[i_]); \
        _Pragma("unroll") for (int i_ = 0; i_ < 2; ++i_) VS[i_] = *(const v4u*)(vp_ + vgo[i_]); } while (0)
#define AT_LSTORE(KS, VS, buf) do { _Pragma("unroll") for (int i_ = 0; i_ < NKC; ++i_) *(LAS v4u*)(lds + (buf) * AT_STAGE + klo[i_]) = KS[i_]; \
        _Pragma("unroll") for (int i_ = 0; i_ < 2; ++i_) *(LAS v4u*)(lds + (buf) * AT_STAGE + vlo[i_]) = VS[i_]; } while (0)
    AT_GLOAD(kA, vA, 0); AT_LSTORE(kA, vA, 0);
    AT_GLOAD(kA, vA, 1);
    __syncthreads();
    for (int it = 0; it < ntiles; it += 2) {
        if (it + 2 < ntiles) AT_GLOAD(kB, vB, it + 2);
        attn_tile<DQ, MOBA>(lds, 0, it, q0, w, qq, g, qrow, own, selbits, sc, qf, o, m, l);
        AT_LSTORE(kA, vA, 1);
        __syncthreads();
        if (it + 3 < ntiles) AT_GLOAD(kA, vA, it + 3);
        attn_tile<DQ, MOBA>(lds, 1, it + 1, q0, w, qq, g, qrow, own, selbits, sc, qf, o, m, l);
        if (it + 2 < ntiles) AT_LSTORE(kB, vB, 0);
        __syncthreads();
    }
    float ls = l + shfl_xor_(l, 16, lane); ls += shfl_xor_(ls, 32, lane);
    const float inv = 1.0f / ls;
#pragma unroll
    for (int i = 0; i < 8; ++i) { v2u ob; ob.x = pk2(o[i][0] * inv, o[i][1] * inv); ob.y = pk2(o[i][2] * inv, o[i][3] * inv);
        *(v2u*)(Og + (size_t)qrow * ldo + 16 * i + 4 * g) = ob; }
#undef AT_GLOAD
#undef AT_LSTORE
}
template <bool BT, class Epi>
__device__ __forceinline__ void gemm32(LAS float* lds, const float* A, int lda, size_t sA, const float* B, int ldb, size_t sB,
                                       int M, int N, int K, int nbatch, const int* rowidx, const Epi& epi, const int tid, const int G) {
    const int lane = tid & 63, wave = tid >> 6, wm = wave >> 1, wn = wave & 1;
    const int tilesM = (M + 127) >> 7, tilesN = (N + 127) >> 7, tilesPer = tilesM * tilesN, ntiles = tilesPer * nbatch;
    LAS float* As = lds;
    LAS float* Bs = lds + 2 * 16 * 132;
    for (int tile = blockIdx.x; tile < ntiles; tile += G) {
        const int bt = tile / tilesPer, r = tile % tilesPer, tm = r / tilesN, tn = r % tilesN;
        const int m0 = tm * 128, n0 = tn * 128;
        const float* Ab = A + (size_t)bt * sA; const float* Bb = B + (size_t)bt * sB;
        const int arow = tid >> 2, akq = (tid & 3) * 4;
        const int gr = m0 + arow; const bool aok = gr < M;
        const int src = aok ? (rowidx ? rowidx[gr] : gr) : 0;
        const float* ap = Ab + (size_t)src * lda + akq;
        const float* bp; bool bok; int bkr, bnq;
        if (BT) { bkr = 0; bnq = 0; const int gn = n0 + arow; bok = gn < N; bp = Bb + (size_t)(bok ? gn : 0) * ldb + akq; }
        else { bkr = tid >> 5; bnq = (tid & 31) * 4; bok = (n0 + bnq) < N; bp = Bb + (size_t)bkr * ldb + (bok ? (n0 + bnq) : 0); }
        f32x16 acc0, acc1;
#pragma unroll
        for (int i = 0; i < 16; ++i) { acc0[i] = 0.f; acc1[i] = 0.f; }
        f32x4 ra, rb;
        const f32x4 z4 = {0.f, 0.f, 0.f, 0.f};
        ra = aok ? *(const f32x4*)ap : z4;
        rb = bok ? *(const f32x4*)bp : z4;
        {
            LAS float* a_ = As; LAS float* b_ = Bs;
#pragma unroll
            for (int j = 0; j < 4; ++j) a_[(akq + j) * 132 + arow] = ra[j];
            if (BT) {
#pragma unroll
                for (int j = 0; j < 4; ++j) b_[(akq + j) * 132 + arow] = rb[j];
            } else *(LAS f32x4*)(b_ + bkr * 132 + bnq) = rb;
        }
        __syncthreads();
        for (int k0 = 0; k0 < K; k0 += 16) {
            const int cur = (k0 >> 4) & 1;
            const bool more = (k0 + 16) < K;
            if (more) {
                ra = aok ? *(const f32x4*)(ap + k0 + 16) : z4;
                if (BT) rb = bok ? *(const f32x4*)(bp + k0 + 16) : z4;
                else rb = bok ? *(const f32x4*)(bp + (size_t)(k0 + 16) * ldb) : z4;
            }
            const LAS float* a_ = As + cur * 16 * 132 + (lane >> 5) * 132 + wm * 32 + (lane & 31);
            const LAS float* b_ = Bs + cur * 16 * 132 + (lane >> 5) * 132 + wn * 64 + (lane & 31);
#pragma unroll
            for (int kk = 0; kk < 16; kk += 2) {
                const float a = a_[kk * 132], b0 = b_[kk * 132], b1 = b_[kk * 132 + 32];
                acc0 = __builtin_amdgcn_mfma_f32_32x32x2f32(a, b0, acc0, 0, 0, 0);
                acc1 = __builtin_amdgcn_mfma_f32_32x32x2f32(a, b1, acc1, 0, 0, 0);
            }
            if (more) {
                LAS float* aw = As + (cur ^ 1) * 16 * 132; LAS float* bw = Bs + (cur ^ 1) * 16 * 132;
#pragma unroll
                for (int j = 0; j < 4; ++j) aw[(akq + j) * 132 + arow] = ra[j];
                if (BT) {
#pragma unroll
                    for (int j = 0; j < 4; ++j) bw[(akq + j) * 132 + arow] = rb[j];
                } else *(LAS f32x4*)(bw + bkr * 132 + bnq) = rb;
            }
            __syncthreads();
        }
#pragma unroll
        for (int i = 0; i < 16; ++i) {
            const int row = m0 + wm * 32 + (i & 3) + 8 * (i >> 2) + 4 * (lane >> 5);
            const int c0 = n0 + wn * 64 + (lane & 31);
            if (row < M) {
                if (c0 < N) epi(bt, row, c0, acc0[i]);
                if (c0 + 32 < N) epi(bt, row, c0 + 32, acc1[i]);
            }
        }
    }
}

struct EpiStore { float* C; int ldc; size_t sC;
    __device__ __forceinline__ void operator()(int bt, int m, int n, float v) const { C[(size_t)bt * sC + (size_t)m * ldc + n] = v; } };
struct EpiDecay { float* C; const float* w0;
    __device__ __forceinline__ void operator()(int, int m, int n, float v) const {
        const float z = -(w0[n] + v); const float sp = z > 20.f ? z : log1pf(expf(z));
        C[(size_t)m * BW + n] = expf(-expf(-sp - 0.5f)); } };
struct EpiSigB { float* C; const float* b;
    __device__ __forceinline__ void operator()(int, int m, int n, float v) const { C[(size_t)m * BW + n] = sigmoidf_(b[n] + v); } };
struct EpiVLerp { float* V; const float* VF; const float* v0;
    __device__ __forceinline__ void operator()(int, int m, int n, float a) const {
        const size_t o = (size_t)m * BW + n; const float v = V[o]; V[o] = v + (VF[o] - v) * sigmoidf_(v0[n] + a); } };
template <bool FIRST> struct EpiGateAcc { float* MIX; const float* gate;
    __device__ __forceinline__ void operator()(int, int m, int n, float a) const {
        const float g = sigmoidf_(gate[(size_t)m * IN_COLS + n]); const size_t o = (size_t)m * D + n;
        MIX[o] = FIRST ? g * a : MIX[o] + g * a; } };
struct EpiResid { float* C; const float* R; int ldc;
    __device__ __forceinline__ void operator()(int, int m, int n, float a) const { const size_t o = (size_t)m * ldc + n; C[o] = ALPHA * R[o] + a; } };
struct EpiSwiglu { float* C; int ldc; size_t roff;
    __device__ __forceinline__ void operator()(int, int m, int n, float a) const {
        const size_t o = (roff + (size_t)m) * ldc + n; const float g = C[o]; C[o] = g * sigmoidf_(g) * a; } };

struct Args { const float* in[34]; float* out; unsigned char* ws; unsigned mask; int li; };

__device__ __forceinline__ unsigned char* opq(unsigned char* p) { asm volatile("" : "+s"(p)); return p; }
#define INP(i) ((const float*)(((const GAS float* const*)args.in)[(i) + zero_live]))
#define x_in INP(0)
#define w_in INP(1)
#define w_in_vres INP(2)
#define rwkv_mu INP(3)
#define rwkv_mu_vres INP(4)
#define rwkv_w0 INP(5)
#define rwkv_w_lora INP(6)
#define rwkv_a0 INP(7)
#define rwkv_a_lora INP(8)
#define rwkv_g_lora INP(9)
#define rwkv_v0 INP(10)
#define rwkv_v_lora INP(11)
#define rwkv_k_k INP(12)
#define rwkv_k_a INP(13)
#define rwkv_r_k INP(14)
#define rwkv_gn_g INP(15)
#define rwkv_gn_b INP(16)
#define mla_q_norm INP(17)
#define mla_w_uq INP(18)
#define mla_kv_norm INP(19)
#define mla_w_ukv INP(20)
#define branch_out INP(21)
#define w_out INP(22)
#define ln1_g INP(23)
#define ln1_b INP(24)
#define ffn_wg INP(25)
#define ffn_wu INP(26)
#define ffn_wd INP(27)
#define moe_router INP(28)
#define moe_wg INP(29)
#define moe_wu INP(30)
#define moe_wd INP(31)
#define ln2_g INP(32)
#define ln2_b INP(33)
#define COSA ((float*)(ws_live + WS_COSA))
#define SINA ((float*)(ws_live + WS_SINA))
#define COSM ((float*)(ws_live + WS_COSM))
#define SINM ((float*)(ws_live + WS_SINM))
#define TOK ((int*)(ws_live + WS_TOK))
#define ROWL ((int*)(ws_live + WS_ROWL))
#define XB ((float*)(ws_live + WS_XB))
#define X1 ((float*)(ws_live + WS_X1))
#define PRE ((float*)(ws_live + WS_PRE))
#define XBF ((bf16*)(ws_live + WS_XBF))
#define WINT ((bf16*)(ws_live + WS_WINT))
#define X1B ((bf16*)(ws_live + WS_X1B))
#define WBO ((bf16*)(ws_live + WS_WBO))
#define WOT ((bf16*)(ws_live + WS_WOT))
#define WGU ((bf16*)(ws_live + WS_WGU))
#define WD ((bf16*)(ws_live + WS_WD))
#define WDD ((bf16*)(ws_live + WS_WDD))
#define HGB ((bf16*)(ws_live + WS_HGB))
#define XG ((bf16*)(ws_live + WS_XG))
#define MIXB ((bf16*)(ws_live + WS_MIXB))
#define YALL ((bf16*)(ws_live + WS_YALL))
#define GATEB ((bf16*)(ws_live + WS_GATEB))
#define QAB ((bf16*)(ws_live + WS_QAB))
#define KAB ((bf16*)(ws_live + WS_KAB))
#define VAB ((bf16*)(ws_live + WS_VAB))
#define QCB ((bf16*)(ws_live + WS_QCB))
#define KCB ((bf16*)(ws_live + WS_KCB))
#define VCB ((bf16*)(ws_live + WS_VCB))
#define KMEAN ((float*)(ws_live + WS_KMEAN))
#define SELB ((unsigned char*)(ws_live + WS_SEL))
#define WUQ ((bf16*)(ws_live + WS_WUQ))
#define WUKV ((bf16*)(ws_live + WS_WUKV))
#define WLORA ((bf16*)(ws_live + WS_WLORA))
#define LA ((bf16*)(ws_live + WS_LA))
#define QNB ((bf16*)(ws_live + WS_QNB))
#define KVNB ((bf16*)(ws_live + WS_KVNB))
#define QF ((float*)(ws_live + WS_QF))
#define KMS ((float*)(ws_live + WS_KMEAN))
#define PROJ ((bf16*)(ws_live + WS_PROJ))
#define VRES ((float*)(ws_live + WS_VRES))
#define QA ((float*)(ws_live + WS_QA))
#define V0 ((float*)(ws_live + WS_V0))
#define V1 ((float*)(ws_live + WS_V1))
#define DEC ((float*)(ws_live + WS_DEC))
#define AA ((bf16*)(ws_live + WS_AA))
#define GG ((bf16*)(ws_live + WS_GG))
#define Y ((bf16*)(ws_live + WS_Y))
#define OUT ((float*)(ws_live + WS_OUT))


__global__ void __launch_bounds__(NTHREADS, 2) fwd_kernel(Args args) {
    extern __shared__ __attribute__((aligned(16))) unsigned char lds_raw[];
#define lds ((LAS float*)lds_raw)
    int wave_live = __builtin_amdgcn_readfirstlane((int)threadIdx.x >> 6);
    int tid_live = threadIdx.x;
#define RETID() do { int ln_; asm volatile("v_mbcnt_lo_u32_b32 %0, -1, 0\n\tv_mbcnt_hi_u32_b32 %0, -1, %0" : "=v"(ln_)); asm volatile("" : "+s"(wave_live)); tid_live = wave_live * 64 + ln_; } while (0)
#define tid tid_live
#define lane (tid_live & 63)
#define wave (__builtin_amdgcn_readfirstlane(tid_live >> 6))
#define gw ((int)blockIdx.x * NWAVES + wave)
#define NGW (G_live * NWAVES)
#define gt ((int)blockIdx.x * NTHREADS + tid_live)
#define NGT (G_live * NTHREADS)
#define misc ((volatile LAS unsigned*)((LAS unsigned char*)lds_raw + LDS_BYTES - 64))
    if (tid < 16) misc[tid] = tid == 6 ? 0xffffffffu : 0u;
    __syncthreads();
#define REOPAQUE() do { asm volatile("" : "+s"(ws_live)); asm volatile("" : "+s"(zero_live)); asm volatile("" : "+s"(G_live)); RETID(); } while (0)
#define TI_WINT(t_, ll_, r_) do { constexpr int NNB_ = NP / 32; const int kb_ = (r_) / NNB_, nb_ = (r_) % NNB_, c_ = nb_ * 32; \
    const float* W_ = w_in + (size_t)(ll_) * D * IN_COLS; int ldw_ = IN_COLS, sc_ = c_; \
    if (c_ < 6432) sc_ = c_; \
    else if (c_ < 6464) { if (ll_) { W_ = w_in_vres; ldw_ = 32; sc_ = 0; } else W_ = nullptr; } \
    else if (c_ < 7552) sc_ = c_ - 32; \
    else if (c_ < 7680) W_ = nullptr; \
    else sc_ = c_ - 160; \
    int scl_ = sc_ + (lane & 31); \
    if (c_ < 2048) { const int cl_ = c_ + (lane & 31), hh_ = cl_ >> 7, cc_ = cl_ & 127, e_ = cc_ & 7; scl_ = hh_ * 128 + (e_ < 4 ? 4 * (cc_ >> 3) + e_ : 64 + 4 * (cc_ >> 3) + (e_ - 4)); } \
    (t_).zero = W_ == nullptr; (t_).p = (W_ ? W_ : w_in) + scl_; (t_).ldw = ldw_; (t_).wt = WINT + (size_t)(ll_) * NP * D; (t_).K = D; (t_).r0 = c_; (t_).k0 = kb_ * 64; } while (0)
#define TI_WBO(t_, mat_, r_) do { const int kb_ = (r_) / 64, nb_ = (r_) % 64, ll_ = (mat_) / 3, seg_ = (mat_) % 3; \
    (t_).zero = false; (t_).p = branch_out + (size_t)(mat_) * BW * D + nb_ * 32 + (lane & 31); (t_).ldw = D; (t_).wt = WBO + (size_t)ll_ * D * 3 * BW + seg_ * BW; (t_).K = 3 * BW; (t_).r0 = nb_ * 32; (t_).k0 = kb_ * 64; } while (0)
#define TI_WUQ(t_, mat_, r_) do { const int kb_ = (r_) / 48, nb_ = (r_) % 48; \
    const int np_ = nb_ * 32 + (lane & 31), hh_ = np_ / 192, cc_ = np_ - hh_ * 192, q_ = cc_ - 128, e_ = q_ & 7; \
    const int sc_ = cc_ < 128 ? hh_ * 192 + cc_ : hh_ * 192 + 128 + (e_ < 4 ? 4 * (q_ >> 3) + e_ : 32 + 4 * (q_ >> 3) + (e_ - 4)); \
    (t_).zero = false; (t_).p = mla_w_uq + (size_t)(mat_) * 512 * 1536 + sc_; (t_).ldw = 1536; (t_).wt = WUQ + (size_t)(mat_) * 1536 * 512; (t_).K = 512; (t_).r0 = nb_ * 32; (t_).k0 = kb_ * 64; } while (0)
#define TI_WUKV(t_, mat_, r_) do { const int kb_ = (r_) / 64, nb_ = (r_) % 64; \
    (t_).zero = false; (t_).p = mla_w_ukv + (size_t)(mat_) * 512 * 2048 + nb_ * 32 + (lane & 31); (t_).ldw = 2048; (t_).wt = WUKV + (size_t)(mat_) * 2048 * 512; (t_).K = 512; (t_).r0 = nb_ * 32; (t_).k0 = kb_ * 64; } while (0)
#define TI_WOT(t_, mat_, r_) do { const int kb_ = (r_) / 64, nb_ = (r_) % 64; \
    (t_).zero = false; (t_).p = w_out + (size_t)(mat_) * D * D + nb_ * 32 + (lane & 31); (t_).ldw = D; (t_).wt = WOT + (size_t)(mat_) * D * D; (t_).K = D; (t_).r0 = nb_ * 32; (t_).k0 = kb_ * 64; } while (0)
constexpr int FC_I_GU = (D / 64) * (NGU / 32), FC_I_D = (DFF / 64) * (D / 32);
#define TI_GU(t_, wg_, wu_, e_, r_) do { const int kb_ = (r_) / (NGU / 32), nb_ = (r_) % (NGU / 32); const int rr_ = lane & 31, hcol_ = 4 * (nb_ * 4 + (rr_ >> 3)) + (rr_ & 3); \
    (t_).zero = false; (t_).p = ((rr_ & 7) < 4 ? (wg_) : (wu_)) + (size_t)(e_) * D * DFF + hcol_; (t_).ldw = DFF; (t_).wt = WGU + (size_t)(e_) * NGU * D; (t_).K = D; (t_).r0 = nb_ * 32; (t_).k0 = kb_ * 64; } while (0)
#define TI_D(t_, wd_, dst_, e_, r_) do { const int kb_ = (r_) / (D / 32), nb_ = (r_) % (D / 32); \
    (t_).zero = false; (t_).p = (wd_) + (size_t)(e_) * DFF * D + nb_ * 32 + (lane & 31); (t_).ldw = D; (t_).wt = (dst_) + (size_t)(e_) * D * DFF; (t_).K = DFF; (t_).r0 = nb_ * 32; (t_).k0 = kb_ * 64; } while (0)
#define TI_RUN1(ta_) do { float va_[32]; ti_load(ta_, va_, lane); ti_finish(ta_, va_, scr, lane); } while (0)
#define TI_RUN2(ta_, tb_) do { float va_[32], vb_[32]; ti_load(ta_, va_, lane); ti_load(tb_, vb_, lane); ti_finish(ta_, va_, scr, lane); ti_finish(tb_, vb_, scr, lane); } while (0)
#define CV_WINT_ITEM(ll_, r_) do { TI t1_; TI_WINT(t1_, ll_, r_); TI_RUN1(t1_); } while (0)
#define CV_WUQ_ITEM(mat_, r_) do { TI t1_; TI_WUQ(t1_, mat_, r_); TI_RUN1(t1_); } while (0)
#define CV_WUKV_ITEM(mat_, r_) do { TI t1_; TI_WUKV(t1_, mat_, r_); TI_RUN1(t1_); } while (0)
#define CV_LORA_ITEM(ll_, r_) do { \
    for (int j_ = 0; j_ < 32; ++j_) { const int x_ = (r_) * 2048 + j_ * 64 + lane, n_ = x_ / 384, k_ = x_ % 384, seg_ = n_ >> 10, c_ = n_ & 1023; \
        float v_ = 0.f; \
        if (seg_ == 0) { if (k_ < 64) v_ = rwkv_w_lora[((size_t)(ll_) * 64 + k_) * BW + c_]; } \
        else if (seg_ == 1) { if (k_ >= 64 && k_ < 128) v_ = rwkv_a_lora[((size_t)(ll_) * 64 + (k_ - 64)) * BW + c_]; } \
        else if (seg_ == 2) { if (k_ >= 128 && k_ < 288) v_ = rwkv_g_lora[((size_t)(ll_) * 160 + (k_ - 128)) * BW + c_]; } \
        else { if ((ll_) == 1 && k_ >= 288 && k_ < 320) v_ = rwkv_v_lora[(size_t)(k_ - 288) * BW + c_]; } \
        WLORA[(size_t)(ll_) * 4096 * 384 + x_] = (bf16)f2bf(v_); } } while (0)
#define FFN_CONV_PAIR(it_) do { const int fi_ = (it_); \
    if (l == 0) { if (fi_ < FC_I_GU) PAIR_OF(TI_GU, ffn_wg, ffn_wu, 0, fi_); else PAIR_OF(TI_D, ffn_wd, WDD, 0, fi_ - FC_I_GU); } \
    else PAIR_OF(TI_GU, moe_wg, moe_wu, fi_ / FC_I_GU, fi_ % FC_I_GU); } while (0)
#define FFN_CONV_N(l_) ((l_) == 0 ? FC_I_GU + FC_I_D : 4 * FC_I_GU)
#define PAIR_OF(TIM_, ...) do { TI ta_, tb_; TIM_(ta_, __VA_ARGS__); TIM_(tb_, __VA_ARGS__ + 1); TI_RUN2(ta_, tb_); } while (0)
#define DQ_PAIR(d_) do { const int d__ = (d_); \
    if (d__ < 3072) { PAIR_OF(TI_WBO, d__ >> 10, (d__ & 1023)); asm volatile("; dq0" ::: "memory"); } \
    else if (d__ < 5120) { PAIR_OF(TI_WOT, 0, d__ - 3072); asm volatile("; dq1" ::: "memory"); } \
    else if (d__ < 18944) { PAIR_OF(TI_WINT, 1, d__ - 5120); asm volatile("; dq2" ::: "memory"); } \
    else if (d__ < 19712) { }   \
    else if (d__ < 20096) { PAIR_OF(TI_WUQ, 1, d__ - 19712); asm volatile("; dq3" ::: "memory"); } \
    else if (d__ < 20608) { PAIR_OF(TI_WUKV, 1, d__ - 20096); asm volatile("; dq4" ::: "memory"); } \
    else if (d__ < 23680) { PAIR_OF(TI_WBO, 3 + ((d__ - 20608) >> 10), ((d__ - 20608) & 1023)); asm volatile("; dq5" ::: "memory"); } \
    else if (d__ < 25728) { PAIR_OF(TI_WOT, 1, d__ - 23680); asm volatile("; dq6" ::: "memory"); } \
    else if (d__ < DQ_J7) { PAIR_OF(TI_GU, moe_wg, moe_wu, 4 + (d__ - 25728) / FC_I_GU, (d__ - 25728) % FC_I_GU); asm volatile("; dq7" ::: "memory"); } \
    else { PAIR_OF(TI_D, moe_wd, WD, (d__ - DQ_J7) / FC_I_D, (d__ - DQ_J7) % FC_I_D); asm volatile("; dq8" ::: "memory"); } } while (0)
#define DQ_HALF(base_) do { const int dit_ = (int)(base_) + 2 * wave; if (dit_ < DQ_N) DQ_PAIR(dit_); } while (0)
#define DQ_PENDING() do { const unsigned pu_ = (unsigned)__builtin_amdgcn_readfirstlane((int)misc[6]); __syncthreads(); \
        if (pu_ != 0xffffffffu) { if (tid == 0) misc[6] = 0xffffffffu; DQ_HALF(pu_); } } while (0)
#define DQ_RUN(COND_) do { DQ_PENDING(); for (;;) { \
        if (tid == 0) { unsigned u_ = 0xffffffffu; \
            if (xb_ld(ctl + CW_DQ + 64 * li_) < (unsigned)DQ_N && (COND_)) u_ = atomicAdd(ctl + CW_DQ + 64 * li_, 32u); \
            misc[4] = u_; } \
        __syncthreads(); \
        const unsigned du_ = (unsigned)__builtin_amdgcn_readfirstlane((int)misc[4]); \
        __syncthreads(); \
        if (du_ >= (unsigned)DQ_N) break; \
        DQ_HALF(du_); \
        if (tid == 0) misc[5] = (COND_) ? 1u : 0u; \
        __syncthreads(); \
        const unsigned go_ = (unsigned)__builtin_amdgcn_readfirstlane((int)misc[5]); \
        __syncthreads(); \
        if (!go_) { if (tid == 0) misc[6] = du_ + 16u; __syncthreads(); break; } \
        DQ_HALF(du_ + 16u); \
    } } while (0)
#define DQ_FLUSH(UPTO_) do { DQ_PENDING(); for (;;) { \
        if (tid == 0) { const unsigned h_ = xb_ld(ctl + CW_DQ + 64 * li_); unsigned u_ = 0xffffffffu, nb_ = 0u; \
            if (h_ < (unsigned)(UPTO_)) { nb_ = ((((unsigned)(UPTO_) - h_ + (unsigned)G_live - 1u) / (unsigned)G_live) + 7u) & ~7u; nb_ = nb_ < 16u ? 16u : nb_; u_ = atomicAdd(ctl + CW_DQ + 64 * li_, nb_); } \
            misc[4] = u_; misc[5] = nb_; } \
        __syncthreads(); \
        const unsigned du_ = (unsigned)__builtin_amdgcn_readfirstlane((int)misc[4]), dn_ = (unsigned)__builtin_amdgcn_readfirstlane((int)misc[5]); \
        __syncthreads(); \
        if (du_ >= (unsigned)DQ_N) break; \
        const int de_ = (int)min(du_ + dn_, (unsigned)DQ_N); \
        _Pragma("unroll 1") \
        for (int dit_ = (int)du_ + 2 * wave; dit_ < de_; dit_ += 16) DQ_PAIR(dit_); \
    } } while (0)
#define DQ_FILL(SLOT_, TH_) DQ_RUN(xb_ld(ctl + CW_PD + 64 * ((SLOT_) + 8 * li_)) < (unsigned)(TH_))
#define PHASE_DONE(SLOT_) do { if (tid == 0) atomicAdd(ctl + CW_PD + 64 * ((SLOT_) + 8 * li_), 1u); } while (0)
#define GRID_BAR() do { { XcdBarrier bar_; bar_.bar = ctl + CW_BAR + li_ * XCD_BAR_WORDS; bar_.x = xb_xcc_id(); bar_.st = misc; xcd_barrier(bar_, tid_live); } asm volatile("" : "+s"(ws_live)); asm volatile("" : "+s"(zero_live)); asm volatile("" : "+s"(G_live)); RETID(); } while (0)

    GAS unsigned char* ws_live = *(GAS unsigned char* const*)&args.ws; int zero_live = 0; int G_live = (int)gridDim.x; unsigned mask_live = args.mask; const int li_ = args.li;
#define RUN(p) ((mask_live >> (l * 12 + (p))) & 1u)
#define ctl ((unsigned*)(ws_live + WS_CTL))
    (void)xcd_barrier_post(ctl + CW_BAR + li_ * XCD_BAR_WORDS, misc, tid_live);
    if (mask_live & (1u << 31)) {
    for (int i = gt; i < SEQ * 64; i += NGT) {
        const int s = i >> 6, j = i & 63;
        const float inv = 1.0f / powf(10000.0f, (float)(2 * j) / 128.0f);
        const float ang = (float)s * inv;
        COSA[i] = cosf(ang); SINA[i] = sinf(ang);
    }
    for (int i = gt; i < SEQ * 32; i += NGT) {
        const int s = i >> 5, j = i & 31;
        const float inv = 1.0f / powf(10000.0f, (float)(2 * j) / 64.0f);
        const float ang = (float)s * inv;
        COSM[i] = cosf(ang); SINM[i] = sinf(ang);
    }

    {
        LAS float* scr = (LAS float*)((LAS unsigned char*)lds_raw) + wave * (64 * 33);
        for (int it = gw; it < (D / 64) * (NP / 32); it += NGW) CV_WINT_ITEM(0, it);
        for (int it = gw; it < 2 * 768; it += NGW) { const int ll = it / 768, r = it % 768; CV_LORA_ITEM(ll, r); }
        for (int it = gw; it < 8 * 48; it += NGW) CV_WUQ_ITEM(0, it);
        for (int it = gw; it < 8 * 64; it += NGW) CV_WUKV_ITEM(0, it);
        for (int t = gw; t < T; t += NGW) {
#pragma unroll
            for (int jj = 0; jj < 8; ++jj) { const f32x4 v = *(const f32x4*)(x_in + (size_t)t * D + jj * 256 + lane * 4);
                v2u o; o.x = pk2(v[0], v[1]); o.y = pk2(v[2], v[3]); *(v2u*)(XBF + (size_t)t * D + jj * 256 + lane * 4) = o; }
        }
    }
    GRID_BAR();
    }
    for (int l = 0; l < 2; ++l) {
        const float* X = (l == 0) ? x_in : XB;
        float* Vcur = (l == 0) ? V0 : V1;
        if (RUN(0)) {
        {
            pg8::Gemm g{XBF, WINT + (size_t)l * NP * D, T, NP, D}; pg8::StaticOrder S; S.init(T, NP, G_live, (int)blockIdx.x);
            EpiInProjF32 E{PROJ, VRES, GATEB, QF, KAB, VAB, COSA, SINA, l};
            pg8::gemm_phase<EpiInProjF32, pg8::StaticOrder, false>((LAS unsigned char*)lds_raw, g, S, E, nullptr, tid);
        }
        REOPAQUE();
        {
            LAS float* scr = (LAS float*)((LAS unsigned char*)lds_raw) + wave * (64 * 33);
            PHASE_DONE(l * 4 + 0);
            DQ_FILL(l * 4 + 0, 65);
        }
        GRID_BAR();
        }
        if (RUN(1)) {
        if (l == 1) { LAS float* scr = (LAS float*)((LAS unsigned char*)lds_raw) + wave * (64 * 33); DQ_FLUSH(DQ_J5); }
        for (int item = blockIdx.x; item < NBATCH * 8 * 8; item += G_live) {
            const int blk = item & 7, h = (item >> 3) & 7, b = item >> 6;
            const int kq = tid >> 4, d8 = (tid & 15) * 8;
            const bf16* kbase = KAB + ((size_t)b * SEQ + blk * 256) * BW + h * 128 + d8;
            float sacc[8];
#pragma unroll
            for (int j = 0; j < 8; ++j) sacc[j] = 0.f;
#pragma unroll
            for (int it = 0; it < 8; ++it) { const v4u kv = *(const v4u*)(kbase + (size_t)(kq + 32 * it) * BW); const unsigned kw[4] = {kv.x, kv.y, kv.z, kv.w};
#pragma unroll
                for (int j = 0; j < 4; ++j) { sacc[2 * j] += __uint_as_float(kw[j] << 16); sacc[2 * j + 1] += __uint_as_float(kw[j] & 0xffff0000u); } }
#pragma unroll
            for (int j = 0; j < 8; ++j) lds[kq * 128 + d8 + j] = sacc[j];
            __syncthreads();
            if (tid < 128) { float a = 0.f;
#pragma unroll
                for (int rr = 0; rr < 32; ++rr) a += lds[rr * 128 + tid];
                KMS[(size_t)item * 128 + tid] = a; }
            __syncthreads();
        }
        {
            const float* mu = rwkv_mu + l * RWKV_COLS;
            for (int i0 = gt; i0 < (T / 4) * 256; i0 += 2 * NGT) {
                v2u row[2][5]; f32x4 mu4[2]; int tq[2], cc[2];
#pragma unroll
                for (int u_ = 0; u_ < 2; ++u_) {
                    const int i = i0 + u_ * NGT, ic = i < (T / 4) * 256 ? i : gt;
                    const int q = ic / 256, c4 = 2048 + (ic - q * 256) * 4, t0 = 4 * q, s0 = t0 & (SEQ - 1);
                    tq[u_] = i < (T / 4) * 256 ? t0 : -1; cc[u_] = c4;
                    const bf16* pr = PROJ + (size_t)t0 * PLD + (OFF_RWKV - PSH) + c4;
                    row[u_][0] = *(const v2u*)(s0 > 0 ? pr - PLD : pr);
                    if (s0 == 0) row[u_][0] = (v2u){0u, 0u};
#pragma unroll
                    for (int k = 0; k < 4; ++k) row[u_][k + 1] = *(const v2u*)(pr + (size_t)k * PLD);
                    mu4[u_] = *(const f32x4*)(mu + c4);
                }
#pragma unroll
                for (int u_ = 0; u_ < 2; ++u_) if (tq[u_] >= 0) {
                    float* dst = Vcur + (size_t)tq[u_] * BW + (cc[u_] & 1023);
#pragma unroll
                    for (int k = 0; k < 4; ++k) { const f32x4 cu = bf4_to_f32(row[u_][k + 1]), pv = bf4_to_f32(row[u_][k]); *(f32x4*)(dst + (size_t)k * BW) = cu + (pv - cu) * mu4[u_]; }
                }
            }
            for (int i = gt; i < T * 96; i += NGT) {
                const int t = i / 96, c4 = (i - t * 96) * 4, s = t & (SEQ - 1);
                f32x4 v = {0.f, 0.f, 0.f, 0.f};
                if (c4 < 288) {
                    const f32x4 cur = bf4_to_f32(*(const v2u*)(PROJ + (size_t)t * PLD + (OFF_RWKV - PSH) + 3072 + c4));
                    f32x4 prev = {0.f, 0.f, 0.f, 0.f}; if (s > 0) prev = bf4_to_f32(*(const v2u*)(PROJ + (size_t)(t - 1) * PLD + (OFF_RWKV - PSH) + 3072 + c4));
                    v = cur + (prev - cur) * *(const f32x4*)(mu + 3072 + c4);
                    if (c4 < 64) { v[0] = tanhf(v[0]); v[1] = tanhf(v[1]); v[2] = tanhf(v[2]); v[3] = tanhf(v[3]); }
                    else if (c4 >= 128) { v[0] = sigmoidf_(v[0]); v[1] = sigmoidf_(v[1]); v[2] = sigmoidf_(v[2]); v[3] = sigmoidf_(v[3]); }
                } else if (c4 < 320 && l == 1) {
                    const f32x4 cur = *(const f32x4*)(VRES + (size_t)t * 32 + (c4 - 288));
                    f32x4 prev = {0.f, 0.f, 0.f, 0.f}; if (s > 0) prev = *(const f32x4*)(VRES + (size_t)(t - 1) * 32 + (c4 - 288));
                    v = cur + (prev - cur) * *(const f32x4*)(rwkv_mu_vres + (c4 - 288));
                }
                v2u o; o.x = pk2(v[0], v[1]); o.y = pk2(v[2], v[3]); *(v2u*)(LA + (size_t)t * 384 + c4) = o;
            }
        }
        for (int t = gw; t < T; t += NGW) {
            const bf16* q = PROJ + (size_t)t * PLD + (OFF_MLA - PSH);
#pragma unroll
            for (int part = 0; part < 2; ++part) {
                const v4u qw = *(const v4u*)(q + part * 512 + lane * 8); v2u qlo, qhi; qlo.x = qw.x; qlo.y = qw.y; qhi.x = qw.z; qhi.y = qw.w;
                const f32x4 a = bf4_to_f32(qlo), b2 = bf4_to_f32(qhi);
                const float ss = (a[0] * a[0] + a[1] * a[1]) + (a[2] * a[2] + a[3] * a[3]) + (b2[0] * b2[0] + b2[1] * b2[1]) + (b2[2] * b2[2] + b2[3] * b2[3]);
                const float rs = rsqrtf(wave_sum(ss, lane) * (1.0f / 512.0f) + 1e-6f);
                const float* gn = (part ? mla_kv_norm : mla_q_norm) + l * 512 + lane * 8;
                const f32x4 g0 = *(const f32x4*)gn, g1 = *(const f32x4*)(gn + 4);
                v4u w; w.x = pk2(a[0] * rs * g0[0], a[1] * rs * g0[1]); w.y = pk2(a[2] * rs * g0[2], a[3] * rs * g0[3]);
                w.z = pk2(b2[0] * rs * g1[0], b2[1] * rs * g1[1]); w.w = pk2(b2[2] * rs * g1[2], b2[3] * rs * g1[3]);
                *(v4u*)((part ? KVNB : QNB) + (size_t)t * 512 + lane * 8) = w;
            }
            if (lane < 32) {
                const int s = t & (SEQ - 1);
                const float x1 = __builtin_bit_cast(float, (unsigned)q[1024 + lane] << 16), x2 = __builtin_bit_cast(float, (unsigned)q[1024 + 32 + lane] << 16), c = COSM[s * 32 + lane], sn = SINM[s * 32 + lane];
                const bf16 o1 = (bf16)f2bf(x1 * c - x2 * sn), o2 = (bf16)f2bf(x2 * c + x1 * sn);
#pragma unroll
                for (int hh = 0; hh < 8; ++hh) { KCB[(size_t)t * 1536 + hh * 192 + 128 + lane] = o1; KCB[(size_t)t * 1536 + hh * 192 + 160 + lane] = o2; }
            }
        }
        GRID_BAR();
        }
        if (RUN(2)) {
        {
            pg8::Gemm g{LA, WLORA + (size_t)l * 4096 * 384, T, l ? 4096 : 3072, 384 + zero_live}; pg8::StaticOrder S; S.init(T, l ? 4096 : 3072, G_live, (int)blockIdx.x);
            EpiLora E{DEC, AA, GG, V1, V0, rwkv_w0 + l * BW, rwkv_a0 + l * BW, rwkv_v0};
            pg8::gemm_phase<EpiLora, pg8::StaticOrder, false>((LAS unsigned char*)lds_raw, g, S, E, nullptr, tid);
        }
        REOPAQUE();
        {
            pg8::Gemm g{QNB, WUQ + (size_t)l * 1536 * 512, T, 1536, 512 + zero_live}; pg8::StaticOrder S; S.init(T, 1536, G_live, (int)blockIdx.x);
            EpiMlaQ E{QCB, COSM, SINM};
            pg8::gemm_phase<EpiMlaQ, pg8::StaticOrder, false>((LAS unsigned char*)lds_raw, g, S, E, nullptr, tid);
        }
        REOPAQUE();
        {
            pg8::Gemm g{KVNB, WUKV + (size_t)l * 2048 * 512, T, 2048, 512 + zero_live}; pg8::StaticOrder S; S.init(T, 2048, G_live, (int)blockIdx.x);
            EpiMlaKV E{KCB, VCB};
            pg8::gemm_phase<EpiMlaKV, pg8::StaticOrder, false>((LAS unsigned char*)lds_raw, g, S, E, nullptr, tid);
        }
        REOPAQUE();
        for (int i = gt; i < T * 8 * 16; i += NGT) {
            const int th = i >> 4, jg = (i & 15) * 4, t = th >> 3, h = th & 7, s = t & (SEQ - 1), own = s >> 8;
            const float* src_ = QF + (size_t)t * BW + h * 128 + jg;
            const f32x4 q1 = *(const f32x4*)src_, q2 = *(const f32x4*)(src_ + 64);
            v2u w1; w1.x = pk2(q1[0], q1[1]); w1.y = pk2(q1[2], q1[3]); v2u w2; w2.x = pk2(q2[0], q2[1]); w2.y = pk2(q2[2], q2[3]);
            *(v2u*)(QAB + (size_t)t * BW + h * 128 + jg) = w1; *(v2u*)(QAB + (size_t)t * BW + h * 128 + 64 + jg) = w2;
            const float* km = KMS + (size_t)(((t >> 11) * 8 + h) * 8) * 128 + jg;
            float gate[7];
#pragma unroll
            for (int n = 0; n < 7; ++n) {
                const f32x4 k1 = *(const f32x4*)(km + n * 128), k2 = *(const f32x4*)(km + n * 128 + 64);
                const float part = ((q1[0] * k1[0] + q1[1] * k1[1]) + (q1[2] * k1[2] + q1[3] * k1[3])) + ((q2[0] * k2[0] + q2[1] * k2[1]) + (q2[2] * k2[2] + q2[3] * k2[3]));
                gate[n] = row_allsum16(part);
            }
            unsigned bits = 0;
#pragma unroll
            for (int n = 0; n < 7; ++n) {
                int rank = 0;
#pragma unroll
                for (int m2 = 0; m2 < 7; ++m2) if (m2 != n) rank += (m2 < own && (gate[m2] > gate[n] || (gate[m2] == gate[n] && m2 < n))) ? 1 : 0;
                bits |= ((n < own) && (rank < 3)) ? (1u << n) : 0u;
            }
            if ((i & 15) == 0) SELB[(size_t)t * 8 + h] = (unsigned char)bits;
        }
        {
            LAS float* scr = (LAS float*)((LAS unsigned char*)lds_raw) + wave * (64 * 33);
            __syncthreads();
            PHASE_DONE(l * 4 + 2);
            DQ_FILL(l * 4 + 2, l == 0 ? 129 : 65);
        }
        GRID_BAR();
        }
        if (RUN(3)) {
        if (!(mask_live & (1u << 30)))
        for (int item = blockIdx.x; item < 128; item += G_live) {
            const int bh = item >> 1, half = item & 1, b = bh >> 4, h = bh & 15;
            const size_t base = (size_t)b * SEQ * BW + h * 64;
            constexpr int CH = 32, BUFF = 6 * CH * 64;
            LAS float* ypart = lds + 2 * BUFF;
            const int st_step = tid >> 4, st_j = (tid & 15) * 4;
            const int cbase = l * BW + h * 64 + st_j;
            const f32x4 ckk = *(const f32x4*)(rwkv_k_k + cbase), cka = *(const f32x4*)(rwkv_k_a + cbase);
            const int cg = lane & 15, rl = tid >> 4, irow = 32 * half + rl;
            const bool stager = tid < CH * 16;
            f32x4 g_w = {0.f, 0.f, 0.f, 0.f}, g_v = g_w; v2u g_ab = {0u, 0u};
            v2u g_rc = {0u, 0u}, g_rp = g_rc, g_kc = g_rc, g_kp = g_rc; int g_s = 0;
            const f32x4 mur = *(const f32x4*)(rwkv_mu + l * RWKV_COLS + h * 64 + st_j), muk = *(const f32x4*)(rwkv_mu + l * RWKV_COLS + 1024 + h * 64 + st_j);
            const bf16* pbase = PROJ + (size_t)b * SEQ * PLD + (OFF_RWKV - PSH) + h * 64 + st_j;
            float sa = 0.f, sb = 0.f, sc2 = 0.f, sd = 0.f;
#define SC_GLOAD(c) do { if (stager) { const size_t o_ = base + (size_t)((c) * CH + st_step) * BW + st_j; \
                g_s = (c) * CH + st_step; const bf16* pk_ = pbase + (size_t)g_s * PLD; \
                g_kc = *(const v2u*)(pk_ + 1024); g_kp = *(const v2u*)(pk_ - (g_s > 0 ? PLD : 0) + 1024); \
                g_rc = *(const v2u*)(pk_ - (g_s > 0 ? PLD : 0)); g_rp = *(const v2u*)(pk_ - (g_s > 1 ? 2 * PLD : 0)); \
                g_w = *(const f32x4*)(DEC + o_); g_ab = *(const v2u*)(AA + o_); g_v = *(const f32x4*)(Vcur + o_); } } while (0)
#define SC_LSTORE(bufi) do { if (stager) { \
                const f32x4 kc_ = bf4_to_f32(g_kc), rc_ = bf4_to_f32(g_rc); f32x4 kp_ = bf4_to_f32(g_kp), rp_ = bf4_to_f32(g_rp); \
                if (g_s == 0) kp_ = (f32x4){0.f, 0.f, 0.f, 0.f}; if (g_s <= 1) rp_ = (f32x4){0.f, 0.f, 0.f, 0.f}; \
                const f32x4 g_k = kc_ + (kp_ - kc_) * muk, g_r = rc_ + (rp_ - rc_) * mur, g_a = bf4_to_f32(g_ab); \
                f32x4 kk_ = g_k * ckk; \
                const float n2_ = row_allsum16((kk_[0] * kk_[0] + kk_[1] * kk_[1]) + (kk_[2] * kk_[2] + kk_[3] * kk_[3])); \
                kk_ = kk_ * __builtin_amdgcn_rcpf(fmaxf(sqrtf(n2_), 1e-12f)); \
                const f32x4 k2_ = g_k * (1.0f + (g_a - 1.0f) * cka); \
                LAS float* bb_ = lds + (bufi) * BUFF + st_step * 64 + st_j; \
                *(LAS f32x4*)(bb_ + 0 * CH * 64) = g_r; *(LAS f32x4*)(bb_ + 1 * CH * 64) = g_w; *(LAS f32x4*)(bb_ + 2 * CH * 64) = k2_; \
                *(LAS f32x4*)(bb_ + 3 * CH * 64) = kk_; *(LAS f32x4*)(bb_ + 4 * CH * 64) = kk_ * g_a; *(LAS f32x4*)(bb_ + 5 * CH * 64) = g_v; } } while (0)
#define SC_LD(X, st_) do { const LAS float* p_ = bb + (st_) * 64 + 4 * cg; \
                X##r = *(const LAS f32x4*)(p_ + 0 * CH * 64); X##w = *(const LAS f32x4*)(p_ + 1 * CH * 64); X##k = *(const LAS f32x4*)(p_ + 2 * CH * 64); \
                X##q = *(const LAS f32x4*)(p_ + 3 * CH * 64); X##b = *(const LAS f32x4*)(p_ + 4 * CH * 64); X##v = bb[5 * CH * 64 + (st_) * 64 + irow]; } while (0)
#define SC_STEP(X, st_) do { float d_, y_, t0_, t1_, t2_, t3_; \
                asm("v_mul_f32 %0, %4, %8\n\tv_mul_f32 %1, %4, %12\n\tv_mul_f32 %2, %6, %10\n\tv_mul_f32 %3, %6, %14\n\t" \
                    "v_fma_f32 %0, %5, %9, %0\n\tv_fma_f32 %1, %5, %13, %1\n\tv_fma_f32 %2, %7, %11, %2\n\tv_fma_f32 %3, %7, %15, %3\n\t" \
                    "v_add_f32 %0, %0, %2\n\tv_add_f32 %1, %1, %3" \
                    : "=&v"(d_), "=&v"(y_), "=&v"(t0_), "=&v"(t1_) \
                    : "v"(sa), "v"(sb), "v"(sc2), "v"(sd), "v"(X##q[0]), "v"(X##q[1]), "v"(X##q[2]), "v"(X##q[3]), "v"(X##r[0]), "v"(X##r[1]), "v"(X##r[2]), "v"(X##r[3])); \
                asm("s_nop 1\n\tv_add_f32_dpp %0, %0, %0 quad_perm:[1,0,3,2] row_mask:0xf bank_mask:0xf bound_ctrl:1\n\ts_nop 1\n\t" \
                    "v_add_f32_dpp %0, %0, %0 quad_perm:[2,3,0,1] row_mask:0xf bank_mask:0xf bound_ctrl:1" : "+v"(y_)); \
                ypart[(st_) * 128 + rl * 4 + (cg >> 2)] = y_;     \
                asm("v_mul_f32 %5, %9, %10\n\tv_mul_f32 %6, %9, %11\n\t" \
                    "v_add_f32_dpp %0, %0, %0 row_ror:8 row_mask:0xf bank_mask:0xf bound_ctrl:1\n\t" \
                    "v_mul_f32 %7, %9, %12\n\tv_mul_f32 %8, %9, %13\n\t" \
                    "v_add_f32_dpp %0, %0, %0 row_ror:4 row_mask:0xf bank_mask:0xf bound_ctrl:1\n\t" \
                    "v_fma_f32 %5, %1, %14, %5\n\tv_fma_f32 %6, %2, %15, %6\n\t" \
                    "v_add_f32_dpp %0, %0, %0 row_ror:2 row_mask:0xf bank_mask:0xf bound_ctrl:1\n\t" \
                    "v_fma_f32 %7, %3, %16, %7\n\tv_fma_f32 %8, %4, %17, %8\n\t" \
                    "v_add_f32_dpp %0, %0, %0 row_ror:1 row_mask:0xf bank_mask:0xf bound_ctrl:1\n\t" \
                    "s_nop 1\n\t" \
                    "v_fma_f32 %1, -%0, %18, %5\n\tv_fma_f32 %2, -%0, %19, %6\n\tv_fma_f32 %3, -%0, %20, %7\n\tv_fma_f32 %4, -%0, %21, %8" \
                    : "+v"(d_), "+v"(sa), "+v"(sb), "+v"(sc2), "+v"(sd), "=&v"(t0_), "=&v"(t1_), "=&v"(t2_), "=&v"(t3_) \
                    : "v"(X##v), "v"(X##k[0]), "v"(X##k[1]), "v"(X##k[2]), "v"(X##k[3]), "v"(X##w[0]), "v"(X##w[1]), "v"(X##w[2]), "v"(X##w[3]), \
                      "v"(X##b[0]), "v"(X##b[1]), "v"(X##b[2]), "v"(X##b[3])); } while (0)
            SC_GLOAD(0); SC_LSTORE(0);
            __syncthreads();
            for (int c = 0; c < SEQ / CH; ++c) {
                const bool more = (c + 1) < SEQ / CH;
                if (c == SEQ / CH - 2 && tid == 0) atomicAdd(ctl + CW_SD + 64 * (l + 2 * li_), 1u);
                if (more) SC_GLOAD(c + 1);
                const LAS float* bb = lds + (c & 1) * BUFF;
                f32x4 Ar, Aw, Ak, Aq, Ab, Br, Bw, Bk, Bq, Bb; float Av, Bv;
                SC_LD(A, 0);
#pragma unroll 1
                for (int st = 0; st < CH; st += 2) {
                    SC_LD(B, st + 1);
                    SC_STEP(A, st);
                    if (st + 2 < CH) SC_LD(A, st + 2);
                    SC_STEP(B, st + 1);
                }
                __syncthreads();
                {
                    const int stp = tid >> 4, r2 = (tid & 15) * 2;
                    const LAS f32x4* pp = (const LAS f32x4*)(ypart + stp * 128 + r2 * 4);
                    const f32x4 a0 = pp[0], a1 = pp[1];
                    if (c * CH + stp > 0) { bf16* yo = Y + base + (size_t)(c * CH + stp - 1) * BW + 32 * half + r2;
                        *(unsigned*)yo = pk2((a0[0] + a0[1]) + (a0[2] + a0[3]), (a1[0] + a1[1]) + (a1[2] + a1[3])); }
                }
                if (more) SC_LSTORE((c + 1) & 1);
                __syncthreads();
            }
            {
                const bf16* pl_ = PROJ + ((size_t)b * SEQ + SEQ - 1) * PLD + (OFF_RWKV - PSH) + h * 64 + 4 * cg;
                const f32x4 rcl = bf4_to_f32(*(const v2u*)pl_), rpl = bf4_to_f32(*(const v2u*)(pl_ - PLD));
                const f32x4 rl4 = rcl + (rpl - rcl) * *(const f32x4*)(rwkv_mu + l * RWKV_COLS + h * 64 + 4 * cg);
                const float yl = row_allsum16((sa * rl4[0] + sb * rl4[1]) + (sc2 * rl4[2] + sd * rl4[3]));
                if (cg == 0) Y[base + (size_t)(SEQ - 1) * BW + irow] = (bf16)f2bf(yl);
            }
#undef SC_GLOAD
#undef SC_LSTORE
#undef SC_LD
#undef SC_STEP
        }
        if (!(mask_live & (1u << 29)))
        for (;;) {
            if (tid == 0) misc[4] = atomicAdd(ctl + CW_AQ + 64 * (l + 2 * li_), 1u);
            __syncthreads();
            const unsigned u = misc[4];
            __syncthreads();
            if (u >= 1024u) break;
            const int qt = 15 - (int)(u >> 6), kind = (u >> 5) & 1, b = (u >> 3) & 3, h = u & 7;
            const size_t r0 = (size_t)b * SEQ;
            if (kind == 0)
                attn_unit<128, true>((LAS unsigned char*)lds_raw, QAB + r0 * BW + h * 128, BW, KAB + r0 * BW + h * 128, BW, VAB + r0 * BW + h * 128, BW,
                                     YALL + r0 * (3 * BW) + h * 128, 3 * BW, SELB + r0 * 8 + h, qt, 0.08838834764831845f * 1.4426950408889634f, tid);
            else
                attn_unit<192, false>((LAS unsigned char*)lds_raw, QCB + r0 * 1536 + h * 192, 1536, KCB + r0 * 1536 + h * 192, 1536, VCB + r0 * BW + h * 128, BW,
                                      YALL + r0 * (3 * BW) + 2 * BW + h * 128, 3 * BW, nullptr, qt, 0.07216878364870323f * 1.4426950408889634f, tid);
        }
        {
            LAS float* scr = (LAS float*)((LAS unsigned char*)lds_raw) + wave * (64 * 33);
            const unsigned ncu = (unsigned)(FFN_CONV_N(l) / 32);
            DQ_RUN(xb_ld(ctl + CW_SD + 64 * (l + 2 * li_)) < 128u && xb_ld(ctl + CW_DQ + 64 * li_) < (unsigned)(l == 0 ? DQ_J3 : DQ_J6));
            for (;;) {
                if (tid == 0) {
                    unsigned u_ = 0xffffffffu;
                    if (xb_ld(ctl + CW_SD + 64 * (l + 2 * li_)) < 128u) u_ = atomicAdd(ctl + CW_CQ + 64 * (l + 2 * li_), 1u);
                    misc[4] = u_;
                }
                __syncthreads();
                const unsigned u = (unsigned)__builtin_amdgcn_readfirstlane((int)misc[4]);
                __syncthreads();
                if (u >= ncu) break;
#pragma unroll 1
                for (int k_ = 0; k_ < 2; ++k_) { const int it = (int)u * 32 + k_ * 16 + 2 * wave; FFN_CONV_PAIR(it); }
            }
            DQ_FLUSH(l == 0 ? DQ_J3 : DQ_J6);
        }
        GRID_BAR();
        {
            const int pc = l * BW + (gt & 255) * 4;
            const f32x4 p_g = *(const f32x4*)(rwkv_gn_g + pc), p_b = *(const f32x4*)(rwkv_gn_b + pc), p_ka = *(const f32x4*)(rwkv_k_a + pc), p_rk = *(const f32x4*)(rwkv_r_k + pc);
            const bf16* pY = Y; const bf16* pA = AA; const float* pV = Vcur; const bf16* pG = GG; bf16* pO = YALL + BW;
            const bf16* pP = PROJ + (OFF_RWKV - PSH) + (gt & 255) * 4;
            const f32x4 p_mr = *(const f32x4*)(rwkv_mu + l * RWKV_COLS + (gt & 255) * 4), p_mk = *(const f32x4*)(rwkv_mu + l * RWKV_COLS + 1024 + (gt & 255) * 4);
            for (int i0 = gt; i0 < T * 16 * 16; i0 += 4 * NGT) {
                f32x4 y[4], aa[4], vv[4], gg[4]; v2u rc[4], rp[4], kc[4], kp[4], yb[4], ab[4], gb[4];
#pragma unroll
                for (int u_ = 0; u_ < 4; ++u_) { const int i = i0 + u_ * NGT, ic = i < T * 256 ? i : gt; const size_t o = (size_t)(ic >> 8) * BW + (ic & 255) * 4;
                    const bf16* pp = pP + (size_t)(ic >> 8) * PLD; const int back = ((ic >> 8) & (SEQ - 1)) > 0 ? PLD : 0;
                    yb[u_] = *(const v2u*)(pY + o); ab[u_] = *(const v2u*)(pA + o); vv[u_] = *(const f32x4*)(pV + o); gb[u_] = *(const v2u*)(pG + o);
                    rc[u_] = *(const v2u*)pp; rp[u_] = *(const v2u*)(pp - back); kc[u_] = *(const v2u*)(pp + 1024); kp[u_] = *(const v2u*)(pp - back + 1024); }
#pragma unroll
                for (int u_ = 0; u_ < 4; ++u_) { const int i = i0 + u_ * NGT;
                    y[u_] = bf4_to_f32(yb[u_]); aa[u_] = bf4_to_f32(ab[u_]); gg[u_] = bf4_to_f32(gb[u_]);
                    f32x4 kr, rr;
                    { const bool first = (((i < T * 256 ? i : gt) >> 8) & (SEQ - 1)) == 0; const f32x4 z4 = {0.f, 0.f, 0.f, 0.f};
                      const f32x4 rcf = bf4_to_f32(rc[u_]), kcf = bf4_to_f32(kc[u_]), rpf = first ? z4 : bf4_to_f32(rp[u_]), kpf = first ? z4 : bf4_to_f32(kp[u_]);
                      rr = rcf + (rpf - rcf) * p_mr; kr = kcf + (kpf - kcf) * p_mk; }
                    const float mu = row_allsum16((y[u_][0] + y[u_][1]) + (y[u_][2] + y[u_][3])) * (1.0f / 64.0f);
                    const f32x4 d = y[u_] - mu;
                    const float var = row_allsum16((d[0] * d[0] + d[1] * d[1]) + (d[2] * d[2] + d[3] * d[3])) * (1.0f / 64.0f);
                    const f32x4 yn = d * rsqrtf(var + 64e-5f) * p_g + p_b;
                    const f32x4 k2 = kr * (1.0f + (aa[u_] - 1.0f) * p_ka);
                    const f32x4 rk = rr * k2 * p_rk;
                    const float bon = row_allsum16((rk[0] + rk[1]) + (rk[2] + rk[3]));
                    const f32x4 o4 = (yn + bon * vv[u_]) * gg[u_];
                    v2u ob; ob.x = pk2(o4[0], o4[1]); ob.y = pk2(o4[2], o4[3]);
                    if (i < T * 256) *(v2u*)(pO + (size_t)(i >> 8) * (3 * BW) + (i & 255) * 4) = ob;
                }
            }
        }
        GRID_BAR();
        }
        if (RUN(4)) {
        {
            pg8::StaticOrder S; S.init(T, D, G_live, (int)blockIdx.x);
            pg8::Gemm g{YALL, WBO + (size_t)l * D * 3 * BW, T, D, 3 * BW}; EpiBranch3 E{MIXB, GATEB};
            pg8::gemm_phase<EpiBranch3, pg8::StaticOrder, false>((LAS unsigned char*)lds_raw, g, S, E, nullptr, tid);
        }
        GRID_BAR();
        }
        if (RUN(5)) {
        {
            pg8::Gemm g{MIXB, WOT + (size_t)l * D * D, T, D, D}; pg8::StaticOrder S; S.init(T, D, G_live, (int)blockIdx.x);
            EpiResidF32 E{PRE, X};
            pg8::gemm_phase<EpiResidF32, pg8::StaticOrder, false>((LAS unsigned char*)lds_raw, g, S, E, nullptr, tid);
        }
        GRID_BAR();
        }
        if (RUN(6)) {
        {
            LAS float* scr = (LAS float*)((LAS unsigned char*)lds_raw) + wave * (64 * 33);
            const int ntot = FFN_CONV_N(l);
            const int ndone = (int)min(xb_ld(ctl + CW_CQ + 64 * (l + 2 * li_)), (unsigned)(ntot / 32)) * 32;
            for (int it = ndone + 2 * gw; it < ntot; it += 2 * NGW) FFN_CONV_PAIR(it);
            if (l == 1) DQ_FLUSH(DQ_J7);
        }
        for (int t = gw; t < T; t += NGW) {
            const float* pr = PRE + (size_t)t * D;
            f32x4 v[8]; float s = 0.f;
#pragma unroll
            for (int jj = 0; jj < 8; ++jj) { v[jj] = *(const f32x4*)(pr + jj * 256 + lane * 4); s += (v[jj][0] + v[jj][1]) + (v[jj][2] + v[jj][3]); }
            const float mean = wave_sum(s, lane) * (1.0f / D); float s2 = 0.f;
#pragma unroll
            for (int jj = 0; jj < 8; ++jj) { v[jj] = v[jj] - mean; s2 += (v[jj][0] * v[jj][0] + v[jj][1] * v[jj][1]) + (v[jj][2] * v[jj][2] + v[jj][3] * v[jj][3]); }
            const float rstd = rsqrtf(wave_sum(s2, lane) * (1.0f / D) + 1e-5f);
#pragma unroll
            for (int jj = 0; jj < 8; ++jj) {
                const f32x4 g = *(const f32x4*)(ln1_g + l * D + jj * 256 + lane * 4), bb = *(const f32x4*)(ln1_b + l * D + jj * 256 + lane * 4);
                v[jj] = v[jj] * rstd * g + bb;
                *(f32x4*)(X1 + (size_t)t * D + jj * 256 + lane * 4) = v[jj];
                v2u ob; ob.x = pk2(v[jj][0], v[jj][1]); ob.y = pk2(v[jj][2], v[jj][3]); *(v2u*)(X1B + (size_t)t * D + jj * 256 + lane * 4) = ob;
            }
            if (l == 1) {
                float lg[8];
#pragma unroll
                for (int e = 0; e < 8; ++e) lg[e] = 0.f;
#pragma unroll
                for (int jj = 0; jj < 8; ++jj)
#pragma unroll
                    for (int cc = 0; cc < 4; ++cc) {
                        const int d = jj * 256 + lane * 4 + cc;
                        const f32x4 r0 = *(const f32x4*)(moe_router + (size_t)d * 8), r1 = *(const f32x4*)(moe_router + (size_t)d * 8 + 4);
                        const float xv = v[jj][cc];
                        lg[0] += xv * r0[0]; lg[1] += xv * r0[1]; lg[2] += xv * r0[2]; lg[3] += xv * r0[3];
                        lg[4] += xv * r1[0]; lg[5] += xv * r1[1]; lg[6] += xv * r1[2]; lg[7] += xv * r1[3];
                    }
#pragma unroll
                for (int e = 0; e < 8; ++e) lg[e] = wave_sum(lg[e], lane);
                if (lane == 0) {
                    int e0 = 0; float b0 = lg[0];
#pragma unroll
                    for (int e = 1; e < 8; ++e) if (lg[e] > b0) { b0 = lg[e]; e0 = e; }
                    int e1 = -1; float b1 = -INFINITY;
#pragma unroll
                    for (int e = 0; e < 8; ++e) if (e != e0 && lg[e] > b1) { b1 = lg[e]; e1 = e; }
                    const float w1 = 1.0f / (1.0f + expf(b0 - b1)), w0 = 1.0f - w1;
                    const int p0 = (int)atomicAdd(ctl + CW_CNT + 64 * e0, 1u), p1 = (int)atomicAdd(ctl + CW_CNT + 64 * e1, 1u);
                    int* tk = TOK + (size_t)t * 8;
                    tk[0] = e0; tk[1] = e1; tk[2] = p0; tk[3] = p1; tk[4] = __float_as_int(w0); tk[5] = __float_as_int(w1);
                }
            }
        }
        GRID_BAR();
        }
        float* OUTX = (l == 0) ? XB : (float*)(*(GAS float* const*)&args.out);
        if (l == 0) {
            if (RUN(7)) {
                pg8::Gemm g{X1B, WGU, T, NGU, D}; pg8::StaticOrder S; S.init(T, NGU, G_live, (int)blockIdx.x);
                EpiSwigluBf16 E{HGB, NGU / 256};
                pg8::gemm_phase<EpiSwigluBf16, pg8::StaticOrder, false>((LAS unsigned char*)lds_raw, g, S, E, nullptr, tid);
                REOPAQUE();
                {
                    LAS float* scr = (LAS float*)((LAS unsigned char*)lds_raw) + wave * (64 * 33);
                    PHASE_DONE(1);
                    DQ_FILL(1, 129);
                }
                GRID_BAR();
            }
            if (RUN(8)) {
                pg8::Gemm g{HGB, WDD, T, D, DFF}; pg8::StaticOrder S; S.init(T, D, G_live, (int)blockIdx.x);
                EpiResidF32 E{PRE, X1};
                pg8::gemm_phase<EpiResidF32, pg8::StaticOrder, false>((LAS unsigned char*)lds_raw, g, S, E, nullptr, tid);
                GRID_BAR();
            }
        } else {
            if (RUN(10)) {
            unsigned poff[9]; poff[0] = 0;
#pragma unroll
            for (int e = 0; e < 8; ++e) poff[e + 1] = poff[e] + ((xb_ld(ctl + CW_CNT + 64 * e) + 255u) & ~255u);
            for (int t = gw; t < T; t += NGW) {
                int* tk = TOK + (size_t)t * 8;
                const int e0 = tk[0], e1 = tk[1];
                unsigned o0 = 0, o1 = 0;
#pragma unroll
                for (int e = 0; e < 8; ++e) { o0 = (e == e0) ? poff[e] : o0; o1 = (e == e1) ? poff[e] : o1; }
                const int s0 = (int)o0 + tk[2], s1 = (int)o1 + tk[3];
                if (lane == 0) { tk[6] = s0; tk[7] = s1; }
#pragma unroll
                for (int j = 0; j < 4; ++j) { const v4u xv = *(const v4u*)(X1B + (size_t)t * D + j * 512 + lane * 8);
                    *(v4u*)(XG + (size_t)s0 * D + j * 512 + lane * 8) = xv; *(v4u*)(XG + (size_t)s1 * D + j * 512 + lane * 8) = xv; }
            }
            if (blockIdx.x == 0 && tid < 80) {
                unsigned e_of = 0; const unsigned mt = tid;
#pragma unroll
                for (int e = 1; e < 8; ++e) e_of += (mt * 256u >= poff[e]) ? 1u : 0u;
                ctl[CW_TILE + tid] = e_of;
                if (tid == 0) ctl[CW_TILE - 1] = poff[8] / 256u;
            }
            {
                const unsigned nmt_ = poff[8] / 256u, nfull_ = (nmt_ / 32u) * 32u; const size_t z0 = (size_t)nfull_ * 256 * D / 4, z1 = (size_t)nmt_ * 256 * D / 4;
                for (size_t i = z0 + gt; i < z1; i += NGT) *(f32x4*)(OUT + i * 4) = (f32x4){0.f, 0.f, 0.f, 0.f};
            }
            GRID_BAR();
            }
            const int nMt = (int)ctl[CW_TILE - 1];
            if (RUN(7)) {
                pg8::Gemm g{XG, WGU, MOE_ROWS, NGU, D}; MoeOrder S{ctl + CW_TILE, nMt, NGU / 256, G_live, (int)blockIdx.x};
                EpiSwigluBf16 E{HGB, NGU / 256};
                pg8::gemm_phase<EpiSwigluBf16, MoeOrder, false>((LAS unsigned char*)lds_raw, g, S, E, nullptr, tid);
                REOPAQUE();
                {
                    LAS float* scr = (LAS float*)((LAS unsigned char*)lds_raw) + wave * (64 * 33);
                    const int rem_ = ((int)ctl[CW_TILE - 1] * (NGU / 256)) % G_live;
                    PHASE_DONE(5);
                    DQ_FILL(5, (rem_ ? G_live - rem_ : 0) + 1);
                    DQ_FLUSH(DQ_N);
                }
                GRID_BAR();
            }
            if (RUN(8)) {
                const int nFull = (nMt / 32) * 32;
                { pg8::Gemm g{HGB, WD, MOE_ROWS, D, DFF}; MoeOrder S{ctl + CW_TILE, nFull, D / 256, G_live, (int)blockIdx.x};
                  EpiStoreF32 E{OUT, D / 256};
                  pg8::gemm_phase<EpiStoreF32, MoeOrder, false>((LAS unsigned char*)lds_raw, g, S, E, nullptr, tid); }
                REOPAQUE();
                { pg8::Gemm g{HGB, WD, MOE_ROWS, D, DFF / 4 + zero_live, DFF}; MoeOrder S{ctl + CW_TILE, nMt - nFull, D / 256, G_live, (int)blockIdx.x, nFull, 4, (DFF / 4) * 2};
                  EpiAtomicF32 E{OUT, D / 256};
                  pg8::gemm_phase<EpiAtomicF32, MoeOrder, false>((LAS unsigned char*)lds_raw, g, S, E, nullptr, tid); }
                GRID_BAR();
            }
        }
        if (RUN(9)) {
        if (l == 0) { LAS float* scr = (LAS float*)((LAS unsigned char*)lds_raw) + wave * (64 * 33); DQ_FLUSH(DQ_J4); }
        for (int t = gw; t < T; t += NGW) {
            f32x4 v[8]; float s = 0.f;
            if (l == 0) {
#pragma unroll
                for (int jj = 0; jj < 8; ++jj) v[jj] = *(const f32x4*)(PRE + (size_t)t * D + jj * 256 + lane * 4);
            } else {
                const int* tk = TOK + (size_t)t * 8;
                const float w0 = __int_as_float(tk[4]), w1 = __int_as_float(tk[5]); const int s0 = tk[6], s1 = tk[7];
                const int e0 = tk[0], e1 = tk[1];
#pragma unroll
                for (int jj = 0; jj < 8; ++jj) {
                    const f32x4 xx = *(const f32x4*)(X1 + (size_t)t * D + jj * 256 + lane * 4);
                    const f32x4 a = *(const f32x4*)(OUT + (size_t)s0 * D + jj * 256 + lane * 4), bq = *(const f32x4*)(OUT + (size_t)s1 * D + jj * 256 + lane * 4);
                    const f32x4 f = (e0 < e1) ? (w0 * a + w1 * bq) : (w1 * bq + w0 * a);
                    v[jj] = ALPHA * xx + f;
                }
            }
#pragma unroll
            for (int jj = 0; jj < 8; ++jj) s += (v[jj][0] + v[jj][1]) + (v[jj][2] + v[jj][3]);
            const float mean = wave_sum(s, lane) * (1.0f / D); float s2 = 0.f;
#pragma unroll
            for (int jj = 0; jj < 8; ++jj) { v[jj] = v[jj] - mean; s2 += (v[jj][0] * v[jj][0] + v[jj][1] * v[jj][1]) + (v[jj][2] * v[jj][2] + v[jj][3] * v[jj][3]); }
            const float rstd = rsqrtf(wave_sum(s2, lane) * (1.0f / D) + 1e-5f);
#pragma unroll
            for (int jj = 0; jj < 8; ++jj) {
                const f32x4 g = *(const f32x4*)(ln2_g + l * D + jj * 256 + lane * 4), bb = *(const f32x4*)(ln2_b + l * D + jj * 256 + lane * 4);
                const f32x4 o = v[jj] * rstd * g + bb;
                *(f32x4*)(OUTX + (size_t)t * D + jj * 256 + lane * 4) = o;
                if (l == 0) { v2u ob; ob.x = pk2(o[0], o[1]); ob.y = pk2(o[2], o[3]); *(v2u*)(XBF + (size_t)t * D + jj * 256 + lane * 4) = ob; }
            }
        }
        GRID_BAR();
        }
    }
}

extern "C" void kernel_launch(void* const* d_in, const int* in_sizes, int n_in, void* d_out, int out_size, void* d_ws, size_t ws_size, hipStream_t stream) {
    static int grid = 0;
    if (grid == 0) {
        if (n_in != 34 || out_size != T * D || ws_size < WS_END) { fprintf(stderr, "kernel_launch: bad sizes n_in %d out %d ws %zu need %zu\n", n_in, out_size, ws_size, (size_t)WS_END); grid = -1; return; }
        int dev = 0, cus = 0, per_cu = 0;
        if (hipGetDevice(&dev) != hipSuccess || hipDeviceGetAttribute(&cus, hipDeviceAttributeMultiprocessorCount, dev) != hipSuccess) { grid = -1; return; }
        if (hipFuncSetAttribute((const void*)fwd_kernel, hipFuncAttributeMaxDynamicSharedMemorySize, LDS_BYTES) != hipSuccess) { fprintf(stderr, "hipFuncSetAttribute failed\n"); grid = -1; return; }
        if (hipOccupancyMaxActiveBlocksPerMultiprocessor(&per_cu, (const void*)fwd_kernel, NTHREADS, LDS_BYTES) != hipSuccess || per_cu < 1) fprintf(stderr, "occupancy query says %d\n", per_cu);
        (void)hipGetLastError();
        grid = cus;
    }
    if (grid < 0) return;
    hipMemsetAsync((char*)d_ws + WS_CTL, 0, CTL_BYTES, stream);
    Args a{};
    for (int i = 0; i < 34; ++i) a.in[i] = (const float*)d_in[i];
    a.out = (float*)d_out; a.ws = (unsigned char*)d_ws; a.mask = 0x9FFFFFFFu; a.li = 0;
    hipLaunchKernelGGL(fwd_kernel, dim3(grid), dim3(NTHREADS), LDS_BYTES, stream, a);
#ifdef PROBE_MASK
    a.mask = PROBE_MASK; a.li = 1;
    hipLaunchKernelGGL(fwd_kernel, dim3(grid), dim3(NTHREADS), LDS_BYTES, stream, a);
#endif
}
```

```cpp
#include <hip/hip_runtime.h>
#include <stdint.h>
#include <stdio.h>

constexpr int D = 2048, NBATCH = 4, SEQ = 2048, T = NBATCH * SEQ;
constexpr int BW = 1024;
constexpr int IN_COLS = 13664;
constexpr int OFF_RWKV = 3072, OFF_MLA = 6432, OFF_GATE = 7520;
constexpr int RWKV_COLS = 3360;
constexpr int DFF = 5632, NEXP = 8;
constexpr float ALPHA = 1.41421356237f;
constexpr int NTHREADS = 512, NWAVES = 8;
constexpr int LDS_BYTES = 131072 + 17408 + 512;

#define LAS __attribute__((address_space(3)))
#define GAS __attribute__((address_space(1)))
typedef float f32x16 __attribute__((ext_vector_type(16)));
typedef float f32x4 __attribute__((ext_vector_type(4)));

constexpr size_t MiB = 1u << 20;
constexpr size_t al(size_t x) { return (x + 255) & ~(size_t)255; }
constexpr size_t WS_CTL = 0, CTL_BYTES = 1 * MiB;
constexpr size_t WS_COSA = 1 * MiB;
constexpr size_t WS_SINA = WS_COSA + 2048 * 64 * 4;
constexpr size_t WS_COSM = WS_SINA + 2048 * 64 * 4;
constexpr size_t WS_SINM = WS_COSM + 2048 * 32 * 4;
constexpr size_t WS_TOK = 3 * MiB;
constexpr size_t WS_ROWL = WS_TOK + (size_t)T * 8 * 4;
constexpr size_t WS_XB = 4 * MiB;
constexpr size_t WS_X1 = WS_XB + (size_t)T * D * 4;
constexpr size_t WS_PRE = WS_X1 + (size_t)T * D * 4;
constexpr int NP = 13824;
constexpr size_t WS_XBF = WS_PRE + (size_t)T * D * 4;
constexpr size_t WS_WINT = WS_XBF + (size_t)T * D * 2;
constexpr size_t WS_X1B = WS_WINT + (size_t)2 * NP * D * 2;
constexpr size_t WS_WBO = WS_X1B + (size_t)T * D * 2;
constexpr size_t WS_WOT = WS_WBO + (size_t)6 * D * BW * 2;
constexpr size_t WS_WUQ = WS_WOT + (size_t)2 * D * D * 2;
constexpr size_t WS_WUKV = WS_WUQ + (size_t)2 * 1536 * 512 * 2;
constexpr size_t WS_WLORA = WS_WUKV + (size_t)2 * 2048 * 512 * 2;
constexpr size_t WS_V0 = WS_WLORA + (size_t)2 * 4096 * 384 * 2;
constexpr size_t WS_MIXER = WS_V0 + (size_t)T * BW * 4;
constexpr int MOE_ROWS = 2 * T + NEXP * 256;
constexpr int NGU = 2 * DFF;
constexpr int PLD = 4448, PSH = 3072;
constexpr size_t WS_PROJ = WS_MIXER;
constexpr size_t WS_V1 = al(WS_PROJ + (size_t)T * PLD * 2);
constexpr size_t WS_DEC = WS_V1 + (size_t)T * BW * 4;
constexpr size_t WS_AA = WS_DEC + (size_t)T * BW * 4;
constexpr size_t WS_GG = WS_AA + (size_t)T * BW * 4;
constexpr size_t WS_Y = WS_GG + (size_t)T * BW * 4;
constexpr size_t WS_LA = WS_Y + (size_t)T * BW * 4;
constexpr size_t WS_QNB = WS_LA + (size_t)T * 384 * 2;
constexpr size_t WS_KVNB = WS_QNB + (size_t)T * 512 * 2;
constexpr size_t WS_YALL = WS_KVNB + (size_t)T * 512 * 2;
constexpr size_t WS_GATEB = WS_YALL + (size_t)T * 3 * BW * 2;
constexpr size_t WS_QAB = WS_GATEB + (size_t)T * 3 * D * 2;
constexpr size_t WS_KAB = WS_QAB + (size_t)T * BW * 2;
constexpr size_t WS_VAB = WS_KAB + (size_t)T * BW * 2;
constexpr size_t WS_QCB = WS_VAB + (size_t)T * BW * 2;
constexpr size_t WS_KCB = WS_QCB + (size_t)T * 1536 * 2;
constexpr size_t WS_VCB = WS_KCB + (size_t)T * 1536 * 2;
constexpr size_t WS_MIXB = WS_VCB + (size_t)T * BW * 2;
constexpr size_t WS_L_END = WS_MIXB + (size_t)T * D * 2;
constexpr size_t WS_HGB = WS_MIXER;
constexpr size_t WS_XG = WS_HGB + (size_t)MOE_ROWS * DFF * 2;
constexpr size_t WS_OUT = WS_XG + (size_t)MOE_ROWS * D * 2;
static_assert(WS_OUT + (size_t)MOE_ROWS * D * 4 <= WS_L_END, "FFN activations must stay inside region L");
constexpr size_t WS_WGU = WS_L_END;
constexpr size_t WS_VRES = WS_WGU;
constexpr size_t WS_QF = al(WS_VRES + (size_t)T * 32 * 4);
static_assert(WS_QF + (size_t)T * BW * 4 <= WS_WGU + (size_t)4 * NGU * D * 2, "region P must end inside WGU[0..3]");
constexpr size_t WS_WD = WS_WGU + (size_t)NEXP * NGU * D * 2;
constexpr size_t WS_WDD = WS_WGU + (size_t)NGU * D * 2;
constexpr size_t WS_END = WS_WD + (size_t)NEXP * D * DFF * 2;
constexpr size_t WS_KMEAN = WS_TOK + 512 * 1024;
constexpr size_t WS_SEL = WS_TOK + 768 * 1024;

static_assert(WS_END <= (size_t)1560 * MiB, "ws budget");
constexpr int CW_CNT = 1024;
constexpr int CW_OFF = 2048;
constexpr int CW_AQ = 3072;
constexpr int CW_CQ = 3328;
constexpr int CW_SD = 3584;
constexpr int CQ_ITEMS = 16;
constexpr int CW_DQ = 12288;
constexpr int CW_PD = 12544;
constexpr int DQ_J3 = 5120, DQ_J4 = 18944, DQ_J5 = 20608, DQ_J6 = 25728, DQ_J7 = DQ_J6 + 4 * 11264, DQ_N = DQ_J7 + 8 * 5632;
constexpr int CW_TILE = 2304;
constexpr int CW_BAR = 4096;

#define XB_TMO      128
#define XB_XCNT(j)  (256  + 64 * (j))
#define XB_XSUB(j)  (1280 + 64 * (j))
#define XB_XGEN(j)  (2304 + 64 * (j))
#define XB_TOP      3328
#define XB_TOPGEN   3392
#define XCD_BAR_WORDS 3456
#define XB_SPIN_CAP (1u << 22)

__device__ __forceinline__ unsigned xb_ld(unsigned* p)              { return __hip_atomic_load(p, __ATOMIC_RELAXED, __HIP_MEMORY_SCOPE_AGENT); }
__device__ __forceinline__ unsigned xb_add(unsigned* p, unsigned v) { return __hip_atomic_fetch_add(p, v, __ATOMIC_RELAXED, __HIP_MEMORY_SCOPE_AGENT); }
__device__ __forceinline__ unsigned xb_xcc_id() { return (unsigned)__builtin_amdgcn_s_getreg((3 << 11) | 20) & 0xFu; }
#define XB_SPIN(cond, bar) do { unsigned _sp = 0; while (cond) { __builtin_amdgcn_s_sleep(1); \
    if ((++_sp & 255u) == 0u) { if (xb_ld(&(bar)[XB_TMO])) break; if (_sp > XB_SPIN_CAP) { atomicAdd(&(bar)[XB_TMO], 1u); break; } } } } while (0)

struct XcdBarrier { unsigned* bar; unsigned x; volatile LAS unsigned* st; };

__device__ __forceinline__ XcdBarrier xcd_barrier_post(unsigned* bar, volatile LAS unsigned* st, const int tid0) {
    XcdBarrier b; b.bar = bar; b.x = xb_xcc_id(); b.st = st;
    if (tid0 == 0) (void)xb_add(&bar[XB_XCNT(b.x)], 1u);
    return b;
}
__device__ __forceinline__ void xcd_barrier_complete(unsigned* bar, unsigned x, unsigned& nloc, unsigned& nx) {
    const unsigned G = gridDim.x * gridDim.y * gridDim.z;
    unsigned sum, cnt, mine, sp = 0u;
    for (;;) {
        sum = 0u; cnt = 0u; mine = 0u;
#pragma unroll
        for (unsigned j = 0; j < 16; ++j) { const unsigned c = xb_ld(&bar[XB_XCNT(j)]); sum += c; cnt += (c > 0u) ? 1u : 0u; mine = (j == x) ? c : mine; }
        if (sum == G) break;
        __builtin_amdgcn_s_sleep(1);
        if ((++sp & 255u) == 0u) { if (xb_ld(&bar[XB_TMO])) break; if (sp > XB_SPIN_CAP) { atomicAdd(&bar[XB_TMO], 1u); break; } }
    }
    nloc = mine > 0u ? mine : 1u; nx = cnt > 0u ? cnt : 1u;
}
__device__ __forceinline__ void xcd_barrier(const XcdBarrier& b, const int tid0) {
    asm volatile("s_waitcnt vmcnt(0)" ::: "memory");
    __syncthreads();
    if (tid0 == 0) {
        unsigned* bar = b.bar;
        __builtin_amdgcn_s_waitcnt(0);
        unsigned nloc = b.st[0], nx = b.st[1];
        if (nloc == 0u) { xcd_barrier_complete(bar, b.x, nloc, nx); b.st[0] = nloc; b.st[1] = nx; }
        const unsigned old = xb_add(&bar[XB_XSUB(b.x)], 1u);
        const unsigned gen = old / nloc;
        if (old + 1u == (gen + 1u) * nloc) {
            __builtin_amdgcn_fence(__ATOMIC_RELEASE, "agent");
            asm volatile("s_waitcnt vmcnt(0)" ::: "memory");
            const unsigned og = xb_add(&bar[XB_TOP], 1u);
            const unsigned tg = og / nx;
            if (og + 1u == (tg + 1u) * nx) xb_add(&bar[XB_TOPGEN], 1u);
            else XB_SPIN(xb_ld(&bar[XB_TOPGEN]) == tg, bar);
            __builtin_amdgcn_fence(__ATOMIC_ACQUIRE, "agent");
            xb_add(&bar[XB_XGEN(b.x)], 1u);
            asm volatile("s_waitcnt vmcnt(0)" ::: "memory");
        } else {
            XB_SPIN(xb_ld(&bar[XB_XGEN(b.x)]) == gen, bar);
            __builtin_amdgcn_fence(__ATOMIC_ACQUIRE, "agent");
            asm volatile("s_waitcnt vmcnt(0)" ::: "memory");
        }
    }
    __syncthreads();
}

__device__ __forceinline__ float shfl_xor_(float v, int mask, int ln) { return __builtin_bit_cast(float, __builtin_amdgcn_ds_bpermute((ln ^ mask) << 2, __builtin_bit_cast(int, v))); }
__device__ __forceinline__ float wave_sum(float v, int ln) {
    v += __builtin_bit_cast(float, __builtin_amdgcn_update_dpp(0, __builtin_bit_cast(int, v), 0x128, 0xf, 0xf, false));
    v += __builtin_bit_cast(float, __builtin_amdgcn_update_dpp(0, __builtin_bit_cast(int, v), 0x124, 0xf, 0xf, false));
    v += __builtin_bit_cast(float, __builtin_amdgcn_update_dpp(0, __builtin_bit_cast(int, v), 0x122, 0xf, 0xf, false));
    v += __builtin_bit_cast(float, __builtin_amdgcn_update_dpp(0, __builtin_bit_cast(int, v), 0x121, 0xf, 0xf, false));
    v += shfl_xor_(v, 16, ln); v += shfl_xor_(v, 32, ln);
    return v;
}
__device__ __forceinline__ float sigmoidf_(float x) { return 1.0f / (1.0f + expf(-x)); }

namespace pg8 {
#define PG8_LAS __attribute__((address_space(3)))
typedef unsigned short bf16_t;
typedef short bf16x8 __attribute__((ext_vector_type(8)));
typedef float f32x4 __attribute__((ext_vector_type(4)));
typedef unsigned u32x4 __attribute__((ext_vector_type(4)));
constexpr int BM = 256, BK = 64, HALF = 128, HTB = HALF * BK * 2  , STAGE_BYTES = 8 * HTB, NXCD = 8, WGM = 8;

__host__ __device__ __forceinline__ int lds_byte(int r, int c) { const int st = (r >> 4) * 2 + (c >> 5), rr = r & 15, cc = c & 31, ob = rr * 64 + cc * 2; return st * 1024 + (ob ^ (((ob >> 9) & 1) << 5)); }
__host__ __device__ __forceinline__ void stage_rc(int b, int& R, int& C) { const int st = b / 1024, sb = b % 1024, swz = sb ^ (((sb >> 9) & 1) << 5); R = (st >> 1) * 16 + swz / 64; C = (st & 1) * 32 + (swz % 64) / 2; }
__host__ __device__ __forceinline__ int perm32(int rho) { const int n = rho >> 4, i = rho & 15; return 8 * (i >> 2) + 4 * n + (i & 3); }

struct Unit { int pm, pn; int ko = 0; };
struct Gemm { const bf16_t* A; const bf16_t* Bt; int M, N, K; int ld = 0; };

struct StaticOrder {
    int nM, nN, nwg, G, c;
    __host__ __device__ void init(int M, int N, int G_, int c_) { nM = M / BM; nN = N / BM; nwg = nM * nN; G = G_; c = c_; }
    __host__ __device__ bool next(int i, Unit& u) const {
        const long L = (long)i * G + c; if (L >= nwg) return false;
        int wgid = (int)L; { const int q = nwg / NXCD, r = nwg % NXCD, xcd = wgid % NXCD, off = wgid / NXCD; wgid = (xcd < r ? xcd * (q + 1) : r * (q + 1) + (xcd - r) * q) + off; }
        const int nig = WGM * nN, gid = wgid / nig, fm = gid * WGM, gsz = (nM - fm) < WGM ? (nM - fm) : WGM;
        u.pm = fm + ((wgid % nig) % gsz); u.pn = (wgid % nig) / gsz; return true;
    }
    __device__ __forceinline__ void a_ready(const Unit&) const {}
    __device__ __forceinline__ void done(const Unit&) const {}
};
__device__ __forceinline__ unsigned cvt_pk_bf16(float lo, float hi) { unsigned r; asm volatile("v_cvt_pk_bf16_f32 %0, %1, %2" : "=v"(r) : "v"(lo), "v"(hi)); return r; }
typedef float f32x2 __attribute__((ext_vector_type(2)));
template <class Epi, class Sched, bool STAMP = false>
__device__ __forceinline__ void gemm_phase(PG8_LAS unsigned char* lds, const Gemm g, const Sched& S, const Epi& E, unsigned long long* stamps, const int tid) {
    const int wid = __builtin_amdgcn_readfirstlane(tid >> 6), lane = tid & 63, wr = wid >> 2, wc = wid & 3, fr = lane & 15, fq = lane >> 4;
    const int K = g.K, nt = K / BK, LD = g.ld ? g.ld : g.K;
    int ts_lo = 0, ts_hi = 0, nts = 0; const unsigned long long rt_entry = STAMP ? (unsigned long long)wall_clock64() : 0ull;
#define PG8_STAMP() do { if (STAMP && wid == 0 && nts < 64) { const unsigned long long _c = (unsigned long long)clock64(); \
        ts_lo = (lane == nts) ? (int)(unsigned)_c : ts_lo; ts_hi = (lane == nts) ? (int)(unsigned)(_c >> 32) : ts_hi; ++nts; } } while (0)
    PG8_STAMP();
    unsigned voffA[2], voffB[2];
#pragma unroll
    for (int i = 0; i < 2; ++i) { int R, C; stage_rc(tid * 16 + i * 8192, R, C); const int Rb = Epi::PERM ? ((R & ~31) + perm32(R & 31)) : R;
        voffA[i] = (unsigned)(R * LD + C) * 2u; voffB[i] = (unsigned)(Rb * LD + C) * 2u; }
    const size_t kstep = (size_t)(BK * 2);
    const size_t hstep = (size_t)HALF * LD * 2;
    const size_t tstep = 2 * hstep;
    const unsigned ldsw = (unsigned)wid * 1024u;
    const int aoff = lds_byte(wr * 64 + fr, fq * 8), boff = lds_byte(wc * 32 + fr, fq * 8);
#define PG8_SA(b, h) (((b) * 2 + (h)) * HTB)
#define PG8_SB(b, h) ((4 + (b) * 2 + (h)) * HTB)
#define PG8_STAGE(bufoff, gbase, voff) do { _Pragma("unroll") for (int _i = 0; _i < 2; ++_i) \
        __builtin_amdgcn_global_load_lds((const unsigned*)((const char*)(gbase) + (voff)[_i]), (PG8_LAS unsigned*)(lds + (bufoff) + ldsw + _i * 8192), 16, 0, 0); } while (0)
#define PG8_LDA(dst, b, h) do { _Pragma("unroll") for (int m = 0; m < 4; ++m) _Pragma("unroll") for (int k = 0; k < 2; ++k) dst[m][k] = *(const PG8_LAS bf16x8*)(lds + PG8_SA(b, h) + aoff + m * 2048 + k * 1024); } while (0)
#define PG8_LDB(dst, b, h) do { _Pragma("unroll") for (int n = 0; n < 2; ++n) _Pragma("unroll") for (int k = 0; k < 2; ++k) dst[n][k] = *(const PG8_LAS bf16x8*)(lds + PG8_SB(b, h) + boff + n * 2048 + k * 1024); } while (0)
#define PG8_MMA(ai, bj, At, Bt) do { __builtin_amdgcn_s_setprio(1); _Pragma("unroll") for (int m = 0; m < 4; ++m) _Pragma("unroll") for (int n = 0; n < 2; ++n) _Pragma("unroll") for (int k = 0; k < 2; ++k) \
        acc[ai][bj][m][n] = __builtin_amdgcn_mfma_f32_16x16x32_bf16(Bt[n][k], At[m][k], acc[ai][bj][m][n], 0, 0, 0); __builtin_amdgcn_s_setprio(0); } while (0)
#define PG8_WAIT_V(n) asm volatile("s_waitcnt vmcnt(" #n ")" ::: "memory")
#define PG8_WAIT_L(n) asm volatile("s_waitcnt lgkmcnt(" #n ")" ::: "memory")
#define PG8_BAR __builtin_amdgcn_s_barrier()
#define PG8_SCHED __builtin_amdgcn_sched_barrier(0)
    Unit cur, nxt; int ui = 0;
    if (!S.next(0, cur)) return;
    f32x4 acc[2][2][4][2];
#pragma unroll
    for (int a = 0; a < 2; ++a)
#pragma unroll
        for (int b = 0; b < 2; ++b)
#pragma unroll
            for (int m = 0; m < 4; ++m)
#pragma unroll
                for (int n = 0; n < 2; ++n) acc[a][b][m][n] = (f32x4){0.f, 0.f, 0.f, 0.f};
    bf16x8 At[4][2], B0[2][2], B1[2][2];
    {
        const bf16x8 z8 = {0, 0, 0, 0, 0, 0, 0, 0};
#pragma unroll
        for (int m = 0; m < 4; ++m) { At[m][0] = z8; At[m][1] = z8; }
#pragma unroll
        for (int n = 0; n < 2; ++n) { B0[n][0] = z8; B0[n][1] = z8; B1[n][0] = z8; B1[n][1] = z8; }
    }
    const char* cA = (const char*)g.A + (size_t)cur.pm * tstep + cur.ko; const char* cB = (const char*)g.Bt + (size_t)cur.pn * tstep + cur.ko;
    S.a_ready(cur);
    PG8_STAGE(PG8_SB(0, 0), cB, voffB); PG8_STAGE(PG8_SA(0, 0), cA, voffA); PG8_STAGE(PG8_SB(0, 1), cB + hstep, voffB); PG8_STAGE(PG8_SA(0, 1), cA + hstep, voffA);
    if (wr == 1) PG8_BAR;
    PG8_WAIT_V(4); PG8_BAR;
    PG8_STAGE(PG8_SB(1, 0), cB + kstep, voffB); PG8_STAGE(PG8_SA(1, 0), cA + kstep, voffA); PG8_STAGE(PG8_SB(1, 1), cB + hstep + kstep, voffB);
    PG8_WAIT_V(6); PG8_BAR;
    PG8_STAMP();
    for (;;) {
        const bool has_next = S.next(ui + 1, nxt);
        const char* nA = has_next ? (const char*)g.A + (size_t)nxt.pm * tstep + nxt.ko : cA; const char* nB = has_next ? (const char*)g.Bt + (size_t)nxt.pn * tstep + nxt.ko : cB;
        for (int t = 0; t < nt; t += 2) {
            const bool last = (t == nt - 2);
            const char* a1 = cA + (size_t)(t + 1) * kstep;
            const char* a2 = last ? nA : cA + (size_t)(t + 2) * kstep; const char* b2 = last ? nB : cB + (size_t)(t + 2) * kstep;
            const char* a3 = a2 + kstep; const char* b3 = b2 + kstep;
            if (last && has_next) S.a_ready(nxt);
            PG8_LDB(B0, 0, 0); PG8_SCHED; PG8_LDA(At, 0, 0); PG8_STAGE(PG8_SA(1, 1), a1 + hstep, voffA);
            PG8_WAIT_L(8); PG8_BAR; PG8_WAIT_L(0); PG8_MMA(0, 0, At, B0); PG8_BAR; PG8_SCHED;
            PG8_LDB(B1, 0, 1); PG8_STAGE(PG8_SB(0, 0), b2, voffB);
            PG8_BAR; PG8_WAIT_L(0); PG8_MMA(0, 1, At, B1); PG8_BAR;
            PG8_LDA(At, 0, 1); PG8_STAGE(PG8_SA(0, 0), a2, voffA);
            PG8_BAR; PG8_WAIT_L(0); PG8_MMA(1, 0, At, B0); PG8_BAR; PG8_SCHED;
            PG8_STAGE(PG8_SB(0, 1), b2 + hstep, voffB);
            PG8_WAIT_V(6); PG8_BAR; PG8_MMA(1, 1, At, B1); PG8_BAR;
            PG8_LDB(B0, 1, 0); PG8_SCHED; PG8_LDA(At, 1, 0); PG8_STAGE(PG8_SA(0, 1), a2 + hstep, voffA);
            PG8_WAIT_L(8); PG8_BAR; PG8_WAIT_L(0); PG8_MMA(0, 0, At, B0); PG8_BAR; PG8_SCHED;
            PG8_LDB(B1, 1, 1); PG8_STAGE(PG8_SB(1, 0), b3, voffB);
            PG8_BAR; PG8_WAIT_L(0); PG8_MMA(0, 1, At, B1); PG8_BAR;
            PG8_LDA(At, 1, 1); PG8_STAGE(PG8_SA(1, 0), a3, voffA);
            PG8_BAR; PG8_WAIT_L(0); PG8_MMA(1, 0, At, B0); PG8_BAR; PG8_SCHED;
            PG8_STAGE(PG8_SB(1, 1), b3 + hstep, voffB);
            PG8_WAIT_V(6); PG8_BAR; PG8_MMA(1, 1, At, B1); PG8_BAR;
        }
        PG8_STAMP();
        if constexpr (Epi::KEEP_ACC) E.seam(acc, cur, wr, wc, fr, fq, cur.ko / Epi::SEG_BYTES);
        else
        if constexpr (!Epi::AFTER_DRAIN) { if constexpr (Epi::STAGED) E.staged(acc, cur, wr, wc, fr, fq, lds + STAGE_BYTES, wid, lane); else E(acc, cur, wr, wc, fr, fq); S.done(cur); }
        PG8_STAMP();
        if (!has_next) break;
        bool zero_acc = true;
        if constexpr (Epi::KEEP_ACC) zero_acc = cur.ko == 2 * Epi::SEG_BYTES;
        if (zero_acc) {
#pragma unroll
        for (int a = 0; a < 2; ++a)
#pragma unroll
            for (int b = 0; b < 2; ++b)
#pragma unroll
                for (int m = 0; m < 4; ++m)
#pragma unroll
                    for (int n = 0; n < 2; ++n) acc[a][b][m][n] = (f32x4){0.f, 0.f, 0.f, 0.f};
        }
        cur = nxt; cA = nA; cB = nB; ++ui;
    }
    PG8_WAIT_V(0);
    if (wr == 0) PG8_BAR;
    PG8_BAR;
    if constexpr (Epi::AFTER_DRAIN) { E.fused(acc, cur, wr, wc, fr, fq, lds, wid, lane); S.done(cur); }
    PG8_STAMP();
    if (STAMP && wid == 0) { stamps[lane] = lane < nts ? (((unsigned long long)(unsigned)ts_hi << 32) | (unsigned)ts_lo) : 0ull;
        if (lane == 62) stamps[62] = rt_entry; if (lane == 63) stamps[63] = (unsigned long long)wall_clock64(); }
#undef PG8_STAMP
#undef PG8_SA
#undef PG8_SB
#undef PG8_STAGE
#undef PG8_LDA
#undef PG8_LDB
#undef PG8_MMA
#undef PG8_WAIT_V
#undef PG8_WAIT_L
#undef PG8_BAR
#undef PG8_SCHED
}
}


typedef unsigned short bf16;
typedef unsigned v4u __attribute__((ext_vector_type(4)));
typedef unsigned v2u __attribute__((ext_vector_type(2)));
__device__ __forceinline__ unsigned f2bf(float f) { unsigned u = __builtin_bit_cast(unsigned, f); return (u + 0x7fffu + ((u >> 16) & 1u)) >> 16; }
typedef __bf16 bf16x2_t __attribute__((ext_vector_type(2)));
__device__ __forceinline__ unsigned pk2(float lo, float hi) { bf16x2_t v; v[0] = (__bf16)lo; v[1] = (__bf16)hi; return __builtin_bit_cast(unsigned, v); }
__device__ __forceinline__ float row_allsum16(float x) {
    x += __builtin_bit_cast(float, __builtin_amdgcn_update_dpp(0, __builtin_bit_cast(int, x), 0x128, 0xf, 0xf, false));
    x += __builtin_bit_cast(float, __builtin_amdgcn_update_dpp(0, __builtin_bit_cast(int, x), 0x124, 0xf, 0xf, false));
    x += __builtin_bit_cast(float, __builtin_amdgcn_update_dpp(0, __builtin_bit_cast(int, x), 0x122, 0xf, 0xf, false));
    x += __builtin_bit_cast(float, __builtin_amdgcn_update_dpp(0, __builtin_bit_cast(int, x), 0x121, 0xf, 0xf, false));
    return x;
}
__device__ __forceinline__ float fsigmoid(float x) { return __builtin_amdgcn_rcpf(1.0f + __expf(-x)); }
__device__ __forceinline__ void transpose_item(const float* p, int ldw, bf16* WT, int K, int dst_row0, int k0, LAS float* scr, int ln) {
    if (p) {
        float tv[32];
#pragma unroll
        for (int i = 0; i < 32; ++i) tv[i] = p[(size_t)(k0 + 2 * i + (ln >> 5)) * ldw];
#pragma unroll
        for (int i = 0; i < 32; ++i) scr[(2 * i + (ln >> 5)) * 33 + (ln & 31)] = tv[i];
    } else {
#pragma unroll 8
        for (int i = 0; i < 32; ++i) { const int kk = 2 * i + (ln >> 5); scr[kk * 33 + (ln & 31)] = 0.f; }
    }
    asm volatile("s_waitcnt lgkmcnt(0)" ::: "memory");
    const int c = ln & 7;
#pragma unroll
    for (int j = 0; j < 4; ++j) { const int n = (ln >> 3) + 8 * j; const LAS float* s = scr + (8 * c) * 33 + n;
        v4u o; o.x = pk2(s[0 * 33], s[1 * 33]); o.y = pk2(s[2 * 33], s[3 * 33]); o.z = pk2(s[4 * 33], s[5 * 33]); o.w = pk2(s[6 * 33], s[7 * 33]);
        *(v4u*)(WT + (size_t)(dst_row0 + n) * K + k0 + 8 * c) = o; }
    asm volatile("s_waitcnt lgkmcnt(0)" ::: "memory");
}
struct TI { const float* p; bf16* wt; int ldw, K, r0, k0; bool zero; };
__device__ __forceinline__ void ti_load(const TI& t, float (&tv)[32], int ln) {
#pragma unroll
    for (int i = 0; i < 32; ++i) tv[i] = t.p[(size_t)(t.k0 + 2 * i + (ln >> 5)) * t.ldw];
}
__device__ __forceinline__ void ti_finish(const TI& t, const float (&tv)[32], LAS float* scr, int ln) {
#pragma unroll
    for (int i = 0; i < 32; ++i) scr[(2 * i + (ln >> 5)) * 33 + (ln & 31)] = t.zero ? 0.f : tv[i];
    asm volatile("s_waitcnt lgkmcnt(0)" ::: "memory");
    const int c = ln & 7;
#pragma unroll
    for (int j = 0; j < 4; ++j) { const int n = (ln >> 3) + 8 * j; const LAS float* s = scr + (8 * c) * 33 + n;
        v4u o; o.x = pk2(s[0 * 33], s[1 * 33]); o.y = pk2(s[2 * 33], s[3 * 33]); o.z = pk2(s[4 * 33], s[5 * 33]); o.w = pk2(s[6 * 33], s[7 * 33]);
        *(v4u*)(t.wt + (size_t)(t.r0 + n) * t.K + t.k0 + 8 * c) = o; }
    asm volatile("s_waitcnt lgkmcnt(0)" ::: "memory");
}
__device__ __forceinline__ f32x4 bf4_to_f32(const v2u w) { f32x4 r; r[0] = __builtin_bit_cast(float, w.x << 16); r[1] = __builtin_bit_cast(float, w.x & 0xffff0000u);
    r[2] = __builtin_bit_cast(float, w.y << 16); r[3] = __builtin_bit_cast(float, w.y & 0xffff0000u); return r; }
constexpr int STG_RS = 528;
#define EBAR() do { asm volatile("s_waitcnt lgkmcnt(0)" ::: "memory"); __builtin_amdgcn_s_barrier(); asm volatile("" ::: "memory"); } while (0)
#define EPI_ENTER(wr_) do { if ((wr_) == 0) __builtin_amdgcn_s_barrier(); } while (0)
#define EPI_LEAVE(wr_) do { if ((wr_) == 1) __builtin_amdgcn_s_barrier(); } while (0)
#define STG_READBACK512(ai_, m_, BODY) do { int ln_ = lane; asm volatile("" : "+v"(ln_)); _Pragma("unroll") for (int h_ = 0; h_ < 2; ++h_) { const int lr_ = 4 * wid + 2 * h_ + (ln_ >> 5), cb_ = (ln_ & 31) * 16; \
        const v4u sv_ = *(const LAS v4u*)(stg + lr_ * STG_RS + cb_); const int trow_ = 128 * (ai_) + 64 * (lr_ >> 4) + 16 * (m_) + (lr_ & 15); BODY } } while (0)

struct EpiSwigluBf16 {
    static constexpr bool PERM = true, AFTER_DRAIN = false, HAS_MID = false, STAGED = true, KEEP_ACC = false;
    bf16* H; int nN;
    __device__ __forceinline__ void staged(const f32x4 (&acc)[2][2][4][2], const pg8::Unit& u, int wr, int wc, int fr, int fq, LAS unsigned char* stg, int wid, int lane) const {
        const int pnl = u.pn % nN, lrw = 16 * wr + fr;
        bf16* dst = H + (size_t)u.pm * 256 * DFF + 128 * pnl;
        EPI_ENTER(wr);
#pragma unroll
        for (int ai = 0; ai < 2; ++ai)
#pragma unroll
            for (int m = 0; m < 4; ++m) {
#pragma unroll
                for (int bj = 0; bj < 2; ++bj) {
                    const f32x4 g = acc[ai][bj][m][0], uu = acc[ai][bj][m][1]; float h[4];
#pragma unroll
                    for (int j = 0; j < 4; ++j) h[j] = g[j] * fsigmoid(g[j]) * uu[j];
                    v2u o; o.x = pk2(h[0], h[1]); o.y = pk2(h[2], h[3]);
                    *(LAS v2u*)(stg + lrw * 272 + (64 * bj + 16 * wc + 4 * fq) * 2) = o;
                }
                EBAR();
                {
                    int ln_ = lane; asm volatile("" : "+v"(ln_));
                    const int lr = 4 * wid + (ln_ >> 4), cb = (ln_ & 15) * 16;
                    const v4u sv = *(const LAS v4u*)(stg + lr * 272 + cb);
                    const int trow = 128 * ai + 64 * (lr >> 4) + 16 * m + (lr & 15);
                    *(v4u*)(dst + (size_t)trow * DFF + (ln_ & 15) * 8) = sv;
                }
                EBAR();
            }
        EPI_LEAVE(wr);
    }
};
struct EpiResidF32 {
    static constexpr bool PERM = true, AFTER_DRAIN = false, HAS_MID = false, STAGED = true, KEEP_ACC = false;
    float* C; const float* R;
    __device__ __forceinline__ void staged(const f32x4 (&acc)[2][2][4][2], const pg8::Unit& u, int wr, int wc, int fr, int fq, LAS unsigned char* stg, int wid, int lane) const {
        const int lrw = 16 * wr + fr; const size_t t0 = (size_t)u.pm * 256 * D + (size_t)u.pn * 256;
        EPI_ENTER(wr);
#pragma unroll
        for (int ai = 0; ai < 2; ++ai)
#pragma unroll
            for (int m = 0; m < 4; ++m)
#pragma unroll
                for (int bj = 0; bj < 2; ++bj) {
                    *(LAS f32x4*)(stg + lrw * STG_RS + (wc * 32 + 8 * fq) * 4) = acc[ai][bj][m][0];
                    *(LAS f32x4*)(stg + lrw * STG_RS + (wc * 32 + 8 * fq) * 4 + 16) = acc[ai][bj][m][1];
                    EBAR();
                    STG_READBACK512(ai, m, { const size_t o_ = t0 + (size_t)trow_ * D + bj * 128 + (ln_ & 31) * 4;
                        const f32x4 r_ = *(const f32x4*)(R + o_); *(f32x4*)(C + o_) = ALPHA * r_ + __builtin_bit_cast(f32x4, sv_); });
                    EBAR();
                }
        EPI_LEAVE(wr);
    }
};
struct EpiStoreF32 {
    static constexpr bool PERM = true, AFTER_DRAIN = false, HAS_MID = false, STAGED = true, KEEP_ACC = false;
    float* C; int nN;
    __device__ __forceinline__ void staged(const f32x4 (&acc)[2][2][4][2], const pg8::Unit& u, int wr, int wc, int fr, int fq, LAS unsigned char* stg, int wid, int lane) const {
        const int lrw = 16 * wr + fr; const size_t t0 = (size_t)u.pm * 256 * D + (size_t)(u.pn % nN) * 256;
        EPI_ENTER(wr);
#pragma unroll
        for (int ai = 0; ai < 2; ++ai)
#pragma unroll
            for (int m = 0; m < 4; ++m)
#pragma unroll
                for (int bj = 0; bj < 2; ++bj) {
                    *(LAS f32x4*)(stg + lrw * STG_RS + (wc * 32 + 8 * fq) * 4) = acc[ai][bj][m][0];
                    *(LAS f32x4*)(stg + lrw * STG_RS + (wc * 32 + 8 * fq) * 4 + 16) = acc[ai][bj][m][1];
                    EBAR();
                    STG_READBACK512(ai, m, { *(v4u*)(C + t0 + (size_t)trow_ * D + bj * 128 + (ln_ & 31) * 4) = sv_; });
                    EBAR();
                }
        EPI_LEAVE(wr);
    }
};
template <int MODE> struct EpiBranch {
    static constexpr bool PERM = true, AFTER_DRAIN = false, HAS_MID = false, STAGED = false, KEEP_ACC = false;
    float* MIXp; bf16* MIXBp; const float* gate;
    __device__ __forceinline__ void operator()(const f32x4 (&acc)[2][2][4][2], const pg8::Unit& u, int wr, int wc, int fr, int fq) const {
        const int row0 = u.pm * 256 + wr * 64 + fr, col0 = u.pn * 256 + wc * 32 + 8 * fq;
#pragma unroll
        for (int ai = 0; ai < 2; ++ai)
#pragma unroll
            for (int m = 0; m < 4; ++m)
#pragma unroll
                for (int bj = 0; bj < 2; ++bj) {
                    const int row = row0 + ai * 128 + m * 16, col = col0 + bj * 128; const size_t o = (size_t)row * D + col;
                    const f32x4 g0 = *(const f32x4*)(gate + (size_t)row * IN_COLS + col), g1 = *(const f32x4*)(gate + (size_t)row * IN_COLS + col + 4);
                    f32x4 r0, r1;
#pragma unroll
                    for (int j = 0; j < 4; ++j) { r0[j] = fsigmoid(g0[j]) * acc[ai][bj][m][0][j]; r1[j] = fsigmoid(g1[j]) * acc[ai][bj][m][1][j]; }
                    if (MODE >= 1) { r0 += *(const f32x4*)(MIXp + o); r1 += *(const f32x4*)(MIXp + o + 4); }
                    if (MODE <= 1) { *(f32x4*)(MIXp + o) = r0; *(f32x4*)(MIXp + o + 4) = r1; }
                    else { v4u w; w.x = pk2(r0[0], r0[1]); w.y = pk2(r0[2], r0[3]); w.z = pk2(r1[0], r1[1]); w.w = pk2(r1[2], r1[3]); *(v4u*)(MIXBp + o) = w; }
                }
    }
};

struct EpiLora {
    static constexpr bool PERM = true, AFTER_DRAIN = false, HAS_MID = false, STAGED = false, KEEP_ACC = false;
    float* DECp; bf16* AAp; bf16* GGp; float* Vp; const float* VFp; const float* w0; const float* a0; const float* v0;
    __device__ __forceinline__ void operator()(const f32x4 (&acc)[2][2][4][2], const pg8::Unit& u, int wr, int wc, int fr, int fq) const {
        const int row0 = u.pm * 256 + wr * 64 + fr, seg = __builtin_amdgcn_readfirstlane(u.pn >> 2), col0 = (u.pn & 3) * 256 + wc * 32 + 8 * fq;
        if (seg == 0) {
#pragma unroll
            for (int bj = 0; bj < 2; ++bj) { const int col = col0 + bj * 128; const f32x4 b0 = *(const f32x4*)(w0 + col), b1 = *(const f32x4*)(w0 + col + 4);
#pragma unroll
                for (int ai = 0; ai < 2; ++ai)
#pragma unroll
                    for (int m = 0; m < 4; ++m) { const size_t o = (size_t)(row0 + ai * 128 + m * 16) * BW + col;
                        f32x4 x0 = acc[ai][bj][m][0] + b0, x1 = acc[ai][bj][m][1] + b1;
#pragma unroll
                        for (int j = 0; j < 4; ++j) { const float z0 = -x0[j], z1 = -x1[j];
                            const float sp0 = z0 > 20.f ? z0 : __logf(1.0f + __expf(z0)), sp1 = z1 > 20.f ? z1 : __logf(1.0f + __expf(z1));
                            x0[j] = __expf(-__expf(-sp0 - 0.5f)); x1[j] = __expf(-__expf(-sp1 - 0.5f)); }
                        *(f32x4*)(DECp + o) = x0; *(f32x4*)(DECp + o + 4) = x1; } }
        } else if (seg == 1) {
#pragma unroll
            for (int bj = 0; bj < 2; ++bj) { const int col = col0 + bj * 128; const f32x4 b0 = *(const f32x4*)(a0 + col), b1 = *(const f32x4*)(a0 + col + 4);
#pragma unroll
                for (int ai = 0; ai < 2; ++ai)
#pragma unroll
                    for (int m = 0; m < 4; ++m) { const size_t o = (size_t)(row0 + ai * 128 + m * 16) * BW + col;
                        f32x4 x0 = acc[ai][bj][m][0] + b0, x1 = acc[ai][bj][m][1] + b1;
#pragma unroll
                        for (int j = 0; j < 4; ++j) { x0[j] = fsigmoid(x0[j]); x1[j] = fsigmoid(x1[j]); }
                        v4u w; w.x = pk2(x0[0], x0[1]); w.y = pk2(x0[2], x0[3]); w.z = pk2(x1[0], x1[1]); w.w = pk2(x1[2], x1[3]); *(v4u*)(AAp + o) = w; } }
        } else if (seg == 2) {
#pragma unroll
            for (int bj = 0; bj < 2; ++bj) { const int col = col0 + bj * 128;
#pragma unroll
                for (int ai = 0; ai < 2; ++ai)
#pragma unroll
                    for (int m = 0; m < 4; ++m) { const size_t o = (size_t)(row0 + ai * 128 + m * 16) * BW + col;
                        const f32x4 x0 = acc[ai][bj][m][0], x1 = acc[ai][bj][m][1];
                        v4u w; w.x = pk2(x0[0], x0[1]); w.y = pk2(x0[2], x0[3]); w.z = pk2(x1[0], x1[1]); w.w = pk2(x1[2], x1[3]); *(v4u*)(GGp + o) = w; } }
        } else {
#pragma unroll
            for (int bj = 0; bj < 2; ++bj) { const int col = col0 + bj * 128; const f32x4 b0 = *(const f32x4*)(v0 + col), b1 = *(const f32x4*)(v0 + col + 4);
#pragma unroll
                for (int ai = 0; ai < 2; ++ai)
#pragma unroll
                    for (int m = 0; m < 4; ++m) { const size_t o = (size_t)(row0 + ai * 128 + m * 16) * BW + col;
                        f32x4 x0 = acc[ai][bj][m][0] + b0, x1 = acc[ai][bj][m][1] + b1;
                        const f32x4 v0_ = *(const f32x4*)(Vp + o), v1_ = *(const f32x4*)(Vp + o + 4), f0 = *(const f32x4*)(VFp + o), f1 = *(const f32x4*)(VFp + o + 4);
#pragma unroll
                        for (int j = 0; j < 4; ++j) { x0[j] = v0_[j] + (f0[j] - v0_[j]) * fsigmoid(x0[j]); x1[j] = v1_[j] + (f1[j] - v1_[j]) * fsigmoid(x1[j]); }
                        *(f32x4*)(Vp + o) = x0; *(f32x4*)(Vp + o + 4) = x1;
                        asm volatile("" ::: "memory"); } }
        }
    }
};
struct EpiMlaQ {
    static constexpr bool PERM = true, AFTER_DRAIN = false, HAS_MID = false, STAGED = false, KEEP_ACC = false;
    bf16* QCBp; const float* COSMp; const float* SINMp;
    __device__ __forceinline__ void operator()(const f32x4 (&acc)[2][2][4][2], const pg8::Unit& u, int wr, int wc, int fr, int fq) const {
        const int row0 = u.pm * 256 + wr * 64 + fr;
#pragma unroll
        for (int bj = 0; bj < 2; ++bj) {
            const int c = u.pn * 256 + bj * 128 + wc * 32 + 8 * fq, h = c / 192, cc = c - h * 192;
#pragma unroll
            for (int ai = 0; ai < 2; ++ai)
#pragma unroll
                for (int m = 0; m < 4; ++m) {
                    const int row = row0 + ai * 128 + m * 16; const f32x4 x1 = acc[ai][bj][m][0], x2 = acc[ai][bj][m][1];
                    bf16* dst = QCBp + (size_t)row * 1536 + h * 192;
                    if (cc < 128) { v4u w; w.x = pk2(x1[0], x1[1]); w.y = pk2(x1[2], x1[3]); w.z = pk2(x2[0], x2[1]); w.w = pk2(x2[2], x2[3]); *(v4u*)(dst + cc) = w; }
                    else { const int j0 = 4 * ((cc - 128) >> 3), s = row & (SEQ - 1);
                        const f32x4 cs = *(const f32x4*)(COSMp + s * 32 + j0), sn = *(const f32x4*)(SINMp + s * 32 + j0);
                        const f32x4 o1 = x1 * cs - x2 * sn, o2 = x2 * cs + x1 * sn;
                        v2u a; a.x = pk2(o1[0], o1[1]); a.y = pk2(o1[2], o1[3]); v2u b; b.x = pk2(o2[0], o2[1]); b.y = pk2(o2[2], o2[3]);
                        *(v2u*)(dst + 128 + j0) = a; *(v2u*)(dst + 160 + j0) = b; }
                }
        }
    }
};
struct EpiMlaKV {
    static constexpr bool PERM = true, AFTER_DRAIN = false, HAS_MID = false, STAGED = false, KEEP_ACC = false;
    bf16* KCBp; bf16* VCBp;
    __device__ __forceinline__ void operator()(const f32x4 (&acc)[2][2][4][2], const pg8::Unit& u, int wr, int wc, int fr, int fq) const {
        const int row0 = u.pm * 256 + wr * 64 + fr;
#pragma unroll
        for (int bj = 0; bj < 2; ++bj) {
            const int c = u.pn * 256 + bj * 128 + wc * 32 + 8 * fq, h = c >> 8, cc = c & 255;
#pragma unroll
            for (int ai = 0; ai < 2; ++ai)
#pragma unroll
                for (int m = 0; m < 4; ++m) {
                    const int row = row0 + ai * 128 + m * 16; const f32x4 x1 = acc[ai][bj][m][0], x2 = acc[ai][bj][m][1];
                    v4u w; w.x = pk2(x1[0], x1[1]); w.y = pk2(x1[2], x1[3]); w.z = pk2(x2[0], x2[1]); w.w = pk2(x2[2], x2[3]);
                    if (cc < 128) *(v4u*)(KCBp + (size_t)row * 1536 + h * 192 + cc) = w;
                    else *(v4u*)(VCBp + (size_t)row * BW + h * 128 + (cc - 128)) = w;
                }
        }
    }
};

struct EpiBranch3 {
    static constexpr bool PERM = true, AFTER_DRAIN = false, HAS_MID = false, STAGED = false, KEEP_ACC = true;
    static constexpr int SEG_BYTES = BW * 2;
    bf16* MIXBp; const bf16* G;
    __device__ __forceinline__ void seam(f32x4 (&acc)[2][2][4][2], const pg8::Unit& u, int wr, int wc, int fr, int fq, int seg) const {
        int row0 = u.pm * 256 + wr * 64 + fr, col0 = u.pn * 256 + wc * 32 + 8 * fq;
        asm volatile("" : "+v"(row0), "+v"(col0));
        const bool fin = seg == 2;
#pragma unroll
        for (int ai = 0; ai < 2; ++ai)
#pragma unroll
            for (int m = 0; m < 4; ++m)
#pragma unroll
                for (int bj = 0; bj < 2; ++bj) {
                    const int row = row0 + ai * 128 + m * 16, col = col0 + bj * 128;
                    const bf16* gp = G + (size_t)row * (3 * D) + seg * D + col;
                    const v4u a = *(const v4u*)gp, b = *(const v4u*)(gp + (fin ? 0 : D));
                    const unsigned aw[4] = {a.x, a.y, a.z, a.w}, bw[4] = {b.x, b.y, b.z, b.w}; float r[8];
#pragma unroll
                    for (int j = 0; j < 4; ++j) {
                        const float g0 = __uint_as_float(aw[j] << 16), g1 = __uint_as_float(aw[j] & 0xffff0000u);
                        const float q0 = g0 * __builtin_amdgcn_rcpf(__uint_as_float(bw[j] << 16)), q1 = g1 * __builtin_amdgcn_rcpf(__uint_as_float(bw[j] & 0xffff0000u));
                        r[2 * j] = (acc[ai][bj][m][j >> 1][(j & 1) * 2] *= (fin ? g0 : q0)); r[2 * j + 1] = (acc[ai][bj][m][j >> 1][(j & 1) * 2 + 1] *= (fin ? g1 : q1));
                    }
                    if (fin) { v4u w; w.x = pk2(r[0], r[1]); w.y = pk2(r[2], r[3]); w.z = pk2(r[4], r[5]); w.w = pk2(r[6], r[7]); *(v4u*)(MIXBp + (size_t)row * D + col) = w; }
                    asm volatile("" : "+v"(acc[ai][bj][m][0]), "+v"(acc[ai][bj][m][1]) :: "memory");
                }
    }
};
struct SegOrder {
    pg8::StaticOrder base;
    __device__ __forceinline__ bool next(int i, pg8::Unit& u) const { const int ti = i / 3; if (!base.next(ti, u)) return false; u.ko = (i - 3 * ti) * (BW * 2); return true; }
    __device__ __forceinline__ void a_ready(const pg8::Unit&) const {}
    __device__ __forceinline__ void done(const pg8::Unit&) const {}
};
struct MoeOrder {
    const unsigned* tile_e; int nMt, nN, G, c; int mt0 = 0, ks = 1, kbytes = 0;
    __device__ __forceinline__ bool next(int i, pg8::Unit& u) const {
        const long L = (long)i * G + c; if (L >= (long)nMt * nN * ks) return false;
        const int mt = mt0 + (int)(L / (nN * ks)), rem = (int)(L % (nN * ks)), pnl = rem / ks;
        u.pm = mt; u.pn = (int)tile_e[mt] * nN + pnl; u.ko = (rem % ks) * kbytes; return true;
    }
    __device__ __forceinline__ void a_ready(const pg8::Unit&) const {}
    __device__ __forceinline__ void done(const pg8::Unit&) const {}
};
struct EpiAtomicF32 {
    static constexpr bool PERM = true, AFTER_DRAIN = false, HAS_MID = false, STAGED = true, KEEP_ACC = false;
    float* C; int nN;
    __device__ __forceinline__ void staged(const f32x4 (&acc)[2][2][4][2], const pg8::Unit& u, int wr, int wc, int fr, int fq, LAS unsigned char* stg, int wid, int lane) const {
        const int lrw = 16 * wr + fr; const size_t t0 = (size_t)u.pm * 256 * D + (size_t)(u.pn % nN) * 256;
        EPI_ENTER(wr);
#pragma unroll
        for (int ai = 0; ai < 2; ++ai)
#pragma unroll
            for (int m = 0; m < 4; ++m)
#pragma unroll
                for (int bj = 0; bj < 2; ++bj) {
                    *(LAS f32x4*)(stg + lrw * STG_RS + (wc * 32 + 8 * fq) * 4) = acc[ai][bj][m][0];
                    *(LAS f32x4*)(stg + lrw * STG_RS + (wc * 32 + 8 * fq) * 4 + 16) = acc[ai][bj][m][1];
                    EBAR();
                    { int ln_ = lane; asm volatile("" : "+v"(ln_));
#pragma unroll
                      for (int q_ = 0; q_ < 8; ++q_) { const int lr_ = 4 * wid + (q_ >> 1), cf_ = (q_ & 1) * 64 + ln_;
                          const float sv_ = *(const LAS float*)(stg + lr_ * STG_RS + cf_ * 4);
                          const int trow_ = 128 * ai + 64 * (lr_ >> 4) + 16 * m + (lr_ & 15);
                          atomicAdd(C + t0 + (size_t)trow_ * D + bj * 128 + cf_, sv_); } }
                    EBAR();
                }
        EPI_LEAVE(wr);
    }
};

struct EpiStoreBf16s { bf16* C; int ldc; size_t sC;
    __device__ __forceinline__ void operator()(int bt, int m, int n, float v) const { C[(size_t)bt * sC + (size_t)m * ldc + n] = (bf16)f2bf(v); } };
struct EpiInProjF32 {
    static constexpr bool PERM = true, AFTER_DRAIN = false, HAS_MID = false, STAGED = false, KEEP_ACC = false;
    bf16* PROJp; float* VRESp; bf16* GATEp; float* QFp; bf16* KABp; bf16* VABp; const float* COSAp; const float* SINAp; int layer;
    __device__ __forceinline__ void operator()(const f32x4 (&acc)[2][2][4][2], const pg8::Unit& u, int wr, int wc, int fr, int fq) const {
        int row0 = u.pm * 256 + wr * 64 + fr;
        asm volatile("" : "+v"(row0), "+v"(fq));
        if (u.pn >= 30) {
#pragma unroll
            for (int bj = 0; bj < 2; ++bj) { const int c = (u.pn - 30) * 256 + bj * 128 + wc * 32 + 8 * fq;
#pragma unroll
                for (int ai = 0; ai < 2; ++ai)
#pragma unroll
                    for (int m = 0; m < 4; ++m) { const f32x4 x0 = acc[ai][bj][m][0], x1 = acc[ai][bj][m][1];
                        v4u w; w.x = pk2(fsigmoid(x0[0]), fsigmoid(x0[1])); w.y = pk2(fsigmoid(x0[2]), fsigmoid(x0[3]));
                        w.z = pk2(fsigmoid(x1[0]), fsigmoid(x1[1])); w.w = pk2(fsigmoid(x1[2]), fsigmoid(x1[3]));
                        *(v4u*)(GATEp + (size_t)(row0 + ai * 128 + m * 16) * (3 * D) + c) = w; } }
            return;
        }
        if (u.pn < 8) {
            const bool isk = u.pn >= 4;
#pragma unroll
            for (int bj = 0; bj < 2; ++bj) {
                const int c = (u.pn & 3) * 256 + bj * 128 + wc * 32 + 8 * fq, hh = c >> 7, j0 = ((c & 127) >> 3) * 4;
#pragma unroll
                for (int ai = 0; ai < 2; ++ai)
#pragma unroll
                    for (int m = 0; m < 4; ++m) { const int row = row0 + ai * 128 + m * 16, s = row & (SEQ - 1);
                        const f32x4 cs = *(const f32x4*)(COSAp + s * 64 + j0), sn = *(const f32x4*)(SINAp + s * 64 + j0);
                        const f32x4 x1 = acc[ai][bj][m][0], x2 = acc[ai][bj][m][1];
                        const f32x4 o1 = x1 * cs - x2 * sn, o2 = x2 * cs + x1 * sn;
                        if (!isk) { float* q = QFp + (size_t)row * BW + hh * 128 + j0; *(f32x4*)q = o1; *(f32x4*)(q + 64) = o2; }
                        else { bf16* k = KABp + (size_t)row * BW + hh * 128 + j0; v2u a; a.x = pk2(o1[0], o1[1]); a.y = pk2(o1[2], o1[3]); v2u b; b.x = pk2(o2[0], o2[1]); b.y = pk2(o2[2], o2[3]);
                            *(v2u*)k = a; *(v2u*)(k + 64) = b; }
                        asm volatile("" ::: "memory");
                    }
            }
            return;
        }
        if (u.pn < 12) {
#pragma unroll
            for (int bj = 0; bj < 2; ++bj) { const int c = (u.pn - 8) * 256 + bj * 128 + wc * 32 + 8 * fq;
#pragma unroll
                for (int ai = 0; ai < 2; ++ai)
#pragma unroll
                    for (int m = 0; m < 4; ++m) { const f32x4 x0 = acc[ai][bj][m][0], x1 = acc[ai][bj][m][1];
                        v4u w; w.x = pk2(x0[0], x0[1]); w.y = pk2(x0[2], x0[3]); w.z = pk2(x1[0], x1[1]); w.w = pk2(x1[2], x1[3]);
                        *(v4u*)(VABp + (size_t)(row0 + ai * 128 + m * 16) * BW + c) = w; } }
            return;
        }
#pragma unroll
        for (int bj = 0; bj < 2; ++bj) {
            const int c = u.pn * 256 + bj * 128 + wc * 32 + 8 * fq;
            if (c >= 6432 && c < 6464) {
                if (layer != 0) {
#pragma unroll
                    for (int ai = 0; ai < 2; ++ai)
#pragma unroll
                        for (int m = 0; m < 4; ++m) { float* p = VRESp + (c - 6432) + (size_t)(row0 + ai * 128 + m * 16) * 32;
                            *(f32x4*)p = acc[ai][bj][m][0]; *(f32x4*)(p + 4) = acc[ai][bj][m][1]; }
                }
            } else if (c < 7552) {
                bf16* dst = PROJp + ((c < 6432 ? c : c - 32) - PSH);
#pragma unroll
                for (int ai = 0; ai < 2; ++ai)
#pragma unroll
                    for (int m = 0; m < 4; ++m) { const f32x4 x0 = acc[ai][bj][m][0], x1 = acc[ai][bj][m][1];
                        v4u w; w.x = pk2(x0[0], x0[1]); w.y = pk2(x0[2], x0[3]); w.z = pk2(x1[0], x1[1]); w.w = pk2(x1[2], x1[3]);
                        *(v4u*)(dst + (size_t)(row0 + ai * 128 + m * 16) * PLD) = w; }
            }
        }
    }
};


__device__ __forceinline__ float fma_(float a, float b, float c) { float r; asm("v_fma_f32 %0, %1, %2, %3" : "=v"(r) : "v"(a), "v"(b), "v"(c)); return r; }
__device__ __forceinline__ float mul_(float a, float b) { float r; asm("v_mul_f32 %0, %1, %2" : "=v"(r) : "v"(a), "v"(b)); return r; }
__device__ __forceinline__ float add_(float a, float b) { float r; asm("v_add_f32 %0, %1, %2" : "=v"(r) : "v"(a), "v"(b)); return r; }
typedef short s16x4 __attribute__((ext_vector_type(4)));
constexpr int AT_KOFF = 0, AT_VOFF = 25600, AT_STAGE = 25600 + 64 * 288;
#define AT_TR16(base, o) \
    asm volatile("ds_read_b64_tr_b16 %0, %16 offset:0\n\tds_read_b64_tr_b16 %1, %16 offset:4608\n\t" \
                 "ds_read_b64_tr_b16 %2, %16 offset:32\n\tds_read_b64_tr_b16 %3, %16 offset:4640\n\t" \
                 "ds_read_b64_tr_b16 %4, %16 offset:64\n\tds_read_b64_tr_b16 %5, %16 offset:4672\n\t" \
                 "ds_read_b64_tr_b16 %6, %16 offset:96\n\tds_read_b64_tr_b16 %7, %16 offset:4704\n\t" \
                 "ds_read_b64_tr_b16 %8, %16 offset:128\n\tds_read_b64_tr_b16 %9, %16 offset:4736\n\t" \
                 "ds_read_b64_tr_b16 %10, %16 offset:160\n\tds_read_b64_tr_b16 %11, %16 offset:4768\n\t" \
                 "ds_read_b64_tr_b16 %12, %16 offset:192\n\tds_read_b64_tr_b16 %13, %16 offset:4800\n\t" \
                 "ds_read_b64_tr_b16 %14, %16 offset:224\n\tds_read_b64_tr_b16 %15, %16 offset:4832\n\t" \
                 "s_waitcnt lgkmcnt(0)" \
                 : "=&v"(o[0]), "=&v"(o[1]), "=&v"(o[2]), "=&v"(o[3]), "=&v"(o[4]), "=&v"(o[5]), "=&v"(o[6]), "=&v"(o[7]), \
                   "=&v"(o[8]), "=&v"(o[9]), "=&v"(o[10]), "=&v"(o[11]), "=&v"(o[12]), "=&v"(o[13]), "=&v"(o[14]), "=&v"(o[15]) \
                 : "v"(base) : "memory")
template <int DQ, bool MOBA>
__device__ __forceinline__ void attn_tile(LAS unsigned char* lds, const int buf, const int it, const int q0, const int w, const int qq, const int g, const int qrow, const int own,
                                          const unsigned selbits, const float sc, const pg8::bf16x8 (&qf)[DQ / 32], f32x4 (&o)[8], float& m, float& l) {
    constexpr int KROW = (DQ + 8) * 2, VROW = 288, NDS = DQ / 32;
    const LAS unsigned char* kb = lds + buf * AT_STAGE + AT_KOFF;
    f32x4 st[4];
#pragma unroll
    for (int c = 0; c < 4; ++c) {
        st[c] = (f32x4){0.f, 0.f, 0.f, 0.f};
#pragma unroll
        for (int ds = 0; ds < NDS; ++ds) {
            const pg8::bf16x8 a = *(const LAS pg8::bf16x8*)(kb + (16 * c + qq) * KROW + (32 * ds + 8 * g) * 2);
            st[c] = __builtin_amdgcn_mfma_f32_16x16x32_bf16(a, qf[ds], st[c], 0, 0, 0);
        }
    }
    const int blk = it >> 2;
    const bool past = MOBA && (blk < own);
    if (past) {
        const bool selok = ((selbits >> blk) & 1u) != 0u;
#pragma unroll
        for (int c = 0; c < 4; ++c)
#pragma unroll
            for (int r = 0; r < 4; ++r) st[c][r] = selok ? st[c][r] : -INFINITY;
    } else if (it * 64 + 63 > q0 + 16 * w) {
#pragma unroll
        for (int c = 0; c < 4; ++c)
#pragma unroll
            for (int r = 0; r < 4; ++r) { const int key = it * 64 + 16 * c + 4 * g + r; st[c][r] = (key <= qrow) ? st[c][r] : -INFINITY; }
    }
    float mloc = fmaxf(fmaxf(st[0][0], st[0][1]), fmaxf(st[0][2], st[0][3]));
#pragma unroll
    for (int c = 1; c < 4; ++c) mloc = fmaxf(mloc, fmaxf(fmaxf(st[c][0], st[c][1]), fmaxf(st[c][2], st[c][3])));
    const int ln_ = qq + 16 * g;
    mloc = fmaxf(mloc, shfl_xor_(mloc, 16, ln_)); mloc = fmaxf(mloc, shfl_xor_(mloc, 32, ln_));
    const float mnew = fmaxf(m, mloc * sc);
    if (__any(mnew > m)) {
        const float alpha = __builtin_amdgcn_exp2f(m - mnew);
        l *= alpha;
#pragma unroll
        for (int i = 0; i < 8; ++i) o[i] *= alpha;
        m = mnew;
    }
    float ps = 0.f;
#pragma unroll
    for (int c = 0; c < 4; ++c)
#pragma unroll
        for (int r = 0; r < 4; ++r) { const float p = __builtin_amdgcn_exp2f(__builtin_fmaf(st[c][r], sc, -m)); st[c][r] = p; ps += p; }
    l += ps;
#pragma unroll
    for (int c0i = 0; c0i < 2; ++c0i) {
        v4u pw; pw.x = pk2(st[2 * c0i][0], st[2 * c0i][1]); pw.y = pk2(st[2 * c0i][2], st[2 * c0i][3]);
        pw.z = pk2(st[2 * c0i + 1][0], st[2 * c0i + 1][1]); pw.w = pk2(st[2 * c0i + 1][2], st[2 * c0i + 1][3]);
        const pg8::bf16x8 pb = __builtin_bit_cast(pg8::bf16x8, pw);
        const unsigned vaddr = (unsigned)(size_t)(lds + buf * AT_STAGE + AT_VOFF) + (unsigned)((32 * c0i + 4 * g + (qq >> 2)) * VROW + 8 * (qq & 3));
        s16x4 vr[16];
        AT_TR16(vaddr, vr);
#pragma unroll
        for (int i = 0; i < 8; ++i) {
            const pg8::bf16x8 a = __builtin_shufflevector(vr[2 * i], vr[2 * i + 1], 0, 1, 2, 3, 4, 5, 6, 7);
            o[i] = __builtin_amdgcn_mfma_f32_16x16x32_bf16(a, pb, o[i], 0, 0, 0);
        }
    }
}
template <int DQ, bool MOBA>
__device__ __forceinline__ void attn_unit(LAS unsigned char* lds, const bf16* Qg, int ldq, const bf16* Kg, int ldk, const bf16* Vg, int ldv,
                                          bf16* Og, int ldo, const unsigned char* sel, int qt, float sc, const int tid) {
    constexpr int KROW = (DQ + 8) * 2, VROW = 288, KCH = DQ / 8, NKC = 64 * KCH / 512, NDS = DQ / 32;
    const int lane = tid & 63, w = __builtin_amdgcn_readfirstlane(tid >> 6), qq = lane & 15, g = lane >> 4;
    const int q0 = qt * 128, qrow = q0 + 16 * w + qq, own = q0 >> 8;
    pg8::bf16x8 qf[NDS];
#pragma unroll
    for (int ds = 0; ds < NDS; ++ds) qf[ds] = *(const pg8::bf16x8*)(Qg + (size_t)qrow * ldq + 32 * ds + 8 * g);
    unsigned selbits = 0; if (MOBA) selbits = sel[(size_t)qrow * 8];
    f32x4 o[8];
#pragma unroll
    for (int i = 0; i < 8; ++i) o[i] = (f32x4){0.f, 0.f, 0.f, 0.f};
    float m = -1e30f, l = 0.f;
    const int ntiles = 2 * (qt + 1);
    v4u kA[NKC], vA[2], kB[NKC], vB[2];
    { const v4u z_ = {0u, 0u, 0u, 0u};
#pragma unroll
      for (int i_ = 0; i_ < NKC; ++i_) { kA[i_] = z_; kB[i_] = z_; }
      vA[0] = z_; vA[1] = z_; vB[0] = z_; vB[1] = z_; }
    unsigned kgo[NKC], vgo[2], klo[NKC], vlo[2];
#pragma unroll
    for (int i_ = 0; i_ < NKC; ++i_) { const int id_ = tid + 512 * i_, row_ = id_ / KCH, ch_ = id_ % KCH; kgo[i_] = (unsigned)(row_ * ldk + ch_ * 8) * 2u; klo[i_] = (unsigned)(row_ * KROW + ch_ * 16); }
#pragma unroll
    for (int i_ = 0; i_ < 2; ++i_) { const int id_ = tid + 512 * i_, row_ = id_ >> 4, ch_ = id_ & 15; vgo[i_] = (unsigned)(row_ * ldv + ch_ * 8) * 2u; vlo[i_] = (unsigned)(AT_VOFF + row_ * VROW + ch_ * 16); }
#define AT_GLOAD(KS, VS, tile) do { const char* kp_ = (const char*)Kg + (size_t)(tile) * 64 * ldk * 2; const char* vp_ = (const char*)Vg + (size_t)(tile) * 64 * ldv * 2; \
        _Pragma("unroll") for (int i_ = 0; i_ < NKC; ++i_) KS[i_] = *(const v4u*)(kp_ + kgo[i_]); \
        _Pragma("unroll") for (int i_ = 0; i_ < 2; ++i_) VS[i_] = *(const v4u*)(vp_ + vgo[i_]); } while (0)
#define AT_LSTORE(KS, VS, buf) do { _Pragma("unroll") for (int i_ = 0; i_ < NKC; ++i_) *(LAS v4u*)(lds + (buf) * AT_STAGE + klo[i_]) = KS[i_]; \
        _Pragma("unroll") for (int i_ = 0; i_ < 2; ++i_) *(LAS v4u*)(lds + (buf) * AT_STAGE + vlo[i_]) = VS[i_]; } while (0)
    AT_GLOAD(kA, vA, 0); AT_LSTORE(kA, vA, 0);
    AT_GLOAD(kA, vA, 1);
    __syncthreads();
    for (int it = 0; it < ntiles; it += 2) {
        if (it + 2 < ntiles) AT_GLOAD(kB, vB, it + 2);
        attn_tile<DQ, MOBA>(lds, 0, it, q0, w, qq, g, qrow, own, selbits, sc, qf, o, m, l);
        AT_LSTORE(kA, vA, 1);
        __syncthreads();
        if (it + 3 < ntiles) AT_GLOAD(kA, vA, it + 3);
        attn_tile<DQ, MOBA>(lds, 1, it + 1, q0, w, qq, g, qrow, own, selbits, sc, qf, o, m, l);
        if (it + 2 < ntiles) AT_LSTORE(kB, vB, 0);
        __syncthreads();
    }
    float ls = l + shfl_xor_(l, 16, lane); ls += shfl_xor_(ls, 32, lane);
    const float inv = 1.0f / ls;
#pragma unroll
    for (int i = 0; i < 8; ++i) { v2u ob; ob.x = pk2(o[i][0] * inv, o[i][1] * inv); ob.y = pk2(o[i][2] * inv, o[i][3] * inv);
        *(v2u*)(Og + (size_t)qrow * ldo + 16 * i + 4 * g) = ob; }
#undef AT_GLOAD
#undef AT_LSTORE
}
template <bool BT, class Epi>
__device__ __forceinline__ void gemm32(LAS float* lds, const float* A, int lda, size_t sA, const float* B, int ldb, size_t sB,
                                       int M, int N, int K, int nbatch, const int* rowidx, const Epi& epi, const int tid, const int G) {
    const int lane = tid & 63, wave = tid >> 6, wm = wave >> 1, wn = wave & 1;
    const int tilesM = (M + 127) >> 7, tilesN = (N + 127) >> 7, tilesPer = tilesM * tilesN, ntiles = tilesPer * nbatch;
    LAS float* As = lds;
    LAS float* Bs = lds + 2 * 16 * 132;
    for (int tile = blockIdx.x; tile < ntiles; tile += G) {
        const int bt = tile / tilesPer, r = tile % tilesPer, tm = r / tilesN, tn = r % tilesN;
        const int m0 = tm * 128, n0 = tn * 128;
        const float* Ab = A + (size_t)bt * sA; const float* Bb = B + (size_t)bt * sB;
        const int arow = tid >> 2, akq = (tid & 3) * 4;
        const int gr = m0 + arow; const bool aok = gr < M;
        const int src = aok ? (rowidx ? rowidx[gr] : gr) : 0;
        const float* ap = Ab + (size_t)src * lda + akq;
        const float* bp; bool bok; int bkr, bnq;
        if (BT) { bkr = 0; bnq = 0; const int gn = n0 + arow; bok = gn < N; bp = Bb + (size_t)(bok ? gn : 0) * ldb + akq; }
        else { bkr = tid >> 5; bnq = (tid & 31) * 4; bok = (n0 + bnq) < N; bp = Bb + (size_t)bkr * ldb + (bok ? (n0 + bnq) : 0); }
        f32x16 acc0, acc1;
#pragma unroll
        for (int i = 0; i < 16; ++i) { acc0[i] = 0.f; acc1[i] = 0.f; }
        f32x4 ra, rb;
        const f32x4 z4 = {0.f, 0.f, 0.f, 0.f};
        ra = aok ? *(const f32x4*)ap : z4;
        rb = bok ? *(const f32x4*)bp : z4;
        {
            LAS float* a_ = As; LAS float* b_ = Bs;
#pragma unroll
            for (int j = 0; j < 4; ++j) a_[(akq + j) * 132 + arow] = ra[j];
            if (BT) {
#pragma unroll
                for (int j = 0; j < 4; ++j) b_[(akq + j) * 132 + arow] = rb[j];
            } else *(LAS f32x4*)(b_ + bkr * 132 + bnq) = rb;
        }
        __syncthreads();
        for (int k0 = 0; k0 < K; k0 += 16) {
            const int cur = (k0 >> 4) & 1;
            const bool more = (k0 + 16) < K;
            if (more) {
                ra = aok ? *(const f32x4*)(ap + k0 + 16) : z4;
                if (BT) rb = bok ? *(const f32x4*)(bp + k0 + 16) : z4;
                else rb = bok ? *(const f32x4*)(bp + (size_t)(k0 + 16) * ldb) : z4;
            }
            const LAS float* a_ = As + cur * 16 * 132 + (lane >> 5) * 132 + wm * 32 + (lane & 31);
            const LAS float* b_ = Bs + cur * 16 * 132 + (lane >> 5) * 132 + wn * 64 + (lane & 31);
#pragma unroll
            for (int kk = 0; kk < 16; kk += 2) {
                const float a = a_[kk * 132], b0 = b_[kk * 132], b1 = b_[kk * 132 + 32];
                acc0 = __builtin_amdgcn_mfma_f32_32x32x2f32(a, b0, acc0, 0, 0, 0);
                acc1 = __builtin_amdgcn_mfma_f32_32x32x2f32(a, b1, acc1, 0, 0, 0);
            }
            if (more) {
                LAS float* aw = As + (cur ^ 1) * 16 * 132; LAS float* bw = Bs + (cur ^ 1) * 16 * 132;
#pragma unroll
                for (int j = 0; j < 4; ++j) aw[(akq + j) * 132 + arow] = ra[j];
                if (BT) {
#pragma unroll
                    for (int j = 0; j < 4; ++j) bw[(akq + j) * 132 + arow] = rb[j];
                } else *(LAS f32x4*)(bw + bkr * 132 + bnq) = rb;
            }
            __syncthreads();
        }
#pragma unroll
        for (int i = 0; i < 16; ++i) {
            const int row = m0 + wm * 32 + (i & 3) + 8 * (i >> 2) + 4 * (lane >> 5);
            const int c0 = n0 + wn * 64 + (lane & 31);
            if (row < M) {
                if (c0 < N) epi(bt, row, c0, acc0[i]);
                if (c0 + 32 < N) epi(bt, row, c0 + 32, acc1[i]);
            }
        }
    }
}

struct EpiStore { float* C; int ldc; size_t sC;
    __device__ __forceinline__ void operator()(int bt, int m, int n, float v) const { C[(size_t)bt * sC + (size_t)m * ldc + n] = v; } };
struct EpiDecay { float* C; const float* w0;
    __device__ __forceinline__ void operator()(int, int m, int n, float v) const {
        const float z = -(w0[n] + v); const float sp = z > 20.f ? z : log1pf(expf(z));
        C[(size_t)m * BW + n] = expf(-expf(-sp - 0.5f)); } };
struct EpiSigB { float* C; const float* b;
    __device__ __forceinline__ void operator()(int, int m, int n, float v) const { C[(size_t)m * BW + n] = sigmoidf_(b[n] + v); } };
struct EpiVLerp { float* V; const float* VF; const float* v0;
    __device__ __forceinline__ void operator()(int, int m, int n, float a) const {
        const size_t o = (size_t)m * BW + n; const float v = V[o]; V[o] = v + (VF[o] - v) * sigmoidf_(v0[n] + a); } };
template <bool FIRST> struct EpiGateAcc { float* MIX; const float* gate;
    __device__ __forceinline__ void operator()(int, int m, int n, float a) const {
        const float g = sigmoidf_(gate[(size_t)m * IN_COLS + n]); const size_t o = (size_t)m * D + n;
        MIX[o] = FIRST ? g * a : MIX[o] + g * a; } };
struct EpiResid { float* C; const float* R; int ldc;
    __device__ __forceinline__ void operator()(int, int m, int n, float a) const { const size_t o = (size_t)m * ldc + n; C[o] = ALPHA * R[o] + a; } };
struct EpiSwiglu { float* C; int ldc; size_t roff;
    __device__ __forceinline__ void operator()(int, int m, int n, float a) const {
        const size_t o = (roff + (size_t)m) * ldc + n; const float g = C[o]; C[o] = g * sigmoidf_(g) * a; } };

struct Args { const float* in[34]; float* out; unsigned char* ws; unsigned mask; int li; };

__device__ __forceinline__ unsigned char* opq(unsigned char* p) { asm volatile("" : "+s"(p)); return p; }
#define INP(i) ((const float*)(((const GAS float* const*)args.in)[(i) + zero_live]))
#define x_in INP(0)
#define w_in INP(1)
#define w_in_vres INP(2)
#define rwkv_mu INP(3)
#define rwkv_mu_vres INP(4)
#define rwkv_w0 INP(5)
#define rwkv_w_lora INP(6)
#define rwkv_a0 INP(7)
#define rwkv_a_lora INP(8)
#define rwkv_g_lora INP(9)
#define rwkv_v0 INP(10)
#define rwkv_v_lora INP(11)
#define rwkv_k_k INP(12)
#define rwkv_k_a INP(13)
#define rwkv_r_k INP(14)
#define rwkv_gn_g INP(15)
#define rwkv_gn_b INP(16)
#define mla_q_norm INP(17)
#define mla_w_uq INP(18)
#define mla_kv_norm INP(19)
#define mla_w_ukv INP(20)
#define branch_out INP(21)
#define w_out INP(22)
#define ln1_g INP(23)
#define ln1_b INP(24)
#define ffn_wg INP(25)
#define ffn_wu INP(26)
#define ffn_wd INP(27)
#define moe_router INP(28)
#define moe_wg INP(29)
#define moe_wu INP(30)
#define moe_wd INP(31)
#define ln2_g INP(32)
#define ln2_b INP(33)
#define COSA ((float*)(ws_live + WS_COSA))
#define SINA ((float*)(ws_live + WS_SINA))
#define COSM ((float*)(ws_live + WS_COSM))
#define SINM ((float*)(ws_live + WS_SINM))
#define TOK ((int*)(ws_live + WS_TOK))
#define ROWL ((int*)(ws_live + WS_ROWL))
#define XB ((float*)(ws_live + WS_XB))
#define X1 ((float*)(ws_live + WS_X1))
#define PRE ((float*)(ws_live + WS_PRE))
#define XBF ((bf16*)(ws_live + WS_XBF))
#define WINT ((bf16*)(ws_live + WS_WINT))
#define X1B ((bf16*)(ws_live + WS_X1B))
#define WBO ((bf16*)(ws_live + WS_WBO))
#define WOT ((bf16*)(ws_live + WS_WOT))
#define WGU ((bf16*)(ws_live + WS_WGU))
#define WD ((bf16*)(ws_live + WS_WD))
#define WDD ((bf16*)(ws_live + WS_WDD))
#define HGB ((bf16*)(ws_live + WS_HGB))
#define XG ((bf16*)(ws_live + WS_XG))
#define MIXB ((bf16*)(ws_live + WS_MIXB))
#define YALL ((bf16*)(ws_live + WS_YALL))
#define GATEB ((bf16*)(ws_live + WS_GATEB))
#define QAB ((bf16*)(ws_live + WS_QAB))
#define KAB ((bf16*)(ws_live + WS_KAB))
#define VAB ((bf16*)(ws_live + WS_VAB))
#define QCB ((bf16*)(ws_live + WS_QCB))
#define KCB ((bf16*)(ws_live + WS_KCB))
#define VCB ((bf16*)(ws_live + WS_VCB))
#define KMEAN ((float*)(ws_live + WS_KMEAN))
#define SELB ((unsigned char*)(ws_live + WS_SEL))
#define WUQ ((bf16*)(ws_live + WS_WUQ))
#define WUKV ((bf16*)(ws_live + WS_WUKV))
#define WLORA ((bf16*)(ws_live + WS_WLORA))
#define LA ((bf16*)(ws_live + WS_LA))
#define QNB ((bf16*)(ws_live + WS_QNB))
#define KVNB ((bf16*)(ws_live + WS_KVNB))
#define QF ((float*)(ws_live + WS_QF))
#define KMS ((float*)(ws_live + WS_KMEAN))
#define PROJ ((bf16*)(ws_live + WS_PROJ))
#define VRES ((float*)(ws_live + WS_VRES))
#define QA ((float*)(ws_live + WS_QA))
#define V0 ((float*)(ws_live + WS_V0))
#define V1 ((float*)(ws_live + WS_V1))
#define DEC ((float*)(ws_live + WS_DEC))
#define AA ((bf16*)(ws_live + WS_AA))
#define GG ((bf16*)(ws_live + WS_GG))
#define Y ((bf16*)(ws_live + WS_Y))
#define OUT ((float*)(ws_live + WS_OUT))


__global__ void __launch_bounds__(NTHREADS, 2) fwd_kernel(Args args) {
    extern __shared__ __attribute__((aligned(16))) unsigned char lds_raw[];
#define lds ((LAS float*)lds_raw)
    int wave_live = __builtin_amdgcn_readfirstlane((int)threadIdx.x >> 6);
    int tid_live = threadIdx.x;
#define RETID() do { int ln_; asm volatile("v_mbcnt_lo_u32_b32 %0, -1, 0\n\tv_mbcnt_hi_u32_b32 %0, -1, %0" : "=v"(ln_)); asm volatile("" : "+s"(wave_live)); tid_live = wave_live * 64 + ln_; } while (0)
#define tid tid_live
#define lane (tid_live & 63)
#define wave (__builtin_amdgcn_readfirstlane(tid_live >> 6))
#define gw ((int)blockIdx.x * NWAVES + wave)
#define NGW (G_live * NWAVES)
#define gt ((int)blockIdx.x * NTHREADS + tid_live)
#define NGT (G_live * NTHREADS)
#define misc ((volatile LAS unsigned*)((LAS unsigned char*)lds_raw + LDS_BYTES - 64))
    if (tid < 16) misc[tid] = tid == 6 ? 0xffffffffu : 0u;
    __syncthreads();
#define REOPAQUE() do { asm volatile("" : "+s"(ws_live)); asm volatile("" : "+s"(zero_live)); asm volatile("" : "+s"(G_live)); RETID(); } while (0)
#define TI_WINT(t_, ll_, r_) do { constexpr int NNB_ = NP / 32; const int kb_ = (r_) / NNB_, nb_ = (r_) % NNB_, c_ = nb_ * 32; \
    const float* W_ = w_in + (size_t)(ll_) * D * IN_COLS; int ldw_ = IN_COLS, sc_ = c_; \
    if (c_ < 6432) sc_ = c_; \
    else if (c_ < 6464) { if (ll_) { W_ = w_in_vres; ldw_ = 32; sc_ = 0; } else W_ = nullptr; } \
    else if (c_ < 7552) sc_ = c_ - 32; \
    else if (c_ < 7680) W_ = nullptr; \
    else sc_ = c_ - 160; \
    int scl_ = sc_ + (lane & 31); \
    if (c_ < 2048) { const int cl_ = c_ + (lane & 31), hh_ = cl_ >> 7, cc_ = cl_ & 127, e_ = cc_ & 7; scl_ = hh_ * 128 + (e_ < 4 ? 4 * (cc_ >> 3) + e_ : 64 + 4 * (cc_ >> 3) + (e_ - 4)); } \
    (t_).zero = W_ == nullptr; (t_).p = (W_ ? W_ : w_in) + scl_; (t_).ldw = ldw_; (t_).wt = WINT + (size_t)(ll_) * NP * D; (t_).K = D; (t_).r0 = c_; (t_).k0 = kb_ * 64; } while (0)
#define TI_WBO(t_, mat_, r_) do { const int kb_ = (r_) / 64, nb_ = (r_) % 64, ll_ = (mat_) / 3, seg_ = (mat_) % 3; \
    (t_).zero = false; (t_).p = branch_out + (size_t)(mat_) * BW * D + nb_ * 32 + (lane & 31); (t_).ldw = D; (t_).wt = WBO + (size_t)ll_ * D * 3 * BW + seg_ * BW; (t_).K = 3 * BW; (t_).r0 = nb_ * 32; (t_).k0 = kb_ * 64; } while (0)
#define TI_WUQ(t_, mat_, r_) do { const int kb_ = (r_) / 48, nb_ = (r_) % 48; \
    const int np_ = nb_ * 32 + (lane & 31), hh_ = np_ / 192, cc_ = np_ - hh_ * 192, q_ = cc_ - 128, e_ = q_ & 7; \
    const int sc_ = cc_ < 128 ? hh_ * 192 + cc_ : hh_ * 192 + 128 + (e_ < 4 ? 4 * (q_ >> 3) + e_ : 32 + 4 * (q_ >> 3) + (e_ - 4)); \
    (t_).zero = false; (t_).p = mla_w_uq + (size_t)(mat_) * 512 * 1536 + sc_; (t_).ldw = 1536; (t_).wt = WUQ + (size_t)(mat_) * 1536 * 512; (t_).K = 512; (t_).r0 = nb_ * 32; (t_).k0 = kb_ * 64; } while (0)
#define TI_WUKV(t_, mat_, r_) do { const int kb_ = (r_) / 64, nb_ = (r_) % 64; \
    (t_).zero = false; (t_).p = mla_w_ukv + (size_t)(mat_) * 512 * 2048 + nb_ * 32 + (lane & 31); (t_).ldw = 2048; (t_).wt = WUKV + (size_t)(mat_) * 2048 * 512; (t_).K = 512; (t_).r0 = nb_ * 32; (t_).k0 = kb_ * 64; } while (0)
#define TI_WOT(t_, mat_, r_) do { const int kb_ = (r_) / 64, nb_ = (r_) % 64; \
    (t_).zero = false; (t_).p = w_out + (size_t)(mat_) * D * D + nb_ * 32 + (lane & 31); (t_).ldw = D; (t_).wt = WOT + (size_t)(mat_) * D * D; (t_).K = D; (t_).r0 = nb_ * 32; (t_).k0 = kb_ * 64; } while (0)
constexpr int FC_I_GU = (D / 64) * (NGU / 32), FC_I_D = (DFF / 64) * (D / 32);
#define TI_GU(t_, wg_, wu_, e_, r_) do { const int kb_ = (r_) / (NGU / 32), nb_ = (r_) % (NGU / 32); const int rr_ = lane & 31, hcol_ = 4 * (nb_ * 4 + (rr_ >> 3)) + (rr_ & 3); \
    (t_).zero = false; (t_).p = ((rr_ & 7) < 4 ? (wg_) : (wu_)) + (size_t)(e_) * D * DFF + hcol_; (t_).ldw = DFF; (t_).wt = WGU + (size_t)(e_) * NGU * D; (t_).K = D; (t_).r0 = nb_ * 32; (t_).k0 = kb_ * 64; } while (0)
#define TI_D(t_, wd_, dst_, e_, r_) do { const int kb_ = (r_) / (D / 32), nb_ = (r_) % (D / 32); \
    (t_).zero = false; (t_).p = (wd_) + (size_t)(e_) * DFF * D + nb_ * 32 + (lane & 31); (t_).ldw = D; (t_).wt = (dst_) + (size_t)(e_) * D * DFF; (t_).K = DFF; (t_).r0 = nb_ * 32; (t_).k0 = kb_ * 64; } while (0)
#define TI_RUN1(ta_) do { float va_[32]; ti_load(ta_, va_, lane); ti_finish(ta_, va_, scr, lane); } while (0)
#define TI_RUN2(ta_, tb_) do { float va_[32], vb_[32]; ti_load(ta_, va_, lane); ti_load(tb_, vb_, lane); ti_finish(ta_, va_, scr, lane); ti_finish(tb_, vb_, scr, lane); } while (0)
#define CV_WINT_ITEM(ll_, r_) do { TI t1_; TI_WINT(t1_, ll_, r_); TI_RUN1(t1_); } while (0)
#define CV_WUQ_ITEM(mat_, r_) do { TI t1_; TI_WUQ(t1_, mat_, r_); TI_RUN1(t1_); } while (0)
#define CV_WUKV_ITEM(mat_, r_) do { TI t1_; TI_WUKV(t1_, mat_, r_); TI_RUN1(t1_); } while (0)
#define CV_LORA_ITEM(ll_, r_) do { \
    for (int j_ = 0; j_ < 32; ++j_) { const int x_ = (r_) * 2048 + j_ * 64 + lane, n_ = x_ / 384, k_ = x_ % 384, seg_ = n_ >> 10, c_ = n_ & 1023; \
        float v_ = 0.f; \
        if (seg_ == 0) { if (k_ < 64) v_ = rwkv_w_lora[((size_t)(ll_) * 64 + k_) * BW + c_]; } \
        else if (seg_ == 1) { if (k_ >= 64 && k_ < 128) v_ = rwkv_a_lora[((size_t)(ll_) * 64 + (k_ - 64)) * BW + c_]; } \
        else if (seg_ == 2) { if (k_ >= 128 && k_ < 288) v_ = rwkv_g_lora[((size_t)(ll_) * 160 + (k_ - 128)) * BW + c_]; } \
        else { if ((ll_) == 1 && k_ >= 288 && k_ < 320) v_ = rwkv_v_lora[(size_t)(k_ - 288) * BW + c_]; } \
        WLORA[(size_t)(ll_) * 4096 * 384 + x_] = (bf16)f2bf(v_); } } while (0)
#define FFN_CONV_PAIR(it_) do { const int fi_ = (it_); \
    if (l == 0) { if (fi_ < FC_I_GU) PAIR_OF(TI_GU, ffn_wg, ffn_wu, 0, fi_); else PAIR_OF(TI_D, ffn_wd, WDD, 0, fi_ - FC_I_GU); } \
    else PAIR_OF(TI_GU, moe_wg, moe_wu, fi_ / FC_I_GU, fi_ % FC_I_GU); } while (0)
#define FFN_CONV_N(l_) ((l_) == 0 ? FC_I_GU + FC_I_D : 4 * FC_I_GU)
#define PAIR_OF(TIM_, ...) do { TI ta_, tb_; TIM_(ta_, __VA_ARGS__); TIM_(tb_, __VA_ARGS__ + 1); TI_RUN2(ta_, tb_); } while (0)
#define DQ_PAIR(d_) do { const int d__ = (d_); \
    if (d__ < 3072) { PAIR_OF(TI_WBO, d__ >> 10, (d__ & 1023)); asm volatile("; dq0" ::: "memory"); } \
    else if (d__ < 5120) { PAIR_OF(TI_WOT, 0, d__ - 3072); asm volatile("; dq1" ::: "memory"); } \
    else if (d__ < 18944) { PAIR_OF(TI_WINT, 1, d__ - 5120); asm volatile("; dq2" ::: "memory"); } \
    else if (d__ < 19712) { }   \
    else if (d__ < 20096) { PAIR_OF(TI_WUQ, 1, d__ - 19712); asm volatile("; dq3" ::: "memory"); } \
    else if (d__ < 20608) { PAIR_OF(TI_WUKV, 1, d__ - 20096); asm volatile("; dq4" ::: "memory"); } \
    else if (d__ < 23680) { PAIR_OF(TI_WBO, 3 + ((d__ - 20608) >> 10), ((d__ - 20608) & 1023)); asm volatile("; dq5" ::: "memory"); } \
    else if (d__ < 25728) { PAIR_OF(TI_WOT, 1, d__ - 23680); asm volatile("; dq6" ::: "memory"); } \
    else if (d__ < DQ_J7) { PAIR_OF(TI_GU, moe_wg, moe_wu, 4 + (d__ - 25728) / FC_I_GU, (d__ - 25728) % FC_I_GU); asm volatile("; dq7" ::: "memory"); } \
    else { PAIR_OF(TI_D, moe_wd, WD, (d__ - DQ_J7) / FC_I_D, (d__ - DQ_J7) % FC_I_D); asm volatile("; dq8" ::: "memory"); } } while (0)
#define DQ_HALF(base_) do { const int dit_ = (int)(base_) + 2 * wave; if (dit_ < DQ_N) DQ_PAIR(dit_); } while (0)
#define DQ_PENDING() do { const unsigned pu_ = (unsigned)__builtin_amdgcn_readfirstlane((int)misc[6]); __syncthreads(); \
        if (pu_ != 0xffffffffu) { if (tid == 0) misc[6] = 0xffffffffu; DQ_HALF(pu_); } } while (0)
#define DQ_RUN(COND_) do { DQ_PENDING(); for (;;) { \
        if (tid == 0) { unsigned u_ = 0xffffffffu; \
            if (xb_ld(ctl + CW_DQ + 64 * li_) < (unsigned)DQ_N && (COND_)) u_ = atomicAdd(ctl + CW_DQ + 64 * li_, 32u); \
            misc[4] = u_; } \
        __syncthreads(); \
        const unsigned du_ = (unsigned)__builtin_amdgcn_readfirstlane((int)misc[4]); \
        __syncthreads(); \
        if (du_ >= (unsigned)DQ_N) break; \
        DQ_HALF(du_); \
        if (tid == 0) misc[5] = (COND_) ? 1u : 0u; \
        __syncthreads(); \
        const unsigned go_ = (unsigned)__builtin_amdgcn_readfirstlane((int)misc[5]); \
        __syncthreads(); \
        if (!go_) { if (tid == 0) misc[6] = du_ + 16u; __syncthreads(); break; } \
        DQ_HALF(du_ + 16u); \
    } } while (0)
#define DQ_FLUSH(UPTO_) do { DQ_PENDING(); for (;;) { \
        if (tid == 0) { const unsigned h_ = xb_ld(ctl + CW_DQ + 64 * li_); unsigned u_ = 0xffffffffu, nb_ = 0u; \
            if (h_ < (unsigned)(UPTO_)) { nb_ = ((((unsigned)(UPTO_) - h_ + (unsigned)G_live - 1u) / (unsigned)G_live) + 7u) & ~7u; nb_ = nb_ < 16u ? 16u : nb_; u_ = atomicAdd(ctl + CW_DQ + 64 * li_, nb_); } \
            misc[4] = u_; misc[5] = nb_; } \
        __syncthreads(); \
        const unsigned du_ = (unsigned)__builtin_amdgcn_readfirstlane((int)misc[4]), dn_ = (unsigned)__builtin_amdgcn_readfirstlane((int)misc[5]); \
        __syncthreads(); \
        if (du_ >= (unsigned)DQ_N) break; \
        const int de_ = (int)min(du_ + dn_, (unsigned)DQ_N); \
        _Pragma("unroll 1") \
        for (int dit_ = (int)du_ + 2 * wave; dit_ < de_; dit_ += 16) DQ_PAIR(dit_); \
    } } while (0)
#define DQ_FILL(SLOT_, TH_) DQ_RUN(xb_ld(ctl + CW_PD + 64 * ((SLOT_) + 8 * li_)) < (unsigned)(TH_))
#define PHASE_DONE(SLOT_) do { if (tid == 0) atomicAdd(ctl + CW_PD + 64 * ((SLOT_) + 8 * li_), 1u); } while (0)
#define GRID_BAR() do { { XcdBarrier bar_; bar_.bar = ctl + CW_BAR + li_ * XCD_BAR_WORDS; bar_.x = xb_xcc_id(); bar_.st = misc; xcd_barrier(bar_, tid_live); } asm volatile("" : "+s"(ws_live)); asm volatile("" : "+s"(zero_live)); asm volatile("" : "+s"(G_live)); RETID(); } while (0)

    GAS unsigned char* ws_live = *(GAS unsigned char* const*)&args.ws; int zero_live = 0; int G_live = (int)gridDim.x; unsigned mask_live = args.mask; const int li_ = args.li;
#define RUN(p) ((mask_live >> (l * 12 + (p))) & 1u)
#define ctl ((unsigned*)(ws_live + WS_CTL))
    (void)xcd_barrier_post(ctl + CW_BAR + li_ * XCD_BAR_WORDS, misc, tid_live);
    if (mask_live & (1u << 31)) {
    for (int i = gt; i < SEQ * 64; i += NGT) {
        const int s = i >> 6, j = i & 63;
        const float inv = 1.0f / powf(10000.0f, (float)(2 * j) / 128.0f);
        const float ang = (float)s * inv;
        COSA[i] = cosf(ang); SINA[i] = sinf(ang);
    }
    for (int i = gt; i < SEQ * 32; i += NGT) {
        const int s = i >> 5, j = i & 31;
        const float inv = 1.0f / powf(10000.0f, (float)(2 * j) / 64.0f);
        const float ang = (float)s * inv;
        COSM[i] = cosf(ang); SINM[i] = sinf(ang);
    }

    {
        LAS float* scr = (LAS float*)((LAS unsigned char*)lds_raw) + wave * (64 * 33);
        for (int it = gw; it < (D / 64) * (NP / 32); it += NGW) CV_WINT_ITEM(0, it);
        for (int it = gw; it < 2 * 768; it += NGW) { const int ll = it / 768, r = it % 768; CV_LORA_ITEM(ll, r); }
        for (int it = gw; it < 8 * 48; it += NGW) CV_WUQ_ITEM(0, it);
        for (int it = gw; it < 8 * 64; it += NGW) CV_WUKV_ITEM(0, it);
        for (int t = gw; t < T; t += NGW) {
#pragma unroll
            for (int jj = 0; jj < 8; ++jj) { const f32x4 v = *(const f32x4*)(x_in + (size_t)t * D + jj * 256 + lane * 4);
                v2u o; o.x = pk2(v[0], v[1]); o.y = pk2(v[2], v[3]); *(v2u*)(XBF + (size_t)t * D + jj * 256 + lane * 4) = o; }
        }
    }
    GRID_BAR();
    }
    for (int l = 0; l < 2; ++l) {
        const float* X = (l == 0) ? x_in : XB;
        float* Vcur = (l == 0) ? V0 : V1;
        if (RUN(0)) {
        {
            pg8::Gemm g{XBF, WINT + (size_t)l * NP * D, T, NP, D}; pg8::StaticOrder S; S.init(T, NP, G_live, (int)blockIdx.x);
            EpiInProjF32 E{PROJ, VRES, GATEB, QF, KAB, VAB, COSA, SINA, l};
            pg8::gemm_phase<EpiInProjF32, pg8::StaticOrder, false>((LAS unsigned char*)lds_raw, g, S, E, nullptr, tid);
        }
        REOPAQUE();
        {
            LAS float* scr = (LAS float*)((LAS unsigned char*)lds_raw) + wave * (64 * 33);
            PHASE_DONE(l * 4 + 0);
            DQ_FILL(l * 4 + 0, 65);
        }
        GRID_BAR();
        }
        if (RUN(1)) {
        if (l == 1) { LAS float* scr = (LAS float*)((LAS unsigned char*)lds_raw) + wave * (64 * 33); DQ_FLUSH(DQ_J5); }
        for (int item = blockIdx.x; item < NBATCH * 8 * 8; item += G_live) {
            const int blk = item & 7, h = (item >> 3) & 7, b = item >> 6;
            const int kq = tid >> 4, d8 = (tid & 15) * 8;
            const bf16* kbase = KAB + ((size_t)b * SEQ + blk * 256) * BW + h * 128 + d8;
            float sacc[8];
#pragma unroll
            for (int j = 0; j < 8; ++j) sacc[j] = 0.f;
#pragma unroll
            for (int it = 0; it < 8; ++it) { const v4u kv = *(const v4u*)(kbase + (size_t)(kq + 32 * it) * BW); const unsigned kw[4] = {kv.x, kv.y, kv.z, kv.w};
#pragma unroll
                for (int j = 0; j < 4; ++j) { sacc[2 * j] += __uint_as_float(kw[j] << 16); sacc[2 * j + 1] += __uint_as_float(kw[j] & 0xffff0000u); } }
#pragma unroll
            for (int j = 0; j < 8; ++j) lds[kq * 128 + d8 + j] = sacc[j];
            __syncthreads();
            if (tid < 128) { float a = 0.f;
#pragma unroll
                for (int rr = 0; rr < 32; ++rr) a += lds[rr * 128 + tid];
                KMS[(size_t)item * 128 + tid] = a; }
            __syncthreads();
        }
        {
            const float* mu = rwkv_mu + l * RWKV_COLS;
            for (int i0 = gt; i0 < (T / 4) * 256; i0 += 2 * NGT) {
                v2u row[2][5]; f32x4 mu4[2]; int tq[2], cc[2];
#pragma unroll
                for (int u_ = 0; u_ < 2; ++u_) {
                    const int i = i0 + u_ * NGT, ic = i < (T / 4) * 256 ? i : gt;
                    const int q = ic / 256, c4 = 2048 + (ic - q * 256) * 4, t0 = 4 * q, s0 = t0 & (SEQ - 1);
                    tq[u_] = i < (T / 4) * 256 ? t0 : -1; cc[u_] = c4;
                    const bf16* pr = PROJ + (size_t)t0 * PLD + (OFF_RWKV - PSH) + c4;
                    row[u_][0] = *(const v2u*)(s0 > 0 ? pr - PLD : pr);
                    if (s0 == 0) row[u_][0] = (v2u){0u, 0u};
#pragma unroll
                    for (int k = 0; k < 4; ++k) row[u_][k + 1] = *(const v2u*)(pr + (size_t)k * PLD);
                    mu4[u_] = *(const f32x4*)(mu + c4);
                }
#pragma unroll
                for (int u_ = 0; u_ < 2; ++u_) if (tq[u_] >= 0) {
                    float* dst = Vcur + (size_t)tq[u_] * BW + (cc[u_] & 1023);
#pragma unroll
                    for (int k = 0; k < 4; ++k) { const f32x4 cu = bf4_to_f32(row[u_][k + 1]), pv = bf4_to_f32(row[u_][k]); *(f32x4*)(dst + (size_t)k * BW) = cu + (pv - cu) * mu4[u_]; }
                }
            }
            for (int i = gt; i < T * 96; i += NGT) {
                const int t = i / 96, c4 = (i - t * 96) * 4, s = t & (SEQ - 1);
                f32x4 v = {0.f, 0.f, 0.f, 0.f};
                if (c4 < 288) {
                    const f32x4 cur = bf4_to_f32(*(const v2u*)(PROJ + (size_t)t * PLD + (OFF_RWKV - PSH) + 3072 + c4));
                    f32x4 prev = {0.f, 0.f, 0.f, 0.f}; if (s > 0) prev = bf4_to_f32(*(const v2u*)(PROJ + (size_t)(t - 1) * PLD + (OFF_RWKV - PSH) + 3072 + c4));
                    v = cur + (prev - cur) * *(const f32x4*)(mu + 3072 + c4);
                    if (c4 < 64) { v[0] = tanhf(v[0]); v[1] = tanhf(v[1]); v[2] = tanhf(v[2]); v[3] = tanhf(v[3]); }
                    else if (c4 >= 128) { v[0] = sigmoidf_(v[0]); v[1] = sigmoidf_(v[1]); v[2] = sigmoidf_(v[2]); v[3] = sigmoidf_(v[3]); }
                } else if (c4 < 320 && l == 1) {
                    const f32x4 cur = *(const f32x4*)(VRES + (size_t)t * 32 + (c4 - 288));
                    f32x4 prev = {0.f, 0.f, 0.f, 0.f}; if (s > 0) prev = *(const f32x4*)(VRES + (size_t)(t - 1) * 32 + (c4 - 288));
                    v = cur + (prev - cur) * *(const f32x4*)(rwkv_mu_vres + (c4 - 288));
                }
                v2u o; o.x = pk2(v[0], v[1]); o.y = pk2(v[2], v[3]); *(v2u*)(LA + (size_t)t * 384 + c4) = o;
            }
        }
        for (int t = gw; t < T; t += NGW) {
            const bf16* q = PROJ + (size_t)t * PLD + (OFF_MLA - PSH);
#pragma unroll
            for (int part = 0; part < 2; ++part) {
                const v4u qw = *(const v4u*)(q + part * 512 + lane * 8); v2u qlo, qhi; qlo.x = qw.x; qlo.y = qw.y; qhi.x = qw.z; qhi.y = qw.w;
                const f32x4 a = bf4_to_f32(qlo), b2 = bf4_to_f32(qhi);
                const float ss = (a[0] * a[0] + a[1] * a[1]) + (a[2] * a[2] + a[3] * a[3]) + (b2[0] * b2[0] + b2[1] * b2[1]) + (b2[2] * b2[2] + b2[3] * b2[3]);
                const float rs = rsqrtf(wave_sum(ss, lane) * (1.0f / 512.0f) + 1e-6f);
                const float* gn = (part ? mla_kv_norm : mla_q_norm) + l * 512 + lane * 8;
                const f32x4 g0 = *(const f32x4*)gn, g1 = *(const f32x4*)(gn + 4);
                v4u w; w.x = pk2(a[0] * rs * g0[0], a[1] * rs * g0[1]); w.y = pk2(a[2] * rs * g0[2], a[3] * rs * g0[3]);
                w.z = pk2(b2[0] * rs * g1[0], b2[1] * rs * g1[1]); w.w = pk2(b2[2] * rs * g1[2], b2[3] * rs * g1[3]);
                *(v4u*)((part ? KVNB : QNB) + (size_t)t * 512 + lane * 8) = w;
            }
            if (lane < 32) {
                const int s = t & (SEQ - 1);
                const float x1 = __builtin_bit_cast(float, (unsigned)q[1024 + lane] << 16), x2 = __builtin_bit_cast(float, (unsigned)q[1024 + 32 + lane] << 16), c = COSM[s * 32 + lane], sn = SINM[s * 32 + lane];
                const bf16 o1 = (bf16)f2bf(x1 * c - x2 * sn), o2 = (bf16)f2bf(x2 * c + x1 * sn);
#pragma unroll
                for (int hh = 0; hh < 8; ++hh) { KCB[(size_t)t * 1536 + hh * 192 + 128 + lane] = o1; KCB[(size_t)t * 1536 + hh * 192 + 160 + lane] = o2; }
            }
        }
        GRID_BAR();
        }
        if (RUN(2)) {
        {
            pg8::Gemm g{LA, WLORA + (size_t)l * 4096 * 384, T, l ? 4096 : 3072, 384 + zero_live}; pg8::StaticOrder S; S.init(T, l ? 4096 : 3072, G_live, (int)blockIdx.x);
            EpiLora E{DEC, AA, GG, V1, V0, rwkv_w0 + l * BW, rwkv_a0 + l * BW, rwkv_v0};
            pg8::gemm_phase<EpiLora, pg8::StaticOrder, false>((LAS unsigned char*)lds_raw, g, S, E, nullptr, tid);
        }
        REOPAQUE();
        {
            pg8::Gemm g{QNB, WUQ + (size_t)l * 1536 * 512, T, 1536, 512 + zero_live}; pg8::StaticOrder S; S.init(T, 1536, G_live, (int)blockIdx.x);
            EpiMlaQ E{QCB, COSM, SINM};
            pg8::gemm_phase<EpiMlaQ, pg8::StaticOrder, false>((LAS unsigned char*)lds_raw, g, S, E, nullptr, tid);
        }
        REOPAQUE();
        {
            pg8::Gemm g{KVNB, WUKV + (size_t)l * 2048 * 512, T, 2048, 512 + zero_live}; pg8::StaticOrder S; S.init(T, 2048, G_live, (int)blockIdx.x);
            EpiMlaKV E{KCB, VCB};
            pg8::gemm_phase<EpiMlaKV, pg8::StaticOrder, false>((LAS unsigned char*)lds_raw, g, S, E, nullptr, tid);
        }
        REOPAQUE();
        for (int i = gt; i < T * 8 * 16; i += NGT) {
            const int th = i >> 4, jg = (i & 15) * 4, t = th >> 3, h = th & 7, s = t & (SEQ - 1), own = s >> 8;
            const float* src_ = QF + (size_t)t * BW + h * 128 + jg;
            const f32x4 q1 = *(const f32x4*)src_, q2 = *(const f32x4*)(src_ + 64);
            v2u w1; w1.x = pk2(q1[0], q1[1]); w1.y = pk2(q1[2], q1[3]); v2u w2; w2.x = pk2(q2[0], q2[1]); w2.y = pk2(q2[2], q2[3]);
            *(v2u*)(QAB + (size_t)t * BW + h * 128 + jg) = w1; *(v2u*)(QAB + (size_t)t * BW + h * 128 + 64 + jg) = w2;
            const float* km = KMS + (size_t)(((t >> 11) * 8 + h) * 8) * 128 + jg;
            float gate[7];
#pragma unroll
            for (int n = 0; n < 7; ++n) {
                const f32x4 k1 = *(const f32x4*)(km + n * 128), k2 = *(const f32x4*)(km + n * 128 + 64);
                const float part = ((q1[0] * k1[0] + q1[1] * k1[1]) + (q1[2] * k1[2] + q1[3] * k1[3])) + ((q2[0] * k2[0] + q2[1] * k2[1]) + (q2[2] * k2[2] + q2[3] * k2[3]));
                gate[n] = row_allsum16(part);
            }
            unsigned bits = 0;
#pragma unroll
            for (int n = 0; n < 7; ++n) {
                int rank = 0;
#pragma unroll
                for (int m2 = 0; m2 < 7; ++m2) if (m2 != n) rank += (m2 < own && (gate[m2] > gate[n] || (gate[m2] == gate[n] && m2 < n))) ? 1 : 0;
                bits |= ((n < own) && (rank < 3)) ? (1u << n) : 0u;
            }
            if ((i & 15) == 0) SELB[(size_t)t * 8 + h] = (unsigned char)bits;
        }
        {
            LAS float* scr = (LAS float*)((LAS unsigned char*)lds_raw) + wave * (64 * 33);
            __syncthreads();
            PHASE_DONE(l * 4 + 2);
            DQ_FILL(l * 4 + 2, l == 0 ? 129 : 65);
        }
        GRID_BAR();
        }
        if (RUN(3)) {
        if (!(mask_live & (1u << 30)))
        for (int item = blockIdx.x; item < 128; item += G_live) {
            const int bh = item >> 1, half = item & 1, b = bh >> 4, h = bh & 15;
            const size_t base = (size_t)b * SEQ * BW + h * 64;
            constexpr int CH = 32, BUFF = 6 * CH * 64;
            LAS float* ypart = lds + 2 * BUFF;
            const int st_step = tid >> 4, st_j = (tid & 15) * 4;
            const int cbase = l * BW + h * 64 + st_j;
            const f32x4 ckk = *(const f32x4*)(rwkv_k_k + cbase), cka = *(const f32x4*)(rwkv_k_a + cbase);
            const int cg = lane & 15, rl = tid >> 4, irow = 32 * half + rl;
            const bool stager = tid < CH * 16;
            f32x4 g_w = {0.f, 0.f, 0.f, 0.f}, g_v = g_w; v2u g_ab = {0u, 0u};
            v2u g_rc = {0u, 0u}, g_rp = g_rc, g_kc = g_rc, g_kp = g_rc; int g_s = 0;
            const f32x4 mur = *(const f32x4*)(rwkv_mu + l * RWKV_COLS + h * 64 + st_j), muk = *(const f32x4*)(rwkv_mu + l * RWKV_COLS + 1024 + h * 64 + st_j);
            const bf16* pbase = PROJ + (size_t)b * SEQ * PLD + (OFF_RWKV - PSH) + h * 64 + st_j;
            float sa = 0.f, sb = 0.f, sc2 = 0.f, sd = 0.f;
#define SC_GLOAD(c) do { if (stager) { const size_t o_ = base + (size_t)((c) * CH + st_step) * BW + st_j; \
                g_s = (c) * CH + st_step; const bf16* pk_ = pbase + (size_t)g_s * PLD; \
                g_kc = *(const v2u*)(pk_ + 1024); g_kp = *(const v2u*)(pk_ - (g_s > 0 ? PLD : 0) + 1024); \
                g_rc = *(const v2u*)(pk_ - (g_s > 0 ? PLD : 0)); g_rp = *(const v2u*)(pk_ - (g_s > 1 ? 2 * PLD : 0)); \
                g_w = *(const f32x4*)(DEC + o_); g_ab = *(const v2u*)(AA + o_); g_v = *(const f32x4*)(Vcur + o_); } } while (0)
#define SC_LSTORE(bufi) do { if (stager) { \
                const f32x4 kc_ = bf4_to_f32(g_kc), rc_ = bf4_to_f32(g_rc); f32x4 kp_ = bf4_to_f32(g_kp), rp_ = bf4_to_f32(g_rp); \
                if (g_s == 0) kp_ = (f32x4){0.f, 0.f, 0.f, 0.f}; if (g_s <= 1) rp_ = (f32x4){0.f, 0.f, 0.f, 0.f}; \
                const f32x4 g_k = kc_ + (kp_ - kc_) * muk, g_r = rc_ + (rp_ - rc_) * mur, g_a = bf4_to_f32(g_ab); \
                f32x4 kk_ = g_k * ckk; \
                const float n2_ = row_allsum16((kk_[0] * kk_[0] + kk_[1] * kk_[1]) + (kk_[2] * kk_[2] + kk_[3] * kk_[3])); \
                kk_ = kk_ * __builtin_amdgcn_rcpf(fmaxf(sqrtf(n2_), 1e-12f)); \
                const f32x4 k2_ = g_k * (1.0f + (g_a - 1.0f) * cka); \
                LAS float* bb_ = lds + (bufi) * BUFF + st_step * 64 + st_j; \
                *(LAS f32x4*)(bb_ + 0 * CH * 64) = g_r; *(LAS f32x4*)(bb_ + 1 * CH * 64) = g_w; *(LAS f32x4*)(bb_ + 2 * CH * 64) = k2_; \
                *(LAS f32x4*)(bb_ + 3 * CH * 64) = kk_; *(LAS f32x4*)(bb_ + 4 * CH * 64) = kk_ * g_a; *(LAS f32x4*)(bb_ + 5 * CH * 64) = g_v; } } while (0)
#define SC_LD(X, st_) do { const LAS float* p_ = bb + (st_) * 64 + 4 * cg; \
                X##r = *(const LAS f32x4*)(p_ + 0 * CH * 64); X##w = *(const LAS f32x4*)(p_ + 1 * CH * 64); X##k = *(const LAS f32x4*)(p_ + 2 * CH * 64); \
                X##q = *(const LAS f32x4*)(p_ + 3 * CH * 64); X##b = *(const LAS f32x4*)(p_ + 4 * CH * 64); X##v = bb[5 * CH * 64 + (st_) * 64 + irow]; } while (0)
#define SC_STEP(X, st_) do { float d_, y_, t0_, t1_, t2_, t3_; \
                asm("v_mul_f32 %0, %4, %8\n\tv_mul_f32 %1, %4, %12\n\tv_mul_f32 %2, %6, %10\n\tv_mul_f32 %3, %6, %14\n\t" \
                    "v_fma_f32 %0, %5, %9, %0\n\tv_fma_f32 %1, %5, %13, %1\n\tv_fma_f32 %2, %7, %11, %2\n\tv_fma_f32 %3, %7, %15, %3\n\t" \
                    "v_add_f32 %0, %0, %2\n\tv_add_f32 %1, %1, %3" \
                    : "=&v"(d_), "=&v"(y_), "=&v"(t0_), "=&v"(t1_) \
                    : "v"(sa), "v"(sb), "v"(sc2), "v"(sd), "v"(X##q[0]), "v"(X##q[1]), "v"(X##q[2]), "v"(X##q[3]), "v"(X##r[0]), "v"(X##r[1]), "v"(X##r[2]), "v"(X##r[3])); \
                asm("s_nop 1\n\tv_add_f32_dpp %0, %0, %0 quad_perm:[1,0,3,2] row_mask:0xf bank_mask:0xf bound_ctrl:1\n\ts_nop 1\n\t" \
                    "v_add_f32_dpp %0, %0, %0 quad_perm:[2,3,0,1] row_mask:0xf bank_mask:0xf bound_ctrl:1" : "+v"(y_)); \
                ypart[(st_) * 128 + rl * 4 + (cg >> 2)] = y_;     \
                asm("v_mul_f32 %5, %9, %10\n\tv_mul_f32 %6, %9, %11\n\t" \
                    "v_add_f32_dpp %0, %0, %0 row_ror:8 row_mask:0xf bank_mask:0xf bound_ctrl:1\n\t" \
                    "v_mul_f32 %7, %9, %12\n\tv_mul_f32 %8, %9, %13\n\t" \
                    "v_add_f32_dpp %0, %0, %0 row_ror:4 row_mask:0xf bank_mask:0xf bound_ctrl:1\n\t" \
                    "v_fma_f32 %5, %1, %14, %5\n\tv_fma_f32 %6, %2, %15, %6\n\t" \
                    "v_add_f32_dpp %0, %0, %0 row_ror:2 row_mask:0xf bank_mask:0xf bound_ctrl:1\n\t" \
                    "v_fma_f32 %7, %3, %16, %7\n\tv_fma_f32 %8, %4, %17, %8\n\t" \
                    "v_add_f32_dpp %0, %0, %0 row_ror:1 row_mask:0xf bank_mask:0xf bound_ctrl:1\n\t" \
                    "s_nop 1\n\t" \
                    "v_fma_f32 %1, -%0, %18, %5\n\tv_fma_f32 %2, -%0, %19, %6\n\tv_fma_f32 %3, -%0, %20, %7\n\tv_fma_f32 %4, -%0, %21, %8" \
                    : "+v"(d_), "+v"(sa), "+v"(sb), "+v"(sc2), "+v"(sd), "=&v"(t0_), "=&v"(t1_), "=&v"(t2_), "=&v"(t3_) \
                    : "v"(X##v), "v"(X##k[0]), "v"(X##k[1]), "v"(X##k[2]), "v"(X##k[3]), "v"(X##w[0]), "v"(X##w[1]), "v"(X##w[2]), "v"(X##w[3]), \
                      "v"(X##b[0]), "v"(X##b[1]), "v"(X##b[2]), "v"(X##b[3])); } while (0)
            SC_GLOAD(0); SC_LSTORE(0);
            __syncthreads();
            for (int c = 0; c < SEQ / CH; ++c) {
                const bool more = (c + 1) < SEQ / CH;
                if (c == SEQ / CH - 2 && tid == 0) atomicAdd(ctl + CW_SD + 64 * (l + 2 * li_), 1u);
                if (more) SC_GLOAD(c + 1);
                const LAS float* bb = lds + (c & 1) * BUFF;
                f32x4 Ar, Aw, Ak, Aq, Ab, Br, Bw, Bk, Bq, Bb; float Av, Bv;
                SC_LD(A, 0);
#pragma unroll 1
                for (int st = 0; st < CH; st += 2) {
                    SC_LD(B, st + 1);
                    SC_STEP(A, st);
                    if (st + 2 < CH) SC_LD(A, st + 2);
                    SC_STEP(B, st + 1);
                }
                __syncthreads();
                {
                    const int stp = tid >> 4, r2 = (tid & 15) * 2;
                    const LAS f32x4* pp = (const LAS f32x4*)(ypart + stp * 128 + r2 * 4);
                    const f32x4 a0 = pp[0], a1 = pp[1];
                    if (c * CH + stp > 0) { bf16* yo = Y + base + (size_t)(c * CH + stp - 1) * BW + 32 * half + r2;
                        *(unsigned*)yo = pk2((a0[0] + a0[1]) + (a0[2] + a0[3]), (a1[0] + a1[1]) + (a1[2] + a1[3])); }
                }
                if (more) SC_LSTORE((c + 1) & 1);
                __syncthreads();
            }
            {
                const bf16* pl_ = PROJ + ((size_t)b * SEQ + SEQ - 1) * PLD + (OFF_RWKV - PSH) + h * 64 + 4 * cg;
                const f32x4 rcl = bf4_to_f32(*(const v2u*)pl_), rpl = bf4_to_f32(*(const v2u*)(pl_ - PLD));
                const f32x4 rl4 = rcl + (rpl - rcl) * *(const f32x4*)(rwkv_mu + l * RWKV_COLS + h * 64 + 4 * cg);
                const float yl = row_allsum16((sa * rl4[0] + sb * rl4[1]) + (sc2 * rl4[2] + sd * rl4[3]));
                if (cg == 0) Y[base + (size_t)(SEQ - 1) * BW + irow] = (bf16)f2bf(yl);
            }
#undef SC_GLOAD
#undef SC_LSTORE
#undef SC_LD
#undef SC_STEP
        }
        if (!(mask_live & (1u << 29)))
        for (;;) {
            if (tid == 0) misc[4] = atomicAdd(ctl + CW_AQ + 64 * (l + 2 * li_), 1u);
            __syncthreads();
            const unsigned u = misc[4];
            __syncthreads();
            if (u >= 1024u) break;
            const int qt = 15 - (int)(u >> 6), kind = (u >> 5) & 1, b = (u >> 3) & 3, h = u & 7;
            const size_t r0 = (size_t)b * SEQ;
            if (kind == 0)
                attn_unit<128, true>((LAS unsigned char*)lds_raw, QAB + r0 * BW + h * 128, BW, KAB + r0 * BW + h * 128, BW, VAB + r0 * BW + h * 128, BW,
                                     YALL + r0 * (3 * BW) + h * 128, 3 * BW, SELB + r0 * 8 + h, qt, 0.08838834764831845f * 1.4426950408889634f, tid);
            else
                attn_unit<192, false>((LAS unsigned char*)lds_raw, QCB + r0 * 1536 + h * 192, 1536, KCB + r0 * 1536 + h * 192, 1536, VCB + r0 * BW + h * 128, BW,
                                      YALL + r0 * (3 * BW) + 2 * BW + h * 128, 3 * BW, nullptr, qt, 0.07216878364870323f * 1.4426950408889634f, tid);
        }
        {
            LAS float* scr = (LAS float*)((LAS unsigned char*)lds_raw) + wave * (64 * 33);
            const unsigned ncu = (unsigned)(FFN_CONV_N(l) / 32);
            DQ_RUN(xb_ld(ctl + CW_SD + 64 * (l + 2 * li_)) < 128u && xb_ld(ctl + CW_DQ + 64 * li_) < (unsigned)(l == 0 ? DQ_J3 : DQ_J6));
            for (;;) {
                if (tid == 0) {
                    unsigned u_ = 0xffffffffu;
                    if (xb_ld(ctl + CW_SD + 64 * (l + 2 * li_)) < 128u) u_ = atomicAdd(ctl + CW_CQ + 64 * (l + 2 * li_), 1u);
                    misc[4] = u_;
                }
                __syncthreads();
                const unsigned u = (unsigned)__builtin_amdgcn_readfirstlane((int)misc[4]);
                __syncthreads();
                if (u >= ncu) break;
#pragma unroll 1
                for (int k_ = 0; k_ < 2; ++k_) { const int it = (int)u * 32 + k_ * 16 + 2 * wave; FFN_CONV_PAIR(it); }
            }
            DQ_FLUSH(l == 0 ? DQ_J3 : DQ_J6);
        }
        GRID_BAR();
        {
            const int pc = l * BW + (gt & 255) * 4;
            const f32x4 p_g = *(const f32x4*)(rwkv_gn_g + pc), p_b = *(const f32x4*)(rwkv_gn_b + pc), p_ka = *(const f32x4*)(rwkv_k_a + pc), p_rk = *(const f32x4*)(rwkv_r_k + pc);
            const bf16* pY = Y; const bf16* pA = AA; const float* pV = Vcur; const bf16* pG = GG; bf16* pO = YALL + BW;
            const bf16* pP = PROJ + (OFF_RWKV - PSH) + (gt & 255) * 4;
            const f32x4 p_mr = *(const f32x4*)(rwkv_mu + l * RWKV_COLS + (gt & 255) * 4), p_mk = *(const f32x4*)(rwkv_mu + l * RWKV_COLS + 1024 + (gt & 255) * 4);
            for (int i0 = gt; i0 < T * 16 * 16; i0 += 4 * NGT) {
                f32x4 y[4], aa[4], vv[4], gg[4]; v2u rc[4], rp[4], kc[4], kp[4], yb[4], ab[4], gb[4];
#pragma unroll
                for (int u_ = 0; u_ < 4; ++u_) { const int i = i0 + u_ * NGT, ic = i < T * 256 ? i : gt; const size_t o = (size_t)(ic >> 8) * BW + (ic & 255) * 4;
                    const bf16* pp = pP + (size_t)(ic >> 8) * PLD; const int back = ((ic >> 8) & (SEQ - 1)) > 0 ? PLD : 0;
                    yb[u_] = *(const v2u*)(pY + o); ab[u_] = *(const v2u*)(pA + o); vv[u_] = *(const f32x4*)(pV + o); gb[u_] = *(const v2u*)(pG + o);
                    rc[u_] = *(const v2u*)pp; rp[u_] = *(const v2u*)(pp - back); kc[u_] = *(const v2u*)(pp + 1024); kp[u_] = *(const v2u*)(pp - back + 1024); }
#pragma unroll
                for (int u_ = 0; u_ < 4; ++u_) { const int i = i0 + u_ * NGT;
                    y[u_] = bf4_to_f32(yb[u_]); aa[u_] = bf4_to_f32(ab[u_]); gg[u_] = bf4_to_f32(gb[u_]);
                    f32x4 kr, rr;
                    { const bool first = (((i < T * 256 ? i : gt) >> 8) & (SEQ - 1)) == 0; const f32x4 z4 = {0.f, 0.f, 0.f, 0.f};
                      const f32x4 rcf = bf4_to_f32(rc[u_]), kcf = bf4_to_f32(kc[u_]), rpf = first ? z4 : bf4_to_f32(rp[u_]), kpf = first ? z4 : bf4_to_f32(kp[u_]);
                      rr = rcf + (rpf - rcf) * p_mr; kr = kcf + (kpf - kcf) * p_mk; }
                    const float mu = row_allsum16((y[u_][0] + y[u_][1]) + (y[u_][2] + y[u_][3])) * (1.0f / 64.0f);
                    const f32x4 d = y[u_] - mu;
                    const float var = row_allsum16((d[0] * d[0] + d[1] * d[1]) + (d[2] * d[2] + d[3] * d[3])) * (1.0f / 64.0f);
                    const f32x4 yn = d * rsqrtf(var + 64e-5f) * p_g + p_b;
                    const f32x4 k2 = kr * (1.0f + (aa[u_] - 1.0f) * p_ka);
                    const f32x4 rk = rr * k2 * p_rk;
                    const float bon = row_allsum16((rk[0] + rk[1]) + (rk[2] + rk[3]));
                    const f32x4 o4 = (yn + bon * vv[u_]) * gg[u_];
                    v2u ob; ob.x = pk2(o4[0], o4[1]); ob.y = pk2(o4[2], o4[3]);
                    if (i < T * 256) *(v2u*)(pO + (size_t)(i >> 8) * (3 * BW) + (i & 255) * 4) = ob;
                }
            }
        }
        GRID_BAR();
        }
        if (RUN(4)) {
        {
            SegOrder S; S.base.init(T, D, G_live, (int)blockIdx.x);
            pg8::Gemm g{YALL, WBO + (size_t)l * D * 3 * BW, T, D, BW + zero_live, 3 * BW}; EpiBranch3 E{MIXB, GATEB};
            pg8::gemm_phase<EpiBranch3, SegOrder, false>((LAS unsigned char*)lds_raw, g, S, E, nullptr, tid);
        }
        GRID_BAR();
        }
        if (RUN(5)) {
        {
            pg8::Gemm g{MIXB, WOT + (size_t)l * D * D, T, D, D}; pg8::StaticOrder S; S.init(T, D, G_live, (int)blockIdx.x);
            EpiResidF32 E{PRE, X};
            pg8::gemm_phase<EpiResidF32, pg8::StaticOrder, false>((LAS unsigned char*)lds_raw, g, S, E, nullptr, tid);
        }
        GRID_BAR();
        }
        if (RUN(6)) {
        {
            LAS float* scr = (LAS float*)((LAS unsigned char*)lds_raw) + wave * (64 * 33);
            const int ntot = FFN_CONV_N(l);
            const int ndone = (int)min(xb_ld(ctl + CW_CQ + 64 * (l + 2 * li_)), (unsigned)(ntot / 32)) * 32;
            for (int it = ndone + 2 * gw; it < ntot; it += 2 * NGW) FFN_CONV_PAIR(it);
            if (l == 1) DQ_FLUSH(DQ_J7);
        }
        for (int t = gw; t < T; t += NGW) {
            const float* pr = PRE + (size_t)t * D;
            f32x4 v[8]; float s = 0.f;
#pragma unroll
            for (int jj = 0; jj < 8; ++jj) { v[jj] = *(const f32x4*)(pr + jj * 256 + lane * 4); s += (v[jj][0] + v[jj][1]) + (v[jj][2] + v[jj][3]); }
            const float mean = wave_sum(s, lane) * (1.0f / D); float s2 = 0.f;
#pragma unroll
            for (int jj = 0; jj < 8; ++jj) { v[jj] = v[jj] - mean; s2 += (v[jj][0] * v[jj][0] + v[jj][1] * v[jj][1]) + (v[jj][2] * v[jj][2] + v[jj][3] * v[jj][3]); }
            const float rstd = rsqrtf(wave_sum(s2, lane) * (1.0f / D) + 1e-5f);
#pragma unroll
            for (int jj = 0; jj < 8; ++jj) {
                const f32x4 g = *(const f32x4*)(ln1_g + l * D + jj * 256 + lane * 4), bb = *(const f32x4*)(ln1_b + l * D + jj * 256 + lane * 4);
                v[jj] = v[jj] * rstd * g + bb;
                *(f32x4*)(X1 + (size_t)t * D + jj * 256 + lane * 4) = v[jj];
                v2u ob; ob.x = pk2(v[jj][0], v[jj][1]); ob.y = pk2(v[jj][2], v[jj][3]); *(v2u*)(X1B + (size_t)t * D + jj * 256 + lane * 4) = ob;
            }
            if (l == 1) {
                float lg[8];
#pragma unroll
                for (int e = 0; e < 8; ++e) lg[e] = 0.f;
#pragma unroll
                for (int jj = 0; jj < 8; ++jj)
#pragma unroll
                    for (int cc = 0; cc < 4; ++cc) {
                        const int d = jj * 256 + lane * 4 + cc;
                        const f32x4 r0 = *(const f32x4*)(moe_router + (size_t)d * 8), r1 = *(const f32x4*)(moe_router + (size_t)d * 8 + 4);
                        const float xv = v[jj][cc];
                        lg[0] += xv * r0[0]; lg[1] += xv * r0[1]; lg[2] += xv * r0[2]; lg[3] += xv * r0[3];
                        lg[4] += xv * r1[0]; lg[5] += xv * r1[1]; lg[6] += xv * r1[2]; lg[7] += xv * r1[3];
                    }
#pragma unroll
                for (int e = 0; e < 8; ++e) lg[e] = wave_sum(lg[e], lane);
                if (lane == 0) {
                    int e0 = 0; float b0 = lg[0];
#pragma unroll
                    for (int e = 1; e < 8; ++e) if (lg[e] > b0) { b0 = lg[e]; e0 = e; }
                    int e1 = -1; float b1 = -INFINITY;
#pragma unroll
                    for (int e = 0; e < 8; ++e) if (e != e0 && lg[e] > b1) { b1 = lg[e]; e1 = e; }
                    const float w1 = 1.0f / (1.0f + expf(b0 - b1)), w0 = 1.0f - w1;
                    const int p0 = (int)atomicAdd(ctl + CW_CNT + 64 * e0, 1u), p1 = (int)atomicAdd(ctl + CW_CNT + 64 * e1, 1u);
                    int* tk = TOK + (size_t)t * 8;
                    tk[0] = e0; tk[1] = e1; tk[2] = p0; tk[3] = p1; tk[4] = __float_as_int(w0); tk[5] = __float_as_int(w1);
                }
            }
        }
        GRID_BAR();
        }
        float* OUTX = (l == 0) ? XB : (float*)(*(GAS float* const*)&args.out);
        if (l == 0) {
            if (RUN(7)) {
                pg8::Gemm g{X1B, WGU, T, NGU, D}; pg8::StaticOrder S; S.init(T, NGU, G_live, (int)blockIdx.x);
                EpiSwigluBf16 E{HGB, NGU / 256};
                pg8::gemm_phase<EpiSwigluBf16, pg8::StaticOrder, false>((LAS unsigned char*)lds_raw, g, S, E, nullptr, tid);
                REOPAQUE();
                {
                    LAS float* scr = (LAS float*)((LAS unsigned char*)lds_raw) + wave * (64 * 33);
                    PHASE_DONE(1);
                    DQ_FILL(1, 129);
                }
                GRID_BAR();
            }
            if (RUN(8)) {
                pg8::Gemm g{HGB, WDD, T, D, DFF}; pg8::StaticOrder S; S.init(T, D, G_live, (int)blockIdx.x);
                EpiResidF32 E{PRE, X1};
                pg8::gemm_phase<EpiResidF32, pg8::StaticOrder, false>((LAS unsigned char*)lds_raw, g, S, E, nullptr, tid);
                GRID_BAR();
            }
        } else {
            if (RUN(10)) {
            unsigned poff[9]; poff[0] = 0;
#pragma unroll
            for (int e = 0; e < 8; ++e) poff[e + 1] = poff[e] + ((xb_ld(ctl + CW_CNT + 64 * e) + 255u) & ~255u);
            for (int t = gw; t < T; t += NGW) {
                int* tk = TOK + (size_t)t * 8;
                const int e0 = tk[0], e1 = tk[1];
                unsigned o0 = 0, o1 = 0;
#pragma unroll
                for (int e = 0; e < 8; ++e) { o0 = (e == e0) ? poff[e] : o0; o1 = (e == e1) ? poff[e] : o1; }
                const int s0 = (int)o0 + tk[2], s1 = (int)o1 + tk[3];
                if (lane == 0) { tk[6] = s0; tk[7] = s1; }
#pragma unroll
                for (int j = 0; j < 4; ++j) { const v4u xv = *(const v4u*)(X1B + (size_t)t * D + j * 512 + lane * 8);
                    *(v4u*)(XG + (size_t)s0 * D + j * 512 + lane * 8) = xv; *(v4u*)(XG + (size_t)s1 * D + j * 512 + lane * 8) = xv; }
            }
            if (blockIdx.x == 0 && tid < 80) {
                unsigned e_of = 0; const unsigned mt = tid;
#pragma unroll
                for (int e = 1; e < 8; ++e) e_of += (mt * 256u >= poff[e]) ? 1u : 0u;
                ctl[CW_TILE + tid] = e_of;
                if (tid == 0) ctl[CW_TILE - 1] = poff[8] / 256u;
            }
            {
                const unsigned nmt_ = poff[8] / 256u, nfull_ = (nmt_ / 32u) * 32u; const size_t z0 = (size_t)nfull_ * 256 * D / 4, z1 = (size_t)nmt_ * 256 * D / 4;
                for (size_t i = z0 + gt; i < z1; i += NGT) *(f32x4*)(OUT + i * 4) = (f32x4){0.f, 0.f, 0.f, 0.f};
            }
            GRID_BAR();
            }
            const int nMt = (int)ctl[CW_TILE - 1];
            if (RUN(7)) {
                pg8::Gemm g{XG, WGU, MOE_ROWS, NGU, D}; MoeOrder S{ctl + CW_TILE, nMt, NGU / 256, G_live, (int)blockIdx.x};
                EpiSwigluBf16 E{HGB, NGU / 256};
                pg8::gemm_phase<EpiSwigluBf16, MoeOrder, false>((LAS unsigned char*)lds_raw, g, S, E, nullptr, tid);
                REOPAQUE();
                {
                    LAS float* scr = (LAS float*)((LAS unsigned char*)lds_raw) + wave * (64 * 33);
                    const int rem_ = ((int)ctl[CW_TILE - 1] * (NGU / 256)) % G_live;
                    PHASE_DONE(5);
                    DQ_FILL(5, (rem_ ? G_live - rem_ : 0) + 1);
                    DQ_FLUSH(DQ_N);
                }
                GRID_BAR();
            }
            if (RUN(8)) {
                const int nFull = (nMt / 32) * 32;
                { pg8::Gemm g{HGB, WD, MOE_ROWS, D, DFF}; MoeOrder S{ctl + CW_TILE, nFull, D / 256, G_live, (int)blockIdx.x};
                  EpiStoreF32 E{OUT, D / 256};
                  pg8::gemm_phase<EpiStoreF32, MoeOrder, false>((LAS unsigned char*)lds_raw, g, S, E, nullptr, tid); }
                REOPAQUE();
                { pg8::Gemm g{HGB, WD, MOE_ROWS, D, DFF / 4 + zero_live, DFF}; MoeOrder S{ctl + CW_TILE, nMt - nFull, D / 256, G_live, (int)blockIdx.x, nFull, 4, (DFF / 4) * 2};
                  EpiAtomicF32 E{OUT, D / 256};
                  pg8::gemm_phase<EpiAtomicF32, MoeOrder, false>((LAS unsigned char*)lds_raw, g, S, E, nullptr, tid); }
                GRID_BAR();
            }
        }
        if (RUN(9)) {
        if (l == 0) { LAS float* scr = (LAS float*)((LAS unsigned char*)lds_raw) + wave * (64 * 33); DQ_FLUSH(DQ_J4); }
        for (int t = gw; t < T; t += NGW) {
            f32x4 v[8]; float s = 0.f;
            if (l == 0) {
#pragma unroll
                for (int jj = 0; jj < 8; ++jj) v[jj] = *(const f32x4*)(PRE + (size_t)t * D + jj * 256 + lane * 4);
            } else {
                const int* tk = TOK + (size_t)t * 8;
                const float w0 = __int_as_float(tk[4]), w1 = __int_as_float(tk[5]); const int s0 = tk[6], s1 = tk[7];
                const int e0 = tk[0], e1 = tk[1];
#pragma unroll
                for (int jj = 0; jj < 8; ++jj) {
                    const f32x4 xx = *(const f32x4*)(X1 + (size_t)t * D + jj * 256 + lane * 4);
                    const f32x4 a = *(const f32x4*)(OUT + (size_t)s0 * D + jj * 256 + lane * 4), bq = *(const f32x4*)(OUT + (size_t)s1 * D + jj * 256 + lane * 4);
                    const f32x4 f = (e0 < e1) ? (w0 * a + w1 * bq) : (w1 * bq + w0 * a);
                    v[jj] = ALPHA * xx + f;
                }
            }
#pragma unroll
            for (int jj = 0; jj < 8; ++jj) s += (v[jj][0] + v[jj][1]) + (v[jj][2] + v[jj][3]);
            const float mean = wave_sum(s, lane) * (1.0f / D); float s2 = 0.f;
#pragma unroll
            for (int jj = 0; jj < 8; ++jj) { v[jj] = v[jj] - mean; s2 += (v[jj][0] * v[jj][0] + v[jj][1] * v[jj][1]) + (v[jj][2] * v[jj][2] + v[jj][3] * v[jj][3]); }
            const float rstd = rsqrtf(wave_sum(s2, lane) * (1.0f / D) + 1e-5f);
#pragma unroll
            for (int jj = 0; jj < 8; ++jj) {
                const f32x4 g = *(const f32x4*)(ln2_g + l * D + jj * 256 + lane * 4), bb = *(const f32x4*)(ln2_b + l * D + jj * 256 + lane * 4);
                const f32x4 o = v[jj] * rstd * g + bb;
                *(f32x4*)(OUTX + (size_t)t * D + jj * 256 + lane * 4) = o;
                if (l == 0) { v2u ob; ob.x = pk2(o[0], o[1]); ob.y = pk2(o[2], o[3]); *(v2u*)(XBF + (size_t)t * D + jj * 256 + lane * 4) = ob; }
            }
        }
        GRID_BAR();
        }
    }
}

extern "C" void kernel_launch(void* const* d_in, const int* in_sizes, int n_in, void* d_out, int out_size, void* d_ws, size_t ws_size, hipStream_t stream) {
    static int grid = 0;
    if (grid == 0) {
        if (n_in != 34 || out_size != T * D || ws_size < WS_END) { fprintf(stderr, "kernel_launch: bad sizes n_in %d out %d ws %zu need %zu\n", n_in, out_size, ws_size, (size_t)WS_END); grid = -1; return; }
        int dev = 0, cus = 0, per_cu = 0;
        if (hipGetDevice(&dev) != hipSuccess || hipDeviceGetAttribute(&cus, hipDeviceAttributeMultiprocessorCount, dev) != hipSuccess) { grid = -1; return; }
        if (hipFuncSetAttribute((const void*)fwd_kernel, hipFuncAttributeMaxDynamicSharedMemorySize, LDS_BYTES) != hipSuccess) { fprintf(stderr, "hipFuncSetAttribute failed\n"); grid = -1; return; }
        if (hipOccupancyMaxActiveBlocksPerMultiprocessor(&per_cu, (const void*)fwd_kernel, NTHREADS, LDS_BYTES) != hipSuccess || per_cu < 1) fprintf(stderr, "occupancy query says %d\n", per_cu);
        (void)hipGetLastError();
        grid = cus;
    }
    if (grid < 0) return;
    hipMemsetAsync((char*)d_ws + WS_CTL, 0, CTL_BYTES, stream);
    Args a{};
    for (int i = 0; i < 34; ++i) a.in[i] = (const float*)d_in[i];
    a.out = (float*)d_out; a.ws = (unsigned char*)d_ws; a.mask = 0x9FFFFFFFu; a.li = 0;
    hipLaunchKernelGGL(fwd_kernel, dim3(grid), dim3(NTHREADS), LDS_BYTES, stream, a);
#ifdef PROBE_MASK
    a.mask = PROBE_MASK; a.li = 1;
    hipLaunchKernelGGL(fwd_kernel, dim3(grid), dim3(NTHREADS), LDS_BYTES, stream, a);
#endif
}
```

```cpp
#include <hip/hip_runtime.h>
#include <stdint.h>
#include <stdio.h>

constexpr int D = 2048, NBATCH = 4, SEQ = 2048, T = NBATCH * SEQ;
constexpr int BW = 1024;
constexpr int IN_COLS = 13664;
constexpr int OFF_RWKV = 3072, OFF_MLA = 6432, OFF_GATE = 7520;
constexpr int RWKV_COLS = 3360;
constexpr int DFF = 5632, NEXP = 8;
constexpr float ALPHA = 1.41421356237f;
constexpr int NTHREADS = 512, NWAVES = 8;
constexpr int LDS_BYTES = 131072 + 17408 + 512;

#define LAS __attribute__((address_space(3)))
#define GAS __attribute__((address_space(1)))
typedef float f32x16 __attribute__((ext_vector_type(16)));
typedef float f32x4 __attribute__((ext_vector_type(4)));

constexpr size_t MiB = 1u << 20;
constexpr size_t al(size_t x) { return (x + 255) & ~(size_t)255; }
constexpr size_t WS_CTL = 0, CTL_BYTES = 1 * MiB;
constexpr size_t WS_COSA = 1 * MiB;
constexpr size_t WS_SINA = WS_COSA + 2048 * 64 * 4;
constexpr size_t WS_COSM = WS_SINA + 2048 * 64 * 4;
constexpr size_t WS_SINM = WS_COSM + 2048 * 32 * 4;
constexpr size_t WS_TOK = 3 * MiB;
constexpr size_t WS_ROWL = WS_TOK + (size_t)T * 8 * 4;
constexpr size_t WS_XB = 4 * MiB;
constexpr size_t WS_X1 = WS_XB + (size_t)T * D * 4;
constexpr size_t WS_PRE = WS_X1 + (size_t)T * D * 4;
constexpr int NP = 13824;
constexpr size_t WS_XBF = WS_PRE + (size_t)T * D * 4;
constexpr size_t WS_WINT = WS_XBF + (size_t)T * D * 2;
constexpr size_t WS_X1B = WS_WINT + (size_t)2 * NP * D * 2;
constexpr size_t WS_WBO = WS_X1B + (size_t)T * D * 2;
constexpr size_t WS_WOT = WS_WBO + (size_t)6 * D * BW * 2;
constexpr size_t WS_WUQ = WS_WOT + (size_t)2 * D * D * 2;
constexpr size_t WS_WUKV = WS_WUQ + (size_t)2 * 1536 * 512 * 2;
constexpr size_t WS_WLORA = WS_WUKV + (size_t)2 * 2048 * 512 * 2;
constexpr size_t WS_V0 = WS_WLORA + (size_t)2 * 4096 * 384 * 2;
constexpr size_t WS_MIXER = WS_V0 + (size_t)T * BW * 4;
constexpr int MOE_ROWS = 2 * T + NEXP * 256;
constexpr int NGU = 2 * DFF;
constexpr int PLD = 4448, PSH = 3072;
constexpr size_t WS_PROJ = WS_MIXER;
constexpr size_t WS_V1 = al(WS_PROJ + (size_t)T * PLD * 2);
constexpr size_t WS_DEC = WS_V1 + (size_t)T * BW * 4;
constexpr size_t WS_AA = WS_DEC + (size_t)T * BW * 4;
constexpr size_t WS_GG = WS_AA + (size_t)T * BW * 4;
constexpr size_t WS_Y = WS_GG + (size_t)T * BW * 4;
constexpr size_t WS_LA = WS_Y + (size_t)T * BW * 4;
constexpr size_t WS_QNB = WS_LA + (size_t)T * 384 * 2;
constexpr size_t WS_KVNB = WS_QNB + (size_t)T * 512 * 2;
constexpr size_t WS_YALL = WS_KVNB + (size_t)T * 512 * 2;
constexpr size_t WS_GATEB = WS_YALL + (size_t)T * 3 * BW * 2;
constexpr size_t WS_QAB = WS_GATEB + (size_t)T * 3 * D * 2;
constexpr size_t WS_KAB = WS_QAB + (size_t)T * BW * 2;
constexpr size_t WS_VAB = WS_KAB + (size_t)T * BW * 2;
constexpr size_t WS_QCB = WS_VAB + (size_t)T * BW * 2;
constexpr size_t WS_KCB = WS_QCB + (size_t)T * 1536 * 2;
constexpr size_t WS_VCB = WS_KCB + (size_t)T * 1536 * 2;
constexpr size_t WS_MIXB = WS_VCB + (size_t)T * BW * 2;
constexpr size_t WS_L_END = WS_MIXB + (size_t)T * D * 2;
constexpr size_t WS_HGB = WS_MIXER;
constexpr size_t WS_XG = WS_HGB + (size_t)MOE_ROWS * DFF * 2;
constexpr size_t WS_OUT = WS_XG + (size_t)MOE_ROWS * D * 2;
static_assert(WS_OUT + (size_t)MOE_ROWS * D * 4 <= WS_L_END, "FFN activations must stay inside region L");
constexpr size_t WS_WGU = WS_L_END;
constexpr size_t WS_VRES = WS_WGU;
constexpr size_t WS_QF = al(WS_VRES + (size_t)T * 32 * 4);
static_assert(WS_QF + (size_t)T * BW * 4 <= WS_WGU + (size_t)4 * NGU * D * 2, "region P must end inside WGU[0..3]");
constexpr size_t WS_WD = WS_WGU + (size_t)NEXP * NGU * D * 2;
constexpr size_t WS_WDD = WS_WGU + (size_t)NGU * D * 2;
constexpr size_t WS_END = WS_WD + (size_t)NEXP * D * DFF * 2;
constexpr size_t WS_KMEAN = WS_TOK + 512 * 1024;
constexpr size_t WS_SEL = WS_TOK + 768 * 1024;

static_assert(WS_END <= (size_t)1560 * MiB, "ws budget");
constexpr int CW_CNT = 1024;
constexpr int CW_OFF = 2048;
constexpr int CW_AQ = 3072;
constexpr int CW_CQ = 3328;
constexpr int CW_SD = 3584;
constexpr int CQ_ITEMS = 16;
constexpr int CW_DQ = 12288;
constexpr int CW_PD = 12544;
constexpr int DQ_J3 = 5120, DQ_J4 = 18944, DQ_J5 = 20608, DQ_J6 = 25728, DQ_J7 = DQ_J6 + 4 * 11264, DQ_N = DQ_J7 + 8 * 5632;
constexpr int CW_TILE = 2304;
constexpr int CW_BAR = 4096;

#define XB_TMO      128
#define XB_XCNT(j)  (256  + 64 * (j))
#define XB_XSUB(j)  (1280 + 64 * (j))
#define XB_XGEN(j)  (2304 + 64 * (j))
#define XB_TOP      3328
#define XB_TOPGEN   3392
#define XCD_BAR_WORDS 3456
#define XB_SPIN_CAP (1u << 22)

__device__ __forceinline__ unsigned xb_ld(unsigned* p)              { return __hip_atomic_load(p, __ATOMIC_RELAXED, __HIP_MEMORY_SCOPE_AGENT); }
__device__ __forceinline__ unsigned xb_add(unsigned* p, unsigned v) { return __hip_atomic_fetch_add(p, v, __ATOMIC_RELAXED, __HIP_MEMORY_SCOPE_AGENT); }
__device__ __forceinline__ unsigned xb_xcc_id() { return (unsigned)__builtin_amdgcn_s_getreg((3 << 11) | 20) & 0xFu; }
#define XB_SPIN(cond, bar) do { unsigned _sp = 0; while (cond) { __builtin_amdgcn_s_sleep(1); \
    if ((++_sp & 255u) == 0u) { if (xb_ld(&(bar)[XB_TMO])) break; if (_sp > XB_SPIN_CAP) { atomicAdd(&(bar)[XB_TMO], 1u); break; } } } } while (0)

struct XcdBarrier { unsigned* bar; unsigned x; volatile LAS unsigned* st; };

__device__ __forceinline__ XcdBarrier xcd_barrier_post(unsigned* bar, volatile LAS unsigned* st, const int tid0) {
    XcdBarrier b; b.bar = bar; b.x = xb_xcc_id(); b.st = st;
    if (tid0 == 0) (void)xb_add(&bar[XB_XCNT(b.x)], 1u);
    return b;
}
__device__ __forceinline__ void xcd_barrier_complete(unsigned* bar, unsigned x, unsigned& nloc, unsigned& nx) {
    const unsigned G = gridDim.x * gridDim.y * gridDim.z;
    unsigned sum, cnt, mine, sp = 0u;
    for (;;) {
        sum = 0u; cnt = 0u; mine = 0u;
#pragma unroll
        for (unsigned j = 0; j < 16; ++j) { const unsigned c = xb_ld(&bar[XB_XCNT(j)]); sum += c; cnt += (c > 0u) ? 1u : 0u; mine = (j == x) ? c : mine; }
        if (sum == G) break;
        __builtin_amdgcn_s_sleep(1);
        if ((++sp & 255u) == 0u) { if (xb_ld(&bar[XB_TMO])) break; if (sp > XB_SPIN_CAP) { atomicAdd(&bar[XB_TMO], 1u); break; } }
    }
    nloc = mine > 0u ? mine : 1u; nx = cnt > 0u ? cnt : 1u;
}
__device__ __forceinline__ void xcd_barrier(const XcdBarrier& b, const int tid0) {
    asm volatile("s_waitcnt vmcnt(0)" ::: "memory");
    __syncthreads();
    if (tid0 == 0) {
        unsigned* bar = b.bar;
        __builtin_amdgcn_s_waitcnt(0);
        unsigned nloc = b.st[0], nx = b.st[1];
        if (nloc == 0u) { xcd_barrier_complete(bar, b.x, nloc, nx); b.st[0] = nloc; b.st[1] = nx; }
        const unsigned old = xb_add(&bar[XB_XSUB(b.x)], 1u);
        const unsigned gen = old / nloc;
        if (old + 1u == (gen + 1u) * nloc) {
            __builtin_amdgcn_fence(__ATOMIC_RELEASE, "agent");
            asm volatile("s_waitcnt vmcnt(0)" ::: "memory");
            const unsigned og = xb_add(&bar[XB_TOP], 1u);
            const unsigned tg = og / nx;
            if (og + 1u == (tg + 1u) * nx) xb_add(&bar[XB_TOPGEN], 1u);
            else XB_SPIN(xb_ld(&bar[XB_TOPGEN]) == tg, bar);
            __builtin_amdgcn_fence(__ATOMIC_ACQUIRE, "agent");
            xb_add(&bar[XB_XGEN(b.x)], 1u);
            asm volatile("s_waitcnt vmcnt(0)" ::: "memory");
        } else {
            XB_SPIN(xb_ld(&bar[XB_XGEN(b.x)]) == gen, bar);
            __builtin_amdgcn_fence(__ATOMIC_ACQUIRE, "agent");
            asm volatile("s_waitcnt vmcnt(0)" ::: "memory");
        }
    }
    __syncthreads();
}

__device__ __forceinline__ float shfl_xor_(float v, int mask, int ln) { return __builtin_bit_cast(float, __builtin_amdgcn_ds_bpermute((ln ^ mask) << 2, __builtin_bit_cast(int, v))); }
__device__ __forceinline__ float wave_sum(float v, int ln) {
    v += __builtin_bit_cast(float, __builtin_amdgcn_update_dpp(0, __builtin_bit_cast(int, v), 0x128, 0xf, 0xf, false));
    v += __builtin_bit_cast(float, __builtin_amdgcn_update_dpp(0, __builtin_bit_cast(int, v), 0x124, 0xf, 0xf, false));
    v += __builtin_bit_cast(float, __builtin_amdgcn_update_dpp(0, __builtin_bit_cast(int, v), 0x122, 0xf, 0xf, false));
    v += __builtin_bit_cast(float, __builtin_amdgcn_update_dpp(0, __builtin_bit_cast(int, v), 0x121, 0xf, 0xf, false));
    v += shfl_xor_(v, 16, ln); v += shfl_xor_(v, 32, ln);
    return v;
}
__device__ __forceinline__ float sigmoidf_(float x) { return 1.0f / (1.0f + expf(-x)); }

namespace pg8 {
#define PG8_LAS __attribute__((address_space(3)))
typedef unsigned short bf16_t;
typedef short bf16x8 __attribute__((ext_vector_type(8)));
typedef float f32x4 __attribute__((ext_vector_type(4)));
typedef unsigned u32x4 __attribute__((ext_vector_type(4)));
constexpr int BM = 256, BK = 64, HALF = 128, HTB = HALF * BK * 2  , STAGE_BYTES = 8 * HTB, NXCD = 8, WGM = 8;

__host__ __device__ __forceinline__ int lds_byte(int r, int c) { const int st = (r >> 4) * 2 + (c >> 5), rr = r & 15, cc = c & 31, ob = rr * 64 + cc * 2; return st * 1024 + (ob ^ (((ob >> 9) & 1) << 5)); }
__host__ __device__ __forceinline__ void stage_rc(int b, int& R, int& C) { const int st = b / 1024, sb = b % 1024, swz = sb ^ (((sb >> 9) & 1) << 5); R = (st >> 1) * 16 + swz / 64; C = (st & 1) * 32 + (swz % 64) / 2; }
__host__ __device__ __forceinline__ int perm32(int rho) { const int n = rho >> 4, i = rho & 15; return 8 * (i >> 2) + 4 * n + (i & 3); }

struct Unit { int pm, pn; int ko = 0; };
struct Gemm { const bf16_t* A; const bf16_t* Bt; int M, N, K; int ld = 0; };

struct StaticOrder {
    int nM, nN, nwg, G, c;
    __host__ __device__ void init(int M, int N, int G_, int c_) { nM = M / BM; nN = N / BM; nwg = nM * nN; G = G_; c = c_; }
    __host__ __device__ bool next(int i, Unit& u) const {
        const long L = (long)i * G + c; if (L >= nwg) return false;
        int wgid = (int)L; { const int q = nwg / NXCD, r = nwg % NXCD, xcd = wgid % NXCD, off = wgid / NXCD; wgid = (xcd < r ? xcd * (q + 1) : r * (q + 1) + (xcd - r) * q) + off; }
        const int nig = WGM * nN, gid = wgid / nig, fm = gid * WGM, gsz = (nM - fm) < WGM ? (nM - fm) : WGM;
        u.pm = fm + ((wgid % nig) % gsz); u.pn = (wgid % nig) / gsz; return true;
    }
    __device__ __forceinline__ void a_ready(const Unit&) const {}
    __device__ __forceinline__ void done(const Unit&) const {}
};
__device__ __forceinline__ unsigned cvt_pk_bf16(float lo, float hi) { unsigned r; asm volatile("v_cvt_pk_bf16_f32 %0, %1, %2" : "=v"(r) : "v"(lo), "v"(hi)); return r; }
typedef float f32x2 __attribute__((ext_vector_type(2)));
template <class Epi, class Sched, bool STAMP = false>
__device__ __forceinline__ void gemm_phase(PG8_LAS unsigned char* lds, const Gemm g, const Sched& S, const Epi& E, unsigned long long* stamps, const int tid) {
    const int wid = __builtin_amdgcn_readfirstlane(tid >> 6), lane = tid & 63, wr = wid >> 2, wc = wid & 3, fr = lane & 15, fq = lane >> 4;
    const int K = g.K, nt = K / BK, LD = g.ld ? g.ld : g.K;
    int ts_lo = 0, ts_hi = 0, nts = 0; const unsigned long long rt_entry = STAMP ? (unsigned long long)wall_clock64() : 0ull;
#define PG8_STAMP() do { if (STAMP && wid == 0 && nts < 64) { const unsigned long long _c = (unsigned long long)clock64(); \
        ts_lo = (lane == nts) ? (int)(unsigned)_c : ts_lo; ts_hi = (lane == nts) ? (int)(unsigned)(_c >> 32) : ts_hi; ++nts; } } while (0)
    PG8_STAMP();
    unsigned voffA[2], voffB[2];
#pragma unroll
    for (int i = 0; i < 2; ++i) { int R, C; stage_rc(tid * 16 + i * 8192, R, C); const int Rb = Epi::PERM ? ((R & ~31) + perm32(R & 31)) : R;
        voffA[i] = (unsigned)(R * LD + C) * 2u; voffB[i] = (unsigned)(Rb * LD + C) * 2u; }
    const size_t kstep = (size_t)(BK * 2);
    const size_t hstep = (size_t)HALF * LD * 2;
    const size_t tstep = 2 * hstep;
    const unsigned ldsw = (unsigned)wid * 1024u;
    const int aoff = lds_byte(wr * 64 + fr, fq * 8), boff = lds_byte(wc * 32 + fr, fq * 8);
#define PG8_SA(b, h) (((b) * 2 + (h)) * HTB)
#define PG8_SB(b, h) ((4 + (b) * 2 + (h)) * HTB)
#define PG8_STAGE(bufoff, gbase, voff) do { _Pragma("unroll") for (int _i = 0; _i < 2; ++_i) \
        __builtin_amdgcn_global_load_lds((const unsigned*)((const char*)(gbase) + (voff)[_i]), (PG8_LAS unsigned*)(lds + (bufoff) + ldsw + _i * 8192), 16, 0, 0); } while (0)
#define PG8_LDA(dst, b, h) do { _Pragma("unroll") for (int m = 0; m < 4; ++m) _Pragma("unroll") for (int k = 0; k < 2; ++k) dst[m][k] = *(const PG8_LAS bf16x8*)(lds + PG8_SA(b, h) + aoff + m * 2048 + k * 1024); } while (0)
#define PG8_LDB(dst, b, h) do { _Pragma("unroll") for (int n = 0; n < 2; ++n) _Pragma("unroll") for (int k = 0; k < 2; ++k) dst[n][k] = *(const PG8_LAS bf16x8*)(lds + PG8_SB(b, h) + boff + n * 2048 + k * 1024); } while (0)
#define PG8_MMA(ai, bj, At, Bt) do { __builtin_amdgcn_s_setprio(1); _Pragma("unroll") for (int m = 0; m < 4; ++m) _Pragma("unroll") for (int n = 0; n < 2; ++n) _Pragma("unroll") for (int k = 0; k < 2; ++k) \
        acc[ai][bj][m][n] = __builtin_amdgcn_mfma_f32_16x16x32_bf16(Bt[n][k], At[m][k], acc[ai][bj][m][n], 0, 0, 0); __builtin_amdgcn_s_setprio(0); } while (0)
#define PG8_WAIT_V(n) asm volatile("s_waitcnt vmcnt(" #n ")" ::: "memory")
#define PG8_WAIT_L(n) asm volatile("s_waitcnt lgkmcnt(" #n ")" ::: "memory")
#define PG8_BAR __builtin_amdgcn_s_barrier()
#define PG8_SCHED __builtin_amdgcn_sched_barrier(0)
    Unit cur, nxt; int ui = 0;
    if (!S.next(0, cur)) return;
    f32x4 acc[2][2][4][2];
#pragma unroll
    for (int a = 0; a < 2; ++a)
#pragma unroll
        for (int b = 0; b < 2; ++b)
#pragma unroll
            for (int m = 0; m < 4; ++m)
#pragma unroll
                for (int n = 0; n < 2; ++n) acc[a][b][m][n] = (f32x4){0.f, 0.f, 0.f, 0.f};
    bf16x8 At[4][2], B0[2][2], B1[2][2];
    {
        const bf16x8 z8 = {0, 0, 0, 0, 0, 0, 0, 0};
#pragma unroll
        for (int m = 0; m < 4; ++m) { At[m][0] = z8; At[m][1] = z8; }
#pragma unroll
        for (int n = 0; n < 2; ++n) { B0[n][0] = z8; B0[n][1] = z8; B1[n][0] = z8; B1[n][1] = z8; }
    }
    const char* cA = (const char*)g.A + (size_t)cur.pm * tstep + cur.ko; const char* cB = (const char*)g.Bt + (size_t)cur.pn * tstep + cur.ko;
    S.a_ready(cur);
    PG8_STAGE(PG8_SB(0, 0), cB, voffB); PG8_STAGE(PG8_SA(0, 0), cA, voffA); PG8_STAGE(PG8_SB(0, 1), cB + hstep, voffB); PG8_STAGE(PG8_SA(0, 1), cA + hstep, voffA);
    if (wr == 1) PG8_BAR;
    PG8_WAIT_V(4); PG8_BAR;
    PG8_STAGE(PG8_SB(1, 0), cB + kstep, voffB); PG8_STAGE(PG8_SA(1, 0), cA + kstep, voffA); PG8_STAGE(PG8_SB(1, 1), cB + hstep + kstep, voffB);
    PG8_WAIT_V(6); PG8_BAR;
    PG8_STAMP();
    for (;;) {
        const bool has_next = S.next(ui + 1, nxt);
        const char* nA = has_next ? (const char*)g.A + (size_t)nxt.pm * tstep + nxt.ko : cA; const char* nB = has_next ? (const char*)g.Bt + (size_t)nxt.pn * tstep + nxt.ko : cB;
        for (int t = 0; t < nt; t += 2) {
            const bool last = (t == nt - 2);
            const char* a1 = cA + (size_t)(t + 1) * kstep;
            const char* a2 = last ? nA : cA + (size_t)(t + 2) * kstep; const char* b2 = last ? nB : cB + (size_t)(t + 2) * kstep;
            const char* a3 = a2 + kstep; const char* b3 = b2 + kstep;
            if (last && has_next) S.a_ready(nxt);
            PG8_LDB(B0, 0, 0); PG8_SCHED; PG8_LDA(At, 0, 0); PG8_STAGE(PG8_SA(1, 1), a1 + hstep, voffA);
            PG8_WAIT_L(8); PG8_BAR; PG8_WAIT_L(0); PG8_MMA(0, 0, At, B0); PG8_BAR; PG8_SCHED;
            PG8_LDB(B1, 0, 1); PG8_STAGE(PG8_SB(0, 0), b2, voffB);
            PG8_BAR; PG8_WAIT_L(0); PG8_MMA(0, 1, At, B1); PG8_BAR;
            PG8_LDA(At, 0, 1); PG8_STAGE(PG8_SA(0, 0), a2, voffA);
            PG8_BAR; PG8_WAIT_L(0); PG8_MMA(1, 0, At, B0); PG8_BAR; PG8_SCHED;
            PG8_STAGE(PG8_SB(0, 1), b2 + hstep, voffB);
            PG8_WAIT_V(6); PG8_BAR; PG8_MMA(1, 1, At, B1); PG8_BAR;
            PG8_LDB(B0, 1, 0); PG8_SCHED; PG8_LDA(At, 1, 0); PG8_STAGE(PG8_SA(0, 1), a2 + hstep, voffA);
            PG8_WAIT_L(8); PG8_BAR; PG8_WAIT_L(0); PG8_MMA(0, 0, At, B0); PG8_BAR; PG8_SCHED;
            PG8_LDB(B1, 1, 1); PG8_STAGE(PG8_SB(1, 0), b3, voffB);
            PG8_BAR; PG8_WAIT_L(0); PG8_MMA(0, 1, At, B1); PG8_BAR;
            PG8_LDA(At, 1, 1); PG8_STAGE(PG8_SA(1, 0), a3, voffA);
            PG8_BAR; PG8_WAIT_L(0); PG8_MMA(1, 0, At, B0); PG8_BAR; PG8_SCHED;
            PG8_STAGE(PG8_SB(1, 1), b3 + hstep, voffB);
            PG8_WAIT_V(6); PG8_BAR; PG8_MMA(1, 1, At, B1); PG8_BAR;
        }
        PG8_STAMP();
        if constexpr (Epi::KEEP_ACC) E.seam(acc, cur, wr, wc, fr, fq, cur.ko / Epi::SEG_BYTES);
        else
        if constexpr (!Epi::AFTER_DRAIN) { if constexpr (Epi::STAGED) E.staged(acc, cur, wr, wc, fr, fq, lds + STAGE_BYTES, wid, lane); else E(acc, cur, wr, wc, fr, fq); S.done(cur); }
        PG8_STAMP();
        if (!has_next) break;
        bool zero_acc = true;
        if constexpr (Epi::KEEP_ACC) zero_acc = cur.ko == 2 * Epi::SEG_BYTES;
        if (zero_acc) {
#pragma unroll
        for (int a = 0; a < 2; ++a)
#pragma unroll
            for (int b = 0; b < 2; ++b)
#pragma unroll
                for (int m = 0; m < 4; ++m)
#pragma unroll
                    for (int n = 0; n < 2; ++n) acc[a][b][m][n] = (f32x4){0.f, 0.f, 0.f, 0.f};
        }
        cur = nxt; cA = nA; cB = nB; ++ui;
    }
    PG8_WAIT_V(0);
    if (wr == 0) PG8_BAR;
    PG8_BAR;
    if constexpr (Epi::AFTER_DRAIN) { E.fused(acc, cur, wr, wc, fr, fq, lds, wid, lane); S.done(cur); }
    PG8_STAMP();
    if (STAMP && wid == 0) { stamps[lane] = lane < nts ? (((unsigned long long)(unsigned)ts_hi << 32) | (unsigned)ts_lo) : 0ull;
        if (lane == 62) stamps[62] = rt_entry; if (lane == 63) stamps[63] = (unsigned long long)wall_clock64(); }
#undef PG8_STAMP
#undef PG8_SA
#undef PG8_SB
#undef PG8_STAGE
#undef PG8_LDA
#undef PG8_LDB
#undef PG8_MMA
#undef PG8_WAIT_V
#undef PG8_WAIT_L
#undef PG8_BAR
#undef PG8_SCHED
}
}


typedef unsigned short bf16;
typedef unsigned v4u __attribute__((ext_vector_type(4)));
typedef unsigned v2u __attribute__((ext_vector_type(2)));
__device__ __forceinline__ unsigned f2bf(float f) { unsigned u = __builtin_bit_cast(unsigned, f); return (u + 0x7fffu + ((u >> 16) & 1u)) >> 16; }
typedef __bf16 bf16x2_t __attribute__((ext_vector_type(2)));
__device__ __forceinline__ unsigned pk2(float lo, float hi) { bf16x2_t v; v[0] = (__bf16)lo; v[1] = (__bf16)hi; return __builtin_bit_cast(unsigned, v); }
__device__ __forceinline__ float row_allsum16(float x) {
    x += __builtin_bit_cast(float, __builtin_amdgcn_update_dpp(0, __builtin_bit_cast(int, x), 0x128, 0xf, 0xf, false));
    x += __builtin_bit_cast(float, __builtin_amdgcn_update_dpp(0, __builtin_bit_cast(int, x), 0x124, 0xf, 0xf, false));
    x += __builtin_bit_cast(float, __builtin_amdgcn_update_dpp(0, __builtin_bit_cast(int, x), 0x122, 0xf, 0xf, false));
    x += __builtin_bit_cast(float, __builtin_amdgcn_update_dpp(0, __builtin_bit_cast(int, x), 0x121, 0xf, 0xf, false));
    return x;
}
__device__ __forceinline__ float fsigmoid(float x) { return __builtin_amdgcn_rcpf(1.0f + __expf(-x)); }
__device__ __forceinline__ void transpose_item(const float* p, int ldw, bf16* WT, int K, int dst_row0, int k0, LAS float* scr, int ln) {
    if (p) {
        float tv[32];
#pragma unroll
        for (int i = 0; i < 32; ++i) tv[i] = p[(size_t)(k0 + 2 * i + (ln >> 5)) * ldw];
#pragma unroll
        for (int i = 0; i < 32; ++i) scr[(2 * i + (ln >> 5)) * 33 + (ln & 31)] = tv[i];
    } else {
#pragma unroll 8
        for (int i = 0; i < 32; ++i) { const int kk = 2 * i + (ln >> 5); scr[kk * 33 + (ln & 31)] = 0.f; }
    }
    asm volatile("s_waitcnt lgkmcnt(0)" ::: "memory");
    const int c = ln & 7;
#pragma unroll
    for (int j = 0; j < 4; ++j) { const int n = (ln >> 3) + 8 * j; const LAS float* s = scr + (8 * c) * 33 + n;
        v4u o; o.x = pk2(s[0 * 33], s[1 * 33]); o.y = pk2(s[2 * 33], s[3 * 33]); o.z = pk2(s[4 * 33], s[5 * 33]); o.w = pk2(s[6 * 33], s[7 * 33]);
        *(v4u*)(WT + (size_t)(dst_row0 + n) * K + k0 + 8 * c) = o; }
    asm volatile("s_waitcnt lgkmcnt(0)" ::: "memory");
}
struct TI { const float* p; bf16* wt; int ldw, K, r0, k0; bool zero; };
__device__ __forceinline__ void ti_load(const TI& t, float (&tv)[32], int ln) {
#pragma unroll
    for (int i = 0; i < 32; ++i) tv[i] = t.p[(size_t)(t.k0 + 2 * i + (ln >> 5)) * t.ldw];
}
__device__ __forceinline__ void ti_finish(const TI& t, const float (&tv)[32], LAS float* scr, int ln) {
#pragma unroll
    for (int i = 0; i < 32; ++i) scr[(2 * i + (ln >> 5)) * 33 + (ln & 31)] = t.zero ? 0.f : tv[i];
    asm volatile("s_waitcnt lgkmcnt(0)" ::: "memory");
    const int c = ln & 7;
#pragma unroll
    for (int j = 0; j < 4; ++j) { const int n = (ln >> 3) + 8 * j; const LAS float* s = scr + (8 * c) * 33 + n;
        v4u o; o.x = pk2(s[0 * 33], s[1 * 33]); o.y = pk2(s[2 * 33], s[3 * 33]); o.z = pk2(s[4 * 33], s[5 * 33]); o.w = pk2(s[6 * 33], s[7 * 33]);
        *(v4u*)(t.wt + (size_t)(t.r0 + n) * t.K + t.k0 + 8 * c) = o; }
    asm volatile("s_waitcnt lgkmcnt(0)" ::: "memory");
}
__device__ __forceinline__ f32x4 bf4_to_f32(const v2u w) { f32x4 r; r[0] = __builtin_bit_cast(float, w.x << 16); r[1] = __builtin_bit_cast(float, w.x & 0xffff0000u);
    r[2] = __builtin_bit_cast(float, w.y << 16); r[3] = __builtin_bit_cast(float, w.y & 0xffff0000u); return r; }
constexpr int STG_RS = 528;
#define EBAR() do { asm volatile("s_waitcnt lgkmcnt(0)" ::: "memory"); __builtin_amdgcn_s_barrier(); asm volatile("" ::: "memory"); } while (0)
#define EPI_ENTER(wr_) do { if ((wr_) == 0) __builtin_amdgcn_s_barrier(); } while (0)
#define EPI_LEAVE(wr_) do { if ((wr_) == 1) __builtin_amdgcn_s_barrier(); } while (0)
#define STG_READBACK512(ai_, m_, BODY) do { int ln_ = lane; asm volatile("" : "+v"(ln_)); _Pragma("unroll") for (int h_ = 0; h_ < 2; ++h_) { const int lr_ = 4 * wid + 2 * h_ + (ln_ >> 5), cb_ = (ln_ & 31) * 16; \
        const v4u sv_ = *(const LAS v4u*)(stg + lr_ * STG_RS + cb_); const int trow_ = 128 * (ai_) + 64 * (lr_ >> 4) + 16 * (m_) + (lr_ & 15); BODY } } while (0)

struct EpiSwigluBf16 {
    static constexpr bool PERM = true, AFTER_DRAIN = false, HAS_MID = false, STAGED = true, KEEP_ACC = false;
    bf16* H; int nN;
    __device__ __forceinline__ void staged(const f32x4 (&acc)[2][2][4][2], const pg8::Unit& u, int wr, int wc, int fr, int fq, LAS unsigned char* stg, int wid, int lane) const {
        const int pnl = u.pn % nN, lrw = 16 * wr + fr;
        bf16* dst = H + (size_t)u.pm * 256 * DFF + 128 * pnl;
        EPI_ENTER(wr);
#pragma unroll
        for (int ai = 0; ai < 2; ++ai)
#pragma unroll
            for (int m = 0; m < 4; ++m) {
#pragma unroll
                for (int bj = 0; bj < 2; ++bj) {
                    const f32x4 g = acc[ai][bj][m][0], uu = acc[ai][bj][m][1]; float h[4];
#pragma unroll
                    for (int j = 0; j < 4; ++j) h[j] = g[j] * fsigmoid(g[j]) * uu[j];
                    v2u o; o.x = pk2(h[0], h[1]); o.y = pk2(h[2], h[3]);
                    *(LAS v2u*)(stg + lrw * 272 + (64 * bj + 16 * wc + 4 * fq) * 2) = o;
                }
                EBAR();
                {
                    int ln_ = lane; asm volatile("" : "+v"(ln_));
                    const int lr = 4 * wid + (ln_ >> 4), cb = (ln_ & 15) * 16;
                    const v4u sv = *(const LAS v4u*)(stg + lr * 272 + cb);
                    const int trow = 128 * ai + 64 * (lr >> 4) + 16 * m + (lr & 15);
                    *(v4u*)(dst + (size_t)trow * DFF + (ln_ & 15) * 8) = sv;
                }
                EBAR();
            }
        EPI_LEAVE(wr);
    }
};
struct EpiResidF32 {
    static constexpr bool PERM = true, AFTER_DRAIN = false, HAS_MID = false, STAGED = true, KEEP_ACC = false;
    float* C; const float* R;
    __device__ __forceinline__ void staged(const f32x4 (&acc)[2][2][4][2], const pg8::Unit& u, int wr, int wc, int fr, int fq, LAS unsigned char* stg, int wid, int lane) const {
        const int lrw = 16 * wr + fr; const size_t t0 = (size_t)u.pm * 256 * D + (size_t)u.pn * 256;
        EPI_ENTER(wr);
#pragma unroll
        for (int ai = 0; ai < 2; ++ai)
#pragma unroll
            for (int m = 0; m < 4; ++m)
#pragma unroll
                for (int bj = 0; bj < 2; ++bj) {
                    *(LAS f32x4*)(stg + lrw * STG_RS + (wc * 32 + 8 * fq) * 4) = acc[ai][bj][m][0];
                    *(LAS f32x4*)(stg + lrw * STG_RS + (wc * 32 + 8 * fq) * 4 + 16) = acc[ai][bj][m][1];
                    EBAR();
                    STG_READBACK512(ai, m, { const size_t o_ = t0 + (size_t)trow_ * D + bj * 128 + (ln_ & 31) * 4;
                        const f32x4 r_ = *(const f32x4*)(R + o_); *(f32x4*)(C + o_) = ALPHA * r_ + __builtin_bit_cast(f32x4, sv_); });
                    EBAR();
                }
        EPI_LEAVE(wr);
    }
};
struct EpiStoreF32 {
    static constexpr bool PERM = true, AFTER_DRAIN = false, HAS_MID = false, STAGED = true, KEEP_ACC = false;
    float* C; int nN;
    __device__ __forceinline__ void staged(const f32x4 (&acc)[2][2][4][2], const pg8::Unit& u, int wr, int wc, int fr, int fq, LAS unsigned char* stg, int wid, int lane) const {
        const int lrw = 16 * wr + fr; const size_t t0 = (size_t)u.pm * 256 * D + (size_t)(u.pn % nN) * 256;
        EPI_ENTER(wr);
#pragma unroll
        for (int ai = 0; ai < 2; ++ai)
#pragma unroll
            for (int m = 0; m < 4; ++m)
#pragma unroll
                for (int bj = 0; bj < 2; ++bj) {
                    *(LAS f32x4*)(stg + lrw * STG_RS + (wc * 32 + 8 * fq) * 4) = acc[ai][bj][m][0];
                    *(LAS f32x4*)(stg + lrw * STG_RS + (wc * 32 + 8 * fq) * 4 + 16) = acc[ai][bj][m][1];
                    EBAR();
                    STG_READBACK512(ai, m, { *(v4u*)(C + t0 + (size_t)trow_ * D + bj * 128 + (ln_ & 31) * 4) = sv_; });
                    EBAR();
                }
        EPI_LEAVE(wr);
    }
};
template <int MODE> struct EpiBranch {
    static constexpr bool PERM = true, AFTER_DRAIN = false, HAS_MID = false, STAGED = false, KEEP_ACC = false;
    float* MIXp; bf16* MIXBp; const float* gate;
    __device__ __forceinline__ void operator()(const f32x4 (&acc)[2][2][4][2], const pg8::Unit& u, int wr, int wc, int fr, int fq) const {
        const int row0 = u.pm * 256 + wr * 64 + fr, col0 = u.pn * 256 + wc * 32 + 8 * fq;
#pragma unroll
        for (int ai = 0; ai < 2; ++ai)
#pragma unroll
            for (int m = 0; m < 4; ++m)
#pragma unroll
                for (int bj = 0; bj < 2; ++bj) {
                    const int row = row0 + ai * 128 + m * 16, col = col0 + bj * 128; const size_t o = (size_t)row * D + col;
                    const f32x4 g0 = *(const f32x4*)(gate + (size_t)row * IN_COLS + col), g1 = *(const f32x4*)(gate + (size_t)row * IN_COLS + col + 4);
                    f32x4 r0, r1;
#pragma unroll
                    for (int j = 0; j < 4; ++j) { r0[j] = fsigmoid(g0[j]) * acc[ai][bj][m][0][j]; r1[j] = fsigmoid(g1[j]) * acc[ai][bj][m][1][j]; }
                    if (MODE >= 1) { r0 += *(const f32x4*)(MIXp + o); r1 += *(const f32x4*)(MIXp + o + 4); }
                    if (MODE <= 1) { *(f32x4*)(MIXp + o) = r0; *(f32x4*)(MIXp + o + 4) = r1; }
                    else { v4u w; w.x = pk2(r0[0], r0[1]); w.y = pk2(r0[2], r0[3]); w.z = pk2(r1[0], r1[1]); w.w = pk2(r1[2], r1[3]); *(v4u*)(MIXBp + o) = w; }
                }
    }
};

struct EpiLora {
    static constexpr bool PERM = true, AFTER_DRAIN = false, HAS_MID = false, STAGED = false, KEEP_ACC = false;
    float* DECp; bf16* AAp; bf16* GGp; float* Vp; const float* VFp; const float* w0; const float* a0; const float* v0;
    __device__ __forceinline__ void operator()(const f32x4 (&acc)[2][2][4][2], const pg8::Unit& u, int wr, int wc, int fr, int fq) const {
        const int row0 = u.pm * 256 + wr * 64 + fr, seg = __builtin_amdgcn_readfirstlane(u.pn >> 2), col0 = (u.pn & 3) * 256 + wc * 32 + 8 * fq;
        if (seg == 0) {
#pragma unroll
            for (int bj = 0; bj < 2; ++bj) { const int col = col0 + bj * 128; const f32x4 b0 = *(const f32x4*)(w0 + col), b1 = *(const f32x4*)(w0 + col + 4);
#pragma unroll
                for (int ai = 0; ai < 2; ++ai)
#pragma unroll
                    for (int m = 0; m < 4; ++m) { const size_t o = (size_t)(row0 + ai * 128 + m * 16) * BW + col;
                        f32x4 x0 = acc[ai][bj][m][0] + b0, x1 = acc[ai][bj][m][1] + b1;
#pragma unroll
                        for (int j = 0; j < 4; ++j) {
                            x0[j] = __expf(-0.6065306597126334f * fsigmoid(x0[j])); x1[j] = __expf(-0.6065306597126334f * fsigmoid(x1[j])); }
                        *(f32x4*)(DECp + o) = x0; *(f32x4*)(DECp + o + 4) = x1; } }
        } else if (seg == 1) {
#pragma unroll
            for (int bj = 0; bj < 2; ++bj) { const int col = col0 + bj * 128; const f32x4 b0 = *(const f32x4*)(a0 + col), b1 = *(const f32x4*)(a0 + col + 4);
#pragma unroll
                for (int ai = 0; ai < 2; ++ai)
#pragma unroll
                    for (int m = 0; m < 4; ++m) { const size_t o = (size_t)(row0 + ai * 128 + m * 16) * BW + col;
                        f32x4 x0 = acc[ai][bj][m][0] + b0, x1 = acc[ai][bj][m][1] + b1;
#pragma unroll
                        for (int j = 0; j < 4; ++j) { x0[j] = fsigmoid(x0[j]); x1[j] = fsigmoid(x1[j]); }
                        v4u w; w.x = pk2(x0[0], x0[1]); w.y = pk2(x0[2], x0[3]); w.z = pk2(x1[0], x1[1]); w.w = pk2(x1[2], x1[3]); *(v4u*)(AAp + o) = w; } }
        } else if (seg == 2) {
#pragma unroll
            for (int bj = 0; bj < 2; ++bj) { const int col = col0 + bj * 128;
#pragma unroll
                for (int ai = 0; ai < 2; ++ai)
#pragma unroll
                    for (int m = 0; m < 4; ++m) { const size_t o = (size_t)(row0 + ai * 128 + m * 16) * BW + col;
                        const f32x4 x0 = acc[ai][bj][m][0], x1 = acc[ai][bj][m][1];
                        v4u w; w.x = pk2(x0[0], x0[1]); w.y = pk2(x0[2], x0[3]); w.z = pk2(x1[0], x1[1]); w.w = pk2(x1[2], x1[3]); *(v4u*)(GGp + o) = w; } }
        } else {
#pragma unroll
            for (int bj = 0; bj < 2; ++bj) { const int col = col0 + bj * 128; const f32x4 b0 = *(const f32x4*)(v0 + col), b1 = *(const f32x4*)(v0 + col + 4);
#pragma unroll
                for (int ai = 0; ai < 2; ++ai)
#pragma unroll
                    for (int m = 0; m < 4; ++m) { const size_t o = (size_t)(row0 + ai * 128 + m * 16) * BW + col;
                        f32x4 x0 = acc[ai][bj][m][0] + b0, x1 = acc[ai][bj][m][1] + b1;
                        const f32x4 v0_ = *(const f32x4*)(Vp + o), v1_ = *(const f32x4*)(Vp + o + 4), f0 = *(const f32x4*)(VFp + o), f1 = *(const f32x4*)(VFp + o + 4);
#pragma unroll
                        for (int j = 0; j < 4; ++j) { x0[j] = v0_[j] + (f0[j] - v0_[j]) * fsigmoid(x0[j]); x1[j] = v1_[j] + (f1[j] - v1_[j]) * fsigmoid(x1[j]); }
                        *(f32x4*)(Vp + o) = x0; *(f32x4*)(Vp + o + 4) = x1;
                        asm volatile("" ::: "memory"); } }
        }
    }
};
struct EpiMlaQ {
    static constexpr bool PERM = true, AFTER_DRAIN = false, HAS_MID = false, STAGED = false, KEEP_ACC = false;
    bf16* QCBp; const float* COSMp; const float* SINMp;
    __device__ __forceinline__ void operator()(const f32x4 (&acc)[2][2][4][2], const pg8::Unit& u, int wr, int wc, int fr, int fq) const {
        const int row0 = u.pm * 256 + wr * 64 + fr;
#pragma unroll
        for (int bj = 0; bj < 2; ++bj) {
            const int c = u.pn * 256 + bj * 128 + wc * 32 + 8 * fq, h = c / 192, cc = c - h * 192;
#pragma unroll
            for (int ai = 0; ai < 2; ++ai)
#pragma unroll
                for (int m = 0; m < 4; ++m) {
                    const int row = row0 + ai * 128 + m * 16; const f32x4 x1 = acc[ai][bj][m][0], x2 = acc[ai][bj][m][1];
                    bf16* dst = QCBp + (size_t)row * 1536 + h * 192;
                    if (cc < 128) { v4u w; w.x = pk2(x1[0], x1[1]); w.y = pk2(x1[2], x1[3]); w.z = pk2(x2[0], x2[1]); w.w = pk2(x2[2], x2[3]); *(v4u*)(dst + cc) = w; }
                    else { const int j0 = 4 * ((cc - 128) >> 3), s = row & (SEQ - 1);
                        const f32x4 cs = *(const f32x4*)(COSMp + s * 32 + j0), sn = *(const f32x4*)(SINMp + s * 32 + j0);
                        const f32x4 o1 = x1 * cs - x2 * sn, o2 = x2 * cs + x1 * sn;
                        v2u a; a.x = pk2(o1[0], o1[1]); a.y = pk2(o1[2], o1[3]); v2u b; b.x = pk2(o2[0], o2[1]); b.y = pk2(o2[2], o2[3]);
                        *(v2u*)(dst + 128 + j0) = a; *(v2u*)(dst + 160 + j0) = b; }
                }
        }
    }
};
struct EpiMlaKV {
    static constexpr bool PERM = true, AFTER_DRAIN = false, HAS_MID = false, STAGED = false, KEEP_ACC = false;
    bf16* KCBp; bf16* VCBp;
    __device__ __forceinline__ void operator()(const f32x4 (&acc)[2][2][4][2], const pg8::Unit& u, int wr, int wc, int fr, int fq) const {
        const int row0 = u.pm * 256 + wr * 64 + fr;
#pragma unroll
        for (int bj = 0; bj < 2; ++bj) {
            const int c = u.pn * 256 + bj * 128 + wc * 32 + 8 * fq, h = c >> 8, cc = c & 255;
#pragma unroll
            for (int ai = 0; ai < 2; ++ai)
#pragma unroll
                for (int m = 0; m < 4; ++m) {
                    const int row = row0 + ai * 128 + m * 16; const f32x4 x1 = acc[ai][bj][m][0], x2 = acc[ai][bj][m][1];
                    v4u w; w.x = pk2(x1[0], x1[1]); w.y = pk2(x1[2], x1[3]); w.z = pk2(x2[0], x2[1]); w.w = pk2(x2[2], x2[3]);
                    if (cc < 128) *(v4u*)(KCBp + (size_t)row * 1536 + h * 192 + cc) = w;
                    else *(v4u*)(VCBp + (size_t)row * BW + h * 128 + (cc - 128)) = w;
                }
        }
    }
};

struct EpiBranch3 {
    static constexpr bool PERM = true, AFTER_DRAIN = false, HAS_MID = false, STAGED = false, KEEP_ACC = true;
    static constexpr int SEG_BYTES = BW * 2;
    bf16* MIXBp; const bf16* G;
    __device__ __forceinline__ void seam(f32x4 (&acc)[2][2][4][2], const pg8::Unit& u, int wr, int wc, int fr, int fq, int seg) const {
        int row0 = u.pm * 256 + wr * 64 + fr, col0 = u.pn * 256 + wc * 32 + 8 * fq;
        asm volatile("" : "+v"(row0), "+v"(col0));
        const bool fin = seg == 2;
#pragma unroll
        for (int ai = 0; ai < 2; ++ai)
#pragma unroll
            for (int mp = 0; mp < 2; ++mp) {
                v4u ga[2][2], gb[2][2];
#pragma unroll
                for (int mm = 0; mm < 2; ++mm)
#pragma unroll
                    for (int bj = 0; bj < 2; ++bj) {
                        const bf16* gp = G + (size_t)(row0 + ai * 128 + (2 * mp + mm) * 16) * (3 * D) + seg * D + col0 + bj * 128;
                        ga[mm][bj] = *(const v4u*)gp; gb[mm][bj] = *(const v4u*)(gp + (fin ? 0 : D));
                    }
#pragma unroll
                for (int mm = 0; mm < 2; ++mm)
#pragma unroll
                    for (int bj = 0; bj < 2; ++bj) {
                        const int m = 2 * mp + mm, row = row0 + ai * 128 + m * 16, col = col0 + bj * 128;
                        const unsigned aw[4] = {ga[mm][bj].x, ga[mm][bj].y, ga[mm][bj].z, ga[mm][bj].w}, bw[4] = {gb[mm][bj].x, gb[mm][bj].y, gb[mm][bj].z, gb[mm][bj].w}; float r[8];
#pragma unroll
                        for (int j = 0; j < 4; ++j) {
                            const float g0 = __uint_as_float(aw[j] << 16), g1 = __uint_as_float(aw[j] & 0xffff0000u);
                            const float q0 = g0 * __builtin_amdgcn_rcpf(__uint_as_float(bw[j] << 16)), q1 = g1 * __builtin_amdgcn_rcpf(__uint_as_float(bw[j] & 0xffff0000u));
                            r[2 * j] = (acc[ai][bj][m][j >> 1][(j & 1) * 2] *= (fin ? g0 : q0)); r[2 * j + 1] = (acc[ai][bj][m][j >> 1][(j & 1) * 2 + 1] *= (fin ? g1 : q1));
                        }
                        if (fin) { v4u w; w.x = pk2(r[0], r[1]); w.y = pk2(r[2], r[3]); w.z = pk2(r[4], r[5]); w.w = pk2(r[6], r[7]); *(v4u*)(MIXBp + (size_t)row * D + col) = w; }
                    }
                asm volatile("" : "+v"(acc[ai][0][2 * mp][0]), "+v"(acc[ai][0][2 * mp][1]) :: "memory");
            }
    }
};
struct SegOrder {
    pg8::StaticOrder base;
    __device__ __forceinline__ bool next(int i, pg8::Unit& u) const { const int ti = i / 3; if (!base.next(ti, u)) return false; u.ko = (i - 3 * ti) * (BW * 2); return true; }
    __device__ __forceinline__ void a_ready(const pg8::Unit&) const {}
    __device__ __forceinline__ void done(const pg8::Unit&) const {}
};
struct MoeOrder {
    const unsigned* tile_e; int nMt, nN, G, c; int mt0 = 0, ks = 1, kbytes = 0;
    __device__ __forceinline__ bool next(int i, pg8::Unit& u) const {
        const long L = (long)i * G + c; if (L >= (long)nMt * nN * ks) return false;
        const int mt = mt0 + (int)(L / (nN * ks)), rem = (int)(L % (nN * ks)), pnl = rem / ks;
        u.pm = mt; u.pn = (int)tile_e[mt] * nN + pnl; u.ko = (rem % ks) * kbytes; return true;
    }
    __device__ __forceinline__ void a_ready(const pg8::Unit&) const {}
    __device__ __forceinline__ void done(const pg8::Unit&) const {}
};
struct EpiAtomicF32 {
    static constexpr bool PERM = true, AFTER_DRAIN = false, HAS_MID = false, STAGED = true, KEEP_ACC = false;
    float* C; int nN;
    __device__ __forceinline__ void staged(const f32x4 (&acc)[2][2][4][2], const pg8::Unit& u, int wr, int wc, int fr, int fq, LAS unsigned char* stg, int wid, int lane) const {
        const int lrw = 16 * wr + fr; const size_t t0 = (size_t)u.pm * 256 * D + (size_t)(u.pn % nN) * 256;
        EPI_ENTER(wr);
#pragma unroll
        for (int ai = 0; ai < 2; ++ai)
#pragma unroll
            for (int m = 0; m < 4; ++m)
#pragma unroll
                for (int bj = 0; bj < 2; ++bj) {
                    *(LAS f32x4*)(stg + lrw * STG_RS + (wc * 32 + 8 * fq) * 4) = acc[ai][bj][m][0];
                    *(LAS f32x4*)(stg + lrw * STG_RS + (wc * 32 + 8 * fq) * 4 + 16) = acc[ai][bj][m][1];
                    EBAR();
                    { int ln_ = lane; asm volatile("" : "+v"(ln_));
#pragma unroll
                      for (int q_ = 0; q_ < 8; ++q_) { const int lr_ = 4 * wid + (q_ >> 1), cf_ = (q_ & 1) * 64 + ln_;
                          const float sv_ = *(const LAS float*)(stg + lr_ * STG_RS + cf_ * 4);
                          const int trow_ = 128 * ai + 64 * (lr_ >> 4) + 16 * m + (lr_ & 15);
                          atomicAdd(C + t0 + (size_t)trow_ * D + bj * 128 + cf_, sv_); } }
                    EBAR();
                }
        EPI_LEAVE(wr);
    }
};

struct EpiStoreBf16s { bf16* C; int ldc; size_t sC;
    __device__ __forceinline__ void operator()(int bt, int m, int n, float v) const { C[(size_t)bt * sC + (size_t)m * ldc + n] = (bf16)f2bf(v); } };
struct EpiInProjF32 {
    static constexpr bool PERM = true, AFTER_DRAIN = false, HAS_MID = false, STAGED = false, KEEP_ACC = false;
    bf16* PROJp; float* VRESp; bf16* GATEp; float* QFp; bf16* KABp; bf16* VABp; const float* COSAp; const float* SINAp; int layer;
    __device__ __forceinline__ void operator()(const f32x4 (&acc)[2][2][4][2], const pg8::Unit& u, int wr, int wc, int fr, int fq) const {
        int row0 = u.pm * 256 + wr * 64 + fr;
        asm volatile("" : "+v"(row0), "+v"(fq));
        if (u.pn >= 30) {
#pragma unroll
            for (int bj = 0; bj < 2; ++bj) { const int c = (u.pn - 30) * 256 + bj * 128 + wc * 32 + 8 * fq;
#pragma unroll
                for (int ai = 0; ai < 2; ++ai)
#pragma unroll
                    for (int m = 0; m < 4; ++m) { const f32x4 x0 = acc[ai][bj][m][0], x1 = acc[ai][bj][m][1];
                        v4u w; w.x = pk2(fsigmoid(x0[0]), fsigmoid(x0[1])); w.y = pk2(fsigmoid(x0[2]), fsigmoid(x0[3]));
                        w.z = pk2(fsigmoid(x1[0]), fsigmoid(x1[1])); w.w = pk2(fsigmoid(x1[2]), fsigmoid(x1[3]));
                        *(v4u*)(GATEp + (size_t)(row0 + ai * 128 + m * 16) * (3 * D) + c) = w; } }
            return;
        }
        if (u.pn < 8) {
            const bool isk = u.pn >= 4;
#pragma unroll
            for (int bj = 0; bj < 2; ++bj) {
                const int c = (u.pn & 3) * 256 + bj * 128 + wc * 32 + 8 * fq, hh = c >> 7, j0 = ((c & 127) >> 3) * 4;
#pragma unroll
                for (int ai = 0; ai < 2; ++ai)
#pragma unroll
                    for (int m = 0; m < 4; ++m) { const int row = row0 + ai * 128 + m * 16, s = row & (SEQ - 1);
                        const f32x4 cs = *(const f32x4*)(COSAp + s * 64 + j0), sn = *(const f32x4*)(SINAp + s * 64 + j0);
                        const f32x4 x1 = acc[ai][bj][m][0], x2 = acc[ai][bj][m][1];
                        const f32x4 o1 = x1 * cs - x2 * sn, o2 = x2 * cs + x1 * sn;
                        if (!isk) { float* q = QFp + (size_t)row * BW + hh * 128 + j0; *(f32x4*)q = o1; *(f32x4*)(q + 64) = o2; }
                        else { bf16* k = KABp + (size_t)row * BW + hh * 128 + j0; v2u a; a.x = pk2(o1[0], o1[1]); a.y = pk2(o1[2], o1[3]); v2u b; b.x = pk2(o2[0], o2[1]); b.y = pk2(o2[2], o2[3]);
                            *(v2u*)k = a; *(v2u*)(k + 64) = b; }
                        asm volatile("" ::: "memory");
                    }
            }
            return;
        }
        if (u.pn < 12) {
#pragma unroll
            for (int bj = 0; bj < 2; ++bj) { const int c = (u.pn - 8) * 256 + bj * 128 + wc * 32 + 8 * fq;
#pragma unroll
                for (int ai = 0; ai < 2; ++ai)
#pragma unroll
                    for (int m = 0; m < 4; ++m) { const f32x4 x0 = acc[ai][bj][m][0], x1 = acc[ai][bj][m][1];
                        v4u w; w.x = pk2(x0[0], x0[1]); w.y = pk2(x0[2], x0[3]); w.z = pk2(x1[0], x1[1]); w.w = pk2(x1[2], x1[3]);
                        *(v4u*)(VABp + (size_t)(row0 + ai * 128 + m * 16) * BW + c) = w; } }
            return;
        }
#pragma unroll
        for (int bj = 0; bj < 2; ++bj) {
            const int c = u.pn * 256 + bj * 128 + wc * 32 + 8 * fq;
            if (c >= 6432 && c < 6464) {
                if (layer != 0) {
#pragma unroll
                    for (int ai = 0; ai < 2; ++ai)
#pragma unroll
                        for (int m = 0; m < 4; ++m) { float* p = VRESp + (c - 6432) + (size_t)(row0 + ai * 128 + m * 16) * 32;
                            *(f32x4*)p = acc[ai][bj][m][0]; *(f32x4*)(p + 4) = acc[ai][bj][m][1]; }
                }
            } else if (c < 7552) {
                bf16* dst = PROJp + ((c < 6432 ? c : c - 32) - PSH);
#pragma unroll
                for (int ai = 0; ai < 2; ++ai)
#pragma unroll
                    for (int m = 0; m < 4; ++m) { const f32x4 x0 = acc[ai][bj][m][0], x1 = acc[ai][bj][m][1];
                        v4u w; w.x = pk2(x0[0], x0[1]); w.y = pk2(x0[2], x0[3]); w.z = pk2(x1[0], x1[1]); w.w = pk2(x1[2], x1[3]);
                        *(v4u*)(dst + (size_t)(row0 + ai * 128 + m * 16) * PLD) = w; }
            }
        }
    }
};


__device__ __forceinline__ float fma_(float a, float b, float c) { float r; asm("v_fma_f32 %0, %1, %2, %3" : "=v"(r) : "v"(a), "v"(b), "v"(c)); return r; }
__device__ __forceinline__ float mul_(float a, float b) { float r; asm("v_mul_f32 %0, %1, %2" : "=v"(r) : "v"(a), "v"(b)); return r; }
__device__ __forceinline__ float add_(float a, float b) { float r; asm("v_add_f32 %0, %1, %2" : "=v"(r) : "v"(a), "v"(b)); return r; }
typedef short s16x4 __attribute__((ext_vector_type(4)));
constexpr int AT_KOFF = 0, AT_VOFF = 25600, AT_STAGE = 25600 + 64 * 288;
#define AT_TR16(base, o) \
    asm volatile("ds_read_b64_tr_b16 %0, %16 offset:0\n\tds_read_b64_tr_b16 %1, %16 offset:4608\n\t" \
                 "ds_read_b64_tr_b16 %2, %16 offset:32\n\tds_read_b64_tr_b16 %3, %16 offset:4640\n\t" \
                 "ds_read_b64_tr_b16 %4, %16 offset:64\n\tds_read_b64_tr_b16 %5, %16 offset:4672\n\t" \
                 "ds_read_b64_tr_b16 %6, %16 offset:96\n\tds_read_b64_tr_b16 %7, %16 offset:4704\n\t" \
                 "ds_read_b64_tr_b16 %8, %16 offset:128\n\tds_read_b64_tr_b16 %9, %16 offset:4736\n\t" \
                 "ds_read_b64_tr_b16 %10, %16 offset:160\n\tds_read_b64_tr_b16 %11, %16 offset:4768\n\t" \
                 "ds_read_b64_tr_b16 %12, %16 offset:192\n\tds_read_b64_tr_b16 %13, %16 offset:4800\n\t" \
                 "ds_read_b64_tr_b16 %14, %16 offset:224\n\tds_read_b64_tr_b16 %15, %16 offset:4832\n\t" \
                 "s_waitcnt lgkmcnt(0)" \
                 : "=&v"(o[0]), "=&v"(o[1]), "=&v"(o[2]), "=&v"(o[3]), "=&v"(o[4]), "=&v"(o[5]), "=&v"(o[6]), "=&v"(o[7]), \
                   "=&v"(o[8]), "=&v"(o[9]), "=&v"(o[10]), "=&v"(o[11]), "=&v"(o[12]), "=&v"(o[13]), "=&v"(o[14]), "=&v"(o[15]) \
                 : "v"(base) : "memory")
template <int DQ, bool MOBA>
__device__ __forceinline__ void attn_tile(LAS unsigned char* lds, const int buf, const int it, const int q0, const int w, const int qq, const int g, const int qrow, const int own,
                                          const unsigned selbits, const float sc, const pg8::bf16x8 (&qf)[DQ / 32], f32x4 (&o)[8], float& m, float& l) {
    constexpr int KROW = (DQ + 8) * 2, VROW = 288, NDS = DQ / 32;
    const LAS unsigned char* kb = lds + buf * AT_STAGE + AT_KOFF;
    f32x4 st[4];
#pragma unroll
    for (int c = 0; c < 4; ++c) {
        st[c] = (f32x4){0.f, 0.f, 0.f, 0.f};
#pragma unroll
        for (int ds = 0; ds < NDS; ++ds) {
            const pg8::bf16x8 a = *(const LAS pg8::bf16x8*)(kb + (16 * c + qq) * KROW + (32 * ds + 8 * g) * 2);
            st[c] = __builtin_amdgcn_mfma_f32_16x16x32_bf16(a, qf[ds], st[c], 0, 0, 0);
        }
    }
    const int blk = it >> 2;
    const bool past = MOBA && (blk < own);
    if (past) {
        const bool selok = ((selbits >> blk) & 1u) != 0u;
#pragma unroll
        for (int c = 0; c < 4; ++c)
#pragma unroll
            for (int r = 0; r < 4; ++r) st[c][r] = selok ? st[c][r] : -INFINITY;
    } else if (it * 64 + 63 > q0 + 16 * w) {
#pragma unroll
        for (int c = 0; c < 4; ++c)
#pragma unroll
            for (int r = 0; r < 4; ++r) { const int key = it * 64 + 16 * c + 4 * g + r; st[c][r] = (key <= qrow) ? st[c][r] : -INFINITY; }
    }
    float mloc = fmaxf(fmaxf(st[0][0], st[0][1]), fmaxf(st[0][2], st[0][3]));
#pragma unroll
    for (int c = 1; c < 4; ++c) mloc = fmaxf(mloc, fmaxf(fmaxf(st[c][0], st[c][1]), fmaxf(st[c][2], st[c][3])));
    const int ln_ = qq + 16 * g;
    mloc = fmaxf(mloc, shfl_xor_(mloc, 16, ln_)); mloc = fmaxf(mloc, shfl_xor_(mloc, 32, ln_));
    const float mnew = fmaxf(m, mloc * sc);
    if (__any(mnew > m)) {
        const float alpha = __builtin_amdgcn_exp2f(m - mnew);
        l *= alpha;
#pragma unroll
        for (int i = 0; i < 8; ++i) o[i] *= alpha;
        m = mnew;
    }
    float ps = 0.f;
#pragma unroll
    for (int c = 0; c < 4; ++c)
#pragma unroll
        for (int r = 0; r < 4; ++r) { const float p = __builtin_amdgcn_exp2f(__builtin_fmaf(st[c][r], sc, -m)); st[c][r] = p; ps += p; }
    l += ps;
#pragma unroll
    for (int c0i = 0; c0i < 2; ++c0i) {
        v4u pw; pw.x = pk2(st[2 * c0i][0], st[2 * c0i][1]); pw.y = pk2(st[2 * c0i][2], st[2 * c0i][3]);
        pw.z = pk2(st[2 * c0i + 1][0], st[2 * c0i + 1][1]); pw.w = pk2(st[2 * c0i + 1][2], st[2 * c0i + 1][3]);
        const pg8::bf16x8 pb = __builtin_bit_cast(pg8::bf16x8, pw);
        const unsigned vaddr = (unsigned)(size_t)(lds + buf * AT_STAGE + AT_VOFF) + (unsigned)((32 * c0i + 4 * g + (qq >> 2)) * VROW + 8 * (qq & 3));
        s16x4 vr[16];
        AT_TR16(vaddr, vr);
#pragma unroll
        for (int i = 0; i < 8; ++i) {
            const pg8::bf16x8 a = __builtin_shufflevector(vr[2 * i], vr[2 * i + 1], 0, 1, 2, 3, 4, 5, 6, 7);
            o[i] = __builtin_amdgcn_mfma_f32_16x16x32_bf16(a, pb, o[i], 0, 0, 0);
        }
    }
}
template <int DQ, bool MOBA>
__device__ __forceinline__ void attn_unit(LAS unsigned char* lds, const bf16* Qg, int ldq, const bf16* Kg, int ldk, const bf16* Vg, int ldv,
                                          bf16* Og, int ldo, const unsigned char* sel, int qt, float sc, const int tid) {
    constexpr int KROW = (DQ + 8) * 2, VROW = 288, KCH = DQ / 8, NKC = 64 * KCH / 512, NDS = DQ / 32;
    const int lane = tid & 63, w = __builtin_amdgcn_readfirstlane(tid >> 6), qq = lane & 15, g = lane >> 4;
    const int q0 = qt * 128, qrow = q0 + 16 * w + qq, own = q0 >> 8;
    pg8::bf16x8 qf[NDS];
#pragma unroll
    for (int ds = 0; ds < NDS; ++ds) qf[ds] = *(const pg8::bf16x8*)(Qg + (size_t)qrow * ldq + 32 * ds + 8 * g);
    unsigned selbits = 0; if (MOBA) selbits = sel[(size_t)qrow * 8];
    f32x4 o[8];
#pragma unroll
    for (int i = 0; i < 8; ++i) o[i] = (f32x4){0.f, 0.f, 0.f, 0.f};
    float m = -1e30f, l = 0.f;
    const int ntiles = 2 * (qt + 1);
    v4u kA[NKC], vA[2], kB[NKC], vB[2];
    { const v4u z_ = {0u, 0u, 0u, 0u};
#pragma unroll
      for (int i_ = 0; i_ < NKC; ++i_) { kA[i_] = z_; kB[i_] = z_; }
      vA[0] = z_; vA[1] = z_; vB[0] = z_; vB[1] = z_; }
    unsigned kgo[NKC], vgo[2], klo[NKC], vlo[2];
#pragma unroll
    for (int i_ = 0; i_ < NKC; ++i_) { const int id_ = tid + 512 * i_, row_ = id_ / KCH, ch_ = id_ % KCH; kgo[i_] = (unsigned)(row_ * ldk + ch_ * 8) * 2u; klo[i_] = (unsigned)(row_ * KROW + ch_ * 16); }
#pragma unroll
    for (int i_ = 0; i_ < 2; ++i_) { const int id_ = tid + 512 * i_, row_ = id_ >> 4, ch_ = id_ & 15; vgo[i_] = (unsigned)(row_ * ldv + ch_ * 8) * 2u; vlo[i_] = (unsigned)(AT_VOFF + row_ * VROW + ch_ * 16); }
#define AT_GLOAD(KS, VS, tile) do { const char* kp_ = (const char*)Kg + (size_t)(tile) * 64 * ldk * 2; const char* vp_ = (const char*)Vg + (size_t)(tile) * 64 * ldv * 2; \
        _Pragma("unroll") for (int i_ = 0; i_ < NKC; ++i_) KS[i_] = *(const v4u*)(kp_ + kgo[i_]); \
        _Pragma("unroll") for (int i_ = 0; i_ < 2; ++i_) VS[i_] = *(const v4u*)(vp_ + vgo[i_]); } while (0)
#define AT_LSTORE(KS, VS, buf) do { _Pragma("unroll") for (int i_ = 0; i_ < NKC; ++i_) *(LAS v4u*)(lds + (buf) * AT_STAGE + klo[i_]) = KS[i_]; \
        _Pragma("unroll") for (int i_ = 0; i_ < 2; ++i_) *(LAS v4u*)(lds + (buf) * AT_STAGE + vlo[i_]) = VS[i_]; } while (0)
    AT_GLOAD(kA, vA, 0); AT_LSTORE(kA, vA, 0);
    AT_GLOAD(kA, vA, 1);
    __syncthreads();
    for (int it = 0; it < ntiles; it += 2) {
        if (it + 2 < ntiles) AT_GLOAD(kB, vB, it + 2);
        attn_tile<DQ, MOBA>(lds, 0, it, q0, w, qq, g, qrow, own, selbits, sc, qf, o, m, l);
        AT_LSTORE(kA, vA, 1);
        __syncthreads();
        if (it + 3 < ntiles) AT_GLOAD(kA, vA, it + 3);
        attn_tile<DQ, MOBA>(lds, 1, it + 1, q0, w, qq, g, qrow, own, selbits, sc, qf, o, m, l);
        if (it + 2 < ntiles) AT_LSTORE(kB, vB, 0);
        __syncthreads();
    }
    float ls = l + shfl_xor_(l, 16, lane); ls += shfl_xor_(ls, 32, lane);
    const float inv = 1.0f / ls;
#pragma unroll
    for (int i = 0; i < 8; ++i) { v2u ob; ob.x = pk2(o[i][0] * inv, o[i][1] * inv); ob.y = pk2(o[i][2] * inv, o[i][3] * inv);
        *(v2u*)(Og + (size_t)qrow * ldo + 16 * i + 4 * g) = ob; }
#undef AT_GLOAD
#undef AT_LSTORE
}
template <bool BT, class Epi>
__device__ __forceinline__ void gemm32(LAS float* lds, const float* A, int lda, size_t sA, const float* B, int ldb, size_t sB,
                                       int M, int N, int K, int nbatch, const int* rowidx, const Epi& epi, const int tid, const int G) {
    const int lane = tid & 63, wave = tid >> 6, wm = wave >> 1, wn = wave & 1;
    const int tilesM = (M + 127) >> 7, tilesN = (N + 127) >> 7, tilesPer = tilesM * tilesN, ntiles = tilesPer * nbatch;
    LAS float* As = lds;
    LAS float* Bs = lds + 2 * 16 * 132;
    for (int tile = blockIdx.x; tile < ntiles; tile += G) {
        const int bt = tile / tilesPer, r = tile % tilesPer, tm = r / tilesN, tn = r % tilesN;
        const int m0 = tm * 128, n0 = tn * 128;
        const float* Ab = A + (size_t)bt * sA; const float* Bb = B + (size_t)bt * sB;
        const int arow = tid >> 2, akq = (tid & 3) * 4;
        const int gr = m0 + arow; const bool aok = gr < M;
        const int src = aok ? (rowidx ? rowidx[gr] : gr) : 0;
        const float* ap = Ab + (size_t)src * lda + akq;
        const float* bp; bool bok; int bkr, bnq;
        if (BT) { bkr = 0; bnq = 0; const int gn = n0 + arow; bok = gn < N; bp = Bb + (size_t)(bok ? gn : 0) * ldb + akq; }
        else { bkr = tid >> 5; bnq = (tid & 31) * 4; bok = (n0 + bnq) < N; bp = Bb + (size_t)bkr * ldb + (bok ? (n0 + bnq) : 0); }
        f32x16 acc0, acc1;
#pragma unroll
        for (int i = 0; i < 16; ++i) { acc0[i] = 0.f; acc1[i] = 0.f; }
        f32x4 ra, rb;
        const f32x4 z4 = {0.f, 0.f, 0.f, 0.f};
        ra = aok ? *(const f32x4*)ap : z4;
        rb = bok ? *(const f32x4*)bp : z4;
        {
            LAS float* a_ = As; LAS float* b_ = Bs;
#pragma unroll
            for (int j = 0; j < 4; ++j) a_[(akq + j) * 132 + arow] = ra[j];
            if (BT) {
#pragma unroll
                for (int j = 0; j < 4; ++j) b_[(akq + j) * 132 + arow] = rb[j];
            } else *(LAS f32x4*)(b_ + bkr * 132 + bnq) = rb;
        }
        __syncthreads();
        for (int k0 = 0; k0 < K; k0 += 16) {
            const int cur = (k0 >> 4) & 1;
            const bool more = (k0 + 16) < K;
            if (more) {
                ra = aok ? *(const f32x4*)(ap + k0 + 16) : z4;
                if (BT) rb = bok ? *(const f32x4*)(bp + k0 + 16) : z4;
                else rb = bok ? *(const f32x4*)(bp + (size_t)(k0 + 16) * ldb) : z4;
            }
            const LAS float* a_ = As + cur * 16 * 132 + (lane >> 5) * 132 + wm * 32 + (lane & 31);
            const LAS float* b_ = Bs + cur * 16 * 132 + (lane >> 5) * 132 + wn * 64 + (lane & 31);
#pragma unroll
            for (int kk = 0; kk < 16; kk += 2) {
                const float a = a_[kk * 132], b0 = b_[kk * 132], b1 = b_[kk * 132 + 32];
                acc0 = __builtin_amdgcn_mfma_f32_32x32x2f32(a, b0, acc0, 0, 0, 0);
                acc1 = __builtin_amdgcn_mfma_f32_32x32x2f32(a, b1, acc1, 0, 0, 0);
            }
            if (more) {
                LAS float* aw = As + (cur ^ 1) * 16 * 132; LAS float* bw = Bs + (cur ^ 1) * 16 * 132;
#pragma unroll
                for (int j = 0; j < 4; ++j) aw[(akq + j) * 132 + arow] = ra[j];
                if (BT) {
#pragma unroll
                    for (int j = 0; j < 4; ++j) bw[(akq + j) * 132 + arow] = rb[j];
                } else *(LAS f32x4*)(bw + bkr * 132 + bnq) = rb;
            }
            __syncthreads();
        }
#pragma unroll
        for (int i = 0; i < 16; ++i) {
            const int row = m0 + wm * 32 + (i & 3) + 8 * (i >> 2) + 4 * (lane >> 5);
            const int c0 = n0 + wn * 64 + (lane & 31);
            if (row < M) {
                if (c0 < N) epi(bt, row, c0, acc0[i]);
                if (c0 + 32 < N) epi(bt, row, c0 + 32, acc1[i]);
            }
        }
    }
}

struct EpiStore { float* C; int ldc; size_t sC;
    __device__ __forceinline__ void operator()(int bt, int m, int n, float v) const { C[(size_t)bt * sC + (size_t)m * ldc + n] = v; } };
struct EpiDecay { float* C; const float* w0;
    __device__ __forceinline__ void operator()(int, int m, int n, float v) const {
        const float z = -(w0[n] + v); const float sp = z > 20.f ? z : log1pf(expf(z));
        C[(size_t)m * BW + n] = expf(-expf(-sp - 0.5f)); } };
struct EpiSigB { float* C; const float* b;
    __device__ __forceinline__ void operator()(int, int m, int n, float v) const { C[(size_t)m * BW + n] = sigmoidf_(b[n] + v); } };
struct EpiVLerp { float* V; const float* VF; const float* v0;
    __device__ __forceinline__ void operator()(int, int m, int n, float a) const {
        const size_t o = (size_t)m * BW + n; const float v = V[o]; V[o] = v + (VF[o] - v) * sigmoidf_(v0[n] + a); } };
template <bool FIRST> struct EpiGateAcc { float* MIX; const float* gate;
    __device__ __forceinline__ void operator()(int, int m, int n, float a) const {
        const float g = sigmoidf_(gate[(size_t)m * IN_COLS + n]); const size_t o = (size_t)m * D + n;
        MIX[o] = FIRST ? g * a : MIX[o] + g * a; } };
struct EpiResid { float* C; const float* R; int ldc;
    __device__ __forceinline__ void operator()(int, int m, int n, float a) const { const size_t o = (size_t)m * ldc + n; C[o] = ALPHA * R[o] + a; } };
struct EpiSwiglu { float* C; int ldc; size_t roff;
    __device__ __forceinline__ void operator()(int, int m, int n, float a) const {
        const size_t o = (roff + (size_t)m) * ldc + n; const float g = C[o]; C[o] = g * sigmoidf_(g) * a; } };

struct Args { const float* in[34]; float* out; unsigned char* ws; unsigned mask; int li; };

__device__ __forceinline__ unsigned char* opq(unsigned char* p) { asm volatile("" : "+s"(p)); return p; }
#define INP(i) ((const float*)(((const GAS float* const*)args.in)[(i) + zero_live]))
#define x_in INP(0)
#define w_in INP(1)
#define w_in_vres INP(2)
#define rwkv_mu INP(3)
#define rwkv_mu_vres INP(4)
#define rwkv_w0 INP(5)
#define rwkv_w_lora INP(6)
#define rwkv_a0 INP(7)
#define rwkv_a_lora INP(8)
#define rwkv_g_lora INP(9)
#define rwkv_v0 INP(10)
#define rwkv_v_lora INP(11)
#define rwkv_k_k INP(12)
#define rwkv_k_a INP(13)
#define rwkv_r_k INP(14)
#define rwkv_gn_g INP(15)
#define rwkv_gn_b INP(16)
#define mla_q_norm INP(17)
#define mla_w_uq INP(18)
#define mla_kv_norm INP(19)
#define mla_w_ukv INP(20)
#define branch_out INP(21)
#define w_out INP(22)
#define ln1_g INP(23)
#define ln1_b INP(24)
#define ffn_wg INP(25)
#define ffn_wu INP(26)
#define ffn_wd INP(27)
#define moe_router INP(28)
#define moe_wg INP(29)
#define moe_wu INP(30)
#define moe_wd INP(31)
#define ln2_g INP(32)
#define ln2_b INP(33)
#define COSA ((float*)(ws_live + WS_COSA))
#define SINA ((float*)(ws_live + WS_SINA))
#define COSM ((float*)(ws_live + WS_COSM))
#define SINM ((float*)(ws_live + WS_SINM))
#define TOK ((int*)(ws_live + WS_TOK))
#define ROWL ((int*)(ws_live + WS_ROWL))
#define XB ((float*)(ws_live + WS_XB))
#define X1 ((float*)(ws_live + WS_X1))
#define PRE ((float*)(ws_live + WS_PRE))
#define XBF ((bf16*)(ws_live + WS_XBF))
#define WINT ((bf16*)(ws_live + WS_WINT))
#define X1B ((bf16*)(ws_live + WS_X1B))
#define WBO ((bf16*)(ws_live + WS_WBO))
#define WOT ((bf16*)(ws_live + WS_WOT))
#define WGU ((bf16*)(ws_live + WS_WGU))
#define WD ((bf16*)(ws_live + WS_WD))
#define WDD ((bf16*)(ws_live + WS_WDD))
#define HGB ((bf16*)(ws_live + WS_HGB))
#define XG ((bf16*)(ws_live + WS_XG))
#define MIXB ((bf16*)(ws_live + WS_MIXB))
#define YALL ((bf16*)(ws_live + WS_YALL))
#define GATEB ((bf16*)(ws_live + WS_GATEB))
#define QAB ((bf16*)(ws_live + WS_QAB))
#define KAB ((bf16*)(ws_live + WS_KAB))
#define VAB ((bf16*)(ws_live + WS_VAB))
#define QCB ((bf16*)(ws_live + WS_QCB))
#define KCB ((bf16*)(ws_live + WS_KCB))
#define VCB ((bf16*)(ws_live + WS_VCB))
#define KMEAN ((float*)(ws_live + WS_KMEAN))
#define SELB ((unsigned char*)(ws_live + WS_SEL))
#define WUQ ((bf16*)(ws_live + WS_WUQ))
#define WUKV ((bf16*)(ws_live + WS_WUKV))
#define WLORA ((bf16*)(ws_live + WS_WLORA))
#define LA ((bf16*)(ws_live + WS_LA))
#define QNB ((bf16*)(ws_live + WS_QNB))
#define KVNB ((bf16*)(ws_live + WS_KVNB))
#define QF ((float*)(ws_live + WS_QF))
#define KMS ((float*)(ws_live + WS_KMEAN))
#define PROJ ((bf16*)(ws_live + WS_PROJ))
#define VRES ((float*)(ws_live + WS_VRES))
#define QA ((float*)(ws_live + WS_QA))
#define V0 ((float*)(ws_live + WS_V0))
#define V1 ((float*)(ws_live + WS_V1))
#define DEC ((float*)(ws_live + WS_DEC))
#define AA ((bf16*)(ws_live + WS_AA))
#define GG ((bf16*)(ws_live + WS_GG))
#define Y ((bf16*)(ws_live + WS_Y))
#define OUT ((float*)(ws_live + WS_OUT))


__global__ void __launch_bounds__(NTHREADS, 2) fwd_kernel(Args args) {
    extern __shared__ __attribute__((aligned(16))) unsigned char lds_raw[];
#define lds ((LAS float*)lds_raw)
    int wave_live = __builtin_amdgcn_readfirstlane((int)threadIdx.x >> 6);
    int tid_live = threadIdx.x;
#define RETID() do { int ln_; asm volatile("v_mbcnt_lo_u32_b32 %0, -1, 0\n\tv_mbcnt_hi_u32_b32 %0, -1, %0" : "=v"(ln_)); asm volatile("" : "+s"(wave_live)); tid_live = wave_live * 64 + ln_; } while (0)
#define tid tid_live
#define lane (tid_live & 63)
#define wave (__builtin_amdgcn_readfirstlane(tid_live >> 6))
#define gw ((int)blockIdx.x * NWAVES + wave)
#define NGW (G_live * NWAVES)
#define gt ((int)blockIdx.x * NTHREADS + tid_live)
#define NGT (G_live * NTHREADS)
#define misc ((volatile LAS unsigned*)((LAS unsigned char*)lds_raw + LDS_BYTES - 64))
    if (tid < 16) misc[tid] = tid == 6 ? 0xffffffffu : 0u;
    __syncthreads();
#define REOPAQUE() do { asm volatile("" : "+s"(ws_live)); asm volatile("" : "+s"(zero_live)); asm volatile("" : "+s"(G_live)); RETID(); } while (0)
#define TI_WINT(t_, ll_, r_) do { constexpr int NNB_ = NP / 32; const int kb_ = (r_) / NNB_, nb_ = (r_) % NNB_, c_ = nb_ * 32; \
    const float* W_ = w_in + (size_t)(ll_) * D * IN_COLS; int ldw_ = IN_COLS, sc_ = c_; \
    if (c_ < 6432) sc_ = c_; \
    else if (c_ < 6464) { if (ll_) { W_ = w_in_vres; ldw_ = 32; sc_ = 0; } else W_ = nullptr; } \
    else if (c_ < 7552) sc_ = c_ - 32; \
    else if (c_ < 7680) W_ = nullptr; \
    else sc_ = c_ - 160; \
    int scl_ = sc_ + (lane & 31); \
    if (c_ < 2048) { const int cl_ = c_ + (lane & 31), hh_ = cl_ >> 7, cc_ = cl_ & 127, e_ = cc_ & 7; scl_ = hh_ * 128 + (e_ < 4 ? 4 * (cc_ >> 3) + e_ : 64 + 4 * (cc_ >> 3) + (e_ - 4)); } \
    (t_).zero = W_ == nullptr; (t_).p = (W_ ? W_ : w_in) + scl_; (t_).ldw = ldw_; (t_).wt = WINT + (size_t)(ll_) * NP * D; (t_).K = D; (t_).r0 = c_; (t_).k0 = kb_ * 64; } while (0)
#define TI_WBO(t_, mat_, r_) do { const int kb_ = (r_) / 64, nb_ = (r_) % 64, ll_ = (mat_) / 3, seg_ = (mat_) % 3; \
    (t_).zero = false; (t_).p = branch_out + (size_t)(mat_) * BW * D + nb_ * 32 + (lane & 31); (t_).ldw = D; (t_).wt = WBO + (size_t)ll_ * D * 3 * BW + seg_ * BW; (t_).K = 3 * BW; (t_).r0 = nb_ * 32; (t_).k0 = kb_ * 64; } while (0)
#define TI_WUQ(t_, mat_, r_) do { const int kb_ = (r_) / 48, nb_ = (r_) % 48; \
    const int np_ = nb_ * 32 + (lane & 31), hh_ = np_ / 192, cc_ = np_ - hh_ * 192, q_ = cc_ - 128, e_ = q_ & 7; \
    const int sc_ = cc_ < 128 ? hh_ * 192 + cc_ : hh_ * 192 + 128 + (e_ < 4 ? 4 * (q_ >> 3) + e_ : 32 + 4 * (q_ >> 3) + (e_ - 4)); \
    (t_).zero = false; (t_).p = mla_w_uq + (size_t)(mat_) * 512 * 1536 + sc_; (t_).ldw = 1536; (t_).wt = WUQ + (size_t)(mat_) * 1536 * 512; (t_).K = 512; (t_).r0 = nb_ * 32; (t_).k0 = kb_ * 64; } while (0)
#define TI_WUKV(t_, mat_, r_) do { const int kb_ = (r_) / 64, nb_ = (r_) % 64; \
    (t_).zero = false; (t_).p = mla_w_ukv + (size_t)(mat_) * 512 * 2048 + nb_ * 32 + (lane & 31); (t_).ldw = 2048; (t_).wt = WUKV + (size_t)(mat_) * 2048 * 512; (t_).K = 512; (t_).r0 = nb_ * 32; (t_).k0 = kb_ * 64; } while (0)
#define TI_WOT(t_, mat_, r_) do { const int kb_ = (r_) / 64, nb_ = (r_) % 64; \
    (t_).zero = false; (t_).p = w_out + (size_t)(mat_) * D * D + nb_ * 32 + (lane & 31); (t_).ldw = D; (t_).wt = WOT + (size_t)(mat_) * D * D; (t_).K = D; (t_).r0 = nb_ * 32; (t_).k0 = kb_ * 64; } while (0)
constexpr int FC_I_GU = (D / 64) * (NGU / 32), FC_I_D = (DFF / 64) * (D / 32);
#define TI_GU(t_, wg_, wu_, e_, r_) do { const int kb_ = (r_) / (NGU / 32), nb_ = (r_) % (NGU / 32); const int rr_ = lane & 31, hcol_ = 4 * (nb_ * 4 + (rr_ >> 3)) + (rr_ & 3); \
    (t_).zero = false; (t_).p = ((rr_ & 7) < 4 ? (wg_) : (wu_)) + (size_t)(e_) * D * DFF + hcol_; (t_).ldw = DFF; (t_).wt = WGU + (size_t)(e_) * NGU * D; (t_).K = D; (t_).r0 = nb_ * 32; (t_).k0 = kb_ * 64; } while (0)
#define TI_D(t_, wd_, dst_, e_, r_) do { const int kb_ = (r_) / (D / 32), nb_ = (r_) % (D / 32); \
    (t_).zero = false; (t_).p = (wd_) + (size_t)(e_) * DFF * D + nb_ * 32 + (lane & 31); (t_).ldw = D; (t_).wt = (dst_) + (size_t)(e_) * D * DFF; (t_).K = DFF; (t_).r0 = nb_ * 32; (t_).k0 = kb_ * 64; } while (0)
#define TI_RUN1(ta_) do { float va_[32]; ti_load(ta_, va_, lane); ti_finish(ta_, va_, scr, lane); } while (0)
#define TI_RUN2(ta_, tb_) do { float va_[32], vb_[32]; ti_load(ta_, va_, lane); ti_load(tb_, vb_, lane); ti_finish(ta_, va_, scr, lane); ti_finish(tb_, vb_, scr, lane); } while (0)
#define CV_WINT_ITEM(ll_, r_) do { TI t1_; TI_WINT(t1_, ll_, r_); TI_RUN1(t1_); } while (0)
#define CV_WUQ_ITEM(mat_, r_) do { TI t1_; TI_WUQ(t1_, mat_, r_); TI_RUN1(t1_); } while (0)
#define CV_WUKV_ITEM(mat_, r_) do { TI t1_; TI_WUKV(t1_, mat_, r_); TI_RUN1(t1_); } while (0)
#define CV_LORA_ITEM(ll_, r_) do { \
    for (int j_ = 0; j_ < 32; ++j_) { const int x_ = (r_) * 2048 + j_ * 64 + lane, n_ = x_ / 384, k_ = x_ % 384, seg_ = n_ >> 10, c_ = n_ & 1023; \
        float v_ = 0.f; \
        if (seg_ == 0) { if (k_ < 64) v_ = rwkv_w_lora[((size_t)(ll_) * 64 + k_) * BW + c_]; } \
        else if (seg_ == 1) { if (k_ >= 64 && k_ < 128) v_ = rwkv_a_lora[((size_t)(ll_) * 64 + (k_ - 64)) * BW + c_]; } \
        else if (seg_ == 2) { if (k_ >= 128 && k_ < 288) v_ = rwkv_g_lora[((size_t)(ll_) * 160 + (k_ - 128)) * BW + c_]; } \
        else { if ((ll_) == 1 && k_ >= 288 && k_ < 320) v_ = rwkv_v_lora[(size_t)(k_ - 288) * BW + c_]; } \
        WLORA[(size_t)(ll_) * 4096 * 384 + x_] = (bf16)f2bf(v_); } } while (0)
#define FFN_CONV_PAIR(it_) do { const int fi_ = (it_); \
    if (l == 0) { if (fi_ < FC_I_GU) PAIR_OF(TI_GU, ffn_wg, ffn_wu, 0, fi_); else PAIR_OF(TI_D, ffn_wd, WDD, 0, fi_ - FC_I_GU); } \
    else PAIR_OF(TI_GU, moe_wg, moe_wu, fi_ / FC_I_GU, fi_ % FC_I_GU); } while (0)
#define FFN_CONV_N(l_) ((l_) == 0 ? FC_I_GU + FC_I_D : 4 * FC_I_GU)
#define PAIR_OF(TIM_, ...) do { TI ta_, tb_; TIM_(ta_, __VA_ARGS__); TIM_(tb_, __VA_ARGS__ + 1); TI_RUN2(ta_, tb_); } while (0)
#define DQ_PAIR(d_) do { const int d__ = (d_); \
    if (d__ < 3072) { PAIR_OF(TI_WBO, d__ >> 10, (d__ & 1023)); asm volatile("; dq0" ::: "memory"); } \
    else if (d__ < 5120) { PAIR_OF(TI_WOT, 0, d__ - 3072); asm volatile("; dq1" ::: "memory"); } \
    else if (d__ < 18944) { PAIR_OF(TI_WINT, 1, d__ - 5120); asm volatile("; dq2" ::: "memory"); } \
    else if (d__ < 19712) { }   \
    else if (d__ < 20096) { PAIR_OF(TI_WUQ, 1, d__ - 19712); asm volatile("; dq3" ::: "memory"); } \
    else if (d__ < 20608) { PAIR_OF(TI_WUKV, 1, d__ - 20096); asm volatile("; dq4" ::: "memory"); } \
    else if (d__ < 23680) { PAIR_OF(TI_WBO, 3 + ((d__ - 20608) >> 10), ((d__ - 20608) & 1023)); asm volatile("; dq5" ::: "memory"); } \
    else if (d__ < 25728) { PAIR_OF(TI_WOT, 1, d__ - 23680); asm volatile("; dq6" ::: "memory"); } \
    else if (d__ < DQ_J7) { PAIR_OF(TI_GU, moe_wg, moe_wu, 4 + (d__ - 25728) / FC_I_GU, (d__ - 25728) % FC_I_GU); asm volatile("; dq7" ::: "memory"); } \
    else { PAIR_OF(TI_D, moe_wd, WD, (d__ - DQ_J7) / FC_I_D, (d__ - DQ_J7) % FC_I_D); asm volatile("; dq8" ::: "memory"); } } while (0)
#define DQ_HALF(base_) do { const int dit_ = (int)(base_) + 2 * wave; if (dit_ < DQ_N) DQ_PAIR(dit_); } while (0)
#define DQ_PENDING() do { const unsigned pu_ = (unsigned)__builtin_amdgcn_readfirstlane((int)misc[6]); __syncthreads(); \
        if (pu_ != 0xffffffffu) { if (tid == 0) misc[6] = 0xffffffffu; DQ_HALF(pu_); } } while (0)
#define DQ_RUN(COND_) do { DQ_PENDING(); for (;;) { \
        if (tid == 0) { unsigned u_ = 0xffffffffu; \
            if (xb_ld(ctl + CW_DQ + 64 * li_) < (unsigned)DQ_N && (COND_)) u_ = atomicAdd(ctl + CW_DQ + 64 * li_, 32u); \
            misc[4] = u_; } \
        __syncthreads(); \
        const unsigned du_ = (unsigned)__builtin_amdgcn_readfirstlane((int)misc[4]); \
        __syncthreads(); \
        if (du_ >= (unsigned)DQ_N) break; \
        DQ_HALF(du_); \
        if (tid == 0) misc[5] = (COND_) ? 1u : 0u; \
        __syncthreads(); \
        const unsigned go_ = (unsigned)__builtin_amdgcn_readfirstlane((int)misc[5]); \
        __syncthreads(); \
        if (!go_) { if (tid == 0) misc[6] = du_ + 16u; __syncthreads(); break; } \
        DQ_HALF(du_ + 16u); \
    } } while (0)
#define DQ_FLUSH(UPTO_) do { DQ_PENDING(); for (;;) { \
        if (tid == 0) { const unsigned h_ = xb_ld(ctl + CW_DQ + 64 * li_); unsigned u_ = 0xffffffffu, nb_ = 0u; \
            if (h_ < (unsigned)(UPTO_)) { nb_ = ((((unsigned)(UPTO_) - h_ + (unsigned)G_live - 1u) / (unsigned)G_live) + 7u) & ~7u; nb_ = nb_ < 16u ? 16u : nb_; u_ = atomicAdd(ctl + CW_DQ + 64 * li_, nb_); } \
            misc[4] = u_; misc[5] = nb_; } \
        __syncthreads(); \
        const unsigned du_ = (unsigned)__builtin_amdgcn_readfirstlane((int)misc[4]), dn_ = (unsigned)__builtin_amdgcn_readfirstlane((int)misc[5]); \
        __syncthreads(); \
        if (du_ >= (unsigned)DQ_N) break; \
        const int de_ = (int)min(du_ + dn_, (unsigned)DQ_N); \
        _Pragma("unroll 1") \
        for (int dit_ = (int)du_ + 2 * wave; dit_ < de_; dit_ += 16) DQ_PAIR(dit_); \
    } } while (0)
#define DQ_FILL(SLOT_, TH_) DQ_RUN(xb_ld(ctl + CW_PD + 64 * ((SLOT_) + 8 * li_)) < (unsigned)(TH_))
#define PHASE_DONE(SLOT_) do { if (tid == 0) atomicAdd(ctl + CW_PD + 64 * ((SLOT_) + 8 * li_), 1u); } while (0)
#define GRID_BAR() do { { XcdBarrier bar_; bar_.bar = ctl + CW_BAR + li_ * XCD_BAR_WORDS; bar_.x = xb_xcc_id(); bar_.st = misc; xcd_barrier(bar_, tid_live); } asm volatile("" : "+s"(ws_live)); asm volatile("" : "+s"(zero_live)); asm volatile("" : "+s"(G_live)); RETID(); } while (0)

    GAS unsigned char* ws_live = *(GAS unsigned char* const*)&args.ws; int zero_live = 0; int G_live = (int)gridDim.x; unsigned mask_live = args.mask; const int li_ = args.li;
#define RUN(p) ((mask_live >> (l * 12 + (p))) & 1u)
#define ctl ((unsigned*)(ws_live + WS_CTL))
    (void)xcd_barrier_post(ctl + CW_BAR + li_ * XCD_BAR_WORDS, misc, tid_live);
    if (mask_live & (1u << 31)) {
    for (int i = gt; i < SEQ * 64; i += NGT) {
        const int s = i >> 6, j = i & 63;
        const float inv = 1.0f / powf(10000.0f, (float)(2 * j) / 128.0f);
        const float ang = (float)s * inv;
        COSA[i] = cosf(ang); SINA[i] = sinf(ang);
    }
    for (int i = gt; i < SEQ * 32; i += NGT) {
        const int s = i >> 5, j = i & 31;
        const float inv = 1.0f / powf(10000.0f, (float)(2 * j) / 64.0f);
        const float ang = (float)s * inv;
        COSM[i] = cosf(ang); SINM[i] = sinf(ang);
    }

    {
        LAS float* scr = (LAS float*)((LAS unsigned char*)lds_raw) + wave * (64 * 33);
        for (int it = gw; it < (D / 64) * (NP / 32); it += NGW) CV_WINT_ITEM(0, it);
        for (int it = gw; it < 2 * 768; it += NGW) { const int ll = it / 768, r = it % 768; CV_LORA_ITEM(ll, r); }
        for (int it = gw; it < 8 * 48; it += NGW) CV_WUQ_ITEM(0, it);
        for (int it = gw; it < 8 * 64; it += NGW) CV_WUKV_ITEM(0, it);
        for (int t = gw; t < T; t += NGW) {
#pragma unroll
            for (int jj = 0; jj < 8; ++jj) { const f32x4 v = *(const f32x4*)(x_in + (size_t)t * D + jj * 256 + lane * 4);
                v2u o; o.x = pk2(v[0], v[1]); o.y = pk2(v[2], v[3]); *(v2u*)(XBF + (size_t)t * D + jj * 256 + lane * 4) = o; }
        }
    }
    GRID_BAR();
    }
    for (int l = 0; l < 2; ++l) {
        const float* X = (l == 0) ? x_in : XB;
        float* Vcur = (l == 0) ? V0 : V1;
        if (RUN(0)) {
        {
            pg8::Gemm g{XBF, WINT + (size_t)l * NP * D, T, NP, D}; pg8::StaticOrder S; S.init(T, NP, G_live, (int)blockIdx.x);
            EpiInProjF32 E{PROJ, VRES, GATEB, QF, KAB, VAB, COSA, SINA, l};
            pg8::gemm_phase<EpiInProjF32, pg8::StaticOrder, false>((LAS unsigned char*)lds_raw, g, S, E, nullptr, tid);
        }
        REOPAQUE();
        {
            LAS float* scr = (LAS float*)((LAS unsigned char*)lds_raw) + wave * (64 * 33);
            PHASE_DONE(l * 4 + 0);
            DQ_FILL(l * 4 + 0, 65);
        }
        GRID_BAR();
        }
        if (RUN(1)) {
        if (l == 1) { LAS float* scr = (LAS float*)((LAS unsigned char*)lds_raw) + wave * (64 * 33); DQ_FLUSH(DQ_J5); }
        for (int item = blockIdx.x; item < NBATCH * 8 * 8; item += G_live) {
            const int blk = item & 7, h = (item >> 3) & 7, b = item >> 6;
            const int kq = tid >> 4, d8 = (tid & 15) * 8;
            const bf16* kbase = KAB + ((size_t)b * SEQ + blk * 256) * BW + h * 128 + d8;
            float sacc[8];
#pragma unroll
            for (int j = 0; j < 8; ++j) sacc[j] = 0.f;
#pragma unroll
            for (int it = 0; it < 8; ++it) { const v4u kv = *(const v4u*)(kbase + (size_t)(kq + 32 * it) * BW); const unsigned kw[4] = {kv.x, kv.y, kv.z, kv.w};
#pragma unroll
                for (int j = 0; j < 4; ++j) { sacc[2 * j] += __uint_as_float(kw[j] << 16); sacc[2 * j + 1] += __uint_as_float(kw[j] & 0xffff0000u); } }
#pragma unroll
            for (int j = 0; j < 8; ++j) lds[kq * 128 + d8 + j] = sacc[j];
            __syncthreads();
            if (tid < 128) { float a = 0.f;
#pragma unroll
                for (int rr = 0; rr < 32; ++rr) a += lds[rr * 128 + tid];
                KMS[(size_t)item * 128 + tid] = a; }
            __syncthreads();
        }
        {
            const float* mu = rwkv_mu + l * RWKV_COLS;
            for (int i0 = gt; i0 < (T / 4) * 256; i0 += 2 * NGT) {
                v2u row[2][5]; f32x4 mu4[2]; int tq[2], cc[2];
#pragma unroll
                for (int u_ = 0; u_ < 2; ++u_) {
                    const int i = i0 + u_ * NGT, ic = i < (T / 4) * 256 ? i : gt;
                    const int q = ic / 256, c4 = 2048 + (ic - q * 256) * 4, t0 = 4 * q, s0 = t0 & (SEQ - 1);
                    tq[u_] = i < (T / 4) * 256 ? t0 : -1; cc[u_] = c4;
                    const bf16* pr = PROJ + (size_t)t0 * PLD + (OFF_RWKV - PSH) + c4;
                    row[u_][0] = *(const v2u*)(s0 > 0 ? pr - PLD : pr);
                    if (s0 == 0) row[u_][0] = (v2u){0u, 0u};
#pragma unroll
                    for (int k = 0; k < 4; ++k) row[u_][k + 1] = *(const v2u*)(pr + (size_t)k * PLD);
                    mu4[u_] = *(const f32x4*)(mu + c4);
                }
#pragma unroll
                for (int u_ = 0; u_ < 2; ++u_) if (tq[u_] >= 0) {
                    float* dst = Vcur + (size_t)tq[u_] * BW + (cc[u_] & 1023);
#pragma unroll
                    for (int k = 0; k < 4; ++k) { const f32x4 cu = bf4_to_f32(row[u_][k + 1]), pv = bf4_to_f32(row[u_][k]); *(f32x4*)(dst + (size_t)k * BW) = cu + (pv - cu) * mu4[u_]; }
                }
            }
            for (int i = gt; i < T * 96; i += NGT) {
                const int t = i / 96, c4 = (i - t * 96) * 4, s = t & (SEQ - 1);
                f32x4 v = {0.f, 0.f, 0.f, 0.f};
                if (c4 < 288) {
                    const f32x4 cur = bf4_to_f32(*(const v2u*)(PROJ + (size_t)t * PLD + (OFF_RWKV - PSH) + 3072 + c4));
                    f32x4 prev = {0.f, 0.f, 0.f, 0.f}; if (s > 0) prev = bf4_to_f32(*(const v2u*)(PROJ + (size_t)(t - 1) * PLD + (OFF_RWKV - PSH) + 3072 + c4));
                    v = cur + (prev - cur) * *(const f32x4*)(mu + 3072 + c4);
                    if (c4 < 64) { v[0] = tanhf(v[0]); v[1] = tanhf(v[1]); v[2] = tanhf(v[2]); v[3] = tanhf(v[3]); }
                    else if (c4 >= 128) { v[0] = sigmoidf_(v[0]); v[1] = sigmoidf_(v[1]); v[2] = sigmoidf_(v[2]); v[3] = sigmoidf_(v[3]); }
                } else if (c4 < 320 && l == 1) {
                    const f32x4 cur = *(const f32x4*)(VRES + (size_t)t * 32 + (c4 - 288));
                    f32x4 prev = {0.f, 0.f, 0.f, 0.f}; if (s > 0) prev = *(const f32x4*)(VRES + (size_t)(t - 1) * 32 + (c4 - 288));
                    v = cur + (prev - cur) * *(const f32x4*)(rwkv_mu_vres + (c4 - 288));
                }
                v2u o; o.x = pk2(v[0], v[1]); o.y = pk2(v[2], v[3]); *(v2u*)(LA + (size_t)t * 384 + c4) = o;
            }
        }
        for (int t = gw; t < T; t += NGW) {
            const bf16* q = PROJ + (size_t)t * PLD + (OFF_MLA - PSH);
#pragma unroll
            for (int part = 0; part < 2; ++part) {
                const v4u qw = *(const v4u*)(q + part * 512 + lane * 8); v2u qlo, qhi; qlo.x = qw.x; qlo.y = qw.y; qhi.x = qw.z; qhi.y = qw.w;
                const f32x4 a = bf4_to_f32(qlo), b2 = bf4_to_f32(qhi);
                const float ss = (a[0] * a[0] + a[1] * a[1]) + (a[2] * a[2] + a[3] * a[3]) + (b2[0] * b2[0] + b2[1] * b2[1]) + (b2[2] * b2[2] + b2[3] * b2[3]);
                const float rs = rsqrtf(wave_sum(ss, lane) * (1.0f / 512.0f) + 1e-6f);
                const float* gn = (part ? mla_kv_norm : mla_q_norm) + l * 512 + lane * 8;
                const f32x4 g0 = *(const f32x4*)gn, g1 = *(const f32x4*)(gn + 4);
                v4u w; w.x = pk2(a[0] * rs * g0[0], a[1] * rs * g0[1]); w.y = pk2(a[2] * rs * g0[2], a[3] * rs * g0[3]);
                w.z = pk2(b2[0] * rs * g1[0], b2[1] * rs * g1[1]); w.w = pk2(b2[2] * rs * g1[2], b2[3] * rs * g1[3]);
                *(v4u*)((part ? KVNB : QNB) + (size_t)t * 512 + lane * 8) = w;
            }
            if (lane < 32) {
                const int s = t & (SEQ - 1);
                const float x1 = __builtin_bit_cast(float, (unsigned)q[1024 + lane] << 16), x2 = __builtin_bit_cast(float, (unsigned)q[1024 + 32 + lane] << 16), c = COSM[s * 32 + lane], sn = SINM[s * 32 + lane];
                const bf16 o1 = (bf16)f2bf(x1 * c - x2 * sn), o2 = (bf16)f2bf(x2 * c + x1 * sn);
#pragma unroll
                for (int hh = 0; hh < 8; ++hh) { KCB[(size_t)t * 1536 + hh * 192 + 128 + lane] = o1; KCB[(size_t)t * 1536 + hh * 192 + 160 + lane] = o2; }
            }
        }
        GRID_BAR();
        }
        if (RUN(2)) {
        {
            pg8::Gemm g{LA, WLORA + (size_t)l * 4096 * 384, T, l ? 4096 : 3072, 384 + zero_live}; pg8::StaticOrder S; S.init(T, l ? 4096 : 3072, G_live, (int)blockIdx.x);
            EpiLora E{DEC, AA, GG, V1, V0, rwkv_w0 + l * BW, rwkv_a0 + l * BW, rwkv_v0};
            pg8::gemm_phase<EpiLora, pg8::StaticOrder, false>((LAS unsigned char*)lds_raw, g, S, E, nullptr, tid);
        }
        REOPAQUE();
        {
            pg8::Gemm g{QNB, WUQ + (size_t)l * 1536 * 512, T, 1536, 512 + zero_live}; pg8::StaticOrder S; S.init(T, 1536, G_live, (int)blockIdx.x);
            EpiMlaQ E{QCB, COSM, SINM};
            pg8::gemm_phase<EpiMlaQ, pg8::StaticOrder, false>((LAS unsigned char*)lds_raw, g, S, E, nullptr, tid);
        }
        REOPAQUE();
        {
            pg8::Gemm g{KVNB, WUKV + (size_t)l * 2048 * 512, T, 2048, 512 + zero_live}; pg8::StaticOrder S; S.init(T, 2048, G_live, (int)blockIdx.x);
            EpiMlaKV E{KCB, VCB};
            pg8::gemm_phase<EpiMlaKV, pg8::StaticOrder, false>((LAS unsigned char*)lds_raw, g, S, E, nullptr, tid);
        }
        REOPAQUE();
        for (int i = gt; i < T * 8 * 16; i += NGT) {
            const int th = i >> 4, jg = (i & 15) * 4, t = th >> 3, h = th & 7, s = t & (SEQ - 1), own = s >> 8;
            const float* src_ = QF + (size_t)t * BW + h * 128 + jg;
            const f32x4 q1 = *(const f32x4*)src_, q2 = *(const f32x4*)(src_ + 64);
            v2u w1; w1.x = pk2(q1[0], q1[1]); w1.y = pk2(q1[2], q1[3]); v2u w2; w2.x = pk2(q2[0], q2[1]); w2.y = pk2(q2[2], q2[3]);
            *(v2u*)(QAB + (size_t)t * BW + h * 128 + jg) = w1; *(v2u*)(QAB + (size_t)t * BW + h * 128 + 64 + jg) = w2;
            const float* km = KMS + (size_t)(((t >> 11) * 8 + h) * 8) * 128 + jg;
            float gate[7];
#pragma unroll
            for (int n = 0; n < 7; ++n) {
                const f32x4 k1 = *(const f32x4*)(km + n * 128), k2 = *(const f32x4*)(km + n * 128 + 64);
                const float part = ((q1[0] * k1[0] + q1[1] * k1[1]) + (q1[2] * k1[2] + q1[3] * k1[3])) + ((q2[0] * k2[0] + q2[1] * k2[1]) + (q2[2] * k2[2] + q2[3] * k2[3]));
                gate[n] = row_allsum16(part);
            }
            unsigned bits = 0;
#pragma unroll
            for (int n = 0; n < 7; ++n) {
                int rank = 0;
#pragma unroll
                for (int m2 = 0; m2 < 7; ++m2) if (m2 != n) rank += (m2 < own && (gate[m2] > gate[n] || (gate[m2] == gate[n] && m2 < n))) ? 1 : 0;
                bits |= ((n < own) && (rank < 3)) ? (1u << n) : 0u;
            }
            if ((i & 15) == 0) SELB[(size_t)t * 8 + h] = (unsigned char)bits;
        }
        {
            LAS float* scr = (LAS float*)((LAS unsigned char*)lds_raw) + wave * (64 * 33);
            __syncthreads();
            PHASE_DONE(l * 4 + 2);
            DQ_FILL(l * 4 + 2, l == 0 ? 129 : 65);
        }
        GRID_BAR();
        }
        if (RUN(3)) {
        if (!(mask_live & (1u << 30)))
        for (int item = blockIdx.x; item < 128; item += G_live) {
            const int bh = item >> 1, half = item & 1, b = bh >> 4, h = bh & 15;
            const size_t base = (size_t)b * SEQ * BW + h * 64;
            constexpr int CH = 32, BUFF = 6 * CH * 64;
            LAS float* ypart = lds + 2 * BUFF;
            const int st_step = tid >> 4, st_j = (tid & 15) * 4;
            const int cbase = l * BW + h * 64 + st_j;
            const f32x4 ckk = *(const f32x4*)(rwkv_k_k + cbase), cka = *(const f32x4*)(rwkv_k_a + cbase);
            const int cg = lane & 15, rl = tid >> 4, irow = 32 * half + rl;
            const bool stager = tid < CH * 16;
            f32x4 g_w = {0.f, 0.f, 0.f, 0.f}, g_v = g_w; v2u g_ab = {0u, 0u};
            v2u g_rc = {0u, 0u}, g_rp = g_rc, g_kc = g_rc, g_kp = g_rc; int g_s = 0;
            const f32x4 mur = *(const f32x4*)(rwkv_mu + l * RWKV_COLS + h * 64 + st_j), muk = *(const f32x4*)(rwkv_mu + l * RWKV_COLS + 1024 + h * 64 + st_j);
            const bf16* pbase = PROJ + (size_t)b * SEQ * PLD + (OFF_RWKV - PSH) + h * 64 + st_j;
            float sa = 0.f, sb = 0.f, sc2 = 0.f, sd = 0.f;
#define SC_GLOAD(c) do { if (stager) { const size_t o_ = base + (size_t)((c) * CH + st_step) * BW + st_j; \
                g_s = (c) * CH + st_step; const bf16* pk_ = pbase + (size_t)g_s * PLD; \
                g_kc = *(const v2u*)(pk_ + 1024); g_kp = *(const v2u*)(pk_ - (g_s > 0 ? PLD : 0) + 1024); \
                g_rc = *(const v2u*)(pk_ - (g_s > 0 ? PLD : 0)); g_rp = *(const v2u*)(pk_ - (g_s > 1 ? 2 * PLD : 0)); \
                g_w = *(const f32x4*)(DEC + o_); g_ab = *(const v2u*)(AA + o_); g_v = *(const f32x4*)(Vcur + o_); } } while (0)
#define SC_LSTORE(bufi) do { if (stager) { \
                const f32x4 kc_ = bf4_to_f32(g_kc), rc_ = bf4_to_f32(g_rc); f32x4 kp_ = bf4_to_f32(g_kp), rp_ = bf4_to_f32(g_rp); \
                if (g_s == 0) kp_ = (f32x4){0.f, 0.f, 0.f, 0.f}; if (g_s <= 1) rp_ = (f32x4){0.f, 0.f, 0.f, 0.f}; \
                const f32x4 g_k = kc_ + (kp_ - kc_) * muk, g_r = rc_ + (rp_ - rc_) * mur, g_a = bf4_to_f32(g_ab); \
                f32x4 kk_ = g_k * ckk; \
                const float n2_ = row_allsum16((kk_[0] * kk_[0] + kk_[1] * kk_[1]) + (kk_[2] * kk_[2] + kk_[3] * kk_[3])); \
                kk_ = kk_ * __builtin_amdgcn_rcpf(fmaxf(sqrtf(n2_), 1e-12f)); \
                const f32x4 k2_ = g_k * (1.0f + (g_a - 1.0f) * cka); \
                LAS float* bb_ = lds + (bufi) * BUFF + st_step * 64 + st_j; \
                *(LAS f32x4*)(bb_ + 0 * CH * 64) = g_r; *(LAS f32x4*)(bb_ + 1 * CH * 64) = g_w; *(LAS f32x4*)(bb_ + 2 * CH * 64) = k2_; \
                *(LAS f32x4*)(bb_ + 3 * CH * 64) = kk_; *(LAS f32x4*)(bb_ + 4 * CH * 64) = kk_ * g_a; *(LAS f32x4*)(bb_ + 5 * CH * 64) = g_v; } } while (0)
#define SC_LD(X, st_) do { const LAS float* p_ = bb + (st_) * 64 + 4 * cg; \
                X##r = *(const LAS f32x4*)(p_ + 0 * CH * 64); X##w = *(const LAS f32x4*)(p_ + 1 * CH * 64); X##k = *(const LAS f32x4*)(p_ + 2 * CH * 64); \
                X##q = *(const LAS f32x4*)(p_ + 3 * CH * 64); X##b = *(const LAS f32x4*)(p_ + 4 * CH * 64); X##v = bb[5 * CH * 64 + (st_) * 64 + irow]; } while (0)
#define SC_STEP(X, st_) do { float d_, y_, t0_, t1_, t2_, t3_; \
                asm("v_mul_f32 %0, %4, %8\n\tv_mul_f32 %1, %4, %12\n\tv_mul_f32 %2, %6, %10\n\tv_mul_f32 %3, %6, %14\n\t" \
                    "v_fma_f32 %0, %5, %9, %0\n\tv_fma_f32 %1, %5, %13, %1\n\tv_fma_f32 %2, %7, %11, %2\n\tv_fma_f32 %3, %7, %15, %3\n\t" \
                    "v_add_f32 %0, %0, %2\n\tv_add_f32 %1, %1, %3" \
                    : "=&v"(d_), "=&v"(y_), "=&v"(t0_), "=&v"(t1_) \
                    : "v"(sa), "v"(sb), "v"(sc2), "v"(sd), "v"(X##q[0]), "v"(X##q[1]), "v"(X##q[2]), "v"(X##q[3]), "v"(X##r[0]), "v"(X##r[1]), "v"(X##r[2]), "v"(X##r[3])); \
                asm("s_nop 1\n\tv_add_f32_dpp %0, %0, %0 quad_perm:[1,0,3,2] row_mask:0xf bank_mask:0xf bound_ctrl:1\n\ts_nop 1\n\t" \
                    "v_add_f32_dpp %0, %0, %0 quad_perm:[2,3,0,1] row_mask:0xf bank_mask:0xf bound_ctrl:1" : "+v"(y_)); \
                ypart[(st_) * 128 + rl * 4 + (cg >> 2)] = y_;     \
                asm("v_mul_f32 %5, %9, %10\n\tv_mul_f32 %6, %9, %11\n\t" \
                    "v_add_f32_dpp %0, %0, %0 row_ror:8 row_mask:0xf bank_mask:0xf bound_ctrl:1\n\t" \
                    "v_mul_f32 %7, %9, %12\n\tv_mul_f32 %8, %9, %13\n\t" \
                    "v_add_f32_dpp %0, %0, %0 row_ror:4 row_mask:0xf bank_mask:0xf bound_ctrl:1\n\t" \
                    "v_fma_f32 %5, %1, %14, %5\n\tv_fma_f32 %6, %2, %15, %6\n\t" \
                    "v_add_f32_dpp %0, %0, %0 row_ror:2 row_mask:0xf bank_mask:0xf bound_ctrl:1\n\t" \
                    "v_fma_f32 %7, %3, %16, %7\n\tv_fma_f32 %8, %4, %17, %8\n\t" \
                    "v_add_f32_dpp %0, %0, %0 row_ror:1 row_mask:0xf bank_mask:0xf bound_ctrl:1\n\t" \
                    "s_nop 1\n\t" \
                    "v_fma_f32 %1, -%0, %18, %5\n\tv_fma_f32 %2, -%0, %19, %6\n\tv_fma_f32 %3, -%0, %20, %7\n\tv_fma_f32 %4, -%0, %21, %8" \
                    : "+v"(d_), "+v"(sa), "+v"(sb), "+v"(sc2), "+v"(sd), "=&v"(t0_), "=&v"(t1_), "=&v"(t2_), "=&v"(t3_) \
                    : "v"(X##v), "v"(X##k[0]), "v"(X##k[1]), "v"(X##k[2]), "v"(X##k[3]), "v"(X##w[0]), "v"(X##w[1]), "v"(X##w[2]), "v"(X##w[3]), \
                      "v"(X##b[0]), "v"(X##b[1]), "v"(X##b[2]), "v"(X##b[3])); } while (0)
            SC_GLOAD(0); SC_LSTORE(0);
            __syncthreads();
            for (int c = 0; c < SEQ / CH; ++c) {
                const bool more = (c + 1) < SEQ / CH;
                if (c == SEQ / CH - 2 && tid == 0) atomicAdd(ctl + CW_SD + 64 * (l + 2 * li_), 1u);
                if (more) SC_GLOAD(c + 1);
                const LAS float* bb = lds + (c & 1) * BUFF;
                f32x4 Ar, Aw, Ak, Aq, Ab, Br, Bw, Bk, Bq, Bb; float Av, Bv;
                SC_LD(A, 0);
#pragma unroll 1
                for (int st = 0; st < CH; st += 2) {
                    SC_LD(B, st + 1);
                    SC_STEP(A, st);
                    if (st + 2 < CH) SC_LD(A, st + 2);
                    SC_STEP(B, st + 1);
                }
                __syncthreads();
                {
                    const int stp = tid >> 4, r2 = (tid & 15) * 2;
                    const LAS f32x4* pp = (const LAS f32x4*)(ypart + stp * 128 + r2 * 4);
                    const f32x4 a0 = pp[0], a1 = pp[1];
                    if (c * CH + stp > 0) { bf16* yo = Y + base + (size_t)(c * CH + stp - 1) * BW + 32 * half + r2;
                        *(unsigned*)yo = pk2((a0[0] + a0[1]) + (a0[2] + a0[3]), (a1[0] + a1[1]) + (a1[2] + a1[3])); }
                }
                if (more) SC_LSTORE((c + 1) & 1);
                __syncthreads();
            }
            {
                const bf16* pl_ = PROJ + ((size_t)b * SEQ + SEQ - 1) * PLD + (OFF_RWKV - PSH) + h * 64 + 4 * cg;
                const f32x4 rcl = bf4_to_f32(*(const v2u*)pl_), rpl = bf4_to_f32(*(const v2u*)(pl_ - PLD));
                const f32x4 rl4 = rcl + (rpl - rcl) * *(const f32x4*)(rwkv_mu + l * RWKV_COLS + h * 64 + 4 * cg);
                const float yl = row_allsum16((sa * rl4[0] + sb * rl4[1]) + (sc2 * rl4[2] + sd * rl4[3]));
                if (cg == 0) Y[base + (size_t)(SEQ - 1) * BW + irow] = (bf16)f2bf(yl);
            }
#undef SC_GLOAD
#undef SC_LSTORE
#undef SC_LD
#undef SC_STEP
        }
        if (!(mask_live & (1u << 29)))
        for (;;) {
            if (tid == 0) misc[4] = atomicAdd(ctl + CW_AQ + 64 * (l + 2 * li_), 1u);
            __syncthreads();
            const unsigned u = misc[4];
            __syncthreads();
            if (u >= 1024u) break;
            const int qt = 15 - (int)(u >> 6), kind = (u >> 5) & 1, b = (u >> 3) & 3, h = u & 7;
            const size_t r0 = (size_t)b * SEQ;
            if (kind == 0)
                attn_unit<128, true>((LAS unsigned char*)lds_raw, QAB + r0 * BW + h * 128, BW, KAB + r0 * BW + h * 128, BW, VAB + r0 * BW + h * 128, BW,
                                     YALL + r0 * (3 * BW) + h * 128, 3 * BW, SELB + r0 * 8 + h, qt, 0.08838834764831845f * 1.4426950408889634f, tid);
            else
                attn_unit<192, false>((LAS unsigned char*)lds_raw, QCB + r0 * 1536 + h * 192, 1536, KCB + r0 * 1536 + h * 192, 1536, VCB + r0 * BW + h * 128, BW,
                                      YALL + r0 * (3 * BW) + 2 * BW + h * 128, 3 * BW, nullptr, qt, 0.07216878364870323f * 1.4426950408889634f, tid);
        }
        {
            LAS float* scr = (LAS float*)((LAS unsigned char*)lds_raw) + wave * (64 * 33);
            const unsigned ncu = (unsigned)(FFN_CONV_N(l) / 32);
            DQ_RUN(xb_ld(ctl + CW_SD + 64 * (l + 2 * li_)) < 128u && xb_ld(ctl + CW_DQ + 64 * li_) < (unsigned)(l == 0 ? DQ_J3 : DQ_J6));
            for (;;) {
                if (tid == 0) {
                    unsigned u_ = 0xffffffffu;
                    if (xb_ld(ctl + CW_SD + 64 * (l + 2 * li_)) < 128u) u_ = atomicAdd(ctl + CW_CQ + 64 * (l + 2 * li_), 1u);
                    misc[4] = u_;
                }
                __syncthreads();
                const unsigned u = (unsigned)__builtin_amdgcn_readfirstlane((int)misc[4]);
                __syncthreads();
                if (u >= ncu) break;
#pragma unroll 1
                for (int k_ = 0; k_ < 2; ++k_) { const int it = (int)u * 32 + k_ * 16 + 2 * wave; FFN_CONV_PAIR(it); }
            }
            DQ_FLUSH(l == 0 ? DQ_J3 : DQ_J6);
        }
        GRID_BAR();
        {
            const int pc = l * BW + (gt & 255) * 4;
            const f32x4 p_g = *(const f32x4*)(rwkv_gn_g + pc), p_b = *(const f32x4*)(rwkv_gn_b + pc), p_ka = *(const f32x4*)(rwkv_k_a + pc), p_rk = *(const f32x4*)(rwkv_r_k + pc);
            const bf16* pY = Y; const bf16* pA = AA; const float* pV = Vcur; const bf16* pG = GG; bf16* pO = YALL + BW;
            const bf16* pP = PROJ + (OFF_RWKV - PSH) + (gt & 255) * 4;
            const f32x4 p_mr = *(const f32x4*)(rwkv_mu + l * RWKV_COLS + (gt & 255) * 4), p_mk = *(const f32x4*)(rwkv_mu + l * RWKV_COLS + 1024 + (gt & 255) * 4);
            for (int i0 = gt; i0 < T * 16 * 16; i0 += 4 * NGT) {
                f32x4 y[4], aa[4], vv[4], gg[4]; v2u rc[4], rp[4], kc[4], kp[4], yb[4], ab[4], gb[4];
#pragma unroll
                for (int u_ = 0; u_ < 4; ++u_) { const int i = i0 + u_ * NGT, ic = i < T * 256 ? i : gt; const size_t o = (size_t)(ic >> 8) * BW + (ic & 255) * 4;
                    const bf16* pp = pP + (size_t)(ic >> 8) * PLD; const int back = ((ic >> 8) & (SEQ - 1)) > 0 ? PLD : 0;
                    yb[u_] = *(const v2u*)(pY + o); ab[u_] = *(const v2u*)(pA + o); vv[u_] = *(const f32x4*)(pV + o); gb[u_] = *(const v2u*)(pG + o);
                    rc[u_] = *(const v2u*)pp; rp[u_] = *(const v2u*)(pp - back); kc[u_] = *(const v2u*)(pp + 1024); kp[u_] = *(const v2u*)(pp - back + 1024); }
#pragma unroll
                for (int u_ = 0; u_ < 4; ++u_) { const int i = i0 + u_ * NGT;
                    y[u_] = bf4_to_f32(yb[u_]); aa[u_] = bf4_to_f32(ab[u_]); gg[u_] = bf4_to_f32(gb[u_]);
                    f32x4 kr, rr;
                    { const bool first = (((i < T * 256 ? i : gt) >> 8) & (SEQ - 1)) == 0; const f32x4 z4 = {0.f, 0.f, 0.f, 0.f};
                      const f32x4 rcf = bf4_to_f32(rc[u_]), kcf = bf4_to_f32(kc[u_]), rpf = first ? z4 : bf4_to_f32(rp[u_]), kpf = first ? z4 : bf4_to_f32(kp[u_]);
                      rr = rcf + (rpf - rcf) * p_mr; kr = kcf + (kpf - kcf) * p_mk; }
                    const float mu = row_allsum16((y[u_][0] + y[u_][1]) + (y[u_][2] + y[u_][3])) * (1.0f / 64.0f);
                    const f32x4 d = y[u_] - mu;
                    const float var = row_allsum16((d[0] * d[0] + d[1] * d[1]) + (d[2] * d[2] + d[3] * d[3])) * (1.0f / 64.0f);
                    const f32x4 yn = d * rsqrtf(var + 64e-5f) * p_g + p_b;
                    const f32x4 k2 = kr * (1.0f + (aa[u_] - 1.0f) * p_ka);
                    const f32x4 rk = rr * k2 * p_rk;
                    const float bon = row_allsum16((rk[0] + rk[1]) + (rk[2] + rk[3]));
                    const f32x4 o4 = (yn + bon * vv[u_]) * gg[u_];
                    v2u ob; ob.x = pk2(o4[0], o4[1]); ob.y = pk2(o4[2], o4[3]);
                    if (i < T * 256) *(v2u*)(pO + (size_t)(i >> 8) * (3 * BW) + (i & 255) * 4) = ob;
                }
            }
        }
        GRID_BAR();
        }
        if (RUN(4)) {
        {
            SegOrder S; S.base.init(T, D, G_live, (int)blockIdx.x);
            pg8::Gemm g{YALL, WBO + (size_t)l * D * 3 * BW, T, D, BW + zero_live, 3 * BW}; EpiBranch3 E{MIXB, GATEB};
            pg8::gemm_phase<EpiBranch3, SegOrder, false>((LAS unsigned char*)lds_raw, g, S, E, nullptr, tid);
        }
        GRID_BAR();
        }
        if (RUN(5)) {
        {
            pg8::Gemm g{MIXB, WOT + (size_t)l * D * D, T, D, D}; pg8::StaticOrder S; S.init(T, D, G_live, (int)blockIdx.x);
            EpiResidF32 E{PRE, X};
            pg8::gemm_phase<EpiResidF32, pg8::StaticOrder, false>((LAS unsigned char*)lds_raw, g, S, E, nullptr, tid);
        }
        GRID_BAR();
        }
        if (RUN(6)) {
        {
            LAS float* scr = (LAS float*)((LAS unsigned char*)lds_raw) + wave * (64 * 33);
            const int ntot = FFN_CONV_N(l);
            const int ndone = (int)min(xb_ld(ctl + CW_CQ + 64 * (l + 2 * li_)), (unsigned)(ntot / 32)) * 32;
            for (int it = ndone + 2 * gw; it < ntot; it += 2 * NGW) FFN_CONV_PAIR(it);
            if (l == 1) DQ_FLUSH(DQ_J7);
        }
        for (int t = gw; t < T; t += NGW) {
            const float* pr = PRE + (size_t)t * D;
            f32x4 v[8]; float s = 0.f;
#pragma unroll
            for (int jj = 0; jj < 8; ++jj) { v[jj] = *(const f32x4*)(pr + jj * 256 + lane * 4); s += (v[jj][0] + v[jj][1]) + (v[jj][2] + v[jj][3]); }
            const float mean = wave_sum(s, lane) * (1.0f / D); float s2 = 0.f;
#pragma unroll
            for (int jj = 0; jj < 8; ++jj) { v[jj] = v[jj] - mean; s2 += (v[jj][0] * v[jj][0] + v[jj][1] * v[jj][1]) + (v[jj][2] * v[jj][2] + v[jj][3] * v[jj][3]); }
            const float rstd = rsqrtf(wave_sum(s2, lane) * (1.0f / D) + 1e-5f);
#pragma unroll
            for (int jj = 0; jj < 8; ++jj) {
                const f32x4 g = *(const f32x4*)(ln1_g + l * D + jj * 256 + lane * 4), bb = *(const f32x4*)(ln1_b + l * D + jj * 256 + lane * 4);
                v[jj] = v[jj] * rstd * g + bb;
                *(f32x4*)(X1 + (size_t)t * D + jj * 256 + lane * 4) = v[jj];
                v2u ob; ob.x = pk2(v[jj][0], v[jj][1]); ob.y = pk2(v[jj][2], v[jj][3]); *(v2u*)(X1B + (size_t)t * D + jj * 256 + lane * 4) = ob;
            }
            if (l == 1) {
                float lg[8];
#pragma unroll
                for (int e = 0; e < 8; ++e) lg[e] = 0.f;
#pragma unroll
                for (int jj = 0; jj < 8; ++jj)
#pragma unroll
                    for (int cc = 0; cc < 4; ++cc) {
                        const int d = jj * 256 + lane * 4 + cc;
                        const f32x4 r0 = *(const f32x4*)(moe_router + (size_t)d * 8), r1 = *(const f32x4*)(moe_router + (size_t)d * 8 + 4);
                        const float xv = v[jj][cc];
                        lg[0] += xv * r0[0]; lg[1] += xv * r0[1]; lg[2] += xv * r0[2]; lg[3] += xv * r0[3];
                        lg[4] += xv * r1[0]; lg[5] += xv * r1[1]; lg[6] += xv * r1[2]; lg[7] += xv * r1[3];
                    }
#pragma unroll
                for (int e = 0; e < 8; ++e) lg[e] = wave_sum(lg[e], lane);
                if (lane == 0) {
                    int e0 = 0; float b0 = lg[0];
#pragma unroll
                    for (int e = 1; e < 8; ++e) if (lg[e] > b0) { b0 = lg[e]; e0 = e; }
                    int e1 = -1; float b1 = -INFINITY;
#pragma unroll
                    for (int e = 0; e < 8; ++e) if (e != e0 && lg[e] > b1) { b1 = lg[e]; e1 = e; }
                    const float w1 = 1.0f / (1.0f + expf(b0 - b1)), w0 = 1.0f - w1;
                    const int p0 = (int)atomicAdd(ctl + CW_CNT + 64 * e0, 1u), p1 = (int)atomicAdd(ctl + CW_CNT + 64 * e1, 1u);
                    int* tk = TOK + (size_t)t * 8;
                    tk[0] = e0; tk[1] = e1; tk[2] = p0; tk[3] = p1; tk[4] = __float_as_int(w0); tk[5] = __float_as_int(w1);
                }
            }
        }
        GRID_BAR();
        }
        float* OUTX = (l == 0) ? XB : (float*)(*(GAS float* const*)&args.out);
        if (l == 0) {
            if (RUN(7)) {
                pg8::Gemm g{X1B, WGU, T, NGU, D}; pg8::StaticOrder S; S.init(T, NGU, G_live, (int)blockIdx.x);
                EpiSwigluBf16 E{HGB, NGU / 256};
                pg8::gemm_phase<EpiSwigluBf16, pg8::StaticOrder, false>((LAS unsigned char*)lds_raw, g, S, E, nullptr, tid);
                REOPAQUE();
                {
                    LAS float* scr = (LAS float*)((LAS unsigned char*)lds_raw) + wave * (64 * 33);
                    PHASE_DONE(1);
                    DQ_FILL(1, 129);
                }
                GRID_BAR();
            }
            if (RUN(8)) {
                pg8::Gemm g{HGB, WDD, T, D, DFF}; pg8::StaticOrder S; S.init(T, D, G_live, (int)blockIdx.x);
                EpiResidF32 E{PRE, X1};
                pg8::gemm_phase<EpiResidF32, pg8::StaticOrder, false>((LAS unsigned char*)lds_raw, g, S, E, nullptr, tid);
                GRID_BAR();
            }
        } else {
            if (RUN(10)) {
            unsigned poff[9]; poff[0] = 0;
#pragma unroll
            for (int e = 0; e < 8; ++e) poff[e + 1] = poff[e] + ((xb_ld(ctl + CW_CNT + 64 * e) + 255u) & ~255u);
            for (int t = gw; t < T; t += NGW) {
                int* tk = TOK + (size_t)t * 8;
                const int e0 = tk[0], e1 = tk[1];
                unsigned o0 = 0, o1 = 0;
#pragma unroll
                for (int e = 0; e < 8; ++e) { o0 = (e == e0) ? poff[e] : o0; o1 = (e == e1) ? poff[e] : o1; }
                const int s0 = (int)o0 + tk[2], s1 = (int)o1 + tk[3];
                if (lane == 0) { tk[6] = s0; tk[7] = s1; }
#pragma unroll
                for (int j = 0; j < 4; ++j) { const v4u xv = *(const v4u*)(X1B + (size_t)t * D + j * 512 + lane * 8);
                    *(v4u*)(XG + (size_t)s0 * D + j * 512 + lane * 8) = xv; *(v4u*)(XG + (size_t)s1 * D + j * 512 + lane * 8) = xv; }
            }
            if (blockIdx.x == 0 && tid < 80) {
                unsigned e_of = 0; const unsigned mt = tid;
#pragma unroll
                for (int e = 1; e < 8; ++e) e_of += (mt * 256u >= poff[e]) ? 1u : 0u;
                ctl[CW_TILE + tid] = e_of;
                if (tid == 0) ctl[CW_TILE - 1] = poff[8] / 256u;
            }
            {
                const unsigned nmt_ = poff[8] / 256u, nfull_ = (nmt_ / 32u) * 32u; const size_t z0 = (size_t)nfull_ * 256 * D / 4, z1 = (size_t)nmt_ * 256 * D / 4;
                for (size_t i = z0 + gt; i < z1; i += NGT) *(f32x4*)(OUT + i * 4) = (f32x4){0.f, 0.f, 0.f, 0.f};
            }
            GRID_BAR();
            }
            const int nMt = (int)ctl[CW_TILE - 1];
            if (RUN(7)) {
                pg8::Gemm g{XG, WGU, MOE_ROWS, NGU, D}; MoeOrder S{ctl + CW_TILE, nMt, NGU / 256, G_live, (int)blockIdx.x};
                EpiSwigluBf16 E{HGB, NGU / 256};
                pg8::gemm_phase<EpiSwigluBf16, MoeOrder, false>((LAS unsigned char*)lds_raw, g, S, E, nullptr, tid);
                REOPAQUE();
                {
                    LAS float* scr = (LAS float*)((LAS unsigned char*)lds_raw) + wave * (64 * 33);
                    const int rem_ = ((int)ctl[CW_TILE - 1] * (NGU / 256)) % G_live;
                    PHASE_DONE(5);
                    DQ_FILL(5, (rem_ ? G_live - rem_ : 0) + 1);
                    DQ_FLUSH(DQ_N);
                }
                GRID_BAR();
            }
            if (RUN(8)) {
                const int nFull = (nMt / 32) * 32;
                { pg8::Gemm g{HGB, WD, MOE_ROWS, D, DFF}; MoeOrder S{ctl + CW_TILE, nFull, D / 256, G_live, (int)blockIdx.x};
                  EpiStoreF32 E{OUT, D / 256};
                  pg8::gemm_phase<EpiStoreF32, MoeOrder, false>((LAS unsigned char*)lds_raw, g, S, E, nullptr, tid); }
                REOPAQUE();
                { pg8::Gemm g{HGB, WD, MOE_ROWS, D, DFF / 4 + zero_live, DFF}; MoeOrder S{ctl + CW_TILE, nMt - nFull, D / 256, G_live, (int)blockIdx.x, nFull, 4, (DFF / 4) * 2};
                  EpiAtomicF32 E{OUT, D / 256};
                  pg8::gemm_phase<EpiAtomicF32, MoeOrder, false>((LAS unsigned char*)lds_raw, g, S, E, nullptr, tid); }
                GRID_BAR();
            }
        }
        if (RUN(9)) {
        if (l == 0) { LAS float* scr = (LAS float*)((LAS unsigned char*)lds_raw) + wave * (64 * 33); DQ_FLUSH(DQ_J4); }
        for (int t = gw; t < T; t += NGW) {
            f32x4 v[8]; float s = 0.f;
            if (l == 0) {
#pragma unroll
                for (int jj = 0; jj < 8; ++jj) v[jj] = *(const f32x4*)(PRE + (size_t)t * D + jj * 256 + lane * 4);
            } else {
                const int* tk = TOK + (size_t)t * 8;
                const float w0 = __int_as_float(tk[4]), w1 = __int_as_float(tk[5]); const int s0 = tk[6], s1 = tk[7];
                const int e0 = tk[0], e1 = tk[1];
#pragma unroll
                for (int jj = 0; jj < 8; ++jj) {
                    const f32x4 xx = *(const f32x4*)(X1 + (size_t)t * D + jj * 256 + lane * 4);
                    const f32x4 a = *(const f32x4*)(OUT + (size_t)s0 * D + jj * 256 + lane * 4), bq = *(const f32x4*)(OUT + (size_t)s1 * D + jj * 256 + lane * 4);
                    const f32x4 f = (e0 < e1) ? (w0 * a + w1 * bq) : (w1 * bq + w0 * a);
                    v[jj] = ALPHA * xx + f;
                }
            }
#pragma unroll
            for (int jj = 0; jj < 8; ++jj) s += (v[jj][0] + v[jj][1]) + (v[jj][2] + v[jj][3]);
            const float mean = wave_sum(s, lane) * (1.0f / D); float s2 = 0.f;
#pragma unroll
            for (int jj = 0; jj < 8; ++jj) { v[jj] = v[jj] - mean; s2 += (v[jj][0] * v[jj][0] + v[jj][1] * v[jj][1]) + (v[jj][2] * v[jj][2] + v[jj][3] * v[jj][3]); }
            const float rstd = rsqrtf(wave_sum(s2, lane) * (1.0f / D) + 1e-5f);
#pragma unroll
            for (int jj = 0; jj < 8; ++jj) {
                const f32x4 g = *(const f32x4*)(ln2_g + l * D + jj * 256 + lane * 4), bb = *(const f32x4*)(ln2_b + l * D + jj * 256 + lane * 4);
                const f32x4 o = v[jj] * rstd * g + bb;
                *(f32x4*)(OUTX + (size_t)t * D + jj * 256 + lane * 4) = o;
                if (l == 0) { v2u ob; ob.x = pk2(o[0], o[1]); ob.y = pk2(o[2], o[3]); *(v2u*)(XBF + (size_t)t * D + jj * 256 + lane * 4) = ob; }
            }
        }
        GRID_BAR();
        }
    }
}

extern "C" void kernel_launch(void* const* d_in, const int* in_sizes, int n_in, void* d_out, int out_size, void* d_ws, size_t ws_size, hipStream_t stream) {
    static int grid = 0;
    if (grid == 0) {
        if (n_in != 34 || out_size != T * D || ws_size < WS_END) { fprintf(stderr, "kernel_launch: bad sizes n_in %d out %d ws %zu need %zu\n", n_in, out_size, ws_size, (size_t)WS_END); grid = -1; return; }
        int dev = 0, cus = 0, per_cu = 0;
        if (hipGetDevice(&dev) != hipSuccess || hipDeviceGetAttribute(&cus, hipDeviceAttributeMultiprocessorCount, dev) != hipSuccess) { grid = -1; return; }
        if (hipFuncSetAttribute((const void*)fwd_kernel, hipFuncAttributeMaxDynamicSharedMemorySize, LDS_BYTES) != hipSuccess) { fprintf(stderr, "hipFuncSetAttribute failed\n"); grid = -1; return; }
        if (hipOccupancyMaxActiveBlocksPerMultiprocessor(&per_cu, (const void*)fwd_kernel, NTHREADS, LDS_BYTES) != hipSuccess || per_cu < 1) fprintf(stderr, "occupancy query says %d\n", per_cu);
        (void)hipGetLastError();
        grid = cus;
    }
    if (grid < 0) return;
    hipMemsetAsync((char*)d_ws + WS_CTL, 0, CTL_BYTES, stream);
    Args a{};
    for (int i = 0; i < 34; ++i) a.in[i] = (const float*)d_in[i];
    a.out = (float*)d_out; a.ws = (unsigned char*)d_ws; a.mask = 0x9FFFFFFFu; a.li = 0;
    hipLaunchKernelGGL(fwd_kernel, dim3(grid), dim3(NTHREADS), LDS_BYTES, stream, a);
#ifdef PROBE_MASK
    a.mask = PROBE_MASK; a.li = 1;
    hipLaunchKernelGGL(fwd_kernel, dim3(grid), dim3(NTHREADS), LDS_BYTES, stream, a);
#endif
}
```

```cpp
#include <hip/hip_runtime.h>
#include <stdint.h>
#include <stdio.h>

constexpr int D = 2048, NBATCH = 4, SEQ = 2048, T = NBATCH * SEQ;
constexpr int BW = 1024;
constexpr int IN_COLS = 13664;
constexpr int OFF_RWKV = 3072, OFF_MLA = 6432, OFF_GATE = 7520;
constexpr int RWKV_COLS = 3360;
constexpr int DFF = 5632, NEXP = 8;
constexpr float ALPHA = 1.41421356237f;
constexpr int NTHREADS = 512, NWAVES = 8;
constexpr int LDS_BYTES = 131072 + 17408 + 512;

#define LAS __attribute__((address_space(3)))
#define GAS __attribute__((address_space(1)))
typedef float f32x16 __attribute__((ext_vector_type(16)));
typedef float f32x4 __attribute__((ext_vector_type(4)));

constexpr size_t MiB = 1u << 20;
constexpr size_t al(size_t x) { return (x + 255) & ~(size_t)255; }
constexpr size_t WS_CTL = 0, CTL_BYTES = 1 * MiB;
constexpr size_t WS_COSA = 1 * MiB;
constexpr size_t WS_SINA = WS_COSA + 2048 * 64 * 4;
constexpr size_t WS_COSM = WS_SINA + 2048 * 64 * 4;
constexpr size_t WS_SINM = WS_COSM + 2048 * 32 * 4;
constexpr size_t WS_TOK = 3 * MiB;
constexpr size_t WS_ROWL = WS_TOK + (size_t)T * 8 * 4;
constexpr size_t WS_XB = 4 * MiB;
constexpr size_t WS_X1 = WS_XB + (size_t)T * D * 4;
constexpr size_t WS_PRE = WS_X1 + (size_t)T * D * 4;
constexpr int NP = 13824;
constexpr size_t WS_XBF = WS_PRE + (size_t)T * D * 4;
constexpr size_t WS_WINT = WS_XBF + (size_t)T * D * 2;
constexpr size_t WS_X1B = WS_WINT + (size_t)2 * NP * D * 2;
constexpr size_t WS_WBO = WS_X1B + (size_t)T * D * 2;
constexpr size_t WS_WOT = WS_WBO + (size_t)6 * D * BW * 2;
constexpr size_t WS_WUQ = WS_WOT + (size_t)2 * D * D * 2;
constexpr size_t WS_WUKV = WS_WUQ + (size_t)2 * 1536 * 512 * 2;
constexpr size_t WS_WLORA = WS_WUKV + (size_t)2 * 2048 * 512 * 2;
constexpr size_t WS_V0 = WS_WLORA + (size_t)2 * 4096 * 384 * 2;
constexpr size_t WS_MIXER = WS_V0 + (size_t)T * BW * 4;
constexpr int MOE_ROWS = 2 * T + NEXP * 256;
constexpr int NGU = 2 * DFF;
constexpr int PLD = 4448, PSH = 3072;
constexpr size_t WS_PROJ = WS_MIXER;
constexpr size_t WS_V1 = al(WS_PROJ + (size_t)T * PLD * 2);
constexpr size_t WS_DEC = WS_V1 + (size_t)T * BW * 4;
constexpr size_t WS_AA = WS_DEC + (size_t)T * BW * 4;
constexpr size_t WS_GG = WS_AA + (size_t)T * BW * 4;
constexpr size_t WS_Y = WS_GG + (size_t)T * BW * 4;
constexpr size_t WS_LA = WS_Y + (size_t)T * BW * 4;
constexpr size_t WS_QNB = WS_LA + (size_t)T * 384 * 2;
constexpr size_t WS_KVNB = WS_QNB + (size_t)T * 512 * 2;
constexpr size_t WS_YALL = WS_KVNB + (size_t)T * 512 * 2;
constexpr size_t WS_GATEB = WS_YALL + (size_t)T * 3 * BW * 2;
constexpr size_t WS_QAB = WS_GATEB + (size_t)T * 3 * D * 2;
constexpr size_t WS_KAB = WS_QAB + (size_t)T * BW * 2;
constexpr size_t WS_VAB = WS_KAB + (size_t)T * BW * 2;
constexpr size_t WS_QCB = WS_VAB + (size_t)T * BW * 2;
constexpr size_t WS_KCB = WS_QCB + (size_t)T * 1536 * 2;
constexpr size_t WS_VCB = WS_KCB + (size_t)T * 1536 * 2;
constexpr size_t WS_MIXB = WS_VCB + (size_t)T * BW * 2;
constexpr size_t WS_L_END = WS_MIXB + (size_t)T * D * 2;
constexpr size_t WS_HGB = WS_MIXER;
constexpr size_t WS_XG = WS_HGB + (size_t)MOE_ROWS * DFF * 2;
constexpr size_t WS_OUT = WS_XG + (size_t)MOE_ROWS * D * 2;
static_assert(WS_OUT + (size_t)MOE_ROWS * D * 4 <= WS_L_END, "FFN activations must stay inside region L");
constexpr size_t WS_WGU = WS_L_END;
constexpr size_t WS_VRES = WS_WGU;
constexpr size_t WS_QF = al(WS_VRES + (size_t)T * 32 * 4);
static_assert(WS_QF + (size_t)T * BW * 4 <= WS_WGU + (size_t)4 * NGU * D * 2, "region P must end inside WGU[0..3]");
constexpr size_t WS_WD = WS_WGU + (size_t)NEXP * NGU * D * 2;
constexpr size_t WS_WDD = WS_WGU + (size_t)NGU * D * 2;
constexpr size_t WS_END = WS_WD + (size_t)NEXP * D * DFF * 2;
constexpr size_t WS_KMEAN = WS_TOK + 512 * 1024;
constexpr size_t WS_SEL = WS_TOK + 768 * 1024;

static_assert(WS_END <= (size_t)1560 * MiB, "ws budget");
constexpr int CW_CNT = 1024;
constexpr int CW_OFF = 2048;
constexpr int CW_AQ = 3072;
constexpr int CW_CQ = 3328;
constexpr int CW_SD = 3584;
constexpr int CQ_ITEMS = 16;
constexpr int CW_DQ = 12288;
constexpr int CW_PD = 12544;
constexpr int DQ_J3 = 5120, DQ_J4 = 18944, DQ_J5 = 20608, DQ_J6 = 25728, DQ_J7 = DQ_J6 + 4 * 11264, DQ_N = DQ_J7 + 8 * 5632;
constexpr int CW_TILE = 2304;
constexpr int CW_BAR = 4096;

#define XB_TMO      128
#define XB_XCNT(j)  (256  + 64 * (j))
#define XB_XSUB(j)  (1280 + 64 * (j))
#define XB_XGEN(j)  (2304 + 64 * (j))
#define XB_TOP      3328
#define XB_TOPGEN   3392
#define XCD_BAR_WORDS 3456
#define XB_SPIN_CAP (1u << 22)

__device__ __forceinline__ unsigned xb_ld(unsigned* p)              { return __hip_atomic_load(p, __ATOMIC_RELAXED, __HIP_MEMORY_SCOPE_AGENT); }
__device__ __forceinline__ unsigned xb_add(unsigned* p, unsigned v) { return __hip_atomic_fetch_add(p, v, __ATOMIC_RELAXED, __HIP_MEMORY_SCOPE_AGENT); }
__device__ __forceinline__ unsigned xb_xcc_id() { return (unsigned)__builtin_amdgcn_s_getreg((3 << 11) | 20) & 0xFu; }
#define XB_SPIN(cond, bar) do { unsigned _sp = 0; while (cond) { __builtin_amdgcn_s_sleep(1); \
    if ((++_sp & 255u) == 0u) { if (xb_ld(&(bar)[XB_TMO])) break; if (_sp > XB_SPIN_CAP) { atomicAdd(&(bar)[XB_TMO], 1u); break; } } } } while (0)

struct XcdBarrier { unsigned* bar; unsigned x; volatile LAS unsigned* st; };

__device__ __forceinline__ XcdBarrier xcd_barrier_post(unsigned* bar, volatile LAS unsigned* st, const int tid0) {
    XcdBarrier b; b.bar = bar; b.x = xb_xcc_id(); b.st = st;
    if (tid0 == 0) (void)xb_add(&bar[XB_XCNT(b.x)], 1u);
    return b;
}
__device__ __forceinline__ void xcd_barrier_complete(unsigned* bar, unsigned x, unsigned& nloc, unsigned& nx) {
    const unsigned G = gridDim.x * gridDim.y * gridDim.z;
    unsigned sum, cnt, mine, sp = 0u;
    for (;;) {
        sum = 0u; cnt = 0u; mine = 0u;
#pragma unroll
        for (unsigned j = 0; j < 16; ++j) { const unsigned c = xb_ld(&bar[XB_XCNT(j)]); sum += c; cnt += (c > 0u) ? 1u : 0u; mine = (j == x) ? c : mine; }
        if (sum == G) break;
        __builtin_amdgcn_s_sleep(1);
        if ((++sp & 255u) == 0u) { if (xb_ld(&bar[XB_TMO])) break; if (sp > XB_SPIN_CAP) { atomicAdd(&bar[XB_TMO], 1u); break; } }
    }
    nloc = mine > 0u ? mine : 1u; nx = cnt > 0u ? cnt : 1u;
}
__device__ __forceinline__ void xcd_barrier(const XcdBarrier& b, const int tid0) {
    asm volatile("s_waitcnt vmcnt(0)" ::: "memory");
    __syncthreads();
    if (tid0 == 0) {
        unsigned* bar = b.bar;
        __builtin_amdgcn_s_waitcnt(0);
        unsigned nloc = b.st[0], nx = b.st[1];
        if (nloc == 0u) { xcd_barrier_complete(bar, b.x, nloc, nx); b.st[0] = nloc; b.st[1] = nx; }
        const unsigned old = xb_add(&bar[XB_XSUB(b.x)], 1u);
        const unsigned gen = old / nloc;
        if (old + 1u == (gen + 1u) * nloc) {
            __builtin_amdgcn_fence(__ATOMIC_RELEASE, "agent");
            asm volatile("s_waitcnt vmcnt(0)" ::: "memory");
            const unsigned og = xb_add(&bar[XB_TOP], 1u);
            const unsigned tg = og / nx;
            if (og + 1u == (tg + 1u) * nx) xb_add(&bar[XB_TOPGEN], 1u);
            else XB_SPIN(xb_ld(&bar[XB_TOPGEN]) == tg, bar);
            __builtin_amdgcn_fence(__ATOMIC_ACQUIRE, "agent");
            xb_add(&bar[XB_XGEN(b.x)], 1u);
            asm volatile("s_waitcnt vmcnt(0)" ::: "memory");
        } else {
            XB_SPIN(xb_ld(&bar[XB_XGEN(b.x)]) == gen, bar);
            __builtin_amdgcn_fence(__ATOMIC_ACQUIRE, "agent");
            asm volatile("s_waitcnt vmcnt(0)" ::: "memory");
        }
    }
    __syncthreads();
}

__device__ __forceinline__ float shfl_xor_(float v, int mask, int ln) { return __builtin_bit_cast(float, __builtin_amdgcn_ds_bpermute((ln ^ mask) << 2, __builtin_bit_cast(int, v))); }
__device__ __forceinline__ float wave_sum(float v, int ln) {
    v += __builtin_bit_cast(float, __builtin_amdgcn_update_dpp(0, __builtin_bit_cast(int, v), 0x128, 0xf, 0xf, false));
    v += __builtin_bit_cast(float, __builtin_amdgcn_update_dpp(0, __builtin_bit_cast(int, v), 0x124, 0xf, 0xf, false));
    v += __builtin_bit_cast(float, __builtin_amdgcn_update_dpp(0, __builtin_bit_cast(int, v), 0x122, 0xf, 0xf, false));
    v += __builtin_bit_cast(float, __builtin_amdgcn_update_dpp(0, __builtin_bit_cast(int, v), 0x121, 0xf, 0xf, false));
    v += shfl_xor_(v, 16, ln); v += shfl_xor_(v, 32, ln);
    return v;
}
__device__ __forceinline__ float sigmoidf_(float x) { return 1.0f / (1.0f + expf(-x)); }

namespace pg8 {
#define PG8_LAS __attribute__((address_space(3)))
typedef unsigned short bf16_t;
typedef short bf16x8 __attribute__((ext_vector_type(8)));
typedef float f32x4 __attribute__((ext_vector_type(4)));
typedef unsigned u32x4 __attribute__((ext_vector_type(4)));
constexpr int BM = 256, BK = 64, HALF = 128, HTB = HALF * BK * 2  , STAGE_BYTES = 8 * HTB, NXCD = 8, WGM = 8;

__host__ __device__ __forceinline__ int lds_byte(int r, int c) { const int st = (r >> 4) * 2 + (c >> 5), rr = r & 15, cc = c & 31, ob = rr * 64 + cc * 2; return st * 1024 + (ob ^ (((ob >> 9) & 1) << 5)); }
__host__ __device__ __forceinline__ void stage_rc(int b, int& R, int& C) { const int st = b / 1024, sb = b % 1024, swz = sb ^ (((sb >> 9) & 1) << 5); R = (st >> 1) * 16 + swz / 64; C = (st & 1) * 32 + (swz % 64) / 2; }
__host__ __device__ __forceinline__ int perm32(int rho) { const int n = rho >> 4, i = rho & 15; return 8 * (i >> 2) + 4 * n + (i & 3); }

struct Unit { int pm, pn; int ko = 0; int fin = 1; };
struct Gemm { const bf16_t* A; const bf16_t* Bt; int M, N, K; int ld = 0; };

template <class E, class = void> struct epi_rot2 { static constexpr bool value = false; };
template <class E> struct epi_rot2<E, decltype((void)E::ROT2)> { static constexpr bool value = E::ROT2; };
struct StaticOrder {
    int nM, nN, nwg, G, c;
    __host__ __device__ void init(int M, int N, int G_, int c_) { nM = M / BM; nN = N / BM; nwg = nM * nN; G = G_; c = c_; }
    __host__ __device__ bool next(int i, Unit& u) const {
        const long L = (long)i * G + c; if (L >= nwg) return false;
        int wgid = (int)L; { const int q = nwg / NXCD, r = nwg % NXCD, xcd = wgid % NXCD, off = wgid / NXCD; wgid = (xcd < r ? xcd * (q + 1) : r * (q + 1) + (xcd - r) * q) + off; }
        const int nig = WGM * nN, gid = wgid / nig, fm = gid * WGM, gsz = (nM - fm) < WGM ? (nM - fm) : WGM;
        u.pm = fm + ((wgid % nig) % gsz); u.pn = (wgid % nig) / gsz; return true;
    }
    __device__ __forceinline__ void a_ready(const Unit&) const {}
    __device__ __forceinline__ void done(const Unit&) const {}
};
__device__ __forceinline__ unsigned cvt_pk_bf16(float lo, float hi) { unsigned r; asm volatile("v_cvt_pk_bf16_f32 %0, %1, %2" : "=v"(r) : "v"(lo), "v"(hi)); return r; }
typedef float f32x2 __attribute__((ext_vector_type(2)));
template <class Epi, class Sched, bool STAMP = false>
__device__ __forceinline__ void gemm_phase(PG8_LAS unsigned char* lds, const Gemm g, const Sched& S, const Epi& E, unsigned long long* stamps, const int tid) {
    const int wid = __builtin_amdgcn_readfirstlane(tid >> 6), lane = tid & 63, wr = wid >> 2, wc = wid & 3, fr = lane & 15, fq = lane >> 4;
    const int K = g.K, nt = K / BK, LD = g.ld ? g.ld : g.K;
    int ts_lo = 0, ts_hi = 0, nts = 0; const unsigned long long rt_entry = STAMP ? (unsigned long long)wall_clock64() : 0ull;
#define PG8_STAMP() do { if (STAMP && wid == 0 && nts < 64) { const unsigned long long _c = (unsigned long long)clock64(); \
        ts_lo = (lane == nts) ? (int)(unsigned)_c : ts_lo; ts_hi = (lane == nts) ? (int)(unsigned)(_c >> 32) : ts_hi; ++nts; } } while (0)
    PG8_STAMP();
    unsigned voffA[2], voffB[2];
#pragma unroll
    for (int i = 0; i < 2; ++i) { int R, C; stage_rc(tid * 16 + i * 8192, R, C); const int Rb = Epi::PERM ? ((R & ~31) + perm32(R & 31)) : R;
        voffA[i] = (unsigned)(R * LD + C) * 2u; voffB[i] = (unsigned)(Rb * LD + C) * 2u; }
    const size_t kstep = (size_t)(BK * 2);
    const size_t hstep = (size_t)HALF * LD * 2;
    const size_t tstep = 2 * hstep;
    const unsigned ldsw = (unsigned)wid * 1024u;
    const int aoff = lds_byte(wr * 64 + fr, fq * 8), boff = lds_byte(wc * 32 + fr, fq * 8);
#define PG8_SA(b, h) (((b) * 2 + (h)) * HTB)
#define PG8_SB(b, h) ((4 + (b) * 2 + (h)) * HTB)
#define PG8_STAGE(bufoff, gbase, voff) do { _Pragma("unroll") for (int _i = 0; _i < 2; ++_i) \
        __builtin_amdgcn_global_load_lds((const unsigned*)((const char*)(gbase) + (voff)[_i]), (PG8_LAS unsigned*)(lds + (bufoff) + ldsw + _i * 8192), 16, 0, 0); } while (0)
#define PG8_LDA(dst, b, h) do { _Pragma("unroll") for (int m = 0; m < 4; ++m) _Pragma("unroll") for (int k = 0; k < 2; ++k) dst[m][k] = *(const PG8_LAS bf16x8*)(lds + PG8_SA(b, h) + aoff + m * 2048 + k * 1024); } while (0)
#define PG8_LDB(dst, b, h) do { _Pragma("unroll") for (int n = 0; n < 2; ++n) _Pragma("unroll") for (int k = 0; k < 2; ++k) dst[n][k] = *(const PG8_LAS bf16x8*)(lds + PG8_SB(b, h) + boff + n * 2048 + k * 1024); } while (0)
#define PG8_MMA(ai, bj, At, Bt) do { __builtin_amdgcn_s_setprio(1); _Pragma("unroll") for (int m = 0; m < 4; ++m) _Pragma("unroll") for (int n = 0; n < 2; ++n) _Pragma("unroll") for (int k = 0; k < 2; ++k) \
        acc[ai][bj][m][n] = __builtin_amdgcn_mfma_f32_16x16x32_bf16(Bt[n][k], At[m][k], acc[ai][bj][m][n], 0, 0, 0); __builtin_amdgcn_s_setprio(0); } while (0)
#define PG8_WAIT_V(n) asm volatile("s_waitcnt vmcnt(" #n ")" ::: "memory")
#define PG8_WAIT_L(n) asm volatile("s_waitcnt lgkmcnt(" #n ")" ::: "memory")
#define PG8_BAR __builtin_amdgcn_s_barrier()
#define PG8_SCHED __builtin_amdgcn_sched_barrier(0)
    Unit cur, nxt; int ui = 0;
    if (!S.next(0, cur)) return;
    f32x4 acc[2][2][4][2];
#pragma unroll
    for (int a = 0; a < 2; ++a)
#pragma unroll
        for (int b = 0; b < 2; ++b)
#pragma unroll
            for (int m = 0; m < 4; ++m)
#pragma unroll
                for (int n = 0; n < 2; ++n) acc[a][b][m][n] = (f32x4){0.f, 0.f, 0.f, 0.f};
    bf16x8 At[4][2], B0[2][2], B1[2][2];
    {
        const bf16x8 z8 = {0, 0, 0, 0, 0, 0, 0, 0};
#pragma unroll
        for (int m = 0; m < 4; ++m) { At[m][0] = z8; At[m][1] = z8; }
#pragma unroll
        for (int n = 0; n < 2; ++n) { B0[n][0] = z8; B0[n][1] = z8; B1[n][0] = z8; B1[n][1] = z8; }
    }
    const char* cA = (const char*)g.A + (size_t)cur.pm * tstep + cur.ko; const char* cB = (const char*)g.Bt + (size_t)cur.pn * tstep + cur.ko;
    S.a_ready(cur);
    PG8_STAGE(PG8_SB(0, 0), cB, voffB); PG8_STAGE(PG8_SA(0, 0), cA, voffA); PG8_STAGE(PG8_SB(0, 1), cB + hstep, voffB); PG8_STAGE(PG8_SA(0, 1), cA + hstep, voffA);
    if (wr == 1) PG8_BAR;
    PG8_WAIT_V(4); PG8_BAR;
    PG8_STAGE(PG8_SB(1, 0), cB + kstep, voffB); PG8_STAGE(PG8_SA(1, 0), cA + kstep, voffA); PG8_STAGE(PG8_SB(1, 1), cB + hstep + kstep, voffB);
    PG8_WAIT_V(6); PG8_BAR;
    PG8_STAMP();
    for (;;) {
        const bool has_next = S.next(ui + 1, nxt);
        const char* nA = has_next ? (const char*)g.A + (size_t)nxt.pm * tstep + nxt.ko : cA; const char* nB = has_next ? (const char*)g.Bt + (size_t)nxt.pn * tstep + nxt.ko : cB;
        for (int t = 0; t < nt; t += 2) {
            const bool last = (t == nt - 2);
            const char* a1 = cA + (size_t)(t + 1) * kstep;
            const char* a2 = last ? nA : cA + (size_t)(t + 2) * kstep; const char* b2 = last ? nB : cB + (size_t)(t + 2) * kstep;
            const char* a3 = a2 + kstep; const char* b3 = b2 + kstep;
            if (last && has_next) S.a_ready(nxt);
            PG8_LDB(B0, 0, 0); PG8_SCHED; PG8_LDA(At, 0, 0); PG8_STAGE(PG8_SA(1, 1), a1 + hstep, voffA);
            PG8_WAIT_L(8); PG8_BAR; PG8_WAIT_L(0); PG8_MMA(0, 0, At, B0); PG8_BAR; PG8_SCHED;
            PG8_LDB(B1, 0, 1); PG8_STAGE(PG8_SB(0, 0), b2, voffB);
            PG8_BAR; PG8_WAIT_L(0); PG8_MMA(0, 1, At, B1); PG8_BAR;
            PG8_LDA(At, 0, 1); PG8_STAGE(PG8_SA(0, 0), a2, voffA);
            PG8_BAR; PG8_WAIT_L(0); PG8_MMA(1, 0, At, B0); PG8_BAR; PG8_SCHED;
            PG8_STAGE(PG8_SB(0, 1), b2 + hstep, voffB);
            PG8_WAIT_V(6); PG8_BAR; PG8_MMA(1, 1, At, B1); PG8_BAR;
            PG8_LDB(B0, 1, 0); PG8_SCHED; PG8_LDA(At, 1, 0); PG8_STAGE(PG8_SA(0, 1), a2 + hstep, voffA);
            PG8_WAIT_L(8); PG8_BAR; PG8_WAIT_L(0); PG8_MMA(0, 0, At, B0); PG8_BAR; PG8_SCHED;
            PG8_LDB(B1, 1, 1); PG8_STAGE(PG8_SB(1, 0), b3, voffB);
            PG8_BAR; PG8_WAIT_L(0); PG8_MMA(0, 1, At, B1); PG8_BAR;
            PG8_LDA(At, 1, 1); PG8_STAGE(PG8_SA(1, 0), a3, voffA);
            PG8_BAR; PG8_WAIT_L(0); PG8_MMA(1, 0, At, B0); PG8_BAR; PG8_SCHED;
            PG8_STAGE(PG8_SB(1, 1), b3 + hstep, voffB);
            PG8_WAIT_V(6); PG8_BAR; PG8_MMA(1, 1, At, B1); PG8_BAR;
        }
        PG8_STAMP();
        if constexpr (Epi::KEEP_ACC) E.seam(acc, cur, wr, wc, fr, fq, cur.ko / Epi::SEG_BYTES);
        else
        if (!epi_rot2<Epi>::value || cur.fin)
        if constexpr (!Epi::AFTER_DRAIN) { if constexpr (Epi::STAGED) E.staged(acc, cur, wr, wc, fr, fq, lds + STAGE_BYTES, wid, lane); else E(acc, cur, wr, wc, fr, fq); S.done(cur); }
        PG8_STAMP();
        if (!has_next) break;
        bool zero_acc = true;
        if constexpr (Epi::KEEP_ACC) zero_acc = cur.ko == 2 * Epi::SEG_BYTES;
        if constexpr (epi_rot2<Epi>::value) zero_acc = cur.fin != 0;
        if (zero_acc) {
#pragma unroll
        for (int a = 0; a < 2; ++a)
#pragma unroll
            for (int b = 0; b < 2; ++b)
#pragma unroll
                for (int m = 0; m < 4; ++m)
#pragma unroll
                    for (int n = 0; n < 2; ++n) acc[a][b][m][n] = (f32x4){0.f, 0.f, 0.f, 0.f};
        }
        cur = nxt; cA = nA; cB = nB; ++ui;
    }
    PG8_WAIT_V(0);
    if (wr == 0) PG8_BAR;
    PG8_BAR;
    if constexpr (Epi::AFTER_DRAIN) { E.fused(acc, cur, wr, wc, fr, fq, lds, wid, lane); S.done(cur); }
    PG8_STAMP();
    if (STAMP && wid == 0) { stamps[lane] = lane < nts ? (((unsigned long long)(unsigned)ts_hi << 32) | (unsigned)ts_lo) : 0ull;
        if (lane == 62) stamps[62] = rt_entry; if (lane == 63) stamps[63] = (unsigned long long)wall_clock64(); }
#undef PG8_STAMP
#undef PG8_SA
#undef PG8_SB
#undef PG8_STAGE
#undef PG8_LDA
#undef PG8_LDB
#undef PG8_MMA
#undef PG8_WAIT_V
#undef PG8_WAIT_L
#undef PG8_BAR
#undef PG8_SCHED
}
}


typedef unsigned short bf16;
typedef unsigned v4u __attribute__((ext_vector_type(4)));
typedef unsigned v2u __attribute__((ext_vector_type(2)));
__device__ __forceinline__ unsigned f2bf(float f) { unsigned u = __builtin_bit_cast(unsigned, f); return (u + 0x7fffu + ((u >> 16) & 1u)) >> 16; }
typedef __bf16 bf16x2_t __attribute__((ext_vector_type(2)));
__device__ __forceinline__ unsigned pk2(float lo, float hi) { bf16x2_t v; v[0] = (__bf16)lo; v[1] = (__bf16)hi; return __builtin_bit_cast(unsigned, v); }
__device__ __forceinline__ float row_allsum16(float x) {
    x += __builtin_bit_cast(float, __builtin_amdgcn_update_dpp(0, __builtin_bit_cast(int, x), 0x128, 0xf, 0xf, false));
    x += __builtin_bit_cast(float, __builtin_amdgcn_update_dpp(0, __builtin_bit_cast(int, x), 0x124, 0xf, 0xf, false));
    x += __builtin_bit_cast(float, __builtin_amdgcn_update_dpp(0, __builtin_bit_cast(int, x), 0x122, 0xf, 0xf, false));
    x += __builtin_bit_cast(float, __builtin_amdgcn_update_dpp(0, __builtin_bit_cast(int, x), 0x121, 0xf, 0xf, false));
    return x;
}
__device__ __forceinline__ float fsigmoid(float x) { return __builtin_amdgcn_rcpf(1.0f + __expf(-x)); }
__device__ __forceinline__ void transpose_item(const float* p, int ldw, bf16* WT, int K, int dst_row0, int k0, LAS float* scr, int ln) {
    if (p) {
        float tv[32];
#pragma unroll
        for (int i = 0; i < 32; ++i) tv[i] = p[(size_t)(k0 + 2 * i + (ln >> 5)) * ldw];
#pragma unroll
        for (int i = 0; i < 32; ++i) scr[(2 * i + (ln >> 5)) * 33 + (ln & 31)] = tv[i];
    } else {
#pragma unroll 8
        for (int i = 0; i < 32; ++i) { const int kk = 2 * i + (ln >> 5); scr[kk * 33 + (ln & 31)] = 0.f; }
    }
    asm volatile("s_waitcnt lgkmcnt(0)" ::: "memory");
    const int c = ln & 7;
#pragma unroll
    for (int j = 0; j < 4; ++j) { const int n = (ln >> 3) + 8 * j; const LAS float* s = scr + (8 * c) * 33 + n;
        v4u o; o.x = pk2(s[0 * 33], s[1 * 33]); o.y = pk2(s[2 * 33], s[3 * 33]); o.z = pk2(s[4 * 33], s[5 * 33]); o.w = pk2(s[6 * 33], s[7 * 33]);
        *(v4u*)(WT + (size_t)(dst_row0 + n) * K + k0 + 8 * c) = o; }
    asm volatile("s_waitcnt lgkmcnt(0)" ::: "memory");
}
struct TI { const float* p; bf16* wt; int ldw, K, r0, k0; bool zero; };
__device__ __forceinline__ void ti_load(const TI& t, float (&tv)[32], int ln) {
#pragma unroll
    for (int i = 0; i < 32; ++i) tv[i] = t.p[(size_t)(t.k0 + 2 * i + (ln >> 5)) * t.ldw];
}
__device__ __forceinline__ void ti_finish(const TI& t, const float (&tv)[32], LAS float* scr, int ln) {
#pragma unroll
    for (int i = 0; i < 32; ++i) scr[(2 * i + (ln >> 5)) * 33 + (ln & 31)] = t.zero ? 0.f : tv[i];
    asm volatile("s_waitcnt lgkmcnt(0)" ::: "memory");
    const int c = ln & 7;
#pragma unroll
    for (int j = 0; j < 4; ++j) { const int n = (ln >> 3) + 8 * j; const LAS float* s = scr + (8 * c) * 33 + n;
        v4u o; o.x = pk2(s[0 * 33], s[1 * 33]); o.y = pk2(s[2 * 33], s[3 * 33]); o.z = pk2(s[4 * 33], s[5 * 33]); o.w = pk2(s[6 * 33], s[7 * 33]);
        *(v4u*)(t.wt + (size_t)(t.r0 + n) * t.K + t.k0 + 8 * c) = o; }
    asm volatile("s_waitcnt lgkmcnt(0)" ::: "memory");
}
__device__ __forceinline__ f32x4 bf4_to_f32(const v2u w) { f32x4 r; r[0] = __builtin_bit_cast(float, w.x << 16); r[1] = __builtin_bit_cast(float, w.x & 0xffff0000u);
    r[2] = __builtin_bit_cast(float, w.y << 16); r[3] = __builtin_bit_cast(float, w.y & 0xffff0000u); return r; }
constexpr int STG_RS = 528;
#define EBAR() do { asm volatile("s_waitcnt lgkmcnt(0)" ::: "memory"); __builtin_amdgcn_s_barrier(); asm volatile("" ::: "memory"); } while (0)
#define EPI_ENTER(wr_) do { if ((wr_) == 0) __builtin_amdgcn_s_barrier(); } while (0)
#define EPI_LEAVE(wr_) do { if ((wr_) == 1) __builtin_amdgcn_s_barrier(); } while (0)
#define STG_READBACK512(ai_, m_, BODY) do { int ln_ = lane; asm volatile("" : "+v"(ln_)); _Pragma("unroll") for (int h_ = 0; h_ < 2; ++h_) { const int lr_ = 4 * wid + 2 * h_ + (ln_ >> 5), cb_ = (ln_ & 31) * 16; \
        const v4u sv_ = *(const LAS v4u*)(stg + lr_ * STG_RS + cb_); const int trow_ = 128 * (ai_) + 64 * (lr_ >> 4) + 16 * (m_) + (lr_ & 15); BODY } } while (0)

struct EpiSwigluBf16 {
    static constexpr bool PERM = true, AFTER_DRAIN = false, HAS_MID = false, STAGED = true, KEEP_ACC = false;
    bf16* H; int nN;
    __device__ __forceinline__ void staged(const f32x4 (&acc)[2][2][4][2], const pg8::Unit& u, int wr, int wc, int fr, int fq, LAS unsigned char* stg, int wid, int lane) const {
        const int pnl = u.pn % nN, lrw = 16 * wr + fr;
        bf16* dst = H + (size_t)u.pm * 256 * DFF + 128 * pnl;
        EPI_ENTER(wr);
#pragma unroll
        for (int ai = 0; ai < 2; ++ai)
#pragma unroll
            for (int m = 0; m < 4; ++m) {
#pragma unroll
                for (int bj = 0; bj < 2; ++bj) {
                    const f32x4 g = acc[ai][bj][m][0], uu = acc[ai][bj][m][1]; float h[4];
#pragma unroll
                    for (int j = 0; j < 4; ++j) h[j] = g[j] * fsigmoid(g[j]) * uu[j];
                    v2u o; o.x = pk2(h[0], h[1]); o.y = pk2(h[2], h[3]);
                    *(LAS v2u*)(stg + lrw * 272 + (64 * bj + 16 * wc + 4 * fq) * 2) = o;
                }
                EBAR();
                {
                    int ln_ = lane; asm volatile("" : "+v"(ln_));
                    const int lr = 4 * wid + (ln_ >> 4), cb = (ln_ & 15) * 16;
                    const v4u sv = *(const LAS v4u*)(stg + lr * 272 + cb);
                    const int trow = 128 * ai + 64 * (lr >> 4) + 16 * m + (lr & 15);
                    *(v4u*)(dst + (size_t)trow * DFF + (ln_ & 15) * 8) = sv;
                }
                EBAR();
            }
        EPI_LEAVE(wr);
    }
};
struct EpiResidF32 {
    static constexpr bool PERM = true, AFTER_DRAIN = false, HAS_MID = false, STAGED = true, KEEP_ACC = false;
    float* C; const float* R;
    __device__ __forceinline__ void staged(const f32x4 (&acc)[2][2][4][2], const pg8::Unit& u, int wr, int wc, int fr, int fq, LAS unsigned char* stg, int wid, int lane) const {
        const int lrw = 16 * wr + fr; const size_t t0 = (size_t)u.pm * 256 * D + (size_t)u.pn * 256;
        EPI_ENTER(wr);
#pragma unroll
        for (int ai = 0; ai < 2; ++ai)
#pragma unroll
            for (int m = 0; m < 4; ++m)
#pragma unroll
                for (int bj = 0; bj < 2; ++bj) {
                    *(LAS f32x4*)(stg + lrw * STG_RS + (wc * 32 + 8 * fq) * 4) = acc[ai][bj][m][0];
                    *(LAS f32x4*)(stg + lrw * STG_RS + (wc * 32 + 8 * fq) * 4 + 16) = acc[ai][bj][m][1];
                    EBAR();
                    STG_READBACK512(ai, m, { const size_t o_ = t0 + (size_t)trow_ * D + bj * 128 + (ln_ & 31) * 4;
                        const f32x4 r_ = *(const f32x4*)(R + o_); *(f32x4*)(C + o_) = ALPHA * r_ + __builtin_bit_cast(f32x4, sv_); });
                    EBAR();
                }
        EPI_LEAVE(wr);
    }
};
struct EpiStoreF32 {
    static constexpr bool PERM = true, AFTER_DRAIN = false, HAS_MID = false, STAGED = true, KEEP_ACC = false;
    float* C; int nN;
    __device__ __forceinline__ void staged(const f32x4 (&acc)[2][2][4][2], const pg8::Unit& u, int wr, int wc, int fr, int fq, LAS unsigned char* stg, int wid, int lane) const {
        const int lrw = 16 * wr + fr; const size_t t0 = (size_t)u.pm * 256 * D + (size_t)(u.pn % nN) * 256;
        EPI_ENTER(wr);
#pragma unroll
        for (int ai = 0; ai < 2; ++ai)
#pragma unroll
            for (int m = 0; m < 4; ++m)
#pragma unroll
                for (int bj = 0; bj < 2; ++bj) {
                    *(LAS f32x4*)(stg + lrw * STG_RS + (wc * 32 + 8 * fq) * 4) = acc[ai][bj][m][0];
                    *(LAS f32x4*)(stg + lrw * STG_RS + (wc * 32 + 8 * fq) * 4 + 16) = acc[ai][bj][m][1];
                    EBAR();
                    STG_READBACK512(ai, m, { *(v4u*)(C + t0 + (size_t)trow_ * D + bj * 128 + (ln_ & 31) * 4) = sv_; });
                    EBAR();
                }
        EPI_LEAVE(wr);
    }
};
template <int MODE> struct EpiBranch {
    static constexpr bool PERM = true, AFTER_DRAIN = false, HAS_MID = false, STAGED = false, KEEP_ACC = false;
    float* MIXp; bf16* MIXBp; const float* gate;
    __device__ __forceinline__ void operator()(const f32x4 (&acc)[2][2][4][2], const pg8::Unit& u, int wr, int wc, int fr, int fq) const {
        const int row0 = u.pm * 256 + wr * 64 + fr, col0 = u.pn * 256 + wc * 32 + 8 * fq;
#pragma unroll
        for (int ai = 0; ai < 2; ++ai)
#pragma unroll
            for (int m = 0; m < 4; ++m)
#pragma unroll
                for (int bj = 0; bj < 2; ++bj) {
                    const int row = row0 + ai * 128 + m * 16, col = col0 + bj * 128; const size_t o = (size_t)row * D + col;
                    const f32x4 g0 = *(const f32x4*)(gate + (size_t)row * IN_COLS + col), g1 = *(const f32x4*)(gate + (size_t)row * IN_COLS + col + 4);
                    f32x4 r0, r1;
#pragma unroll
                    for (int j = 0; j < 4; ++j) { r0[j] = fsigmoid(g0[j]) * acc[ai][bj][m][0][j]; r1[j] = fsigmoid(g1[j]) * acc[ai][bj][m][1][j]; }
                    if (MODE >= 1) { r0 += *(const f32x4*)(MIXp + o); r1 += *(const f32x4*)(MIXp + o + 4); }
                    if (MODE <= 1) { *(f32x4*)(MIXp + o) = r0; *(f32x4*)(MIXp + o + 4) = r1; }
                    else { v4u w; w.x = pk2(r0[0], r0[1]); w.y = pk2(r0[2], r0[3]); w.z = pk2(r1[0], r1[1]); w.w = pk2(r1[2], r1[3]); *(v4u*)(MIXBp + o) = w; }
                }
    }
};

struct EpiLora {
    static constexpr bool PERM = true, AFTER_DRAIN = false, HAS_MID = false, STAGED = false, KEEP_ACC = false;
    float* DECp; bf16* AAp; bf16* GGp; float* Vp; const float* VFp; const float* w0; const float* a0; const float* v0;
    __device__ __forceinline__ void operator()(const f32x4 (&acc)[2][2][4][2], const pg8::Unit& u, int wr, int wc, int fr, int fq) const {
        const int row0 = u.pm * 256 + wr * 64 + fr, seg = __builtin_amdgcn_readfirstlane(u.pn >> 2), col0 = (u.pn & 3) * 256 + wc * 32 + 8 * fq;
        if (seg == 0) {
#pragma unroll
            for (int bj = 0; bj < 2; ++bj) { const int col = col0 + bj * 128; const f32x4 b0 = *(const f32x4*)(w0 + col), b1 = *(const f32x4*)(w0 + col + 4);
#pragma unroll
                for (int ai = 0; ai < 2; ++ai)
#pragma unroll
                    for (int m = 0; m < 4; ++m) { const size_t o = (size_t)(row0 + ai * 128 + m * 16) * BW + col;
                        f32x4 x0 = acc[ai][bj][m][0] + b0, x1 = acc[ai][bj][m][1] + b1;
#pragma unroll
                        for (int j = 0; j < 4; ++j) {
                            x0[j] = __expf(-0.6065306597126334f * fsigmoid(x0[j])); x1[j] = __expf(-0.6065306597126334f * fsigmoid(x1[j])); }
                        *(f32x4*)(DECp + o) = x0; *(f32x4*)(DECp + o + 4) = x1; } }
        } else if (seg == 1) {
#pragma unroll
            for (int bj = 0; bj < 2; ++bj) { const int col = col0 + bj * 128; const f32x4 b0 = *(const f32x4*)(a0 + col), b1 = *(const f32x4*)(a0 + col + 4);
#pragma unroll
                for (int ai = 0; ai < 2; ++ai)
#pragma unroll
                    for (int m = 0; m < 4; ++m) { const size_t o = (size_t)(row0 + ai * 128 + m * 16) * BW + col;
                        f32x4 x0 = acc[ai][bj][m][0] + b0, x1 = acc[ai][bj][m][1] + b1;
#pragma unroll
                        for (int j = 0; j < 4; ++j) { x0[j] = fsigmoid(x0[j]); x1[j] = fsigmoid(x1[j]); }
                        v4u w; w.x = pk2(x0[0], x0[1]); w.y = pk2(x0[2], x0[3]); w.z = pk2(x1[0], x1[1]); w.w = pk2(x1[2], x1[3]); *(v4u*)(AAp + o) = w; } }
        } else if (seg == 2) {
#pragma unroll
            for (int bj = 0; bj < 2; ++bj) { const int col = col0 + bj * 128;
#pragma unroll
                for (int ai = 0; ai < 2; ++ai)
#pragma unroll
                    for (int m = 0; m < 4; ++m) { const size_t o = (size_t)(row0 + ai * 128 + m * 16) * BW + col;
                        const f32x4 x0 = acc[ai][bj][m][0], x1 = acc[ai][bj][m][1];
                        v4u w; w.x = pk2(x0[0], x0[1]); w.y = pk2(x0[2], x0[3]); w.z = pk2(x1[0], x1[1]); w.w = pk2(x1[2], x1[3]); *(v4u*)(GGp + o) = w; } }
        } else {
#pragma unroll
            for (int bj = 0; bj < 2; ++bj) { const int col = col0 + bj * 128; const f32x4 b0 = *(const f32x4*)(v0 + col), b1 = *(const f32x4*)(v0 + col + 4);
#pragma unroll
                for (int ai = 0; ai < 2; ++ai)
#pragma unroll
                    for (int m = 0; m < 4; ++m) { const size_t o = (size_t)(row0 + ai * 128 + m * 16) * BW + col;
                        f32x4 x0 = acc[ai][bj][m][0] + b0, x1 = acc[ai][bj][m][1] + b1;
                        const f32x4 v0_ = *(const f32x4*)(Vp + o), v1_ = *(const f32x4*)(Vp + o + 4), f0 = *(const f32x4*)(VFp + o), f1 = *(const f32x4*)(VFp + o + 4);
#pragma unroll
                        for (int j = 0; j < 4; ++j) { x0[j] = v0_[j] + (f0[j] - v0_[j]) * fsigmoid(x0[j]); x1[j] = v1_[j] + (f1[j] - v1_[j]) * fsigmoid(x1[j]); }
                        *(f32x4*)(Vp + o) = x0; *(f32x4*)(Vp + o + 4) = x1;
                        asm volatile("" ::: "memory"); } }
        }
    }
};
struct EpiMlaQ {
    static constexpr bool PERM = true, AFTER_DRAIN = false, HAS_MID = false, STAGED = false, KEEP_ACC = false;
    bf16* QCBp; const float* COSMp; const float* SINMp;
    __device__ __forceinline__ void operator()(const f32x4 (&acc)[2][2][4][2], const pg8::Unit& u, int wr, int wc, int fr, int fq) const {
        const int row0 = u.pm * 256 + wr * 64 + fr;
#pragma unroll
        for (int bj = 0; bj < 2; ++bj) {
            const int c = u.pn * 256 + bj * 128 + wc * 32 + 8 * fq, h = c / 192, cc = c - h * 192;
#pragma unroll
            for (int ai = 0; ai < 2; ++ai)
#pragma unroll
                for (int m = 0; m < 4; ++m) {
                    const int row = row0 + ai * 128 + m * 16; const f32x4 x1 = acc[ai][bj][m][0], x2 = acc[ai][bj][m][1];
                    bf16* dst = QCBp + (size_t)row * 1536 + h * 192;
                    if (cc < 128) { v4u w; w.x = pk2(x1[0], x1[1]); w.y = pk2(x1[2], x1[3]); w.z = pk2(x2[0], x2[1]); w.w = pk2(x2[2], x2[3]); *(v4u*)(dst + cc) = w; }
                    else { const int j0 = 4 * ((cc - 128) >> 3), s = row & (SEQ - 1);
                        const f32x4 cs = *(const f32x4*)(COSMp + s * 32 + j0), sn = *(const f32x4*)(SINMp + s * 32 + j0);
                        const f32x4 o1 = x1 * cs - x2 * sn, o2 = x2 * cs + x1 * sn;
                        v2u a; a.x = pk2(o1[0], o1[1]); a.y = pk2(o1[2], o1[3]); v2u b; b.x = pk2(o2[0], o2[1]); b.y = pk2(o2[2], o2[3]);
                        *(v2u*)(dst + 128 + j0) = a; *(v2u*)(dst + 160 + j0) = b; }
                }
        }
    }
};
struct EpiMlaKV {
    static constexpr bool PERM = true, AFTER_DRAIN = false, HAS_MID = false, STAGED = false, KEEP_ACC = false;
    bf16* KCBp; bf16* VCBp;
    __device__ __forceinline__ void operator()(const f32x4 (&acc)[2][2][4][2], const pg8::Unit& u, int wr, int wc, int fr, int fq) const {
        const int row0 = u.pm * 256 + wr * 64 + fr;
#pragma unroll
        for (int bj = 0; bj < 2; ++bj) {
            const int c = u.pn * 256 + bj * 128 + wc * 32 + 8 * fq, h = c >> 8, cc = c & 255;
#pragma unroll
            for (int ai = 0; ai < 2; ++ai)
#pragma unroll
                for (int m = 0; m < 4; ++m) {
                    const int row = row0 + ai * 128 + m * 16; const f32x4 x1 = acc[ai][bj][m][0], x2 = acc[ai][bj][m][1];
                    v4u w; w.x = pk2(x1[0], x1[1]); w.y = pk2(x1[2], x1[3]); w.z = pk2(x2[0], x2[1]); w.w = pk2(x2[2], x2[3]);
                    if (cc < 128) *(v4u*)(KCBp + (size_t)row * 1536 + h * 192 + cc) = w;
                    else *(v4u*)(VCBp + (size_t)row * BW + h * 128 + (cc - 128)) = w;
                }
        }
    }
};

struct EpiBranch3 {
    static constexpr bool PERM = true, AFTER_DRAIN = false, HAS_MID = false, STAGED = false, KEEP_ACC = true;
    static constexpr int SEG_BYTES = BW * 2;
    bf16* MIXBp; const bf16* G;
    __device__ __forceinline__ void seam(f32x4 (&acc)[2][2][4][2], const pg8::Unit& u, int wr, int wc, int fr, int fq, int seg) const {
        int row0 = u.pm * 256 + wr * 64 + fr, col0 = u.pn * 256 + wc * 32 + 8 * fq;
        asm volatile("" : "+v"(row0), "+v"(col0));
        const bool fin = seg == 2;
#pragma unroll
        for (int ai = 0; ai < 2; ++ai)
#pragma unroll
            for (int mp = 0; mp < 2; ++mp) {
                v4u ga[2][2], gb[2][2];
#pragma unroll
                for (int mm = 0; mm < 2; ++mm)
#pragma unroll
                    for (int bj = 0; bj < 2; ++bj) {
                        const bf16* gp = G + (size_t)(row0 + ai * 128 + (2 * mp + mm) * 16) * (3 * D) + seg * D + col0 + bj * 128;
                        ga[mm][bj] = *(const v4u*)gp; gb[mm][bj] = *(const v4u*)(gp + (fin ? 0 : D));
                    }
#pragma unroll
                for (int mm = 0; mm < 2; ++mm)
#pragma unroll
                    for (int bj = 0; bj < 2; ++bj) {
                        const int m = 2 * mp + mm, row = row0 + ai * 128 + m * 16, col = col0 + bj * 128;
                        const unsigned aw[4] = {ga[mm][bj].x, ga[mm][bj].y, ga[mm][bj].z, ga[mm][bj].w}, bw[4] = {gb[mm][bj].x, gb[mm][bj].y, gb[mm][bj].z, gb[mm][bj].w}; float r[8];
#pragma unroll
                        for (int j = 0; j < 4; ++j) {
                            const float g0 = __uint_as_float(aw[j] << 16), g1 = __uint_as_float(aw[j] & 0xffff0000u);
                            const float q0 = g0 * __builtin_amdgcn_rcpf(__uint_as_float(bw[j] << 16)), q1 = g1 * __builtin_amdgcn_rcpf(__uint_as_float(bw[j] & 0xffff0000u));
                            r[2 * j] = (acc[ai][bj][m][j >> 1][(j & 1) * 2] *= (fin ? g0 : q0)); r[2 * j + 1] = (acc[ai][bj][m][j >> 1][(j & 1) * 2 + 1] *= (fin ? g1 : q1));
                        }
                        if (fin) { v4u w; w.x = pk2(r[0], r[1]); w.y = pk2(r[2], r[3]); w.z = pk2(r[4], r[5]); w.w = pk2(r[6], r[7]); *(v4u*)(MIXBp + (size_t)row * D + col) = w; }
                    }
                asm volatile("" : "+v"(acc[ai][0][2 * mp][0]), "+v"(acc[ai][0][2 * mp][1]) :: "memory");
            }
    }
};
struct SegOrder {
    pg8::StaticOrder base;
    __device__ __forceinline__ bool next(int i, pg8::Unit& u) const { const int ti = i / 3; if (!base.next(ti, u)) return false; u.ko = (i - 3 * ti) * (BW * 2); return true; }
    __device__ __forceinline__ void a_ready(const pg8::Unit&) const {}
    __device__ __forceinline__ void done(const pg8::Unit&) const {}
};
struct EpiResidF32R : EpiResidF32 { static constexpr bool ROT2 = true; };
struct RotOrder {
    pg8::StaticOrder base; int rot, segb;
    __device__ __forceinline__ bool next(int i, pg8::Unit& u) const { const int ti = i >> 1, k = i & 1; if (!base.next(ti, u)) return false; u.ko = (k ^ rot) * segb; u.fin = k; return true; }
    __device__ __forceinline__ void a_ready(const pg8::Unit&) const {}
    __device__ __forceinline__ void done(const pg8::Unit&) const {}
};
struct MoeOrder {
    const unsigned* tile_e; int nMt, nN, G, c; int mt0 = 0, ks = 1, kbytes = 0;
    __device__ __forceinline__ bool next(int i, pg8::Unit& u) const {
        const long L = (long)i * G + c; if (L >= (long)nMt * nN * ks) return false;
        const int mt = mt0 + (int)(L / (nN * ks)), rem = (int)(L % (nN * ks)), pnl = rem / ks;
        u.pm = mt; u.pn = (int)tile_e[mt] * nN + pnl; u.ko = (rem % ks) * kbytes; return true;
    }
    __device__ __forceinline__ void a_ready(const pg8::Unit&) const {}
    __device__ __forceinline__ void done(const pg8::Unit&) const {}
};
struct EpiAtomicF32 {
    static constexpr bool PERM = true, AFTER_DRAIN = false, HAS_MID = false, STAGED = true, KEEP_ACC = false;
    float* C; int nN;
    __device__ __forceinline__ void staged(const f32x4 (&acc)[2][2][4][2], const pg8::Unit& u, int wr, int wc, int fr, int fq, LAS unsigned char* stg, int wid, int lane) const {
        const int lrw = 16 * wr + fr; const size_t t0 = (size_t)u.pm * 256 * D + (size_t)(u.pn % nN) * 256;
        EPI_ENTER(wr);
#pragma unroll
        for (int ai = 0; ai < 2; ++ai)
#pragma unroll
            for (int m = 0; m < 4; ++m)
#pragma unroll
                for (int bj = 0; bj < 2; ++bj) {
                    *(LAS f32x4*)(stg + lrw * STG_RS + (wc * 32 + 8 * fq) * 4) = acc[ai][bj][m][0];
                    *(LAS f32x4*)(stg + lrw * STG_RS + (wc * 32 + 8 * fq) * 4 + 16) = acc[ai][bj][m][1];
                    EBAR();
                    { int ln_ = lane; asm volatile("" : "+v"(ln_));
#pragma unroll
                      for (int q_ = 0; q_ < 8; ++q_) { const int lr_ = 4 * wid + (q_ >> 1), cf_ = (q_ & 1) * 64 + ln_;
                          const float sv_ = *(const LAS float*)(stg + lr_ * STG_RS + cf_ * 4);
                          const int trow_ = 128 * ai + 64 * (lr_ >> 4) + 16 * m + (lr_ & 15);
                          atomicAdd(C + t0 + (size_t)trow_ * D + bj * 128 + cf_, sv_); } }
                    EBAR();
                }
        EPI_LEAVE(wr);
    }
};

struct EpiStoreBf16s { bf16* C; int ldc; size_t sC;
    __device__ __forceinline__ void operator()(int bt, int m, int n, float v) const { C[(size_t)bt * sC + (size_t)m * ldc + n] = (bf16)f2bf(v); } };
struct EpiInProjF32 {
    static constexpr bool PERM = true, AFTER_DRAIN = false, HAS_MID = false, STAGED = false, KEEP_ACC = false;
    bf16* PROJp; float* VRESp; bf16* GATEp; float* QFp; bf16* KABp; bf16* VABp; const float* COSAp; const float* SINAp; int layer;
    __device__ __forceinline__ void operator()(const f32x4 (&acc)[2][2][4][2], const pg8::Unit& u, int wr, int wc, int fr, int fq) const {
        int row0 = u.pm * 256 + wr * 64 + fr;
        asm volatile("" : "+v"(row0), "+v"(fq));
        if (u.pn >= 30) {
#pragma unroll
            for (int bj = 0; bj < 2; ++bj) { const int c = (u.pn - 30) * 256 + bj * 128 + wc * 32 + 8 * fq;
#pragma unroll
                for (int ai = 0; ai < 2; ++ai)
#pragma unroll
                    for (int m = 0; m < 4; ++m) { const f32x4 x0 = acc[ai][bj][m][0], x1 = acc[ai][bj][m][1];
                        v4u w; w.x = pk2(fsigmoid(x0[0]), fsigmoid(x0[1])); w.y = pk2(fsigmoid(x0[2]), fsigmoid(x0[3]));
                        w.z = pk2(fsigmoid(x1[0]), fsigmoid(x1[1])); w.w = pk2(fsigmoid(x1[2]), fsigmoid(x1[3]));
                        *(v4u*)(GATEp + (size_t)(row0 + ai * 128 + m * 16) * (3 * D) + c) = w; } }
            return;
        }
        if (u.pn < 8) {
            const bool isk = u.pn >= 4;
#pragma unroll
            for (int bj = 0; bj < 2; ++bj) {
                const int c = (u.pn & 3) * 256 + bj * 128 + wc * 32 + 8 * fq, hh = c >> 7, j0 = ((c & 127) >> 3) * 4;
#pragma unroll
                for (int ai = 0; ai < 2; ++ai)
#pragma unroll
                    for (int m = 0; m < 4; ++m) { const int row = row0 + ai * 128 + m * 16, s = row & (SEQ - 1);
                        const f32x4 cs = *(const f32x4*)(COSAp + s * 64 + j0), sn = *(const f32x4*)(SINAp + s * 64 + j0);
                        const f32x4 x1 = acc[ai][bj][m][0], x2 = acc[ai][bj][m][1];
                        const f32x4 o1 = x1 * cs - x2 * sn, o2 = x2 * cs + x1 * sn;
                        if (!isk) { float* q = QFp + (size_t)row * BW + hh * 128 + j0; *(f32x4*)q = o1; *(f32x4*)(q + 64) = o2; }
                        else { bf16* k = KABp + (size_t)row * BW + hh * 128 + j0; v2u a; a.x = pk2(o1[0], o1[1]); a.y = pk2(o1[2], o1[3]); v2u b; b.x = pk2(o2[0], o2[1]); b.y = pk2(o2[2], o2[3]);
                            *(v2u*)k = a; *(v2u*)(k + 64) = b; }
                        asm volatile("" ::: "memory");
                    }
            }
            return;
        }
        if (u.pn < 12) {
#pragma unroll
            for (int bj = 0; bj < 2; ++bj) { const int c = (u.pn - 8) * 256 + bj * 128 + wc * 32 + 8 * fq;
#pragma unroll
                for (int ai = 0; ai < 2; ++ai)
#pragma unroll
                    for (int m = 0; m < 4; ++m) { const f32x4 x0 = acc[ai][bj][m][0], x1 = acc[ai][bj][m][1];
                        v4u w; w.x = pk2(x0[0], x0[1]); w.y = pk2(x0[2], x0[3]); w.z = pk2(x1[0], x1[1]); w.w = pk2(x1[2], x1[3]);
                        *(v4u*)(VABp + (size_t)(row0 + ai * 128 + m * 16) * BW + c) = w; } }
            return;
        }
#pragma unroll
        for (int bj = 0; bj < 2; ++bj) {
            const int c = u.pn * 256 + bj * 128 + wc * 32 + 8 * fq;
            if (c >= 6432 && c < 6464) {
                if (layer != 0) {
#pragma unroll
                    for (int ai = 0; ai < 2; ++ai)
#pragma unroll
                        for (int m = 0; m < 4; ++m) { float* p = VRESp + (c - 6432) + (size_t)(row0 + ai * 128 + m * 16) * 32;
                            *(f32x4*)p = acc[ai][bj][m][0]; *(f32x4*)(p + 4) = acc[ai][bj][m][1]; }
                }
            } else if (c < 7552) {
                bf16* dst = PROJp + ((c < 6432 ? c : c - 32) - PSH);
#pragma unroll
                for (int ai = 0; ai < 2; ++ai)
#pragma unroll
                    for (int m = 0; m < 4; ++m) { const f32x4 x0 = acc[ai][bj][m][0], x1 = acc[ai][bj][m][1];
                        v4u w; w.x = pk2(x0[0], x0[1]); w.y = pk2(x0[2], x0[3]); w.z = pk2(x1[0], x1[1]); w.w = pk2(x1[2], x1[3]);
                        *(v4u*)(dst + (size_t)(row0 + ai * 128 + m * 16) * PLD) = w; }
            }
        }
    }
};


__device__ __forceinline__ float fma_(float a, float b, float c) { float r; asm("v_fma_f32 %0, %1, %2, %3" : "=v"(r) : "v"(a), "v"(b), "v"(c)); return r; }
__device__ __forceinline__ float mul_(float a, float b) { float r; asm("v_mul_f32 %0, %1, %2" : "=v"(r) : "v"(a), "v"(b)); return r; }
__device__ __forceinline__ float add_(float a, float b) { float r; asm("v_add_f32 %0, %1, %2" : "=v"(r) : "v"(a), "v"(b)); return r; }
typedef short s16x4 __attribute__((ext_vector_type(4)));
constexpr int AT_KOFF = 0, AT_VOFF = 25600, AT_STAGE = 25600 + 64 * 288;
#define AT_TR16(base, o) \
    asm volatile("ds_read_b64_tr_b16 %0, %16 offset:0\n\tds_read_b64_tr_b16 %1, %16 offset:4608\n\t" \
                 "ds_read_b64_tr_b16 %2, %16 offset:32\n\tds_read_b64_tr_b16 %3, %16 offset:4640\n\t" \
                 "ds_read_b64_tr_b16 %4, %16 offset:64\n\tds_read_b64_tr_b16 %5, %16 offset:4672\n\t" \
                 "ds_read_b64_tr_b16 %6, %16 offset:96\n\tds_read_b64_tr_b16 %7, %16 offset:4704\n\t" \
                 "ds_read_b64_tr_b16 %8, %16 offset:128\n\tds_read_b64_tr_b16 %9, %16 offset:4736\n\t" \
                 "ds_read_b64_tr_b16 %10, %16 offset:160\n\tds_read_b64_tr_b16 %11, %16 offset:4768\n\t" \
                 "ds_read_b64_tr_b16 %12, %16 offset:192\n\tds_read_b64_tr_b16 %13, %16 offset:4800\n\t" \
                 "ds_read_b64_tr_b16 %14, %16 offset:224\n\tds_read_b64_tr_b16 %15, %16 offset:4832\n\t" \
                 "s_waitcnt lgkmcnt(0)" \
                 : "=&v"(o[0]), "=&v"(o[1]), "=&v"(o[2]), "=&v"(o[3]), "=&v"(o[4]), "=&v"(o[5]), "=&v"(o[6]), "=&v"(o[7]), \
                   "=&v"(o[8]), "=&v"(o[9]), "=&v"(o[10]), "=&v"(o[11]), "=&v"(o[12]), "=&v"(o[13]), "=&v"(o[14]), "=&v"(o[15]) \
                 : "v"(base) : "memory")
template <int DQ, bool MOBA>
__device__ __forceinline__ void attn_tile(LAS unsigned char* lds, const int buf, const int it, const int q0, const int w, const int qq, const int g, const int qrow, const int own,
                                          const unsigned selbits, const float sc, const pg8::bf16x8 (&qf)[DQ / 32], f32x4 (&o)[8], float& m, float& l) {
    constexpr int KROW = (DQ + 8) * 2, VROW = 288, NDS = DQ / 32;
    const LAS unsigned char* kb = lds + buf * AT_STAGE + AT_KOFF;
    f32x4 st[4];
#pragma unroll
    for (int c = 0; c < 4; ++c) {
        st[c] = (f32x4){0.f, 0.f, 0.f, 0.f};
#pragma unroll
        for (int ds = 0; ds < NDS; ++ds) {
            const pg8::bf16x8 a = *(const LAS pg8::bf16x8*)(kb + (16 * c + qq) * KROW + (32 * ds + 8 * g) * 2);
            st[c] = __builtin_amdgcn_mfma_f32_16x16x32_bf16(a, qf[ds], st[c], 0, 0, 0);
        }
    }
    const int blk = it >> 2;
    const bool past = MOBA && (blk < own);
    if (past) {
        const bool selok = ((selbits >> blk) & 1u) != 0u;
#pragma unroll
        for (int c = 0; c < 4; ++c)
#pragma unroll
            for (int r = 0; r < 4; ++r) st[c][r] = selok ? st[c][r] : -INFINITY;
    } else if (it * 64 + 63 > q0 + 16 * w) {
#pragma unroll
        for (int c = 0; c < 4; ++c)
#pragma unroll
            for (int r = 0; r < 4; ++r) { const int key = it * 64 + 16 * c + 4 * g + r; st[c][r] = (key <= qrow) ? st[c][r] : -INFINITY; }
    }
    float mloc = fmaxf(fmaxf(st[0][0], st[0][1]), fmaxf(st[0][2], st[0][3]));
#pragma unroll
    for (int c = 1; c < 4; ++c) mloc = fmaxf(mloc, fmaxf(fmaxf(st[c][0], st[c][1]), fmaxf(st[c][2], st[c][3])));
    const int ln_ = qq + 16 * g;
    mloc = fmaxf(mloc, shfl_xor_(mloc, 16, ln_)); mloc = fmaxf(mloc, shfl_xor_(mloc, 32, ln_));
    const float mnew = fmaxf(m, mloc * sc);
    if (__any(mnew > m)) {
        const float alpha = __builtin_amdgcn_exp2f(m - mnew);
        l *= alpha;
#pragma unroll
        for (int i = 0; i < 8; ++i) o[i] *= alpha;
        m = mnew;
    }
    float ps = 0.f;
#pragma unroll
    for (int c = 0; c < 4; ++c)
#pragma unroll
        for (int r = 0; r < 4; ++r) { const float p = __builtin_amdgcn_exp2f(__builtin_fmaf(st[c][r], sc, -m)); st[c][r] = p; ps += p; }
    l += ps;
#pragma unroll
    for (int c0i = 0; c0i < 2; ++c0i) {
        v4u pw; pw.x = pk2(st[2 * c0i][0], st[2 * c0i][1]); pw.y = pk2(st[2 * c0i][2], st[2 * c0i][3]);
        pw.z = pk2(st[2 * c0i + 1][0], st[2 * c0i + 1][1]); pw.w = pk2(st[2 * c0i + 1][2], st[2 * c0i + 1][3]);
        const pg8::bf16x8 pb = __builtin_bit_cast(pg8::bf16x8, pw);
        const unsigned vaddr = (unsigned)(size_t)(lds + buf * AT_STAGE + AT_VOFF) + (unsigned)((32 * c0i + 4 * g + (qq >> 2)) * VROW + 8 * (qq & 3));
        s16x4 vr[16];
        AT_TR16(vaddr, vr);
#pragma unroll
        for (int i = 0; i < 8; ++i) {
            const pg8::bf16x8 a = __builtin_shufflevector(vr[2 * i], vr[2 * i + 1], 0, 1, 2, 3, 4, 5, 6, 7);
            o[i] = __builtin_amdgcn_mfma_f32_16x16x32_bf16(a, pb, o[i], 0, 0, 0);
        }
    }
}
template <int DQ, bool MOBA>
__device__ __forceinline__ void attn_unit(LAS unsigned char* lds, const bf16* Qg, int ldq, const bf16* Kg, int ldk, const bf16* Vg, int ldv,
                                          bf16* Og, int ldo, const unsigned char* sel, int qt, float sc, const int tid) {
    constexpr int KROW = (DQ + 8) * 2, VROW = 288, KCH = DQ / 8, NKC = 64 * KCH / 512, NDS = DQ / 32;
    const int lane = tid & 63, w = __builtin_amdgcn_readfirstlane(tid >> 6), qq = lane & 15, g = lane >> 4;
    const int q0 = qt * 128, qrow = q0 + 16 * w + qq, own = q0 >> 8;
    pg8::bf16x8 qf[NDS];
#pragma unroll
    for (int ds = 0; ds < NDS; ++ds) qf[ds] = *(const pg8::bf16x8*)(Qg + (size_t)qrow * ldq + 32 * ds + 8 * g);
    unsigned selbits = 0; if (MOBA) selbits = sel[(size_t)qrow * 8];
    f32x4 o[8];
#pragma unroll
    for (int i = 0; i < 8; ++i) o[i] = (f32x4){0.f, 0.f, 0.f, 0.f};
    float m = -1e30f, l = 0.f;
    const int ntiles = 2 * (qt + 1);
    v4u kA[NKC], vA[2], kB[NKC], vB[2];
    { const v4u z_ = {0u, 0u, 0u, 0u};
#pragma unroll
      for (int i_ = 0; i_ < NKC; ++i_) { kA[i_] = z_; kB[i_] = z_; }
      vA[0] = z_; vA[1] = z_; vB[0] = z_; vB[1] = z_; }
    unsigned kgo[NKC], vgo[2], klo[NKC], vlo[2];
#pragma unroll
    for (int i_ = 0; i_ < NKC; ++i_) { const int id_ = tid + 512 * i_, row_ = id_ / KCH, ch_ = id_ % KCH; kgo[i_] = (unsigned)(row_ * ldk + ch_ * 8) * 2u; klo[i_] = (unsigned)(row_ * KROW + ch_ * 16); }
#pragma unroll
    for (int i_ = 0; i_ < 2; ++i_) { const int id_ = tid + 512 * i_, row_ = id_ >> 4, ch_ = id_ & 15; vgo[i_] = (unsigned)(row_ * ldv + ch_ * 8) * 2u; vlo[i_] = (unsigned)(AT_VOFF + row_ * VROW + ch_ * 16); }
#define AT_GLOAD(KS, VS, tile) do { const char* kp_ = (const char*)Kg + (size_t)(tile) * 64 * ldk * 2; const char* vp_ = (const char*)Vg + (size_t)(tile) * 64 * ldv * 2; \
        _Pragma("unroll") for (int i_ = 0; i_ < NKC; ++i_) KS[i_] = *(const v4u*)(kp_ + kgo[i_]); \
        _Pragma("unroll") for (int i_ = 0; i_ < 2; ++i_) VS[i_] = *(const v4u*)(vp_ + vgo[i_]); } while (0)
#define AT_LSTORE(KS, VS, buf) do { _Pragma("unroll") for (int i_ = 0; i_ < NKC; ++i_) *(LAS v4u*)(lds + (buf) * AT_STAGE + klo[i_]) = KS[i_]; \
        _Pragma("unroll") for (int i_ = 0; i_ < 2; ++i_) *(LAS v4u*)(lds + (buf) * AT_STAGE + vlo[i_]) = VS[i_]; } while (0)
    AT_GLOAD(kA, vA, 0); AT_LSTORE(kA, vA, 0);
    AT_GLOAD(kA, vA, 1);
    __syncthreads();
    for (int it = 0; it < ntiles; it += 2) {
        if (it + 2 < ntiles) AT_GLOAD(kB, vB, it + 2);
        attn_tile<DQ, MOBA>(lds, 0, it, q0, w, qq, g, qrow, own, selbits, sc, qf, o, m, l);
        AT_LSTORE(kA, vA, 1);
        __syncthreads();
        if (it + 3 < ntiles) AT_GLOAD(kA, vA, it + 3);
        attn_tile<DQ, MOBA>(lds, 1, it + 1, q0, w, qq, g, qrow, own, selbits, sc, qf, o, m, l);
        if (it + 2 < ntiles) AT_LSTORE(kB, vB, 0);
        __syncthreads();
    }
    float ls = l + shfl_xor_(l, 16, lane); ls += shfl_xor_(ls, 32, lane);
    const float inv = 1.0f / ls;
#pragma unroll
    for (int i = 0; i < 8; ++i) { v2u ob; ob.x = pk2(o[i][0] * inv, o[i][1] * inv); ob.y = pk2(o[i][2] * inv, o[i][3] * inv);
        *(v2u*)(Og + (size_t)qrow * ldo + 16 * i + 4 * g) = ob; }
#undef AT_GLOAD
#undef AT_LSTORE
}
template <bool BT, class Epi>
__device__ __forceinline__ void gemm32(LAS float* lds, const float* A, int lda, size_t sA, const float* B, int ldb, size_t sB,
                                       int M, int N, int K, int nbatch, const int* rowidx, const Epi& epi, const int tid, const int G) {
    const int lane = tid & 63, wave = tid >> 6, wm = wave >> 1, wn = wave & 1;
    const int tilesM = (M + 127) >> 7, tilesN = (N + 127) >> 7, tilesPer = tilesM * tilesN, ntiles = tilesPer * nbatch;
    LAS float* As = lds;
    LAS float* Bs = lds + 2 * 16 * 132;
    for (int tile = blockIdx.x; tile < ntiles; tile += G) {
        const int bt = tile / tilesPer, r = tile % tilesPer, tm = r / tilesN, tn = r % tilesN;
        const int m0 = tm * 128, n0 = tn * 128;
        const float* Ab = A + (size_t)bt * sA; const float* Bb = B + (size_t)bt * sB;
        const int arow = tid >> 2, akq = (tid & 3) * 4;
        const int gr = m0 + arow; const bool aok = gr < M;
        const int src = aok ? (rowidx ? rowidx[gr] : gr) : 0;
        const float* ap = Ab + (size_t)src * lda + akq;
        const float* bp; bool bok; int bkr, bnq;
        if (BT) { bkr = 0; bnq = 0; const int gn = n0 + arow; bok = gn < N; bp = Bb + (size_t)(bok ? gn : 0) * ldb + akq; }
        else { bkr = tid >> 5; bnq = (tid & 31) * 4; bok = (n0 + bnq) < N; bp = Bb + (size_t)bkr * ldb + (bok ? (n0 + bnq) : 0); }
        f32x16 acc0, acc1;
#pragma unroll
        for (int i = 0; i < 16; ++i) { acc0[i] = 0.f; acc1[i] = 0.f; }
        f32x4 ra, rb;
        const f32x4 z4 = {0.f, 0.f, 0.f, 0.f};
        ra = aok ? *(const f32x4*)ap : z4;
        rb = bok ? *(const f32x4*)bp : z4;
        {
            LAS float* a_ = As; LAS float* b_ = Bs;
#pragma unroll
            for (int j = 0; j < 4; ++j) a_[(akq + j) * 132 + arow] = ra[j];
            if (BT) {
#pragma unroll
                for (int j = 0; j < 4; ++j) b_[(akq + j) * 132 + arow] = rb[j];
            } else *(LAS f32x4*)(b_ + bkr * 132 + bnq) = rb;
        }
        __syncthreads();
        for (int k0 = 0; k0 < K; k0 += 16) {
            const int cur = (k0 >> 4) & 1;
            const bool more = (k0 + 16) < K;
            if (more) {
                ra = aok ? *(const f32x4*)(ap + k0 + 16) : z4;
                if (BT) rb = bok ? *(const f32x4*)(bp + k0 + 16) : z4;
                else rb = bok ? *(const f32x4*)(bp + (size_t)(k0 + 16) * ldb) : z4;
            }
            const LAS float* a_ = As + cur * 16 * 132 + (lane >> 5) * 132 + wm * 32 + (lane & 31);
            const LAS float* b_ = Bs + cur * 16 * 132 + (lane >> 5) * 132 + wn * 64 + (lane & 31);
#pragma unroll
            for (int kk = 0; kk < 16; kk += 2) {
                const float a = a_[kk * 132], b0 = b_[kk * 132], b1 = b_[kk * 132 + 32];
                acc0 = __builtin_amdgcn_mfma_f32_32x32x2f32(a, b0, acc0, 0, 0, 0);
                acc1 = __builtin_amdgcn_mfma_f32_32x32x2f32(a, b1, acc1, 0, 0, 0);
            }
            if (more) {
                LAS float* aw = As + (cur ^ 1) * 16 * 132; LAS float* bw = Bs + (cur ^ 1) * 16 * 132;
#pragma unroll
                for (int j = 0; j < 4; ++j) aw[(akq + j) * 132 + arow] = ra[j];
                if (BT) {
#pragma unroll
                    for (int j = 0; j < 4; ++j) bw[(akq + j) * 132 + arow] = rb[j];
                } else *(LAS f32x4*)(bw + bkr * 132 + bnq) = rb;
            }
            __syncthreads();
        }
#pragma unroll
        for (int i = 0; i < 16; ++i) {
            const int row = m0 + wm * 32 + (i & 3) + 8 * (i >> 2) + 4 * (lane >> 5);
            const int c0 = n0 + wn * 64 + (lane & 31);
            if (row < M) {
                if (c0 < N) epi(bt, row, c0, acc0[i]);
                if (c0 + 32 < N) epi(bt, row, c0 + 32, acc1[i]);
            }
        }
    }
}

struct EpiStore { float* C; int ldc; size_t sC;
    __device__ __forceinline__ void operator()(int bt, int m, int n, float v) const { C[(size_t)bt * sC + (size_t)m * ldc + n] = v; } };
struct EpiDecay { float* C; const float* w0;
    __device__ __forceinline__ void operator()(int, int m, int n, float v) const {
        const float z = -(w0[n] + v); const float sp = z > 20.f ? z : log1pf(expf(z));
        C[(size_t)m * BW + n] = expf(-expf(-sp - 0.5f)); } };
struct EpiSigB { float* C; const float* b;
    __device__ __forceinline__ void operator()(int, int m, int n, float v) const { C[(size_t)m * BW + n] = sigmoidf_(b[n] + v); } };
struct EpiVLerp { float* V; const float* VF; const float* v0;
    __device__ __forceinline__ void operator()(int, int m, int n, float a) const {
        const size_t o = (size_t)m * BW + n; const float v = V[o]; V[o] = v + (VF[o] - v) * sigmoidf_(v0[n] + a); } };
template <bool FIRST> struct EpiGateAcc { float* MIX; const float* gate;
    __device__ __forceinline__ void operator()(int, int m, int n, float a) const {
        const float g = sigmoidf_(gate[(size_t)m * IN_COLS + n]); const size_t o = (size_t)m * D + n;
        MIX[o] = FIRST ? g * a : MIX[o] + g * a; } };
struct EpiResid { float* C; const float* R; int ldc;
    __device__ __forceinline__ void operator()(int, int m, int n, float a) const { const size_t o = (size_t)m * ldc + n; C[o] = ALPHA * R[o] + a; } };
struct EpiSwiglu { float* C; int ldc; size_t roff;
    __device__ __forceinline__ void operator()(int, int m, int n, float a) const {
        const size_t o = (roff + (size_t)m) * ldc + n; const float g = C[o]; C[o] = g * sigmoidf_(g) * a; } };

struct Args { const float* in[34]; float* out; unsigned char* ws; unsigned mask; int li; };

__device__ __forceinline__ unsigned char* opq(unsigned char* p) { asm volatile("" : "+s"(p)); return p; }
#define INP(i) ((const float*)(((const GAS float* const*)args.in)[(i) + zero_live]))
#define x_in INP(0)
#define w_in INP(1)
#define w_in_vres INP(2)
#define rwkv_mu INP(3)
#define rwkv_mu_vres INP(4)
#define rwkv_w0 INP(5)
#define rwkv_w_lora INP(6)
#define rwkv_a0 INP(7)
#define rwkv_a_lora INP(8)
#define rwkv_g_lora INP(9)
#define rwkv_v0 INP(10)
#define rwkv_v_lora INP(11)
#define rwkv_k_k INP(12)
#define rwkv_k_a INP(13)
#define rwkv_r_k INP(14)
#define rwkv_gn_g INP(15)
#define rwkv_gn_b INP(16)
#define mla_q_norm INP(17)
#define mla_w_uq INP(18)
#define mla_kv_norm INP(19)
#define mla_w_ukv INP(20)
#define branch_out INP(21)
#define w_out INP(22)
#define ln1_g INP(23)
#define ln1_b INP(24)
#define ffn_wg INP(25)
#define ffn_wu INP(26)
#define ffn_wd INP(27)
#define moe_router INP(28)
#define moe_wg INP(29)
#define moe_wu INP(30)
#define moe_wd INP(31)
#define ln2_g INP(32)
#define ln2_b INP(33)
#define COSA ((float*)(ws_live + WS_COSA))
#define SINA ((float*)(ws_live + WS_SINA))
#define COSM ((float*)(ws_live + WS_COSM))
#define SINM ((float*)(ws_live + WS_SINM))
#define TOK ((int*)(ws_live + WS_TOK))
#define ROWL ((int*)(ws_live + WS_ROWL))
#define XB ((float*)(ws_live + WS_XB))
#define X1 ((float*)(ws_live + WS_X1))
#define PRE ((float*)(ws_live + WS_PRE))
#define XBF ((bf16*)(ws_live + WS_XBF))
#define WINT ((bf16*)(ws_live + WS_WINT))
#define X1B ((bf16*)(ws_live + WS_X1B))
#define WBO ((bf16*)(ws_live + WS_WBO))
#define WOT ((bf16*)(ws_live + WS_WOT))
#define WGU ((bf16*)(ws_live + WS_WGU))
#define WD ((bf16*)(ws_live + WS_WD))
#define WDD ((bf16*)(ws_live + WS_WDD))
#define HGB ((bf16*)(ws_live + WS_HGB))
#define XG ((bf16*)(ws_live + WS_XG))
#define MIXB ((bf16*)(ws_live + WS_MIXB))
#define YALL ((bf16*)(ws_live + WS_YALL))
#define GATEB ((bf16*)(ws_live + WS_GATEB))
#define QAB ((bf16*)(ws_live + WS_QAB))
#define KAB ((bf16*)(ws_live + WS_KAB))
#define VAB ((bf16*)(ws_live + WS_VAB))
#define QCB ((bf16*)(ws_live + WS_QCB))
#define KCB ((bf16*)(ws_live + WS_KCB))
#define VCB ((bf16*)(ws_live + WS_VCB))
#define KMEAN ((float*)(ws_live + WS_KMEAN))
#define SELB ((unsigned char*)(ws_live + WS_SEL))
#define WUQ ((bf16*)(ws_live + WS_WUQ))
#define WUKV ((bf16*)(ws_live + WS_WUKV))
#define WLORA ((bf16*)(ws_live + WS_WLORA))
#define LA ((bf16*)(ws_live + WS_LA))
#define QNB ((bf16*)(ws_live + WS_QNB))
#define KVNB ((bf16*)(ws_live + WS_KVNB))
#define QF ((float*)(ws_live + WS_QF))
#define KMS ((float*)(ws_live + WS_KMEAN))
#define PROJ ((bf16*)(ws_live + WS_PROJ))
#define VRES ((float*)(ws_live + WS_VRES))
#define QA ((float*)(ws_live + WS_QA))
#define V0 ((float*)(ws_live + WS_V0))
#define V1 ((float*)(ws_live + WS_V1))
#define DEC ((float*)(ws_live + WS_DEC))
#define AA ((bf16*)(ws_live + WS_AA))
#define GG ((bf16*)(ws_live + WS_GG))
#define Y ((bf16*)(ws_live + WS_Y))
#define OUT ((float*)(ws_live + WS_OUT))


__global__ void __launch_bounds__(NTHREADS, 2) fwd_kernel(Args args) {
    extern __shared__ __attribute__((aligned(16))) unsigned char lds_raw[];
#define lds ((LAS float*)lds_raw)
    int wave_live = __builtin_amdgcn_readfirstlane((int)threadIdx.x >> 6);
    int tid_live = threadIdx.x;
#define RETID() do { int ln_; asm volatile("v_mbcnt_lo_u32_b32 %0, -1, 0\n\tv_mbcnt_hi_u32_b32 %0, -1, %0" : "=v"(ln_)); asm volatile("" : "+s"(wave_live)); tid_live = wave_live * 64 + ln_; } while (0)
#define tid tid_live
#define lane (tid_live & 63)
#define wave (__builtin_amdgcn_readfirstlane(tid_live >> 6))
#define gw ((int)blockIdx.x * NWAVES + wave)
#define NGW (G_live * NWAVES)
#define gt ((int)blockIdx.x * NTHREADS + tid_live)
#define NGT (G_live * NTHREADS)
#define misc ((volatile LAS unsigned*)((LAS unsigned char*)lds_raw + LDS_BYTES - 64))
    if (tid < 16) misc[tid] = tid == 6 ? 0xffffffffu : 0u;
    __syncthreads();
#define REOPAQUE() do { asm volatile("" : "+s"(ws_live)); asm volatile("" : "+s"(zero_live)); asm volatile("" : "+s"(G_live)); RETID(); } while (0)
#define TI_WINT(t_, ll_, r_) do { constexpr int NNB_ = NP / 32; const int kb_ = (r_) / NNB_, nb_ = (r_) % NNB_, c_ = nb_ * 32; \
    const float* W_ = w_in + (size_t)(ll_) * D * IN_COLS; int ldw_ = IN_COLS, sc_ = c_; \
    if (c_ < 6432) sc_ = c_; \
    else if (c_ < 6464) { if (ll_) { W_ = w_in_vres; ldw_ = 32; sc_ = 0; } else W_ = nullptr; } \
    else if (c_ < 7552) sc_ = c_ - 32; \
    else if (c_ < 7680) W_ = nullptr; \
    else sc_ = c_ - 160; \
    int scl_ = sc_ + (lane & 31); \
    if (c_ < 2048) { const int cl_ = c_ + (lane & 31), hh_ = cl_ >> 7, cc_ = cl_ & 127, e_ = cc_ & 7; scl_ = hh_ * 128 + (e_ < 4 ? 4 * (cc_ >> 3) + e_ : 64 + 4 * (cc_ >> 3) + (e_ - 4)); } \
    (t_).zero = W_ == nullptr; (t_).p = (W_ ? W_ : w_in) + scl_; (t_).ldw = ldw_; (t_).wt = WINT + (size_t)(ll_) * NP * D; (t_).K = D; (t_).r0 = c_; (t_).k0 = kb_ * 64; } while (0)
#define TI_WBO(t_, mat_, r_) do { const int kb_ = (r_) / 64, nb_ = (r_) % 64, ll_ = (mat_) / 3, seg_ = (mat_) % 3; \
    (t_).zero = false; (t_).p = branch_out + (size_t)(mat_) * BW * D + nb_ * 32 + (lane & 31); (t_).ldw = D; (t_).wt = WBO + (size_t)ll_ * D * 3 * BW + seg_ * BW; (t_).K = 3 * BW; (t_).r0 = nb_ * 32; (t_).k0 = kb_ * 64; } while (0)
#define TI_WUQ(t_, mat_, r_) do { const int kb_ = (r_) / 48, nb_ = (r_) % 48; \
    const int np_ = nb_ * 32 + (lane & 31), hh_ = np_ / 192, cc_ = np_ - hh_ * 192, q_ = cc_ - 128, e_ = q_ & 7; \
    const int sc_ = cc_ < 128 ? hh_ * 192 + cc_ : hh_ * 192 + 128 + (e_ < 4 ? 4 * (q_ >> 3) + e_ : 32 + 4 * (q_ >> 3) + (e_ - 4)); \
    (t_).zero = false; (t_).p = mla_w_uq + (size_t)(mat_) * 512 * 1536 + sc_; (t_).ldw = 1536; (t_).wt = WUQ + (size_t)(mat_) * 1536 * 512; (t_).K = 512; (t_).r0 = nb_ * 32; (t_).k0 = kb_ * 64; } while (0)
#define TI_WUKV(t_, mat_, r_) do { const int kb_ = (r_) / 64, nb_ = (r_) % 64; \
    (t_).zero = false; (t_).p = mla_w_ukv + (size_t)(mat_) * 512 * 2048 + nb_ * 32 + (lane & 31); (t_).ldw = 2048; (t_).wt = WUKV + (size_t)(mat_) * 2048 * 512; (t_).K = 512; (t_).r0 = nb_ * 32; (t_).k0 = kb_ * 64; } while (0)
#define TI_WOT(t_, mat_, r_) do { const int kb_ = (r_) / 64, nb_ = (r_) % 64; \
    (t_).zero = false; (t_).p = w_out + (size_t)(mat_) * D * D + nb_ * 32 + (lane & 31); (t_).ldw = D; (t_).wt = WOT + (size_t)(mat_) * D * D; (t_).K = D; (t_).r0 = nb_ * 32; (t_).k0 = kb_ * 64; } while (0)
constexpr int FC_I_GU = (D / 64) * (NGU / 32), FC_I_D = (DFF / 64) * (D / 32);
#define TI_GU(t_, wg_, wu_, e_, r_) do { const int kb_ = (r_) / (NGU / 32), nb_ = (r_) % (NGU / 32); const int rr_ = lane & 31, hcol_ = 4 * (nb_ * 4 + (rr_ >> 3)) + (rr_ & 3); \
    (t_).zero = false; (t_).p = ((rr_ & 7) < 4 ? (wg_) : (wu_)) + (size_t)(e_) * D * DFF + hcol_; (t_).ldw = DFF; (t_).wt = WGU + (size_t)(e_) * NGU * D; (t_).K = D; (t_).r0 = nb_ * 32; (t_).k0 = kb_ * 64; } while (0)
#define TI_D(t_, wd_, dst_, e_, r_) do { const int kb_ = (r_) / (D / 32), nb_ = (r_) % (D / 32); \
    (t_).zero = false; (t_).p = (wd_) + (size_t)(e_) * DFF * D + nb_ * 32 + (lane & 31); (t_).ldw = D; (t_).wt = (dst_) + (size_t)(e_) * D * DFF; (t_).K = DFF; (t_).r0 = nb_ * 32; (t_).k0 = kb_ * 64; } while (0)
#define TI_RUN1(ta_) do { float va_[32]; ti_load(ta_, va_, lane); ti_finish(ta_, va_, scr, lane); } while (0)
#define TI_RUN2(ta_, tb_) do { float va_[32], vb_[32]; ti_load(ta_, va_, lane); ti_load(tb_, vb_, lane); ti_finish(ta_, va_, scr, lane); ti_finish(tb_, vb_, scr, lane); } while (0)
#define CV_WINT_ITEM(ll_, r_) do { TI t1_; TI_WINT(t1_, ll_, r_); TI_RUN1(t1_); } while (0)
#define CV_WUQ_ITEM(mat_, r_) do { TI t1_; TI_WUQ(t1_, mat_, r_); TI_RUN1(t1_); } while (0)
#define CV_WUKV_ITEM(mat_, r_) do { TI t1_; TI_WUKV(t1_, mat_, r_); TI_RUN1(t1_); } while (0)
#define CV_LORA_ITEM(ll_, r_) do { \
    for (int j_ = 0; j_ < 32; ++j_) { const int x_ = (r_) * 2048 + j_ * 64 + lane, n_ = x_ / 384, k_ = x_ % 384, seg_ = n_ >> 10, c_ = n_ & 1023; \
        float v_ = 0.f; \
        if (seg_ == 0) { if (k_ < 64) v_ = rwkv_w_lora[((size_t)(ll_) * 64 + k_) * BW + c_]; } \
        else if (seg_ == 1) { if (k_ >= 64 && k_ < 128) v_ = rwkv_a_lora[((size_t)(ll_) * 64 + (k_ - 64)) * BW + c_]; } \
        else if (seg_ == 2) { if (k_ >= 128 && k_ < 288) v_ = rwkv_g_lora[((size_t)(ll_) * 160 + (k_ - 128)) * BW + c_]; } \
        else { if ((ll_) == 1 && k_ >= 288 && k_ < 320) v_ = rwkv_v_lora[(size_t)(k_ - 288) * BW + c_]; } \
        WLORA[(size_t)(ll_) * 4096 * 384 + x_] = (bf16)f2bf(v_); } } while (0)
#define FFN_CONV_PAIR(it_) do { const int fi_ = (it_); \
    if (l == 0) { if (fi_ < FC_I_GU) PAIR_OF(TI_GU, ffn_wg, ffn_wu, 0, fi_); else PAIR_OF(TI_D, ffn_wd, WDD, 0, fi_ - FC_I_GU); } \
    else PAIR_OF(TI_GU, moe_wg, moe_wu, fi_ / FC_I_GU, fi_ % FC_I_GU); } while (0)
#define FFN_CONV_N(l_) ((l_) == 0 ? FC_I_GU + FC_I_D : 4 * FC_I_GU)
#define PAIR_OF(TIM_, ...) do { TI ta_, tb_; TIM_(ta_, __VA_ARGS__); TIM_(tb_, __VA_ARGS__ + 1); TI_RUN2(ta_, tb_); } while (0)
#define DQ_PAIR(d_) do { const int d__ = (d_); \
    if (d__ < 3072) { PAIR_OF(TI_WBO, d__ >> 10, (d__ & 1023)); asm volatile("; dq0" ::: "memory"); } \
    else if (d__ < 5120) { PAIR_OF(TI_WOT, 0, d__ - 3072); asm volatile("; dq1" ::: "memory"); } \
    else if (d__ < 18944) { PAIR_OF(TI_WINT, 1, d__ - 5120); asm volatile("; dq2" ::: "memory"); } \
    else if (d__ < 19712) { }   \
    else if (d__ < 20096) { PAIR_OF(TI_WUQ, 1, d__ - 19712); asm volatile("; dq3" ::: "memory"); } \
    else if (d__ < 20608) { PAIR_OF(TI_WUKV, 1, d__ - 20096); asm volatile("; dq4" ::: "memory"); } \
    else if (d__ < 23680) { PAIR_OF(TI_WBO, 3 + ((d__ - 20608) >> 10), ((d__ - 20608) & 1023)); asm volatile("; dq5" ::: "memory"); } \
    else if (d__ < 25728) { PAIR_OF(TI_WOT, 1, d__ - 23680); asm volatile("; dq6" ::: "memory"); } \
    else if (d__ < DQ_J7) { PAIR_OF(TI_GU, moe_wg, moe_wu, 4 + (d__ - 25728) / FC_I_GU, (d__ - 25728) % FC_I_GU); asm volatile("; dq7" ::: "memory"); } \
    else { PAIR_OF(TI_D, moe_wd, WD, (d__ - DQ_J7) / FC_I_D, (d__ - DQ_J7) % FC_I_D); asm volatile("; dq8" ::: "memory"); } } while (0)
#define DQ_HALF(base_) do { const int dit_ = (int)(base_) + 2 * wave; if (dit_ < DQ_N) DQ_PAIR(dit_); } while (0)
#define DQ_PENDING() do { const unsigned pu_ = (unsigned)__builtin_amdgcn_readfirstlane((int)misc[6]); __syncthreads(); \
        if (pu_ != 0xffffffffu) { if (tid == 0) misc[6] = 0xffffffffu; DQ_HALF(pu_); } } while (0)
#define DQ_RUN(COND_) do { DQ_PENDING(); for (;;) { \
        if (tid == 0) { unsigned u_ = 0xffffffffu; \
            if (xb_ld(ctl + CW_DQ + 64 * li_) < (unsigned)DQ_N && (COND_)) u_ = atomicAdd(ctl + CW_DQ + 64 * li_, 32u); \
            misc[4] = u_; } \
        __syncthreads(); \
        const unsigned du_ = (unsigned)__builtin_amdgcn_readfirstlane((int)misc[4]); \
        __syncthreads(); \
        if (du_ >= (unsigned)DQ_N) break; \
        DQ_HALF(du_); \
        if (tid == 0) misc[5] = (COND_) ? 1u : 0u; \
        __syncthreads(); \
        const unsigned go_ = (unsigned)__builtin_amdgcn_readfirstlane((int)misc[5]); \
        __syncthreads(); \
        if (!go_) { if (tid == 0) misc[6] = du_ + 16u; __syncthreads(); break; } \
        DQ_HALF(du_ + 16u); \
    } } while (0)
#define DQ_FLUSH(UPTO_) do { DQ_PENDING(); for (;;) { \
        if (tid == 0) { const unsigned h_ = xb_ld(ctl + CW_DQ + 64 * li_); unsigned u_ = 0xffffffffu, nb_ = 0u; \
            if (h_ < (unsigned)(UPTO_)) { nb_ = ((((unsigned)(UPTO_) - h_ + (unsigned)G_live - 1u) / (unsigned)G_live) + 7u) & ~7u; nb_ = nb_ < 16u ? 16u : nb_; u_ = atomicAdd(ctl + CW_DQ + 64 * li_, nb_); } \
            misc[4] = u_; misc[5] = nb_; } \
        __syncthreads(); \
        const unsigned du_ = (unsigned)__builtin_amdgcn_readfirstlane((int)misc[4]), dn_ = (unsigned)__builtin_amdgcn_readfirstlane((int)misc[5]); \
        __syncthreads(); \
        if (du_ >= (unsigned)DQ_N) break; \
        const int de_ = (int)min(du_ + dn_, (unsigned)DQ_N); \
        _Pragma("unroll 1") \
        for (int dit_ = (int)du_ + 2 * wave; dit_ < de_; dit_ += 16) DQ_PAIR(dit_); \
    } } while (0)
#define DQ_FILL(SLOT_, TH_) DQ_RUN(xb_ld(ctl + CW_PD + 64 * ((SLOT_) + 8 * li_)) < (unsigned)(TH_))
#define PHASE_DONE(SLOT_) do { if (tid == 0) atomicAdd(ctl + CW_PD + 64 * ((SLOT_) + 8 * li_), 1u); } while (0)
#define GRID_BAR() do { { XcdBarrier bar_; bar_.bar = ctl + CW_BAR + li_ * XCD_BAR_WORDS; bar_.x = xb_xcc_id(); bar_.st = misc; xcd_barrier(bar_, tid_live); } asm volatile("" : "+s"(ws_live)); asm volatile("" : "+s"(zero_live)); asm volatile("" : "+s"(G_live)); RETID(); } while (0)

    GAS unsigned char* ws_live = *(GAS unsigned char* const*)&args.ws; int zero_live = 0; int G_live = (int)gridDim.x; unsigned mask_live = args.mask; const int li_ = args.li;
#define RUN(p) ((mask_live >> (l * 12 + (p))) & 1u)
#define ctl ((unsigned*)(ws_live + WS_CTL))
    (void)xcd_barrier_post(ctl + CW_BAR + li_ * XCD_BAR_WORDS, misc, tid_live);
    if (mask_live & (1u << 31)) {
    for (int i = gt; i < SEQ * 64; i += NGT) {
        const int s = i >> 6, j = i & 63;
        const float inv = 1.0f / powf(10000.0f, (float)(2 * j) / 128.0f);
        const float ang = (float)s * inv;
        COSA[i] = cosf(ang); SINA[i] = sinf(ang);
    }
    for (int i = gt; i < SEQ * 32; i += NGT) {
        const int s = i >> 5, j = i & 31;
        const float inv = 1.0f / powf(10000.0f, (float)(2 * j) / 64.0f);
        const float ang = (float)s * inv;
        COSM[i] = cosf(ang); SINM[i] = sinf(ang);
    }

    {
        LAS float* scr = (LAS float*)((LAS unsigned char*)lds_raw) + wave * (64 * 33);
        for (int it = gw; it < (D / 64) * (NP / 32); it += NGW) CV_WINT_ITEM(0, it);
        for (int it = gw; it < 2 * 768; it += NGW) { const int ll = it / 768, r = it % 768; CV_LORA_ITEM(ll, r); }
        for (int it = gw; it < 8 * 48; it += NGW) CV_WUQ_ITEM(0, it);
        for (int it = gw; it < 8 * 64; it += NGW) CV_WUKV_ITEM(0, it);
        for (int t = gw; t < T; t += NGW) {
#pragma unroll
            for (int jj = 0; jj < 8; ++jj) { const f32x4 v = *(const f32x4*)(x_in + (size_t)t * D + jj * 256 + lane * 4);
                v2u o; o.x = pk2(v[0], v[1]); o.y = pk2(v[2], v[3]); *(v2u*)(XBF + (size_t)t * D + jj * 256 + lane * 4) = o; }
        }
    }
    GRID_BAR();
    }
    for (int l = 0; l < 2; ++l) {
        const float* X = (l == 0) ? x_in : XB;
        float* Vcur = (l == 0) ? V0 : V1;
        if (RUN(0)) {
        {
            pg8::Gemm g{XBF, WINT + (size_t)l * NP * D, T, NP, D}; pg8::StaticOrder S; S.init(T, NP, G_live, (int)blockIdx.x);
            EpiInProjF32 E{PROJ, VRES, GATEB, QF, KAB, VAB, COSA, SINA, l};
            pg8::gemm_phase<EpiInProjF32, pg8::StaticOrder, false>((LAS unsigned char*)lds_raw, g, S, E, nullptr, tid);
        }
        REOPAQUE();
        {
            LAS float* scr = (LAS float*)((LAS unsigned char*)lds_raw) + wave * (64 * 33);
            PHASE_DONE(l * 4 + 0);
            DQ_FILL(l * 4 + 0, 65);
        }
        GRID_BAR();
        }
        if (RUN(1)) {
        if (l == 1) { LAS float* scr = (LAS float*)((LAS unsigned char*)lds_raw) + wave * (64 * 33); DQ_FLUSH(DQ_J5); }
        for (int item = blockIdx.x; item < NBATCH * 8 * 8; item += G_live) {
            const int blk = item & 7, h = (item >> 3) & 7, b = item >> 6;
            const int kq = tid >> 4, d8 = (tid & 15) * 8;
            const bf16* kbase = KAB + ((size_t)b * SEQ + blk * 256) * BW + h * 128 + d8;
            float sacc[8];
#pragma unroll
            for (int j = 0; j < 8; ++j) sacc[j] = 0.f;
#pragma unroll
            for (int it = 0; it < 8; ++it) { const v4u kv = *(const v4u*)(kbase + (size_t)(kq + 32 * it) * BW); const unsigned kw[4] = {kv.x, kv.y, kv.z, kv.w};
#pragma unroll
                for (int j = 0; j < 4; ++j) { sacc[2 * j] += __uint_as_float(kw[j] << 16); sacc[2 * j + 1] += __uint_as_float(kw[j] & 0xffff0000u); } }
#pragma unroll
            for (int j = 0; j < 8; ++j) lds[kq * 128 + d8 + j] = sacc[j];
            __syncthreads();
            if (tid < 128) { float a = 0.f;
#pragma unroll
                for (int rr = 0; rr < 32; ++rr) a += lds[rr * 128 + tid];
                KMS[(size_t)item * 128 + tid] = a; }
            __syncthreads();
        }
        {
            const float* mu = rwkv_mu + l * RWKV_COLS;
            for (int i0 = gt; i0 < (T / 4) * 256; i0 += 2 * NGT) {
                v2u row[2][5]; f32x4 mu4[2]; int tq[2], cc[2];
#pragma unroll
                for (int u_ = 0; u_ < 2; ++u_) {
                    const int i = i0 + u_ * NGT, ic = i < (T / 4) * 256 ? i : gt;
                    const int q = ic / 256, c4 = 2048 + (ic - q * 256) * 4, t0 = 4 * q, s0 = t0 & (SEQ - 1);
                    tq[u_] = i < (T / 4) * 256 ? t0 : -1; cc[u_] = c4;
                    const bf16* pr = PROJ + (size_t)t0 * PLD + (OFF_RWKV - PSH) + c4;
                    row[u_][0] = *(const v2u*)(s0 > 0 ? pr - PLD : pr);
                    if (s0 == 0) row[u_][0] = (v2u){0u, 0u};
#pragma unroll
                    for (int k = 0; k < 4; ++k) row[u_][k + 1] = *(const v2u*)(pr + (size_t)k * PLD);
                    mu4[u_] = *(const f32x4*)(mu + c4);
                }
#pragma unroll
                for (int u_ = 0; u_ < 2; ++u_) if (tq[u_] >= 0) {
                    float* dst = Vcur + (size_t)tq[u_] * BW + (cc[u_] & 1023);
#pragma unroll
                    for (int k = 0; k < 4; ++k) { const f32x4 cu = bf4_to_f32(row[u_][k + 1]), pv = bf4_to_f32(row[u_][k]); *(f32x4*)(dst + (size_t)k * BW) = cu + (pv - cu) * mu4[u_]; }
                }
            }
            for (int i = gt; i < T * 96; i += NGT) {
                const int t = i / 96, c4 = (i - t * 96) * 4, s = t & (SEQ - 1);
                f32x4 v = {0.f, 0.f, 0.f, 0.f};
                if (c4 < 288) {
                    const f32x4 cur = bf4_to_f32(*(const v2u*)(PROJ + (size_t)t * PLD + (OFF_RWKV - PSH) + 3072 + c4));
                    f32x4 prev = {0.f, 0.f, 0.f, 0.f}; if (s > 0) prev = bf4_to_f32(*(const v2u*)(PROJ + (size_t)(t - 1) * PLD + (OFF_RWKV - PSH) + 3072 + c4));
                    v = cur + (prev - cur) * *(const f32x4*)(mu + 3072 + c4);
                    if (c4 < 64) { v[0] = tanhf(v[0]); v[1] = tanhf(v[1]); v[2] = tanhf(v[2]); v[3] = tanhf(v[3]); }
                    else if (c4 >= 128) { v[0] = sigmoidf_(v[0]); v[1] = sigmoidf_(v[1]); v[2] = sigmoidf_(v[2]); v[3] = sigmoidf_(v[3]); }
                } else if (c4 < 320 && l == 1) {
                    const f32x4 cur = *(const f32x4*)(VRES + (size_t)t * 32 + (c4 - 288));
                    f32x4 prev = {0.f, 0.f, 0.f, 0.f}; if (s > 0) prev = *(const f32x4*)(VRES + (size_t)(t - 1) * 32 + (c4 - 288));
                    v = cur + (prev - cur) * *(const f32x4*)(rwkv_mu_vres + (c4 - 288));
                }
                v2u o; o.x = pk2(v[0], v[1]); o.y = pk2(v[2], v[3]); *(v2u*)(LA + (size_t)t * 384 + c4) = o;
            }
        }
        for (int t = gw; t < T; t += NGW) {
            const bf16* q = PROJ + (size_t)t * PLD + (OFF_MLA - PSH);
#pragma unroll
            for (int part = 0; part < 2; ++part) {
                const v4u qw = *(const v4u*)(q + part * 512 + lane * 8); v2u qlo, qhi; qlo.x = qw.x; qlo.y = qw.y; qhi.x = qw.z; qhi.y = qw.w;
                const f32x4 a = bf4_to_f32(qlo), b2 = bf4_to_f32(qhi);
                const float ss = (a[0] * a[0] + a[1] * a[1]) + (a[2] * a[2] + a[3] * a[3]) + (b2[0] * b2[0] + b2[1] * b2[1]) + (b2[2] * b2[2] + b2[3] * b2[3]);
                const float rs = rsqrtf(wave_sum(ss, lane) * (1.0f / 512.0f) + 1e-6f);
                const float* gn = (part ? mla_kv_norm : mla_q_norm) + l * 512 + lane * 8;
                const f32x4 g0 = *(const f32x4*)gn, g1 = *(const f32x4*)(gn + 4);
                v4u w; w.x = pk2(a[0] * rs * g0[0], a[1] * rs * g0[1]); w.y = pk2(a[2] * rs * g0[2], a[3] * rs * g0[3]);
                w.z = pk2(b2[0] * rs * g1[0], b2[1] * rs * g1[1]); w.w = pk2(b2[2] * rs * g1[2], b2[3] * rs * g1[3]);
                *(v4u*)((part ? KVNB : QNB) + (size_t)t * 512 + lane * 8) = w;
            }
            if (lane < 32) {
                const int s = t & (SEQ - 1);
                const float x1 = __builtin_bit_cast(float, (unsigned)q[1024 + lane] << 16), x2 = __builtin_bit_cast(float, (unsigned)q[1024 + 32 + lane] << 16), c = COSM[s * 32 + lane], sn = SINM[s * 32 + lane];
                const bf16 o1 = (bf16)f2bf(x1 * c - x2 * sn), o2 = (bf16)f2bf(x2 * c + x1 * sn);
#pragma unroll
                for (int hh = 0; hh < 8; ++hh) { KCB[(size_t)t * 1536 + hh * 192 + 128 + lane] = o1; KCB[(size_t)t * 1536 + hh * 192 + 160 + lane] = o2; }
            }
        }
        GRID_BAR();
        }
        if (RUN(2)) {
        {
            pg8::Gemm g{LA, WLORA + (size_t)l * 4096 * 384, T, l ? 4096 : 3072, 384 + zero_live}; pg8::StaticOrder S; S.init(T, l ? 4096 : 3072, G_live, (int)blockIdx.x);
            EpiLora E{DEC, AA, GG, V1, V0, rwkv_w0 + l * BW, rwkv_a0 + l * BW, rwkv_v0};
            pg8::gemm_phase<EpiLora, pg8::StaticOrder, false>((LAS unsigned char*)lds_raw, g, S, E, nullptr, tid);
        }
        REOPAQUE();
        {
            pg8::Gemm g{QNB, WUQ + (size_t)l * 1536 * 512, T, 1536, 512 + zero_live}; pg8::StaticOrder S; S.init(T, 1536, G_live, (int)blockIdx.x);
            EpiMlaQ E{QCB, COSM, SINM};
            pg8::gemm_phase<EpiMlaQ, pg8::StaticOrder, false>((LAS unsigned char*)lds_raw, g, S, E, nullptr, tid);
        }
        REOPAQUE();
        {
            pg8::Gemm g{KVNB, WUKV + (size_t)l * 2048 * 512, T, 2048, 512 + zero_live}; pg8::StaticOrder S; S.init(T, 2048, G_live, (int)blockIdx.x);
            EpiMlaKV E{KCB, VCB};
            pg8::gemm_phase<EpiMlaKV, pg8::StaticOrder, false>((LAS unsigned char*)lds_raw, g, S, E, nullptr, tid);
        }
        REOPAQUE();
        for (int i = gt; i < T * 8 * 16; i += NGT) {
            const int th = i >> 4, jg = (i & 15) * 4, t = th >> 3, h = th & 7, s = t & (SEQ - 1), own = s >> 8;
            const float* src_ = QF + (size_t)t * BW + h * 128 + jg;
            const f32x4 q1 = *(const f32x4*)src_, q2 = *(const f32x4*)(src_ + 64);
            v2u w1; w1.x = pk2(q1[0], q1[1]); w1.y = pk2(q1[2], q1[3]); v2u w2; w2.x = pk2(q2[0], q2[1]); w2.y = pk2(q2[2], q2[3]);
            *(v2u*)(QAB + (size_t)t * BW + h * 128 + jg) = w1; *(v2u*)(QAB + (size_t)t * BW + h * 128 + 64 + jg) = w2;
            const float* km = KMS + (size_t)(((t >> 11) * 8 + h) * 8) * 128 + jg;
            float gate[7];
#pragma unroll
            for (int n = 0; n < 7; ++n) {
                const f32x4 k1 = *(const f32x4*)(km + n * 128), k2 = *(const f32x4*)(km + n * 128 + 64);
                const float part = ((q1[0] * k1[0] + q1[1] * k1[1]) + (q1[2] * k1[2] + q1[3] * k1[3])) + ((q2[0] * k2[0] + q2[1] * k2[1]) + (q2[2] * k2[2] + q2[3] * k2[3]));
                gate[n] = row_allsum16(part);
            }
            unsigned bits = 0;
#pragma unroll
            for (int n = 0; n < 7; ++n) {
                int rank = 0;
#pragma unroll
                for (int m2 = 0; m2 < 7; ++m2) if (m2 != n) rank += (m2 < own && (gate[m2] > gate[n] || (gate[m2] == gate[n] && m2 < n))) ? 1 : 0;
                bits |= ((n < own) && (rank < 3)) ? (1u << n) : 0u;
            }
            if ((i & 15) == 0) SELB[(size_t)t * 8 + h] = (unsigned char)bits;
        }
        {
            LAS float* scr = (LAS float*)((LAS unsigned char*)lds_raw) + wave * (64 * 33);
            __syncthreads();
            PHASE_DONE(l * 4 + 2);
            DQ_FILL(l * 4 + 2, l == 0 ? 129 : 65);
        }
        GRID_BAR();
        }
        if (RUN(3)) {
        if (!(mask_live & (1u << 30)))
        for (int item = blockIdx.x; item < 128; item += G_live) {
            const int bh = item >> 1, half = item & 1, b = bh >> 4, h = bh & 15;
            const size_t base = (size_t)b * SEQ * BW + h * 64;
            constexpr int CH = 32, BUFF = 6 * CH * 64;
            LAS float* ypart = lds + 2 * BUFF;
            const int st_step = tid >> 4, st_j = (tid & 15) * 4;
            const int cbase = l * BW + h * 64 + st_j;
            const f32x4 ckk = *(const f32x4*)(rwkv_k_k + cbase), cka = *(const f32x4*)(rwkv_k_a + cbase);
            const int cg = lane & 15, rl = tid >> 4, irow = 32 * half + rl;
            const bool stager = tid < CH * 16;
            f32x4 g_w = {0.f, 0.f, 0.f, 0.f}, g_v = g_w; v2u g_ab = {0u, 0u};
            v2u g_rc = {0u, 0u}, g_rp = g_rc, g_kc = g_rc, g_kp = g_rc; int g_s = 0;
            const f32x4 mur = *(const f32x4*)(rwkv_mu + l * RWKV_COLS + h * 64 + st_j), muk = *(const f32x4*)(rwkv_mu + l * RWKV_COLS + 1024 + h * 64 + st_j);
            const bf16* pbase = PROJ + (size_t)b * SEQ * PLD + (OFF_RWKV - PSH) + h * 64 + st_j;
            float sa = 0.f, sb = 0.f, sc2 = 0.f, sd = 0.f;
#define SC_GLOAD(c) do { if (stager) { const size_t o_ = base + (size_t)((c) * CH + st_step) * BW + st_j; \
                g_s = (c) * CH + st_step; const bf16* pk_ = pbase + (size_t)g_s * PLD; \
                g_kc = *(const v2u*)(pk_ + 1024); g_kp = *(const v2u*)(pk_ - (g_s > 0 ? PLD : 0) + 1024); \
                g_rc = *(const v2u*)(pk_ - (g_s > 0 ? PLD : 0)); g_rp = *(const v2u*)(pk_ - (g_s > 1 ? 2 * PLD : 0)); \
                g_w = *(const f32x4*)(DEC + o_); g_ab = *(const v2u*)(AA + o_); g_v = *(const f32x4*)(Vcur + o_); } } while (0)
#define SC_LSTORE(bufi) do { if (stager) { \
                const f32x4 kc_ = bf4_to_f32(g_kc), rc_ = bf4_to_f32(g_rc); f32x4 kp_ = bf4_to_f32(g_kp), rp_ = bf4_to_f32(g_rp); \
                if (g_s == 0) kp_ = (f32x4){0.f, 0.f, 0.f, 0.f}; if (g_s <= 1) rp_ = (f32x4){0.f, 0.f, 0.f, 0.f}; \
                const f32x4 g_k = kc_ + (kp_ - kc_) * muk, g_r = rc_ + (rp_ - rc_) * mur, g_a = bf4_to_f32(g_ab); \
                f32x4 kk_ = g_k * ckk; \
                const float n2_ = row_allsum16((kk_[0] * kk_[0] + kk_[1] * kk_[1]) + (kk_[2] * kk_[2] + kk_[3] * kk_[3])); \
                kk_ = kk_ * __builtin_amdgcn_rcpf(fmaxf(sqrtf(n2_), 1e-12f)); \
                const f32x4 k2_ = g_k * (1.0f + (g_a - 1.0f) * cka); \
                LAS float* bb_ = lds + (bufi) * BUFF + st_step * 64 + st_j; \
                *(LAS f32x4*)(bb_ + 0 * CH * 64) = g_r; *(LAS f32x4*)(bb_ + 1 * CH * 64) = g_w; *(LAS f32x4*)(bb_ + 2 * CH * 64) = k2_; \
                *(LAS f32x4*)(bb_ + 3 * CH * 64) = kk_; *(LAS f32x4*)(bb_ + 4 * CH * 64) = kk_ * g_a; *(LAS f32x4*)(bb_ + 5 * CH * 64) = g_v; } } while (0)
#define SC_LD(X, st_) do { const LAS float* p_ = bb + (st_) * 64 + 4 * cg; \
                X##r = *(const LAS f32x4*)(p_ + 0 * CH * 64); X##w = *(const LAS f32x4*)(p_ + 1 * CH * 64); X##k = *(const LAS f32x4*)(p_ + 2 * CH * 64); \
                X##q = *(const LAS f32x4*)(p_ + 3 * CH * 64); X##b = *(const LAS f32x4*)(p_ + 4 * CH * 64); X##v = bb[5 * CH * 64 + (st_) * 64 + irow]; } while (0)
#define SC_STEP(X, st_) do { float d_, y_, t0_, t1_, t2_, t3_; \
                asm("v_mul_f32 %0, %4, %8\n\tv_mul_f32 %1, %4, %12\n\tv_mul_f32 %2, %6, %10\n\tv_mul_f32 %3, %6, %14\n\t" \
                    "v_fma_f32 %0, %5, %9, %0\n\tv_fma_f32 %1, %5, %13, %1\n\tv_fma_f32 %2, %7, %11, %2\n\tv_fma_f32 %3, %7, %15, %3\n\t" \
                    "v_add_f32 %0, %0, %2\n\tv_add_f32 %1, %1, %3" \
                    : "=&v"(d_), "=&v"(y_), "=&v"(t0_), "=&v"(t1_) \
                    : "v"(sa), "v"(sb), "v"(sc2), "v"(sd), "v"(X##q[0]), "v"(X##q[1]), "v"(X##q[2]), "v"(X##q[3]), "v"(X##r[0]), "v"(X##r[1]), "v"(X##r[2]), "v"(X##r[3])); \
                asm("s_nop 1\n\tv_add_f32_dpp %0, %0, %0 quad_perm:[1,0,3,2] row_mask:0xf bank_mask:0xf bound_ctrl:1\n\ts_nop 1\n\t" \
                    "v_add_f32_dpp %0, %0, %0 quad_perm:[2,3,0,1] row_mask:0xf bank_mask:0xf bound_ctrl:1" : "+v"(y_)); \
                ypart[(st_) * 128 + rl * 4 + (cg >> 2)] = y_;     \
                asm("v_mul_f32 %5, %9, %10\n\tv_mul_f32 %6, %9, %11\n\t" \
                    "v_add_f32_dpp %0, %0, %0 row_ror:8 row_mask:0xf bank_mask:0xf bound_ctrl:1\n\t" \
                    "v_mul_f32 %7, %9, %12\n\tv_mul_f32 %8, %9, %13\n\t" \
                    "v_add_f32_dpp %0, %0, %0 row_ror:4 row_mask:0xf bank_mask:0xf bound_ctrl:1\n\t" \
                    "v_fma_f32 %5, %1, %14, %5\n\tv_fma_f32 %6, %2, %15, %6\n\t" \
                    "v_add_f32_dpp %0, %0, %0 row_ror:2 row_mask:0xf bank_mask:0xf bound_ctrl:1\n\t" \
                    "v_fma_f32 %7, %3, %16, %7\n\tv_fma_f32 %8, %4, %17, %8\n\t" \
                    "v_add_f32_dpp %0, %0, %0 row_ror:1 row_mask:0xf bank_mask:0xf bound_ctrl:1\n\t" \
                    "s_nop 1\n\t" \
                    "v_fma_f32 %1, -%0, %18, %5\n\tv_fma_f32 %2, -%0, %19, %6\n\tv_fma_f32 %3, -%0, %20, %7\n\tv_fma_f32 %4, -%0, %21, %8" \
                    : "+v"(d_), "+v"(sa), "+v"(sb), "+v"(sc2), "+v"(sd), "=&v"(t0_), "=&v"(t1_), "=&v"(t2_), "=&v"(t3_) \
                    : "v"(X##v), "v"(X##k[0]), "v"(X##k[1]), "v"(X##k[2]), "v"(X##k[3]), "v"(X##w[0]), "v"(X##w[1]), "v"(X##w[2]), "v"(X##w[3]), \
                      "v"(X##b[0]), "v"(X##b[1]), "v"(X##b[2]), "v"(X##b[3])); } while (0)
            SC_GLOAD(0); SC_LSTORE(0);
            __syncthreads();
            for (int c = 0; c < SEQ / CH; ++c) {
                const bool more = (c + 1) < SEQ / CH;
                if (c == SEQ / CH - 2 && tid == 0) atomicAdd(ctl + CW_SD + 64 * (l + 2 * li_), 1u);
                if (more) SC_GLOAD(c + 1);
                const LAS float* bb = lds + (c & 1) * BUFF;
                f32x4 Ar, Aw, Ak, Aq, Ab, Br, Bw, Bk, Bq, Bb; float Av, Bv;
                SC_LD(A, 0);
#pragma unroll 1
                for (int st = 0; st < CH; st += 2) {
                    SC_LD(B, st + 1);
                    SC_STEP(A, st);
                    if (st + 2 < CH) SC_LD(A, st + 2);
                    SC_STEP(B, st + 1);
                }
                __syncthreads();
                {
                    const int stp = tid >> 4, r2 = (tid & 15) * 2;
                    const LAS f32x4* pp = (const LAS f32x4*)(ypart + stp * 128 + r2 * 4);
                    const f32x4 a0 = pp[0], a1 = pp[1];
                    if (c * CH + stp > 0) { bf16* yo = Y + base + (size_t)(c * CH + stp - 1) * BW + 32 * half + r2;
                        *(unsigned*)yo = pk2((a0[0] + a0[1]) + (a0[2] + a0[3]), (a1[0] + a1[1]) + (a1[2] + a1[3])); }
                }
                if (more) SC_LSTORE((c + 1) & 1);
                __syncthreads();
            }
            {
                const bf16* pl_ = PROJ + ((size_t)b * SEQ + SEQ - 1) * PLD + (OFF_RWKV - PSH) + h * 64 + 4 * cg;
                const f32x4 rcl = bf4_to_f32(*(const v2u*)pl_), rpl = bf4_to_f32(*(const v2u*)(pl_ - PLD));
                const f32x4 rl4 = rcl + (rpl - rcl) * *(const f32x4*)(rwkv_mu + l * RWKV_COLS + h * 64 + 4 * cg);
                const float yl = row_allsum16((sa * rl4[0] + sb * rl4[1]) + (sc2 * rl4[2] + sd * rl4[3]));
                if (cg == 0) Y[base + (size_t)(SEQ - 1) * BW + irow] = (bf16)f2bf(yl);
            }
#undef SC_GLOAD
#undef SC_LSTORE
#undef SC_LD
#undef SC_STEP
        }
        if (!(mask_live & (1u << 29)))
        for (;;) {
            if (tid == 0) misc[4] = atomicAdd(ctl + CW_AQ + 64 * (l + 2 * li_), 1u);
            __syncthreads();
            const unsigned u = misc[4];
            __syncthreads();
            if (u >= 1024u) break;
            const int qt = 15 - (int)(u >> 6), kind = (u >> 5) & 1, b = (u >> 3) & 3, h = u & 7;
            const size_t r0 = (size_t)b * SEQ;
            if (kind == 0)
                attn_unit<128, true>((LAS unsigned char*)lds_raw, QAB + r0 * BW + h * 128, BW, KAB + r0 * BW + h * 128, BW, VAB + r0 * BW + h * 128, BW,
                                     YALL + r0 * (3 * BW) + h * 128, 3 * BW, SELB + r0 * 8 + h, qt, 0.08838834764831845f * 1.4426950408889634f, tid);
            else
                attn_unit<192, false>((LAS unsigned char*)lds_raw, QCB + r0 * 1536 + h * 192, 1536, KCB + r0 * 1536 + h * 192, 1536, VCB + r0 * BW + h * 128, BW,
                                      YALL + r0 * (3 * BW) + 2 * BW + h * 128, 3 * BW, nullptr, qt, 0.07216878364870323f * 1.4426950408889634f, tid);
        }
        {
            LAS float* scr = (LAS float*)((LAS unsigned char*)lds_raw) + wave * (64 * 33);
            const unsigned ncu = (unsigned)(FFN_CONV_N(l) / 32);
            DQ_RUN(xb_ld(ctl + CW_SD + 64 * (l + 2 * li_)) < 128u && xb_ld(ctl + CW_DQ + 64 * li_) < (unsigned)(l == 0 ? DQ_J3 : DQ_J6));
            for (;;) {
                if (tid == 0) {
                    unsigned u_ = 0xffffffffu;
                    if (xb_ld(ctl + CW_SD + 64 * (l + 2 * li_)) < 128u) u_ = atomicAdd(ctl + CW_CQ + 64 * (l + 2 * li_), 1u);
                    misc[4] = u_;
                }
                __syncthreads();
                const unsigned u = (unsigned)__builtin_amdgcn_readfirstlane((int)misc[4]);
                __syncthreads();
                if (u >= ncu) break;
#pragma unroll 1
                for (int k_ = 0; k_ < 2; ++k_) { const int it = (int)u * 32 + k_ * 16 + 2 * wave; FFN_CONV_PAIR(it); }
            }
            DQ_FLUSH(l == 0 ? DQ_J3 : DQ_J6);
        }
        GRID_BAR();
        {
            const int pc = l * BW + (gt & 255) * 4;
            const f32x4 p_g = *(const f32x4*)(rwkv_gn_g + pc), p_b = *(const f32x4*)(rwkv_gn_b + pc), p_ka = *(const f32x4*)(rwkv_k_a + pc), p_rk = *(const f32x4*)(rwkv_r_k + pc);
            const bf16* pY = Y; const bf16* pA = AA; const float* pV = Vcur; const bf16* pG = GG; bf16* pO = YALL + BW;
            const bf16* pP = PROJ + (OFF_RWKV - PSH) + (gt & 255) * 4;
            const f32x4 p_mr = *(const f32x4*)(rwkv_mu + l * RWKV_COLS + (gt & 255) * 4), p_mk = *(const f32x4*)(rwkv_mu + l * RWKV_COLS + 1024 + (gt & 255) * 4);
            for (int i0 = gt; i0 < T * 16 * 16; i0 += 4 * NGT) {
                f32x4 y[4], aa[4], vv[4], gg[4]; v2u rc[4], rp[4], kc[4], kp[4], yb[4], ab[4], gb[4];
#pragma unroll
                for (int u_ = 0; u_ < 4; ++u_) { const int i = i0 + u_ * NGT, ic = i < T * 256 ? i : gt; const size_t o = (size_t)(ic >> 8) * BW + (ic & 255) * 4;
                    const bf16* pp = pP + (size_t)(ic >> 8) * PLD; const int back = ((ic >> 8) & (SEQ - 1)) > 0 ? PLD : 0;
                    yb[u_] = *(const v2u*)(pY + o); ab[u_] = *(const v2u*)(pA + o); vv[u_] = *(const f32x4*)(pV + o); gb[u_] = *(const v2u*)(pG + o);
                    rc[u_] = *(const v2u*)pp; rp[u_] = *(const v2u*)(pp - back); kc[u_] = *(const v2u*)(pp + 1024); kp[u_] = *(const v2u*)(pp - back + 1024); }
#pragma unroll
                for (int u_ = 0; u_ < 4; ++u_) { const int i = i0 + u_ * NGT;
                    y[u_] = bf4_to_f32(yb[u_]); aa[u_] = bf4_to_f32(ab[u_]); gg[u_] = bf4_to_f32(gb[u_]);
                    f32x4 kr, rr;
                    { const bool first = (((i < T * 256 ? i : gt) >> 8) & (SEQ - 1)) == 0; const f32x4 z4 = {0.f, 0.f, 0.f, 0.f};
                      const f32x4 rcf = bf4_to_f32(rc[u_]), kcf = bf4_to_f32(kc[u_]), rpf = first ? z4 : bf4_to_f32(rp[u_]), kpf = first ? z4 : bf4_to_f32(kp[u_]);
                      rr = rcf + (rpf - rcf) * p_mr; kr = kcf + (kpf - kcf) * p_mk; }
                    const float mu = row_allsum16((y[u_][0] + y[u_][1]) + (y[u_][2] + y[u_][3])) * (1.0f / 64.0f);
                    const f32x4 d = y[u_] - mu;
                    const float var = row_allsum16((d[0] * d[0] + d[1] * d[1]) + (d[2] * d[2] + d[3] * d[3])) * (1.0f / 64.0f);
                    const f32x4 yn = d * rsqrtf(var + 64e-5f) * p_g + p_b;
                    const f32x4 k2 = kr * (1.0f + (aa[u_] - 1.0f) * p_ka);
                    const f32x4 rk = rr * k2 * p_rk;
                    const float bon = row_allsum16((rk[0] + rk[1]) + (rk[2] + rk[3]));
                    const f32x4 o4 = (yn + bon * vv[u_]) * gg[u_];
                    v2u ob; ob.x = pk2(o4[0], o4[1]); ob.y = pk2(o4[2], o4[3]);
                    if (i < T * 256) *(v2u*)(pO + (size_t)(i >> 8) * (3 * BW) + (i & 255) * 4) = ob;
                }
            }
        }
        GRID_BAR();
        }
        if (RUN(4)) {
        {
            SegOrder S; S.base.init(T, D, G_live, (int)blockIdx.x);
            pg8::Gemm g{YALL, WBO + (size_t)l * D * 3 * BW, T, D, BW + zero_live, 3 * BW}; EpiBranch3 E{MIXB, GATEB};
            pg8::gemm_phase<EpiBranch3, SegOrder, false>((LAS unsigned char*)lds_raw, g, S, E, nullptr, tid);
        }
        GRID_BAR();
        }
        if (RUN(5)) {
        {
            pg8::Gemm g{MIXB, WOT + (size_t)l * D * D, T, D, D / 2 + zero_live, D}; RotOrder S; S.base.init(T, D, G_live, (int)blockIdx.x); S.rot = ((int)blockIdx.x >> 3) & 1; S.segb = (D / 2) * 2;
            EpiResidF32R E{{PRE, X}};
            pg8::gemm_phase<EpiResidF32R, RotOrder, false>((LAS unsigned char*)lds_raw, g, S, E, nullptr, tid);
        }
        GRID_BAR();
        }
        if (RUN(6)) {
        {
            LAS float* scr = (LAS float*)((LAS unsigned char*)lds_raw) + wave * (64 * 33);
            const int ntot = FFN_CONV_N(l);
            const int ndone = (int)min(xb_ld(ctl + CW_CQ + 64 * (l + 2 * li_)), (unsigned)(ntot / 32)) * 32;
            for (int it = ndone + 2 * gw; it < ntot; it += 2 * NGW) FFN_CONV_PAIR(it);
            if (l == 1) DQ_FLUSH(DQ_J7);
        }
        for (int t = gw; t < T; t += NGW) {
            const float* pr = PRE + (size_t)t * D;
            f32x4 v[8]; float s = 0.f;
#pragma unroll
            for (int jj = 0; jj < 8; ++jj) { v[jj] = *(const f32x4*)(pr + jj * 256 + lane * 4); s += (v[jj][0] + v[jj][1]) + (v[jj][2] + v[jj][3]); }
            const float mean = wave_sum(s, lane) * (1.0f / D); float s2 = 0.f;
#pragma unroll
            for (int jj = 0; jj < 8; ++jj) { v[jj] = v[jj] - mean; s2 += (v[jj][0] * v[jj][0] + v[jj][1] * v[jj][1]) + (v[jj][2] * v[jj][2] + v[jj][3] * v[jj][3]); }
            const float rstd = rsqrtf(wave_sum(s2, lane) * (1.0f / D) + 1e-5f);
#pragma unroll
            for (int jj = 0; jj < 8; ++jj) {
                const f32x4 g = *(const f32x4*)(ln1_g + l * D + jj * 256 + lane * 4), bb = *(const f32x4*)(ln1_b + l * D + jj * 256 + lane * 4);
                v[jj] = v[jj] * rstd * g + bb;
                *(f32x4*)(X1 + (size_t)t * D + jj * 256 + lane * 4) = v[jj];
                v2u ob; ob.x = pk2(v[jj][0], v[jj][1]); ob.y = pk2(v[jj][2], v[jj][3]); *(v2u*)(X1B + (size_t)t * D + jj * 256 + lane * 4) = ob;
            }
            if (l == 1) {
                float lg[8];
#pragma unroll
                for (int e = 0; e < 8; ++e) lg[e] = 0.f;
#pragma unroll
                for (int jj = 0; jj < 8; ++jj)
#pragma unroll
                    for (int cc = 0; cc < 4; ++cc) {
                        const int d = jj * 256 + lane * 4 + cc;
                        const f32x4 r0 = *(const f32x4*)(moe_router + (size_t)d * 8), r1 = *(const f32x4*)(moe_router + (size_t)d * 8 + 4);
                        const float xv = v[jj][cc];
                        lg[0] += xv * r0[0]; lg[1] += xv * r0[1]; lg[2] += xv * r0[2]; lg[3] += xv * r0[3];
                        lg[4] += xv * r1[0]; lg[5] += xv * r1[1]; lg[6] += xv * r1[2]; lg[7] += xv * r1[3];
                    }
#pragma unroll
                for (int e = 0; e < 8; ++e) lg[e] = wave_sum(lg[e], lane);
                if (lane == 0) {
                    int e0 = 0; float b0 = lg[0];
#pragma unroll
                    for (int e = 1; e < 8; ++e) if (lg[e] > b0) { b0 = lg[e]; e0 = e; }
                    int e1 = -1; float b1 = -INFINITY;
#pragma unroll
                    for (int e = 0; e < 8; ++e) if (e != e0 && lg[e] > b1) { b1 = lg[e]; e1 = e; }
                    const float w1 = 1.0f / (1.0f + expf(b0 - b1)), w0 = 1.0f - w1;
                    const int p0 = (int)atomicAdd(ctl + CW_CNT + 64 * e0, 1u), p1 = (int)atomicAdd(ctl + CW_CNT + 64 * e1, 1u);
                    int* tk = TOK + (size_t)t * 8;
                    tk[0] = e0; tk[1] = e1; tk[2] = p0; tk[3] = p1; tk[4] = __float_as_int(w0); tk[5] = __float_as_int(w1);
                }
            }
        }
        GRID_BAR();
        }
        float* OUTX = (l == 0) ? XB : (float*)(*(GAS float* const*)&args.out);
        if (l == 0) {
            if (RUN(7)) {
                pg8::Gemm g{X1B, WGU, T, NGU, D}; pg8::StaticOrder S; S.init(T, NGU, G_live, (int)blockIdx.x);
                EpiSwigluBf16 E{HGB, NGU / 256};
                pg8::gemm_phase<EpiSwigluBf16, pg8::StaticOrder, false>((LAS unsigned char*)lds_raw, g, S, E, nullptr, tid);
                REOPAQUE();
                {
                    LAS float* scr = (LAS float*)((LAS unsigned char*)lds_raw) + wave * (64 * 33);
                    PHASE_DONE(1);
                    DQ_FILL(1, 129);
                }
                GRID_BAR();
            }
            if (RUN(8)) {
                pg8::Gemm g{HGB, WDD, T, D, DFF / 2 + zero_live, DFF}; RotOrder S; S.base.init(T, D, G_live, (int)blockIdx.x); S.rot = ((int)blockIdx.x >> 3) & 1; S.segb = (DFF / 2) * 2;
                EpiResidF32R E{{PRE, X1}};
                pg8::gemm_phase<EpiResidF32R, RotOrder, false>((LAS unsigned char*)lds_raw, g, S, E, nullptr, tid);
                GRID_BAR();
            }
        } else {
            if (RUN(10)) {
            unsigned poff[9]; poff[0] = 0;
#pragma unroll
            for (int e = 0; e < 8; ++e) poff[e + 1] = poff[e] + ((xb_ld(ctl + CW_CNT + 64 * e) + 255u) & ~255u);
            for (int t = gw; t < T; t += NGW) {
                int* tk = TOK + (size_t)t * 8;
                const int e0 = tk[0], e1 = tk[1];
                unsigned o0 = 0, o1 = 0;
#pragma unroll
                for (int e = 0; e < 8; ++e) { o0 = (e == e0) ? poff[e] : o0; o1 = (e == e1) ? poff[e] : o1; }
                const int s0 = (int)o0 + tk[2], s1 = (int)o1 + tk[3];
                if (lane == 0) { tk[6] = s0; tk[7] = s1; }
#pragma unroll
                for (int j = 0; j < 4; ++j) { const v4u xv = *(const v4u*)(X1B + (size_t)t * D + j * 512 + lane * 8);
                    *(v4u*)(XG + (size_t)s0 * D + j * 512 + lane * 8) = xv; *(v4u*)(XG + (size_t)s1 * D + j * 512 + lane * 8) = xv; }
            }
            if (blockIdx.x == 0 && tid < 80) {
                unsigned e_of = 0; const unsigned mt = tid;
#pragma unroll
                for (int e = 1; e < 8; ++e) e_of += (mt * 256u >= poff[e]) ? 1u : 0u;
                ctl[CW_TILE + tid] = e_of;
                if (tid == 0) ctl[CW_TILE - 1] = poff[8] / 256u;
            }
            {
                const unsigned nmt_ = poff[8] / 256u, nfull_ = (nmt_ / 32u) * 32u; const size_t z0 = (size_t)nfull_ * 256 * D / 4, z1 = (size_t)nmt_ * 256 * D / 4;
                for (size_t i = z0 + gt; i < z1; i += NGT) *(f32x4*)(OUT + i * 4) = (f32x4){0.f, 0.f, 0.f, 0.f};
            }
            GRID_BAR();
            }
            const int nMt = (int)ctl[CW_TILE - 1];
            if (RUN(7)) {
                pg8::Gemm g{XG, WGU, MOE_ROWS, NGU, D}; MoeOrder S{ctl + CW_TILE, nMt, NGU / 256, G_live, (int)blockIdx.x};
                EpiSwigluBf16 E{HGB, NGU / 256};
                pg8::gemm_phase<EpiSwigluBf16, MoeOrder, false>((LAS unsigned char*)lds_raw, g, S, E, nullptr, tid);
                REOPAQUE();
                {
                    LAS float* scr = (LAS float*)((LAS unsigned char*)lds_raw) + wave * (64 * 33);
                    const int rem_ = ((int)ctl[CW_TILE - 1] * (NGU / 256)) % G_live;
                    PHASE_DONE(5);
                    DQ_FILL(5, (rem_ ? G_live - rem_ : 0) + 1);
                    DQ_FLUSH(DQ_N);
                }
                GRID_BAR();
            }
            if (RUN(8)) {
                const int nFull = (nMt / 32) * 32;
                { pg8::Gemm g{HGB, WD, MOE_ROWS, D, DFF}; MoeOrder S{ctl + CW_TILE, nFull, D / 256, G_live, (int)blockIdx.x};
                  EpiStoreF32 E{OUT, D / 256};
                  pg8::gemm_phase<EpiStoreF32, MoeOrder, false>((LAS unsigned char*)lds_raw, g, S, E, nullptr, tid); }
                REOPAQUE();
                { pg8::Gemm g{HGB, WD, MOE_ROWS, D, DFF / 4 + zero_live, DFF}; MoeOrder S{ctl + CW_TILE, nMt - nFull, D / 256, G_live, (int)blockIdx.x, nFull, 4, (DFF / 4) * 2};
                  EpiAtomicF32 E{OUT, D / 256};
                  pg8::gemm_phase<EpiAtomicF32, MoeOrder, false>((LAS unsigned char*)lds_raw, g, S, E, nullptr, tid); }
                GRID_BAR();
            }
        }
        if (RUN(9)) {
        if (l == 0) { LAS float* scr = (LAS float*)((LAS unsigned char*)lds_raw) + wave * (64 * 33); DQ_FLUSH(DQ_J4); }
        for (int t = gw; t < T; t += NGW) {
            f32x4 v[8]; float s = 0.f;
            if (l == 0) {
#pragma unroll
                for (int jj = 0; jj < 8; ++jj) v[jj] = *(const f32x4*)(PRE + (size_t)t * D + jj * 256 + lane * 4);
            } else {
                const int* tk = TOK + (size_t)t * 8;
                const float w0 = __int_as_float(tk[4]), w1 = __int_as_float(tk[5]); const int s0 = tk[6], s1 = tk[7];
                const int e0 = tk[0], e1 = tk[1];
#pragma unroll
                for (int jj = 0; jj < 8; ++jj) {
                    const f32x4 xx = *(const f32x4*)(X1 + (size_t)t * D + jj * 256 + lane * 4);
                    const f32x4 a = *(const f32x4*)(OUT + (size_t)s0 * D + jj * 256 + lane * 4), bq = *(const f32x4*)(OUT + (size_t)s1 * D + jj * 256 + lane * 4);
                    const f32x4 f = (e0 < e1) ? (w0 * a + w1 * bq) : (w1 * bq + w0 * a);
                    v[jj] = ALPHA * xx + f;
                }
            }
#pragma unroll
            for (int jj = 0; jj < 8; ++jj) s += (v[jj][0] + v[jj][1]) + (v[jj][2] + v[jj][3]);
            const float mean = wave_sum(s, lane) * (1.0f / D); float s2 = 0.f;
#pragma unroll
            for (int jj = 0; jj < 8; ++jj) { v[jj] = v[jj] - mean; s2 += (v[jj][0] * v[jj][0] + v[jj][1] * v[jj][1]) + (v[jj][2] * v[jj][2] + v[jj][3] * v[jj][3]); }
            const float rstd = rsqrtf(wave_sum(s2, lane) * (1.0f / D) + 1e-5f);
#pragma unroll
            for (int jj = 0; jj < 8; ++jj) {
                const f32x4 g = *(const f32x4*)(ln2_g + l * D + jj * 256 + lane * 4), bb = *(const f32x4*)(ln2_b + l * D + jj * 256 + lane * 4);
                const f32x4 o = v[jj] * rstd * g + bb;
                *(f32x4*)(OUTX + (size_t)t * D + jj * 256 + lane * 4) = o;
                if (l == 0) { v2u ob; ob.x = pk2(o[0], o[1]); ob.y = pk2(o[2], o[3]); *(v2u*)(XBF + (size_t)t * D + jj * 256 + lane * 4) = ob; }
            }
        }
        GRID_BAR();
        }
    }
}

extern "C" void kernel_launch(void* const* d_in, const int* in_sizes, int n_in, void* d_out, int out_size, void* d_ws, size_t ws_size, hipStream_t stream) {
    static int grid = 0;
    if (grid == 0) {
        if (n_in != 34 || out_size != T * D || ws_size < WS_END) { fprintf(stderr, "kernel_launch: bad sizes n_in %d out %d ws %zu need %zu\n", n_in, out_size, ws_size, (size_t)WS_END); grid = -1; return; }
        int dev = 0, cus = 0, per_cu = 0;
        if (hipGetDevice(&dev) != hipSuccess || hipDeviceGetAttribute(&cus, hipDeviceAttributeMultiprocessorCount, dev) != hipSuccess) { grid = -1; return; }
        if (hipFuncSetAttribute((const void*)fwd_kernel, hipFuncAttributeMaxDynamicSharedMemorySize, LDS_BYTES) != hipSuccess) { fprintf(stderr, "hipFuncSetAttribute failed\n"); grid = -1; return; }
        if (hipOccupancyMaxActiveBlocksPerMultiprocessor(&per_cu, (const void*)fwd_kernel, NTHREADS, LDS_BYTES) != hipSuccess || per_cu < 1) fprintf(stderr, "occupancy query says %d\n", per_cu);
        (void)hipGetLastError();
        grid = cus;
    }
    if (grid < 0) return;
    hipMemsetAsync((char*)d_ws + WS_CTL, 0, CTL_BYTES, stream);
    Args a{};
    for (int i = 0; i < 34; ++i) a.in[i] = (const float*)d_in[i];
    a.out = (float*)d_out; a.ws = (unsigned char*)d_ws; a.mask = 0x9FFFFFFFu; a.li = 0;
    hipLaunchKernelGGL(fwd_kernel, dim3(grid), dim3(NTHREADS), LDS_BYTES, stream, a);
#ifdef PROBE_MASK
    a.mask = PROBE_MASK; a.li = 1;
    hipLaunchKernelGGL(fwd_kernel, dim3(grid), dim3(NTHREADS), LDS_BYTES, stream, a);
#endif
}
```
